# Optimizing an MI355X kernel written in HIP

```python
import jax, jax.numpy as jnp
from jax import lax
import numpy as np

D_MODEL = 1024
BATCH = 8
SEQ = 2048
DEPTH = 1
DEC_BATCH = 128
DEC_SEQ = 8
PAST_LEN = 16384
PAGE_SIZE = 128

MIX_WIDTH = D_MODEL
RET_HEADS = 8
RET_DK = 64
RET_DV = MIX_WIDTH // 2 // RET_HEADS
RWKV_HEADS = 8
RWKV_N = MIX_WIDTH // 2 // RWKV_HEADS
RET_W = RET_HEADS * RET_DV
RWKV_W = RWKV_HEADS * RWKV_N
DECAY_LORA = 64
AAA_LORA = 64
GATE_LORA = 128
RET_PROJ = 2 * RET_HEADS * RET_DK + 2 * RET_W
RWKV_PROJ = 3 * RWKV_W + DECAY_LORA + AAA_LORA + GATE_LORA
IN_PROJ = RET_PROJ + RWKV_PROJ
RET_CHUNK = 128
ROPE_BASE = 10000.0
PEER_HEADS = 8
PEER_NKEYS = 128
PEER_EXPERTS = PEER_NKEYS * PEER_NKEYS
PEER_DKEY = 256
PEER_TOPK = 16
PEER_BLOCK = 256
PLE_DIM = 256
RMS_EPS = 1e-6
GN_EPS = 1e-5
RWKV_LN_EPS = 64e-5

kernel_name = 'hymba_retnet_rwkv7_peer_step'


def rmsnorm(x, g):
    xf = x.astype(jnp.float32)
    y = xf * lax.rsqrt(jnp.mean(xf * xf, axis=-1, keepdims=True) + RMS_EPS)
    return (y * g.astype(jnp.float32)).astype(x.dtype)


def head_norm(x, eps):
    xf = x.astype(jnp.float32)
    xc = xf - jnp.mean(xf, axis=-1, keepdims=True)
    return xc * lax.rsqrt(jnp.mean(xc * xc, axis=-1, keepdims=True) + eps)


def rope(x, pos):
    d = x.shape[-1]
    half = d // 2
    inv = ROPE_BASE ** (-jnp.arange(half, dtype=jnp.float32) / half)
    ang = pos.astype(jnp.float32)[:, None] * inv[None, :]
    cos = jnp.cos(ang)[None, :, None, :]
    sin = jnp.sin(ang)[None, :, None, :]
    xf = x.astype(jnp.float32)
    x1, x2 = xf[..., :half], xf[..., half:]
    return jnp.concatenate([x1 * cos - x2 * sin, x2 * cos + x1 * sin], axis=-1)


def retention_chunkwise(q, k, v, s0):
    B, L, H, DK = q.shape
    DV = v.shape[-1]
    C = RET_CHUNK if L % RET_CHUNK == 0 else L
    n = L // C
    lg = jnp.log(1.0 - 2.0 ** (-5.0 - jnp.arange(H, dtype=jnp.float32)))
    idx = jnp.arange(C, dtype=jnp.float32)
    diff = idx[:, None] - idx[None, :]
    dmat = jnp.where(diff[None] >= 0, jnp.exp(jnp.maximum(diff, 0.0)[None] * lg[:, None, None]), 0.0)
    xi = jnp.exp((idx + 1.0)[None, :] * lg[:, None])
    zeta = jnp.exp((C - 1.0 - idx)[None, :] * lg[:, None])
    g_chunk = jnp.exp(C * lg)

    def to_chunks(t):
        return t.astype(jnp.float32).reshape(B, n, C, H, t.shape[-1]).transpose(1, 0, 3, 2, 4)

    def step(S, xs):
        qc, kc, vc = xs
        inner = jnp.einsum('bhid,bhjd->bhij', qc, kc) * dmat
        o = jnp.einsum('bhij,bhjv->bhiv', inner, vc) + jnp.einsum('bhid,bhdv->bhiv', qc, S) * xi[:, :, None]
        S = S * g_chunk[:, None, None] + jnp.einsum('bhjd,bhjv->bhdv', kc * zeta[:, :, None], vc)
        return S, o

    S, o = lax.scan(step, s0.astype(jnp.float32), (to_chunks(q), to_chunks(k), to_chunks(v)))
    o = o.transpose(1, 0, 3, 2, 4).reshape(B, L, H, DV)
    return S, o


def rwkv7_scan(r, log_w, k, kk, a, v, s0):
    def tm(t):
        return t.astype(jnp.float32).transpose(1, 0, 2, 3)

    def step(S, xs):
        rt, lwt, kt, kkt, at, vt = xs
        sa = jnp.einsum('bhij,bhj->bhi', S, -kkt)
        S = (S * jnp.exp(lwt)[:, :, None, :] + sa[..., None] * (kkt * at)[:, :, None, :]
             + vt[..., None] * kt[:, :, None, :])
        y = jnp.einsum('bhij,bhj->bhi', S, rt)
        return S, y

    S, y = lax.scan(step, s0.astype(jnp.float32), (tm(r), tm(log_w), tm(k), tm(kk), tm(a), tm(v)))
    return S, y.transpose(1, 0, 2, 3)


def token_mixers(xn, pos, s_ret, s_wkv, s_shift, w_in, rw_mu, rw_w0, rw_w2, rw_a0, rw_a2, rw_g2,
                 rw_kk, rw_ka, rw_rk, rw_ln_g, rw_ln_b, w_out):
    B, L, _ = xn.shape
    proj = xn @ w_in
    ret_p, rw_p = proj[..., :RET_PROJ], proj[..., RET_PROJ:]
    qk = RET_HEADS * RET_DK
    q = rope(ret_p[..., :qk].reshape(B, L, RET_HEADS, RET_DK), pos)
    k = rope(ret_p[..., qk:2 * qk].reshape(B, L, RET_HEADS, RET_DK), pos) * (RET_DK ** -0.5)
    v = ret_p[..., 2 * qk:2 * qk + RET_W].reshape(B, L, RET_HEADS, RET_DV)
    g_ret = ret_p[..., 2 * qk + RET_W:]
    s_ret_new, o_ret = retention_chunkwise(q, k, v, s_ret)
    o_ret = (head_norm(o_ret, GN_EPS).reshape(B, L, RET_W) * jax.nn.silu(g_ret.astype(jnp.float32))).astype(xn.dtype)
    prev = jnp.concatenate([s_shift[:, None, :].astype(rw_p.dtype), rw_p[:, :-1]], axis=1)
    f = rw_p + (prev - rw_p) * rw_mu
    new_shift = rw_p[:, -1]
    o1, o2, o3 = RWKV_W, 2 * RWKV_W, 3 * RWKV_W
    r = f[..., :o1]
    k7 = f[..., o1:o2]
    v7 = f[..., o2:o3]
    fw = f[..., o3:o3 + DECAY_LORA].astype(jnp.float32)
    fa = f[..., o3 + DECAY_LORA:o3 + DECAY_LORA + AAA_LORA].astype(jnp.float32)
    fg = f[..., o3 + DECAY_LORA + AAA_LORA:].astype(jnp.float32)
    w = -jax.nn.softplus(-(rw_w0 + jnp.tanh(fw) @ rw_w2)) - 0.5
    log_w = -jnp.exp(w)
    a = jax.nn.sigmoid(rw_a0 + fa @ rw_a2)
    gate = jax.nn.sigmoid(fg) @ rw_g2
    kk = (k7 * rw_kk).astype(jnp.float32).reshape(B, L, RWKV_HEADS, RWKV_N)
    kk = kk / jnp.maximum(jnp.sqrt(jnp.sum(kk * kk, axis=-1, keepdims=True)), 1e-12)
    k7 = k7.astype(jnp.float32) * (1.0 + (a - 1.0) * rw_ka)
    hs = (B, L, RWKV_HEADS, RWKV_N)
    r4, k4, v4, a4 = r.astype(jnp.float32).reshape(hs), k7.reshape(hs), v7.astype(jnp.float32).reshape(hs), a.reshape(hs)
    s_wkv_new, o_rw = rwkv7_scan(r4, log_w.reshape(hs), k4, kk, a4, v4, s_wkv)
    o_rw = head_norm(o_rw, RWKV_LN_EPS) * rw_ln_g.reshape(RWKV_HEADS, RWKV_N) + rw_ln_b.reshape(RWKV_HEADS, RWKV_N)
    o_rw = o_rw + jnp.sum(r4 * k4 * rw_rk, axis=-1, keepdims=True) * v4
    o_rw = (o_rw.reshape(B, L, RWKV_W) * gate).astype(xn.dtype)
    out = jnp.concatenate([o_ret, o_rw], axis=-1) @ w_out
    return out, s_ret_new, s_wkv_new, new_shift


def peer(xn, wq, keys, u_tab, v_tab):
    B, L, D = xn.shape
    T = B * L
    nb = -(-T // PEER_BLOCK)
    xt = jnp.pad(xn.reshape(T, D), ((0, nb * PEER_BLOCK - T), (0, 0))).reshape(nb, PEER_BLOCK, D)

    def block(xb):
        q = (xb @ wq).reshape(PEER_BLOCK, PEER_HEADS, 2, PEER_DKEY // 2)
        s = jnp.einsum('phcd,hcnd->phcn', q, keys).astype(jnp.float32)
        sv, si = lax.top_k(s, PEER_TOPK)
        cand = sv[:, :, 0, :, None] + sv[:, :, 1, None, :]
        cv, ci = lax.top_k(cand.reshape(PEER_BLOCK, PEER_HEADS, PEER_TOPK * PEER_TOPK), PEER_TOPK)
        e = (jnp.take_along_axis(si[:, :, 0], ci // PEER_TOPK, axis=-1) * PEER_NKEYS
             + jnp.take_along_axis(si[:, :, 1], ci % PEER_TOPK, axis=-1))
        gsm = jax.nn.softmax(cv, axis=-1)
        hval = jnp.einsum('pd,phkd->phk', xb, u_tab[e])
        act = (jax.nn.gelu(hval.astype(jnp.float32), approximate=False) * gsm).astype(xb.dtype)
        return jnp.einsum('phk,phkd->pd', act, v_tab[e])

    y = lax.map(block, xt).reshape(nb * PEER_BLOCK, D)[:T]
    return y.reshape(B, L, D)


def layer(h, p_l, pos, s_ret, s_wkv, s_shift, lp):
    (norm_mix, w_in, rw_mu, rw_w0, rw_w2, rw_a0, rw_a2, rw_g2, rw_kk, rw_ka, rw_rk, rw_ln_g, rw_ln_b,
     w_out, norm_ffn, peer_wq, peer_keys, peer_u, peer_v, ple_norm, ple_gate, ple_proj) = lp
    xn = rmsnorm(h, norm_mix)
    mix, s_ret_new, s_wkv_new, new_shift = token_mixers(
        xn, pos, s_ret, s_wkv, s_shift, w_in, rw_mu, rw_w0, rw_w2, rw_a0, rw_a2, rw_g2,
        rw_kk, rw_ka, rw_rk, rw_ln_g, rw_ln_b, w_out)
    h = h + mix
    h = h + peer(rmsnorm(h, norm_ffn), peer_wq, peer_keys, peer_u, peer_v)
    gate = jax.nn.sigmoid((rmsnorm(h, ple_norm) @ ple_gate).astype(jnp.float32))
    h = h + (gate * (p_l @ ple_proj)).astype(h.dtype)
    return h, s_ret_new, s_wkv_new, new_shift


def setup_inputs(seed: int = 0) -> dict:
    key = jax.random.key(seed)
    ks = jax.random.split(key, 40)
    f32 = jnp.float32

    def nrm(k, shape, scale):
        return jax.random.normal(k, shape, f32) * scale

    return {
        'x_prompt': nrm(ks[0], (BATCH, SEQ, D_MODEL), 1.0),
        'x_sample': nrm(ks[1], (DEC_BATCH, DEC_SEQ, D_MODEL), 1.0),
        'state_ret': nrm(ks[2], (DEPTH, DEC_BATCH, RET_HEADS, RET_DK, RET_DV), 0.5),
        'state_wkv': nrm(ks[3], (DEPTH, DEC_BATCH, RWKV_HEADS, RWKV_N, RWKV_N), 0.5),
        'state_shift': nrm(ks[4], (DEPTH, DEC_BATCH, RWKV_PROJ), 1.0),
        'p_prompt': nrm(ks[5], (DEPTH, BATCH, SEQ, PLE_DIM), 1.0),
        'p_sample': nrm(ks[6], (DEPTH, DEC_BATCH, DEC_SEQ, PLE_DIM), 1.0),
        'norm_mix': 1.0 + nrm(ks[7], (DEPTH, D_MODEL), 0.05),
        'w_in': nrm(ks[8], (DEPTH, D_MODEL, IN_PROJ), D_MODEL ** -0.5),
        'rw_mu': jax.random.uniform(ks[9], (DEPTH, RWKV_PROJ), f32, 0.0, 1.0),
        'rw_w0': jax.random.uniform(ks[10], (DEPTH, RWKV_W), f32, -5.0, 0.0),
        'rw_w2': nrm(ks[11], (DEPTH, DECAY_LORA, RWKV_W), 0.1),
        'rw_a0': nrm(ks[12], (DEPTH, RWKV_W), 0.5),
        'rw_a2': nrm(ks[13], (DEPTH, AAA_LORA, RWKV_W), 0.5 * AAA_LORA ** -0.5),
        'rw_g2': nrm(ks[14], (DEPTH, GATE_LORA, RWKV_W), GATE_LORA ** -0.5),
        'rw_kk': 0.85 + nrm(ks[15], (DEPTH, RWKV_W), 0.05),
        'rw_ka': 1.0 + nrm(ks[16], (DEPTH, RWKV_W), 0.05),
        'rw_rk': nrm(ks[17], (DEPTH, RWKV_HEADS, RWKV_N), 0.1),
        'rw_ln_g': 1.0 + nrm(ks[18], (DEPTH, RWKV_W), 0.05),
        'rw_ln_b': nrm(ks[19], (DEPTH, RWKV_W), 0.01),
        'w_out': nrm(ks[20], (DEPTH, MIX_WIDTH, D_MODEL), MIX_WIDTH ** -0.5),
        'norm_ffn': 1.0 + nrm(ks[21], (DEPTH, D_MODEL), 0.05),
        'peer_wq': nrm(ks[22], (DEPTH, D_MODEL, PEER_HEADS * PEER_DKEY), D_MODEL ** -0.5),
        'peer_keys': nrm(ks[23], (DEPTH, PEER_HEADS, 2, PEER_NKEYS, PEER_DKEY // 2), (PEER_DKEY // 2) ** -0.5),
        'peer_u': nrm(ks[24], (DEPTH, PEER_EXPERTS, D_MODEL), D_MODEL ** -0.5),
        'peer_v': nrm(ks[25], (DEPTH, PEER_EXPERTS, D_MODEL), 0.5 * PEER_HEADS ** -0.5),
        'ple_norm': 1.0 + nrm(ks[26], (DEPTH, D_MODEL), 0.05),
        'ple_gate': nrm(ks[27], (DEPTH, D_MODEL, D_MODEL), D_MODEL ** -0.5),
        'ple_proj': nrm(ks[28], (DEPTH, PLE_DIM, D_MODEL), PLE_DIM ** -0.5),
        'norm_final': 1.0 + nrm(ks[29], (D_MODEL,), 0.05),
    }


def reference(x_prompt, x_sample, state_ret, state_wkv, state_shift, p_prompt, p_sample,
              norm_mix, w_in, rw_mu, rw_w0, rw_w2, rw_a0, rw_a2, rw_g2, rw_kk, rw_ka, rw_rk,
              rw_ln_g, rw_ln_b, w_out, norm_ffn, peer_wq, peer_keys, peer_u, peer_v,
              ple_norm, ple_gate, ple_proj, norm_final):
    pos_p = jnp.arange(SEQ, dtype=jnp.int32)
    pos_s = PAST_LEN + jnp.arange(DEC_SEQ, dtype=jnp.int32)
    zero_ret = jnp.zeros((BATCH, RET_HEADS, RET_DK, RET_DV), jnp.float32)
    zero_wkv = jnp.zeros((BATCH, RWKV_HEADS, RWKV_N, RWKV_N), jnp.float32)
    zero_shift = jnp.zeros((BATCH, RWKV_PROJ), x_prompt.dtype)
    hp, hs = x_prompt, x_sample
    rp_l, wp_l, sp_l, rs_l, ws_l, ss_l = [], [], [], [], [], []
    for i in range(DEPTH):
        lp = (norm_mix[i], w_in[i], rw_mu[i], rw_w0[i], rw_w2[i], rw_a0[i], rw_a2[i], rw_g2[i],
              rw_kk[i], rw_ka[i], rw_rk[i], rw_ln_g[i], rw_ln_b[i], w_out[i], norm_ffn[i],
              peer_wq[i], peer_keys[i], peer_u[i], peer_v[i], ple_norm[i], ple_gate[i], ple_proj[i])
        hp, rp, wp, sp = layer(hp, p_prompt[i], pos_p, zero_ret, zero_wkv, zero_shift, lp)
        hs, rs, ws, ss = layer(hs, p_sample[i], pos_s, state_ret[i], state_wkv[i], state_shift[i], lp)
        rp_l.append(rp); wp_l.append(wp); sp_l.append(sp)
        rs_l.append(rs); ws_l.append(ws); ss_l.append(ss)
    y_prompt = rmsnorm(hp, norm_final)
    y_sample = rmsnorm(hs, norm_final)
    ret_prompt = jnp.stack(rp_l)
    wkv_prompt = jnp.stack(wp_l)
    shift_prompt = jnp.stack(sp_l)
    ret_sample = jnp.stack(rs_l)
    wkv_sample = jnp.stack(ws_l)
    shift_sample = jnp.stack(ss_l)
    return (y_prompt, y_sample, ret_prompt, wkv_prompt, shift_prompt, ret_sample, wkv_sample, shift_sample)
```

```cpp
#include <hip/hip_runtime.h>
#include <hip/hip_cooperative_groups.h>
#include <cstdio>
namespace cg = cooperative_groups;

#ifndef MK_MULTI
#define MK_MULTI 0
#endif

typedef unsigned short bf16_t;
typedef __attribute__((ext_vector_type(8))) short bf16x8;
typedef __attribute__((ext_vector_type(16))) float f32x16;
typedef __attribute__((ext_vector_type(2))) __bf16 bf2_t;
typedef __attribute__((ext_vector_type(2))) float f2_t;
#define DI __device__ __forceinline__

constexpr int T = 17408, TP = 16384;
constexpr int NPH = 14;

constexpr size_t O_RETP = (size_t)T * 1024;
constexpr size_t O_WKVP = O_RETP + 262144;
constexpr size_t O_SHP = O_WKVP + 262144;
constexpr size_t O_RETS = O_SHP + 14336;
constexpr size_t O_WKVS = O_RETS + 4194304;
constexpr size_t O_SHS = O_WKVS + 4194304;

constexpr size_t OFF_WIN = 0;
constexpr size_t OFF_WOUT = OFF_WIN + (size_t)3840 * 1024 * 2;
constexpr size_t OFF_WQ = OFF_WOUT + (size_t)1024 * 1024 * 2;
constexpr size_t OFF_KEYS = OFF_WQ + (size_t)2048 * 1024 * 2;
constexpr size_t OFF_PG = OFF_KEYS + (size_t)16 * 128 * 128 * 2;
constexpr size_t OFF_PP = OFF_PG + (size_t)1024 * 1024 * 2;
constexpr size_t OFF_W2 = OFF_PP + (size_t)1024 * 256 * 2;
constexpr size_t OFF_A2 = OFF_W2 + (size_t)512 * 64 * 2;
constexpr size_t OFF_G2 = OFF_A2 + (size_t)512 * 64 * 2;
constexpr size_t OFF_ROPE = OFF_G2 + (size_t)512 * 128 * 2;
constexpr size_t OFF_CTR = OFF_ROPE + (size_t)2056 * 32 * 2 * 4;
constexpr size_t OFF_ACT = OFF_CTR + 32768;
constexpr size_t OFF_TAB = OFF_ACT + (size_t)T * 1024 * 2;
constexpr size_t OFF_PREP = OFF_TAB + (size_t)2 * 16384 * 1024 * 2;
constexpr size_t SZ512 = (size_t)T * 512 * 2;
constexpr size_t OFF_R = OFF_PREP;
constexpr size_t OFF_K = OFF_R + SZ512;
constexpr size_t OFF_V = OFF_K + SZ512;
constexpr size_t OFF_KK = OFF_V + SZ512;
constexpr size_t OFF_BB = OFF_KK + SZ512;
constexpr size_t OFF_GATE = OFF_BB + SZ512;
constexpr size_t OFF_EW = OFF_GATE + SZ512;
constexpr size_t OFF_LORA = OFF_EW + (size_t)T * 512 * 4;
constexpr size_t OFF_INVN = OFF_LORA + (size_t)T * 256 * 2;
constexpr size_t WS_END = OFF_INVN + (size_t)T * 8 * 4;
constexpr size_t OFF_QPEER = OFF_PREP;
constexpr size_t OFF_IDX = OFF_QPEER + (size_t)T * 2048 * 2;
constexpr size_t OFF_GSM = OFF_IDX + (size_t)T * 128 * 4;

constexpr int SMEM_BYTES = 79872;

struct Params {
  const float* in[30];
  float* out;
  char* ws;
};

typedef const __attribute__((address_space(4))) Params* KP;
__device__ __forceinline__ KP getp() {
  KP q = (KP)__builtin_amdgcn_kernarg_segment_ptr();
  asm volatile("" : "+s"(q));
  return q;
}
DI int tidx() { int t = threadIdx.x; asm volatile("" : "+v"(t)); return t; }
DI bf16_t f2bf(float x) { unsigned u = __float_as_uint(x); u += 0x7fffu + ((u >> 16) & 1u); return (bf16_t)(u >> 16); }
DI float bf2f(bf16_t b) { return __uint_as_float(((unsigned)b) << 16); }
DI unsigned pack2(float a, float b) { return (unsigned)f2bf(a) | ((unsigned)f2bf(b) << 16); }
DI float lo2f(unsigned u) { return __uint_as_float(u << 16); }
DI float hi2f(unsigned u) { return __uint_as_float(u & 0xffff0000u); }
DI int crow(int reg, int h) { return (reg & 3) + 8 * (reg >> 2) + 4 * h; }
DI float wave_sum(float v) {
#pragma unroll
  for (int o = 32; o >= 1; o >>= 1) v += __shfl_xor(v, o);
  return v;
}
DI float allreduce16(float v) {
  v += __int_as_float(__builtin_amdgcn_update_dpp(0, __float_as_int(v), 0x128, 0xf, 0xf, false));
  v += __int_as_float(__builtin_amdgcn_update_dpp(0, __float_as_int(v), 0x124, 0xf, 0xf, false));
  v += __int_as_float(__builtin_amdgcn_update_dpp(0, __float_as_int(v), 0x122, 0xf, 0xf, false));
  v += __int_as_float(__builtin_amdgcn_update_dpp(0, __float_as_int(v), 0x121, 0xf, 0xf, false));
  return v;
}
#define DPP_ADD(v, ctrl) v += __int_as_float(__builtin_amdgcn_update_dpp(0, __float_as_int(v), ctrl, 0xf, 0xf, false))
DI void allreduce16x2(float& a, float& b) {
  DPP_ADD(a, 0x128); DPP_ADD(b, 0x128);
  DPP_ADD(a, 0x124); DPP_ADD(b, 0x124);
  DPP_ADD(a, 0x122); DPP_ADD(b, 0x122);
  DPP_ADD(a, 0x121); DPP_ADD(b, 0x121);
}
DI float allreduce8(float v) {
  v += __int_as_float(__builtin_amdgcn_update_dpp(0, __float_as_int(v), 0xB1, 0xf, 0xf, false));
  v += __int_as_float(__builtin_amdgcn_update_dpp(0, __float_as_int(v), 0x4E, 0xf, 0xf, false));
  v += __int_as_float(__builtin_amdgcn_update_dpp(0, __float_as_int(v), 0x141, 0xf, 0xf, false));
  return v;
}
DI void unpack8f(const uint4& u, float (&f)[8]) {
  f[0] = lo2f(u.x); f[1] = hi2f(u.x); f[2] = lo2f(u.y); f[3] = hi2f(u.y);
  f[4] = lo2f(u.z); f[5] = hi2f(u.z); f[6] = lo2f(u.w); f[7] = hi2f(u.w);
}
DI uint4 pack8f(const float (&f)[8]) {
  return make_uint4(pack2(f[0], f[1]), pack2(f[2], f[3]), pack2(f[4], f[5]), pack2(f[6], f[7]));
}
DI float sigmoidf_(float x) { return 1.f / (1.f + __expf(-x)); }
DI const float* xrow(KP p, int t) {
  return t < TP ? p->in[0] + (size_t)t * 1024 : p->in[1] + (size_t)(t - TP) * 1024;
}
struct TokInfo { int sample, b, l; };
DI TokInfo tokinfo(int t) {
  TokInfo ti;
  if (t >= TP) { ti.sample = 1; ti.b = (t - TP) >> 3; ti.l = (t - TP) & 7; }
  else { ti.sample = 0; ti.b = t >> 11; ti.l = t & 2047; }
  return ti;
}

#define XB_TMO      128
#define XB_XCNT(j)  (256  + 64 * (j))
#define XB_XSUB(j)  (1280 + 64 * (j))
#define XB_XGEN(j)  (2304 + 64 * (j))
#define XB_TOP      3328
#define XB_TOPGEN   3392
#define XCD_BAR_WORDS 3456
#define XB_SPIN_CAP (1u << 20)
#define LAS __attribute__((address_space(3)))
DI unsigned xb_ld(unsigned* p) { return __hip_atomic_load(p, __ATOMIC_RELAXED, __HIP_MEMORY_SCOPE_AGENT); }
DI unsigned xb_add(unsigned* p, unsigned v) { return __hip_atomic_fetch_add(p, v, __ATOMIC_RELAXED, __HIP_MEMORY_SCOPE_AGENT); }
DI unsigned xb_xcc_id() { return (unsigned)__builtin_amdgcn_s_getreg((3 << 11) | 20) & 0xFu; }
#define XB_SPIN(cond, bar) do { unsigned _sp = 0; while (cond) { __builtin_amdgcn_s_sleep(1); \
    if ((++_sp & 255u) == 0u) { if (xb_ld(&(bar)[XB_TMO])) break; if (_sp > XB_SPIN_CAP) { atomicAdd(&(bar)[XB_TMO], 1u); break; } } } } while (0)
struct XcdBarrier { unsigned* bar; unsigned x; volatile LAS unsigned* st; };
DI XcdBarrier xcd_barrier_post(unsigned* bar, volatile LAS unsigned* st) {
  XcdBarrier b; b.bar = bar; b.x = xb_xcc_id(); b.st = st;
  if (threadIdx.x == 0) (void)xb_add(&bar[XB_XCNT(b.x)], 1u);
  return b;
}
DI void xcd_barrier_complete(unsigned* bar, unsigned x, unsigned& nloc, unsigned& nx) {
  const unsigned G = gridDim.x * gridDim.y * gridDim.z;
  unsigned sum, cnt, mine, sp = 0u;
  for (;;) {
    sum = 0u; cnt = 0u; mine = 0u;
#pragma unroll
    for (unsigned j = 0; j < 16; ++j) { const unsigned c = xb_ld(&bar[XB_XCNT(j)]); sum += c; cnt += (c > 0u) ? 1u : 0u; mine = (j == x) ? c : mine; }
    if (sum == G) break;
    __builtin_amdgcn_s_sleep(1);
    if ((++sp & 255u) == 0u) { if (xb_ld(&bar[XB_TMO])) break; if (sp > XB_SPIN_CAP) { atomicAdd(&bar[XB_TMO], 1u); break; } }
  }
  nloc = mine > 0u ? mine : 1u; nx = cnt > 0u ? cnt : 1u;
}
DI void xcd_barrier(const XcdBarrier& b) {
  asm volatile("s_waitcnt vmcnt(0)" ::: "memory");
  __syncthreads();
  if (threadIdx.x == 0) {
    unsigned* bar = b.bar;
    __builtin_amdgcn_s_waitcnt(0);
    unsigned nloc = b.st[0], nx = b.st[1];
    if (nloc == 0u) { xcd_barrier_complete(bar, b.x, nloc, nx); b.st[0] = nloc; b.st[1] = nx; }
    const unsigned old = xb_add(&bar[XB_XSUB(b.x)], 1u);
    const unsigned gen = old / nloc;
    if (old + 1u == (gen + 1u) * nloc) {
      __builtin_amdgcn_fence(__ATOMIC_RELEASE, "agent");
      asm volatile("s_waitcnt vmcnt(0)" ::: "memory");
      const unsigned og = xb_add(&bar[XB_TOP], 1u);
      const unsigned tg = og / nx;
      if (og + 1u == (tg + 1u) * nx) xb_add(&bar[XB_TOPGEN], 1u);
      else XB_SPIN(xb_ld(&bar[XB_TOPGEN]) == tg, bar);
      __builtin_amdgcn_fence(__ATOMIC_ACQUIRE, "agent");
      xb_add(&bar[XB_XGEN(b.x)], 1u);
      asm volatile("s_waitcnt vmcnt(0)" ::: "memory");
    } else {
      XB_SPIN(xb_ld(&bar[XB_XGEN(b.x)]) == gen, bar);
      __builtin_amdgcn_fence(__ATOMIC_ACQUIRE, "agent");
      asm volatile("s_waitcnt vmcnt(0)" ::: "memory");
    }
  }
  __syncthreads();
}

constexpr int LDT = 72;
constexpr int GBUF = 2 * 128 * LDT;
template <bool AF32>
DI void gemm128(const void* __restrict__ Ap, int lda, const bf16_t* __restrict__ Bt, int ldb, int K,
                f32x16 (&acc)[2][2], char* smem) {
  bf16_t* S0 = (bf16_t*)smem;
  const int tid = tidx(), lane = tid & 63, w = tid >> 6;
  const int wm = w >> 1, wn = w & 1, r = lane & 31, h = lane >> 5;
  const int lrow = tid >> 3, lch = tid & 7;
#pragma unroll
  for (int i = 0; i < 2; ++i)
#pragma unroll
    for (int j = 0; j < 2; ++j)
#pragma unroll
      for (int e = 0; e < 16; ++e) acc[i][j][e] = 0.f;
  uint4 ra0, ra1, ra2, ra3, rb0, rb1, rb2, rb3;
  const bf16_t* Ab = (const bf16_t*)Ap + (size_t)lrow * lda + lch * 8;
  const float* Af = (const float*)Ap + (size_t)lrow * lda + lch * 8;
  const bf16_t* Bb = Bt + (size_t)lrow * ldb + lch * 8;
  const size_t a32 = (size_t)32 * lda, b32 = (size_t)32 * ldb;
#define GEMM_LDA(dst, q, k0)                                                                          \
  if constexpr (AF32) {                                                                               \
    const float4 f0 = *(const float4*)(Af + (q) * a32 + (k0));                                        \
    const float4 f1 = *(const float4*)(Af + (q) * a32 + (k0) + 4);                                    \
    dst = make_uint4(pack2(f0.x, f0.y), pack2(f0.z, f0.w), pack2(f1.x, f1.y), pack2(f1.z, f1.w));     \
  } else {                                                                                            \
    dst = *(const uint4*)(Ab + (q) * a32 + (k0));                                                     \
  }
#define GEMM_LOADG(k0)                                                                                \
  {                                                                                                   \
    GEMM_LDA(ra0, 0, k0) GEMM_LDA(ra1, 1, k0) GEMM_LDA(ra2, 2, k0) GEMM_LDA(ra3, 3, k0)               \
    rb0 = *(const uint4*)(Bb + (k0));                                                                 \
    rb1 = *(const uint4*)(Bb + b32 + (k0));                                                           \
    rb2 = *(const uint4*)(Bb + 2 * b32 + (k0));                                                       \
    rb3 = *(const uint4*)(Bb + 3 * b32 + (k0));                                                       \
  }
#define GEMM_STORE(buf)                                                                               \
  {                                                                                                   \
    bf16_t* ad = S0 + (buf) * GBUF + lrow * LDT + lch * 8;                                            \
    bf16_t* bd = ad + 128 * LDT;                                                                      \
    *(uint4*)(ad) = ra0; *(uint4*)(ad + 32 * LDT) = ra1; *(uint4*)(ad + 64 * LDT) = ra2; *(uint4*)(ad + 96 * LDT) = ra3; \
    *(uint4*)(bd) = rb0; *(uint4*)(bd + 32 * LDT) = rb1; *(uint4*)(bd + 64 * LDT) = rb2; *(uint4*)(bd + 96 * LDT) = rb3; \
  }
  const int nk = K >> 6;
  GEMM_LOADG(0)
  GEMM_STORE(0)
  if (nk > 1) GEMM_LOADG(64)
  __syncthreads();
  for (int kt = 0; kt < nk; ++kt) {
    if (kt + 1 < nk) GEMM_STORE((kt + 1) & 1)
    if (kt + 2 < nk) GEMM_LOADG((kt + 2) << 6)
    __builtin_amdgcn_sched_barrier(0);
    const bf16_t* As = S0 + (kt & 1) * GBUF;
    const bf16_t* Bs = As + 128 * LDT;
#pragma unroll
    for (int ks = 0; ks < 4; ++ks) {
      bf16x8 a0 = *(const bf16x8*)(As + (wm * 64 + r) * LDT + ks * 16 + h * 8);
      bf16x8 a1 = *(const bf16x8*)(As + (wm * 64 + 32 + r) * LDT + ks * 16 + h * 8);
      bf16x8 b0 = *(const bf16x8*)(Bs + (wn * 64 + r) * LDT + ks * 16 + h * 8);
      bf16x8 b1 = *(const bf16x8*)(Bs + (wn * 64 + 32 + r) * LDT + ks * 16 + h * 8);
      acc[0][0] = __builtin_amdgcn_mfma_f32_32x32x16_bf16(a0, b0, acc[0][0], 0, 0, 0);
      acc[0][1] = __builtin_amdgcn_mfma_f32_32x32x16_bf16(a0, b1, acc[0][1], 0, 0, 0);
      acc[1][0] = __builtin_amdgcn_mfma_f32_32x32x16_bf16(a1, b0, acc[1][0], 0, 0, 0);
      acc[1][1] = __builtin_amdgcn_mfma_f32_32x32x16_bf16(a1, b1, acc[1][1], 0, 0, 0);
    }
    __syncthreads();
  }
}
template <class F>
DI void epi_each(f32x16 (&acc)[2][2], F f) {
  const int lane = tidx() & 63, w = tidx() >> 6;
  const int wm = w >> 1, wn = w & 1, r = lane & 31, h = lane >> 5;
#pragma unroll
  for (int mi = 0; mi < 2; ++mi)
#pragma unroll
    for (int ni = 0; ni < 2; ++ni)
#pragma unroll
      for (int i = 0; i < 16; ++i) f(wm * 64 + mi * 32 + crow(i, h), wn * 64 + ni * 32 + r, acc[mi][ni][i]);
}

DI void transpose_tile(const float* __restrict__ src, bf16_t* __restrict__ dst, int K, int N, int kt, int nt, float* sm) {
  const int tid = tidx();
  const int k0 = kt * 64, n0 = nt * 64;
#pragma unroll
  for (int i = 0; i < 16; ++i) {
    int k = i * 4 + (tid >> 6), n = tid & 63;
    sm[k * 65 + n] = src[(size_t)(k0 + k) * N + n0 + n];
  }
  __syncthreads();
  int n = tid >> 2, ks = (tid & 3) * 16;
  unsigned pk[8];
#pragma unroll
  for (int j = 0; j < 8; ++j) pk[j] = pack2(sm[(ks + 2 * j) * 65 + n], sm[(ks + 2 * j + 1) * 65 + n]);
  uint4* d = (uint4*)(dst + (size_t)(n0 + n) * K + k0 + ks);
  d[0] = make_uint4(pk[0], pk[1], pk[2], pk[3]);
  d[1] = make_uint4(pk[4], pk[5], pk[6], pk[7]);
  __syncthreads();
}
DI void rmsnorm_row_bf(const float* __restrict__ x, const float* __restrict__ g, bf16_t* __restrict__ o, int lane) {
  float4 v[4];
  float ss = 0.f;
#pragma unroll
  for (int i = 0; i < 4; ++i) {
    v[i] = ((const float4*)x)[i * 64 + lane];
    ss += v[i].x * v[i].x + v[i].y * v[i].y + v[i].z * v[i].z + v[i].w * v[i].w;
  }
  ss = wave_sum(ss);
  float sc = rsqrtf(ss * (1.f / 1024.f) + 1e-6f);
#pragma unroll
  for (int i = 0; i < 4; ++i) {
    float4 gg = ((const float4*)g)[i * 64 + lane];
    uint2 pk = make_uint2(pack2(v[i].x * sc * gg.x, v[i].y * sc * gg.y), pack2(v[i].z * sc * gg.z, v[i].w * sc * gg.w));
    ((uint2*)o)[i * 64 + lane] = pk;
  }
}

#define TJ(IDX, OFF, KK_, NN_)                                                                             \
  {                                                                                                        \
    const int ntl = ((KK_) / 64) * ((NN_) / 64);                                                           \
    if (it < ntl) {                                                                                        \
      transpose_tile(p->in[IDX], (bf16_t*)(p->ws + (OFF)), (KK_), (NN_), it / ((NN_) / 64), it % ((NN_) / 64), (float*)smem); \
      continue;                                                                                            \
    }                                                                                                      \
    it -= ntl;                                                                                             \
  }

DI void phase0(KP p, char* smem) {
  const int tid = tidx(), lane = tid & 63, w = tid >> 6;
  constexpr int N_TR = 960 + 8 + 8 + 16;
  constexpr int N_KEYS = 128, N_ROPE = 257, N_NORM = T / 4;
  for (int item = blockIdx.x; item < N_TR + N_KEYS + N_ROPE + N_NORM; item += gridDim.x) {
    int it = item;
    TJ(8, OFF_WIN, 1024, 3840)
    TJ(11, OFF_W2, 64, 512)
    TJ(13, OFF_A2, 64, 512)
    TJ(14, OFF_G2, 128, 512)
    if (it < N_KEYS) {
      const float* src = p->in[23] + (size_t)it * 2048 + tid * 8;
      float4 f0 = *(const float4*)src, f1 = *(const float4*)(src + 4);
      *(uint4*)((bf16_t*)(p->ws + OFF_KEYS) + (size_t)it * 2048 + tid * 8) =
          make_uint4(pack2(f0.x, f0.y), pack2(f0.z, f0.w), pack2(f1.x, f1.y), pack2(f1.z, f1.w));
      continue;
    }
    it -= N_KEYS;
    if (it < N_ROPE) {
      int e = it * 256 + tid;
      int pidx = e >> 5, f = e & 31;
      if (pidx < 2056) {
        const float pos = (pidx < 2048) ? (float)pidx : (float)(16384 + pidx - 2048);
        const float inv = exp2f(-(float)f * 0.41524101186092f);
        const float ang = pos * inv;
        const float kq = rintf(ang * 0.15915494309189535f);
        float rr = fmaf(-kq, 6.28125f, ang);
        rr = fmaf(-kq, 1.9353071795864769e-3f, rr);
        float* rt = (float*)(p->ws + OFF_ROPE);
        rt[e * 2] = cosf(rr);
        rt[e * 2 + 1] = sinf(rr);
      }
      continue;
    }
    it -= N_ROPE;
    {
      int t = it * 4 + w;
      rmsnorm_row_bf(xrow(p, t), p->in[7], (bf16_t*)(p->ws + OFF_ACT) + (size_t)t * 1024, lane);
    }
  }
}

DI void phase1(KP p, char* smem) {
  const int lane = tidx() & 63, w = tidx() >> 6;
  const int wm = w >> 1, wn = w & 1, r = lane & 31, h = lane >> 5;
  bf16_t* RET = (bf16_t*)p->out;
  bf16_t* RWP = (bf16_t*)(p->ws + OFF_TAB);
  const float2* rope = (const float2*)(p->ws + OFF_ROPE);
  for (int tile = blockIdx.x; tile < 136 * 30; tile += gridDim.x) {
    const int mt = tile / 30, nt = tile % 30;
    const int m0 = mt * 128, n0 = nt * 128;
    f32x16 acc[2][2];
    gemm128<false>((const bf16_t*)(p->ws + OFF_ACT) + (size_t)m0 * 1024, 1024,
                   (const bf16_t*)(p->ws + OFF_WIN) + (size_t)n0 * 1024, 1024, 1024, acc, smem);
    const int nb = n0 + wn * 64;
    if (nb < 1024) {
      float2 cs[2][16];
#pragma unroll
      for (int mi = 0; mi < 2; ++mi)
#pragma unroll
        for (int i = 0; i < 16; ++i) {
          const TokInfo ti = tokinfo(m0 + wm * 64 + mi * 32 + crow(i, h));
          cs[mi][i] = rope[(ti.sample ? 2048 + ti.l : ti.l) * 32 + r];
        }
      const float scl = (nb >= 512) ? 0.125f : 1.f;
#pragma unroll
      for (int mi = 0; mi < 2; ++mi)
#pragma unroll
        for (int i = 0; i < 16; ++i) {
          const float v0 = acc[mi][0][i], v1 = acc[mi][1][i];
          acc[mi][0][i] = (v0 * cs[mi][i].x - v1 * cs[mi][i].y) * scl;
          acc[mi][1][i] = (v1 * cs[mi][i].x + v0 * cs[mi][i].y) * scl;
        }
    }
#pragma unroll
    for (int mi = 0; mi < 2; ++mi)
#pragma unroll
      for (int i = 0; i < 16; ++i) {
        const int t = m0 + wm * 64 + mi * 32 + crow(i, h);
        const float v0 = acc[mi][0][i], v1 = acc[mi][1][i];
        if (nb < 2048) {
          RET[(size_t)t * 2048 + nb + r] = f2bf(v0);
          RET[(size_t)t * 2048 + nb + 32 + r] = f2bf(v1);
        } else {
          const TokInfo ti = tokinfo(t);
          const int c = nb - 2048 + r;
          RWP[(size_t)t * 1792 + c] = f2bf(v0);
          RWP[(size_t)t * 1792 + c + 32] = f2bf(v1);
          if (ti.sample) {
            if (ti.l == 7) { p->out[O_SHS + ti.b * 1792 + c] = v0; p->out[O_SHS + ti.b * 1792 + c + 32] = v1; }
          } else {
            if (ti.l == 2047) { p->out[O_SHP + ti.b * 1792 + c] = v0; p->out[O_SHP + ti.b * 1792 + c + 32] = v1; }
          }
        }
      }
  }
}

DI void phase2(KP p) {
  const int lane = tidx() & 63, w = tidx() >> 6;
  const bf16_t* RWP = (const bf16_t*)(p->ws + OFF_TAB);
  bf16_t* Rb = (bf16_t*)(p->ws + OFF_R);
  bf16_t* Kb = (bf16_t*)(p->ws + OFF_K);
  bf16_t* Vb = (bf16_t*)(p->ws + OFF_V);
  bf16_t* LA = (bf16_t*)(p->ws + OFF_LORA);
  float* INVN = (float*)(p->ws + OFF_INVN);
  const float* mu = p->in[9];
  const float* kkw = p->in[15];
  for (int t = blockIdx.x * 4 + w; t < T; t += gridDim.x * 4) {
    const TokInfo ti = tokinfo(t);
    const bf16_t* cur = RWP + (size_t)t * 1792;
    const bf16_t* prv = cur - 1792;
    const float* sh = p->in[4] + (size_t)ti.b * 1792;
    float f[4][8];
#pragma unroll
    for (int i = 0; i < 4; ++i) {
      const int c8 = (lane + 64 * i) * 8;
      if (i < 3 || lane < 32) {
        float cv[8], pv[8];
        unpack8f(*(const uint4*)(cur + c8), cv);
        if (ti.l > 0) unpack8f(*(const uint4*)(prv + c8), pv);
        else if (ti.sample) {
          const float4 s0 = *(const float4*)(sh + c8), s1 = *(const float4*)(sh + c8 + 4);
          pv[0] = s0.x; pv[1] = s0.y; pv[2] = s0.z; pv[3] = s0.w; pv[4] = s1.x; pv[5] = s1.y; pv[6] = s1.z; pv[7] = s1.w;
        } else {
#pragma unroll
          for (int k = 0; k < 8; ++k) pv[k] = 0.f;
        }
        const float4 m0 = *(const float4*)(mu + c8), m1 = *(const float4*)(mu + c8 + 4);
        const float mm[8] = {m0.x, m0.y, m0.z, m0.w, m1.x, m1.y, m1.z, m1.w};
#pragma unroll
        for (int k = 0; k < 8; ++k) f[i][k] = cv[k] + (pv[k] - cv[k]) * mm[k];
      } else {
#pragma unroll
        for (int k = 0; k < 8; ++k) f[i][k] = 0.f;
      }
    }
    *(uint4*)(Rb + (size_t)t * 512 + lane * 8) = pack8f(f[0]);
    {
      const uint4 kb = pack8f(f[1]);
      *(uint4*)(Kb + (size_t)t * 512 + lane * 8) = kb;
      float kr[8];
      unpack8f(kb, kr);
      const float4 q0 = *(const float4*)(kkw + lane * 8), q1 = *(const float4*)(kkw + lane * 8 + 4);
      const float qq[8] = {q0.x, q0.y, q0.z, q0.w, q1.x, q1.y, q1.z, q1.w};
      float ss = 0.f;
#pragma unroll
      for (int k = 0; k < 8; ++k) { const float kq = kr[k] * qq[k]; ss += kq * kq; }
      ss = allreduce8(ss);
      if ((lane & 7) == 0) INVN[t * 8 + (lane >> 3)] = 1.f / fmaxf(sqrtf(ss), 1e-12f);
    }
    *(uint4*)(Vb + (size_t)t * 512 + lane * 8) = pack8f(f[2]);
    if (lane < 32) {
      float o[8];
#pragma unroll
      for (int k = 0; k < 8; ++k) {
        const float x = f[3][k];
        o[k] = (lane < 8) ? tanhf(x) : ((lane < 16) ? x : 1.f / (1.f + expf(-x)));
      }
      *(uint4*)(LA + (size_t)t * 256 + lane * 8) = pack8f(o);
    }
  }
}

DI void phase3(KP p, char* smem) {
  const bf16_t* LA = (const bf16_t*)(p->ws + OFF_LORA);
  bf16_t* Kb = (bf16_t*)(p->ws + OFF_K);
  bf16_t* KKb = (bf16_t*)(p->ws + OFF_KK);
  bf16_t* BBb = (bf16_t*)(p->ws + OFF_BB);
  bf16_t* GTb = (bf16_t*)(p->ws + OFF_GATE);
  float* EW = (float*)(p->ws + OFF_EW);
  const float* INVN = (const float*)(p->ws + OFF_INVN);
  const float* w0 = p->in[10];
  const float* a0 = p->in[12];
  const float* kkw = p->in[15];
  const float* kaw = p->in[16];
  for (int item = blockIdx.x; item < 136 * 12; item += gridDim.x) {
    const int mt = item / 12, rem = item % 12, kind = rem >> 2, nt = rem & 3;
    const int m0 = mt * 128, n0 = nt * 128;
    f32x16 acc[2][2];
    if (kind == 0) {
      gemm128<false>(LA + (size_t)m0 * 256, 256, (const bf16_t*)(p->ws + OFF_W2) + n0 * 64, 64, 64, acc, smem);
      epi_each(acc, [&](int rr, int cc, float v) {
        const int t = m0 + rr, c = n0 + cc;
        const float x = v + w0[c];
        const float z = -x;
        const float sp = fmaxf(z, 0.f) + log1pf(expf(-fabsf(z)));
        const float ww = -sp - 0.5f;
        EW[(size_t)t * 512 + c] = expf(-expf(ww));
      });
    } else if (kind == 1) {
      gemm128<false>(LA + (size_t)m0 * 256 + 64, 256, (const bf16_t*)(p->ws + OFF_A2) + n0 * 64, 64, 64, acc, smem);
      {
        const int lane = tidx() & 63, w = tidx() >> 6;
        const int wm = w >> 1, wn = w & 1, r = lane & 31, h = lane >> 5;
#pragma unroll 1
        for (int mi = 0; mi < 2; ++mi) {
          const int tb = m0 + wm * 64 + mi * 32;
          float inv[16];
#pragma unroll
          for (int i = 0; i < 16; ++i) inv[i] = INVN[(tb + crow(i, h)) * 8 + ((n0 + wn * 64) >> 6)];
#pragma unroll
          for (int ni = 0; ni < 2; ++ni) {
            const int c = n0 + wn * 64 + ni * 32 + r;
            const float a0c = a0[c], kkc = kkw[c], kac = kaw[c];
            float k7v[16];
#pragma unroll
            for (int i = 0; i < 16; ++i) k7v[i] = bf2f(Kb[(size_t)(tb + crow(i, h)) * 512 + c]);
#pragma unroll
            for (int i = 0; i < 16; ++i) {
              const float av = (mi == 0) ? acc[0][ni][i] : acc[1][ni][i];
              const float a = 1.f / (1.f + expf(-(av + a0c)));
              const size_t o = (size_t)(tb + crow(i, h)) * 512 + c;
              const float kkv = k7v[i] * kkc * inv[i];
              Kb[o] = f2bf(k7v[i] * (1.f + (a - 1.f) * kac));
              KKb[o] = f2bf(kkv);
              BBb[o] = f2bf(kkv * a);
            }
          }
        }
      }
    } else {
      gemm128<false>(LA + (size_t)m0 * 256 + 128, 256, (const bf16_t*)(p->ws + OFF_G2) + n0 * 128, 128, 128, acc, smem);
      epi_each(acc, [&](int rr, int cc, float v) { GTb[(size_t)(m0 + rr) * 512 + n0 + cc] = f2bf(v); });
    }
  }
}

DI void rwkv_scan(KP p, int tok0, int hd, int q, int nsteps, const float* __restrict__ S0, float* __restrict__ Sout, char* smem) {
  const int tid = tidx(), lane = tid & 63, w = tid >> 6, g = lane >> 4, l16 = lane & 15;
  const int rl = w * 4 + g;
  const int row = q * 16 + rl;
  const int j0 = l16 * 4;
  const bf16_t* Rb = (const bf16_t*)(p->ws + OFF_R);
  const bf16_t* Kb = (const bf16_t*)(p->ws + OFF_K);
  const bf16_t* Vb = (const bf16_t*)(p->ws + OFF_V);
  const bf16_t* KKb = (const bf16_t*)(p->ws + OFF_KK);
  const bf16_t* BBb = (const bf16_t*)(p->ws + OFF_BB);
  const float* EW = (const float*)(p->ws + OFF_EW);
  bf16_t* ACT = (bf16_t*)(p->ws + OFF_ACT);
  float* ew_s = (float*)smem;
  float* kk_s = ew_s + 2048;
  float* bb_s = kk_s + 2048;
  float* kp_s = bb_s + 2048;
  float* r_s = kp_s + 2048;
  float* v_s = r_s + 2048;
  float* y_s = v_s + 512;
  f2_t s01 = (f2_t){0.f, 0.f}, s23 = (f2_t){0.f, 0.f};
  if (S0) { const float4 t4 = *(const float4*)(S0 + row * 64 + j0); s01 = (f2_t){t4.x, t4.y}; s23 = (f2_t){t4.z, t4.w}; }
  uint4 rg_r = make_uint4(0, 0, 0, 0), rg_k = rg_r, rg_kk = rg_r, rg_bb = rg_r, rg_v = rg_r;
  float4 rg_e0 = make_float4(0, 0, 0, 0), rg_e1 = rg_e0;
  const int st_l = tid >> 3, c8 = (tid & 7) * 8;
  auto gload = [&](int sb) {
    if (sb + st_l < nsteps) {
      const size_t o = (size_t)(tok0 + sb + st_l) * 512 + hd * 64 + c8;
      rg_r = *(const uint4*)(Rb + o);
      rg_k = *(const uint4*)(Kb + o);
      rg_kk = *(const uint4*)(KKb + o);
      rg_bb = *(const uint4*)(BBb + o);
      rg_e0 = *(const float4*)(EW + o);
      rg_e1 = *(const float4*)(EW + o + 4);
    }
    if (tid < 64) {
      const int sv = tid >> 1;
      if (sb + sv < nsteps) rg_v = *(const uint4*)(Vb + (size_t)(tok0 + sb + sv) * 512 + hd * 64 + q * 16 + (tid & 1) * 8);
    }
  };
  auto unpack8 = [&](float* d, const uint4& u) {
    *(float4*)d = make_float4(lo2f(u.x), hi2f(u.x), lo2f(u.y), hi2f(u.y));
    *(float4*)(d + 4) = make_float4(lo2f(u.z), hi2f(u.z), lo2f(u.w), hi2f(u.w));
  };
  auto sstore = [&]() {
    const int o = st_l * 64 + c8;
    unpack8(r_s + o, rg_r);
    unpack8(kp_s + o, rg_k);
    unpack8(kk_s + o, rg_kk);
    unpack8(bb_s + o, rg_bb);
    *(float4*)(ew_s + o) = rg_e0;
    *(float4*)(ew_s + o + 4) = rg_e1;
    if (tid < 64) unpack8(v_s + (tid >> 1) * 16 + (tid & 1) * 8, rg_v);
  };
  gload(0);
  for (int sb = 0; sb < nsteps; sb += 32) {
    __syncthreads();
    sstore();
    __syncthreads();
    if (sb + 32 < nsteps) gload(sb + 32);
    const int tc = min(32, nsteps - sb);
#define SC_LD(X, st)                                              \
  {                                                               \
    const float* b_ = ew_s + (st) * 64 + j0;                      \
    X##e = *(const float4*)(b_);                                  \
    X##q = *(const float4*)(b_ + 2048);                           \
    X##b = *(const float4*)(b_ + 4096);                           \
    X##k = *(const float4*)(b_ + 6144);                           \
    X##r = *(const float4*)(b_ + 8192);                           \
    X##v = v_s[(st) * 16 + rl];                                   \
  }
#define SC_STEP(X, st)                                                                     \
  {                                                                                        \
    const f2_t p2 = s01 * (f2_t){X##q.x, X##q.y} + s23 * (f2_t){X##q.z, X##q.w};           \
    float pdp = p2.x + p2.y;                                                               \
      \
    const f2_t vk01 = (f2_t){X##k.x, X##k.y} * X##v, vk23 = (f2_t){X##k.z, X##k.w} * X##v; \
    const f2_t base01 = s01 * (f2_t){X##e.x, X##e.y} + vk01;                               \
    const f2_t base23 = s23 * (f2_t){X##e.z, X##e.w} + vk23;                               \
    allreduce16x2(pdp, ypart);     \
    if (l16 == 0 && (st) > 0) y_s[((st) - 1) * 16 + rl] = ypart;                           \
    s01 = base01 - (f2_t){X##b.x, X##b.y} * pdp;                              \
    s23 = base23 - (f2_t){X##b.z, X##b.w} * pdp;                                           \
    const f2_t y2 = s01 * (f2_t){X##r.x, X##r.y} + s23 * (f2_t){X##r.z, X##r.w};           \
    ypart = y2.x + y2.y;                                                                   \
  }
    {
      float4 Ae, Aq, Ab, Ak, Ar, Be, Bq, Bb, Bk, Br;
      float Av, Bv;
      float ypart = 0.f;
      SC_LD(A, 0)
      for (int st = 0; st < tc; st += 2) {
        SC_LD(B, st + 1)
        SC_STEP(A, st)
        SC_LD(A, min(st + 2, tc - 1))
        SC_STEP(B, st + 1)
      }
      ypart = allreduce16(ypart);
      if (l16 == 0) y_s[(tc - 1) * 16 + rl] = ypart;
    }
    __syncthreads();
    if (tid < tc * 8) {
      const int st = tid >> 3, pr = tid & 7;
      const unsigned pk = pack2(y_s[st * 16 + 2 * pr], y_s[st * 16 + 2 * pr + 1]);
      *(unsigned*)(ACT + (size_t)(tok0 + sb + st) * 1024 + 512 + hd * 64 + q * 16 + 2 * pr) = pk;
    }
  }
  *(float4*)(Sout + row * 64 + j0) = make_float4(s01.x, s01.y, s23.x, s23.y);
}

constexpr int RL = 136;
DI void ret_prompt(KP p, int b, int hd, char* smem) {
  const int tid = tidx(), lane = tid & 63, w = tid >> 6, r = lane & 31, h = lane >> 5;
  const bf16_t* RET = (const bf16_t*)p->out;
  bf16_t* ACT = (bf16_t*)(p->ws + OFF_ACT);
  bf16_t* Vt = (bf16_t*)smem;
  bf16_t* Kzt = (bf16_t*)(smem + 17408);
  bf16_t* St = (bf16_t*)(smem + 34816);
  bf16_t* Sc = (bf16_t*)(smem + 44032);
  float* Of = (float*)(smem + 44032);
  float* dec = (float*)(smem + 78848);
  const float lg = log1pf(-exp2f(-5.f - (float)hd));
  if (tid < 129) dec[tid] = expf((float)tid * lg);
  for (int e = tid; e < 64 * 72; e += 256) St[e] = 0;
  __syncthreads();
  const float g128 = dec[128];
  f32x16 Sacc;
#pragma unroll
  for (int e = 0; e < 16; ++e) Sacc[e] = 0.f;
  const int vt = w >> 1, dt = w & 1;
  for (int c = 0; c < 16; ++c) {
    const int tokc = b * 2048 + c * 128;
    {
      const int j = tid >> 1, hf = tid & 1;
      const bf16_t* vsrc = RET + (size_t)(tokc + j) * 2048 + 1024 + hd * 64 + hf * 32;
      const bf16_t* ksrc = RET + (size_t)(tokc + j) * 2048 + 512 + hd * 64 + hf * 32;
      const float zj = dec[127 - j];
#pragma unroll
      for (int qd = 0; qd < 4; ++qd) {
        const uint4 uv = *(const uint4*)(vsrc + qd * 8);
        const uint4 uk = *(const uint4*)(ksrc + qd * 8);
        const unsigned vv[4] = {uv.x, uv.y, uv.z, uv.w};
        const unsigned kk[4] = {uk.x, uk.y, uk.z, uk.w};
#pragma unroll
        for (int e = 0; e < 4; ++e) {
          const int col = hf * 32 + qd * 8 + e * 2;
          Vt[col * RL + j] = (bf16_t)(vv[e] & 0xffffu);
          Vt[(col + 1) * RL + j] = (bf16_t)(vv[e] >> 16);
          Kzt[col * RL + j] = f2bf(lo2f(kk[e]) * zj);
          Kzt[(col + 1) * RL + j] = f2bf(hi2f(kk[e]) * zj);
        }
      }
    }
    bf16x8 qf[4];
    {
      const bf16_t* qsrc = RET + (size_t)(tokc + 32 * w + r) * 2048 + hd * 64 + h * 8;
#pragma unroll
      for (int ks = 0; ks < 4; ++ks) qf[ks] = *(const bf16x8*)(qsrc + ks * 16);
    }
    for (int jt = 0; jt <= w; ++jt) {
      f32x16 sc;
#pragma unroll
      for (int e = 0; e < 16; ++e) sc[e] = 0.f;
      const bf16_t* ksrc = RET + (size_t)(tokc + 32 * jt + r) * 2048 + 512 + hd * 64 + h * 8;
#pragma unroll
      for (int ks = 0; ks < 4; ++ks) {
        const bf16x8 kf = *(const bf16x8*)(ksrc + ks * 16);
        sc = __builtin_amdgcn_mfma_f32_32x32x16_bf16(qf[ks], kf, sc, 0, 0, 0);
      }
#pragma unroll
      for (int e = 0; e < 16; ++e) {
        const int i = 32 * w + crow(e, h), j = 32 * jt + r;
        const int d = i - j;
        const float val = (d >= 0) ? sc[e] * dec[d >= 0 ? d : 0] : 0.f;
        Sc[i * RL + j] = f2bf(val);
      }
    }
    __syncthreads();
    f32x16 oacc[2];
#pragma unroll
    for (int nt = 0; nt < 2; ++nt) {
#pragma unroll
      for (int e = 0; e < 16; ++e) oacc[nt][e] = 0.f;
#pragma unroll
      for (int ks = 0; ks < 4; ++ks) {
        const bf16x8 sf = *(const bf16x8*)(St + (nt * 32 + r) * 72 + ks * 16 + h * 8);
        oacc[nt] = __builtin_amdgcn_mfma_f32_32x32x16_bf16(qf[ks], sf, oacc[nt], 0, 0, 0);
      }
#pragma unroll
      for (int e = 0; e < 16; ++e) oacc[nt][e] *= dec[32 * w + crow(e, h) + 1];
    }
    for (int ks = 0; ks < 2 * (w + 1); ++ks) {
      const bf16x8 af = *(const bf16x8*)(Sc + (32 * w + r) * RL + ks * 16 + h * 8);
#pragma unroll
      for (int nt = 0; nt < 2; ++nt) {
        const bf16x8 vf = *(const bf16x8*)(Vt + (nt * 32 + r) * RL + ks * 16 + h * 8);
        oacc[nt] = __builtin_amdgcn_mfma_f32_32x32x16_bf16(af, vf, oacc[nt], 0, 0, 0);
      }
    }
#pragma unroll
    for (int e = 0; e < 16; ++e) Sacc[e] *= g128;
#pragma unroll
    for (int ks = 0; ks < 8; ++ks) {
      const bf16x8 af = *(const bf16x8*)(Vt + (vt * 32 + r) * RL + ks * 16 + h * 8);
      const bf16x8 bf = *(const bf16x8*)(Kzt + (dt * 32 + r) * RL + ks * 16 + h * 8);
      Sacc = __builtin_amdgcn_mfma_f32_32x32x16_bf16(af, bf, Sacc, 0, 0, 0);
    }
    __syncthreads();
#pragma unroll
    for (int nt = 0; nt < 2; ++nt)
#pragma unroll
      for (int e = 0; e < 16; ++e) Of[(32 * w + crow(e, h)) * 66 + nt * 32 + r] = oacc[nt][e];
#pragma unroll
    for (int e = 0; e < 16; ++e) St[(vt * 32 + crow(e, h)) * 72 + dt * 32 + r] = f2bf(Sacc[e]);
    __syncthreads();
    {
      const int i = tid >> 1, hf = tid & 1;
      const int t = tokc + i;
      float vals[32];
      float sm = 0.f;
#pragma unroll
      for (int k = 0; k < 32; ++k) { vals[k] = Of[i * 66 + hf * 32 + k]; sm += vals[k]; }
      sm += __shfl_xor(sm, 1);
      const float mean = sm * (1.f / 64.f);
      float vs = 0.f;
#pragma unroll
      for (int k = 0; k < 32; ++k) { vals[k] -= mean; vs += vals[k] * vals[k]; }
      vs += __shfl_xor(vs, 1);
      const float rs = rsqrtf(vs * (1.f / 64.f) + 1e-5f);
      const bf16_t* gsrc = RET + (size_t)t * 2048 + 1536 + hd * 64 + hf * 32;
      bf16_t* dst = ACT + (size_t)t * 1024 + hd * 64 + hf * 32;
#pragma unroll
      for (int qd = 0; qd < 4; ++qd) {
        const uint4 ug = *(const uint4*)(gsrc + qd * 8);
        const unsigned gg[4] = {ug.x, ug.y, ug.z, ug.w};
        unsigned o4[4];
#pragma unroll
        for (int e = 0; e < 4; ++e) {
          const float g0 = lo2f(gg[e]), g1 = hi2f(gg[e]);
          const float a0 = vals[qd * 8 + 2 * e] * rs * (g0 / (1.f + __expf(-g0)));
          const float a1 = vals[qd * 8 + 2 * e + 1] * rs * (g1 / (1.f + __expf(-g1)));
          o4[e] = pack2(a0, a1);
        }
        *(uint4*)(dst + qd * 8) = make_uint4(o4[0], o4[1], o4[2], o4[3]);
      }
    }
    __syncthreads();
  }
  float* so = p->out + O_RETP + (size_t)(b * 8 + hd) * 4096;
#pragma unroll
  for (int gq = 0; gq < 4; ++gq)
    *(float4*)(so + (dt * 32 + r) * 64 + vt * 32 + 8 * gq + 4 * h) =
        make_float4(Sacc[4 * gq], Sacc[4 * gq + 1], Sacc[4 * gq + 2], Sacc[4 * gq + 3]);
}

DI void ret_sample(KP p, int b, int hd, char* smem) {
  const int tid = tidx();
  const bf16_t* RET = (const bf16_t*)p->out;
  bf16_t* ACT = (bf16_t*)(p->ws + OFF_ACT);
  float* q_s = (float*)smem;
  float* k_s = q_s + 512;
  float* v_s = k_s + 512;
  float* A_s = v_s + 512;
  float* part = A_s + 64;
  const int tok0 = TP + b * 8;
  const float lg = log1pf(-exp2f(-5.f - (float)hd));
  __syncthreads();
  {
    const int e = tid * 2, rw = e >> 6, cl = e & 63;
    const bf16_t* base = RET + (size_t)(tok0 + rw) * 2048 + hd * 64 + cl;
    const unsigned uq = *(const unsigned*)(base), uk = *(const unsigned*)(base + 512), uv = *(const unsigned*)(base + 1024);
    q_s[e] = lo2f(uq); q_s[e + 1] = hi2f(uq);
    k_s[e] = lo2f(uk); k_s[e + 1] = hi2f(uk);
    v_s[e] = lo2f(uv); v_s[e + 1] = hi2f(uv);
  }
  __syncthreads();
  if (tid < 64) {
    const int i = tid >> 3, j = tid & 7;
    float a = 0.f;
    if (i >= j) {
#pragma unroll 4
      for (int d = 0; d < 64; ++d) a = fmaf(q_s[i * 64 + d], k_s[j * 64 + d], a);
      a *= expf((float)(i - j) * lg);
    }
    A_s[tid] = a;
  }
  {
    const int dg = tid >> 6, v = tid & 63;
    const float* S0 = p->in[2] + (size_t)(b * 8 + hd) * 4096;
    float* So = p->out + O_RETS + (size_t)(b * 8 + hd) * 4096;
    float oi[8];
#pragma unroll
    for (int i = 0; i < 8; ++i) oi[i] = 0.f;
    const float g8 = expf(8.f * lg);
    float kv[8];
#pragma unroll
    for (int j = 0; j < 8; ++j) kv[j] = v_s[j * 64 + v] * expf((float)(7 - j) * lg);
#pragma unroll 1
    for (int hb = 0; hb < 2; ++hb) {
      float sv[8];
#pragma unroll
      for (int dd = 0; dd < 8; ++dd) sv[dd] = S0[(dg * 16 + hb * 8 + dd) * 64 + v];
#pragma unroll
      for (int dd = 0; dd < 8; ++dd) {
        const int d = dg * 16 + hb * 8 + dd;
        const float s = sv[dd];
        float sn = s * g8;
#pragma unroll
        for (int j = 0; j < 8; ++j) sn = fmaf(k_s[j * 64 + d], kv[j], sn);
        So[d * 64 + v] = sn;
#pragma unroll
        for (int i = 0; i < 8; ++i) oi[i] = fmaf(q_s[i * 64 + d], s, oi[i]);
      }
    }
#pragma unroll
    for (int i = 0; i < 8; ++i) part[(dg * 8 + i) * 64 + v] = oi[i];
  }
  __syncthreads();
#pragma unroll
  for (int rep = 0; rep < 2; ++rep) {
    const int i = (tid >> 6) + 4 * rep, v = tid & 63;
    float o = part[(0 * 8 + i) * 64 + v] + part[(1 * 8 + i) * 64 + v] + part[(2 * 8 + i) * 64 + v] + part[(3 * 8 + i) * 64 + v];
    o *= expf((float)(i + 1) * lg);
    for (int j = 0; j <= i; ++j) o = fmaf(A_s[i * 8 + j], v_s[j * 64 + v], o);
    const float mean = wave_sum(o) * (1.f / 64.f);
    const float dv = o - mean;
    const float var = wave_sum(dv * dv) * (1.f / 64.f);
    const int t = tok0 + i;
    const float gt = bf2f(RET[(size_t)t * 2048 + 1536 + hd * 64 + v]);
    ACT[(size_t)t * 1024 + hd * 64 + v] = f2bf(dv * rsqrtf(var + 1e-5f) * (gt / (1.f + __expf(-gt))));
  }
}

constexpr size_t TAB_V8 = (size_t)16384 * 1024;
constexpr size_t TAB_SC = (size_t)2 * 16384 * 1024;
DI void convert_tab(KP p, int it) {
  const int tid = tidx(), lane = tid & 63, w = tid >> 6;
  const int row0 = it * 8 + w * 2;
  const float* src = (row0 < 16384) ? p->in[24] + (size_t)row0 * 1024 : p->in[25] + (size_t)(row0 - 16384) * 1024;
  float4 v[2][4];
#pragma unroll
  for (int rr = 0; rr < 2; ++rr)
#pragma unroll
    for (int i = 0; i < 4; ++i) v[rr][i] = *(const float4*)(src + rr * 1024 + i * 256 + lane * 4);
#pragma unroll
  for (int rr = 0; rr < 2; ++rr) {
    float am = 0.f;
#pragma unroll
    for (int i = 0; i < 4; ++i)
      am = fmaxf(am, fmaxf(fmaxf(fabsf(v[rr][i].x), fabsf(v[rr][i].y)), fmaxf(fabsf(v[rr][i].z), fabsf(v[rr][i].w))));
#pragma unroll
    for (int o = 32; o >= 1; o >>= 1) am = fmaxf(am, __shfl_xor(am, o));
    am = fmaxf(am, 1e-30f);
    const float inv = 127.f / am;
    unsigned char* dst = (unsigned char*)(p->ws + OFF_TAB) + (size_t)(row0 + rr) * 1024;
#pragma unroll
    for (int i = 0; i < 4; ++i) {
      const unsigned q0 = (unsigned)((int)rintf(v[rr][i].x * inv) + 128);
      const unsigned q1 = (unsigned)((int)rintf(v[rr][i].y * inv) + 128);
      const unsigned q2 = (unsigned)((int)rintf(v[rr][i].z * inv) + 128);
      const unsigned q3 = (unsigned)((int)rintf(v[rr][i].w * inv) + 128);
      *(unsigned*)(dst + i * 256 + lane * 4) = q0 | (q1 << 8) | (q2 << 16) | (q3 << 24);
    }
    if (lane == 0) ((float*)(p->ws + OFF_TAB + TAB_SC))[row0 + rr] = am * (1.f / 127.f);
  }
}

DI void phase4_other(KP p, int it, char* smem) {
  if (it < 64) { ret_prompt(p, it >> 3, it & 7, smem); return; }
  it -= 64;
  if (it < 4096) {
    const int bh = it >> 2, q = it & 3, b = bh >> 3, hd = bh & 7;
    rwkv_scan(p, TP + b * 8, hd, q, 8, p->in[3] + (size_t)bh * 4096, p->out + O_WKVS + (size_t)bh * 4096, smem);
    return;
  }
  it -= 4096;
  if (it < 1024) { ret_sample(p, it >> 3, it & 7, smem); return; }
  it -= 1024;
  if (it < 4096) { convert_tab(p, it); return; }
  it -= 4096;
#define TJ4(IDX, OFF, KK_, NN_)                                                                            \
  {                                                                                                        \
    const int ntl = ((KK_) / 64) * ((NN_) / 64);                                                           \
    if (it < ntl) {                                                                                        \
      transpose_tile(p->in[IDX], (bf16_t*)(p->ws + (OFF)), (KK_), (NN_), it / ((NN_) / 64), it % ((NN_) / 64), (float*)smem); \
      return;                                                                                              \
    }                                                                                                      \
    it -= ntl;                                                                                             \
  }
  TJ4(20, OFF_WOUT, 1024, 1024)
  TJ4(22, OFF_WQ, 1024, 2048)
  TJ4(27, OFF_PG, 1024, 1024)
  TJ4(28, OFF_PP, 256, 1024)
}
DI void phase4(KP p, char* smem) {
  constexpr int N_OTHER = 64 + 4096 + 1024 + 4096 + (256 + 512 + 256 + 64);
  int* s_item = (int*)(smem + SMEM_BYTES - 16);
  unsigned* ctr = (unsigned*)(p->ws + OFF_CTR);
  unsigned* cukey = (unsigned*)(p->ws + OFF_CTR + 16384);
  __syncthreads();
  if (tidx() == 0) {
    const unsigned hw = (unsigned)__builtin_amdgcn_s_getreg((7 << 11) | (8 << 6) | 4);
    const unsigned key = (xb_xcc_id() << 8) | (hw & 0xffu);
    const unsigned old = atomicAdd(&cukey[key], 1u);
    int it = -1;
    if (old == 0u) { const unsigned q = atomicAdd(&ctr[1], 1u); if (q < 256u) it = (int)q; }
    *s_item = it;
  }
  __syncthreads();
  {
    const int it = *s_item;
    if (it >= 0) {
      const int bh = it >> 2, q = it & 3, b = bh >> 3, hd = bh & 7;
      __builtin_amdgcn_s_setprio(3);
      rwkv_scan(p, b * 2048, hd, q, 2048, nullptr, p->out + O_WKVP + (size_t)bh * 4096, smem);
      __builtin_amdgcn_s_setprio(0);
    }
  }
  for (;;) {
    __syncthreads();
    if (tidx() == 0) *s_item = (int)atomicAdd(&ctr[0], 1u);
    __syncthreads();
    const int it = *s_item;
    if (it >= N_OTHER) break;
    phase4_other(p, it, smem);
  }
  for (;;) {
    __syncthreads();
    if (tidx() == 0) *s_item = (int)atomicAdd(&ctr[1], 1u);
    __syncthreads();
    const int it = *s_item;
    if (it >= 256) break;
    const int bh = it >> 2, q = it & 3, b = bh >> 3, hd = bh & 7;
    rwkv_scan(p, b * 2048, hd, q, 2048, nullptr, p->out + O_WKVP + (size_t)bh * 4096, smem);
  }
}

DI void phase5(KP p) {
  const int lane = tidx() & 63, w = tidx() >> 6;
  bf16_t* ACT = (bf16_t*)(p->ws + OFF_ACT);
  const bf16_t* Rb = (const bf16_t*)(p->ws + OFF_R);
  const bf16_t* Kb = (const bf16_t*)(p->ws + OFF_K);
  const bf16_t* Vb = (const bf16_t*)(p->ws + OFF_V);
  const bf16_t* GTb = (const bf16_t*)(p->ws + OFF_GATE);
  const int c8 = lane * 8;
  float rk8[8], lg8[8], lb8[8];
  {
    const float4 a0 = *(const float4*)(p->in[17] + c8), a1 = *(const float4*)(p->in[17] + c8 + 4);
    const float4 b0 = *(const float4*)(p->in[18] + c8), b1 = *(const float4*)(p->in[18] + c8 + 4);
    const float4 d0 = *(const float4*)(p->in[19] + c8), d1 = *(const float4*)(p->in[19] + c8 + 4);
    rk8[0] = a0.x; rk8[1] = a0.y; rk8[2] = a0.z; rk8[3] = a0.w; rk8[4] = a1.x; rk8[5] = a1.y; rk8[6] = a1.z; rk8[7] = a1.w;
    lg8[0] = b0.x; lg8[1] = b0.y; lg8[2] = b0.z; lg8[3] = b0.w; lg8[4] = b1.x; lg8[5] = b1.y; lg8[6] = b1.z; lg8[7] = b1.w;
    lb8[0] = d0.x; lb8[1] = d0.y; lb8[2] = d0.z; lb8[3] = d0.w; lb8[4] = d1.x; lb8[5] = d1.y; lb8[6] = d1.z; lb8[7] = d1.w;
  }
  for (int t = blockIdx.x * 4 + w; t < T; t += gridDim.x * 4) {
    const size_t o = (size_t)t * 512 + c8;
    bf16_t* yp = ACT + (size_t)t * 1024 + 512 + c8;
    const uint4 uy = *(const uint4*)yp, ur = *(const uint4*)(Rb + o), uk = *(const uint4*)(Kb + o),
                uv = *(const uint4*)(Vb + o), ug = *(const uint4*)(GTb + o);
    float y[8], r[8], k[8], v[8], g[8];
    unpack8f(uy, y); unpack8f(ur, r); unpack8f(uk, k); unpack8f(uv, v); unpack8f(ug, g);
    float sm = 0.f, rk = 0.f;
#pragma unroll
    for (int e = 0; e < 8; ++e) { sm += y[e]; rk = fmaf(r[e] * k[e], rk8[e], rk); }
    sm = allreduce8(sm);
    rk = allreduce8(rk);
    const float mean = sm * (1.f / 64.f);
    float vs = 0.f;
#pragma unroll
    for (int e = 0; e < 8; ++e) { y[e] -= mean; vs += y[e] * y[e]; }
    vs = allreduce8(vs);
    const float rs = rsqrtf(vs * (1.f / 64.f) + 64e-5f);
    float ov[8];
#pragma unroll
    for (int e = 0; e < 8; ++e) ov[e] = (y[e] * rs * lg8[e] + lb8[e] + rk * v[e]) * g[e];
    *(uint4*)yp = pack8f(ov);
  }
}

DI void phase6(KP p, char* smem) {
  for (int tile = blockIdx.x; tile < 136 * 8; tile += gridDim.x) {
    const int mt = tile >> 3, nt = tile & 7;
    const int m0 = mt * 128, n0 = nt * 128;
    f32x16 acc[2][2];
    gemm128<false>((const bf16_t*)(p->ws + OFF_ACT) + (size_t)m0 * 1024, 1024,
                   (const bf16_t*)(p->ws + OFF_WOUT) + (size_t)n0 * 1024, 1024, 1024, acc, smem);
    {
      const int lane = tidx() & 63, w = tidx() >> 6;
      const int wm = w >> 1, wn = w & 1, r = lane & 31, h = lane >> 5;
      const float* xb = (m0 < TP) ? p->in[0] + (size_t)m0 * 1024 : p->in[1] + (size_t)(m0 - TP) * 1024;
#pragma unroll
      for (int mi = 0; mi < 2; ++mi)
#pragma unroll
        for (int ni = 0; ni < 2; ++ni)
#pragma unroll
          for (int i = 0; i < 16; ++i)
            acc[mi][ni][i] += xb[(size_t)(wm * 64 + mi * 32 + crow(i, h)) * 1024 + n0 + wn * 64 + ni * 32 + r];
#pragma unroll
      for (int mi = 0; mi < 2; ++mi)
#pragma unroll
        for (int ni = 0; ni < 2; ++ni)
#pragma unroll
          for (int i = 0; i < 16; ++i)
            p->out[(size_t)(m0 + wm * 64 + mi * 32 + crow(i, h)) * 1024 + n0 + wn * 64 + ni * 32 + r] = acc[mi][ni][i];
    }
  }
}

DI void phase7(KP p) {
  const int lane = tidx() & 63, w = tidx() >> 6;
  for (int t = blockIdx.x * 4 + w; t < T; t += gridDim.x * 4)
    rmsnorm_row_bf(p->out + (size_t)t * 1024, p->in[21], (bf16_t*)(p->ws + OFF_ACT) + (size_t)t * 1024, lane);
}

DI void phase8(KP p, char* smem) {
  bf16_t* QP = (bf16_t*)(p->ws + OFF_QPEER);
  for (int tile = blockIdx.x; tile < 136 * 16; tile += gridDim.x) {
    const int mt = tile >> 4, nt = tile & 15;
    const int m0 = mt * 128, n0 = nt * 128;
    f32x16 acc[2][2];
    gemm128<false>((const bf16_t*)(p->ws + OFF_ACT) + (size_t)m0 * 1024, 1024,
                   (const bf16_t*)(p->ws + OFF_WQ) + (size_t)n0 * 1024, 1024, 1024, acc, smem);
    epi_each(acc, [&](int rr, int cc, float v) { QP[(size_t)(m0 + rr) * 2048 + n0 + cc] = f2bf(v); });
  }
}

DI unsigned sortkey(float f) { unsigned u = __float_as_uint(f); return (u & 0x80000000u) ? ~u : (u | 0x80000000u); }
DI float unsortkey(unsigned k) { unsigned u = (k & 0x80000000u) ? (k ^ 0x80000000u) : ~k; return __uint_as_float(u); }
DI void ins16(unsigned (&l)[16], unsigned x) {
#pragma unroll
  for (int i = 0; i < 16; ++i) { const unsigned hi = max(l[i], x); x = min(l[i], x); l[i] = hi; }
}
DI void cswap_desc(unsigned& a, unsigned& b) { const unsigned hi = max(a, b), lo = min(a, b); a = hi; b = lo; }
DI void bsort16(unsigned (&v)[16]) {
#pragma unroll
  for (int ke = 1; ke <= 4; ++ke)
#pragma unroll
    for (int je = ke - 1; je >= 0; --je)
#pragma unroll
      for (int i = 0; i < 16; ++i) {
        const int k = 1 << ke, j = 1 << je, l = i ^ j;
        if (l > i) { if ((i & k) == 0) cswap_desc(v[i], v[l]); else cswap_desc(v[l], v[i]); }
      }
}
DI void bmerge16(unsigned (&a)[16], const unsigned (&b)[16]) {
#pragma unroll
  for (int i = 0; i < 16; ++i) a[i] = max(a[i], b[15 - i]);
#pragma unroll
  for (int je = 3; je >= 0; --je)
#pragma unroll
    for (int i = 0; i < 16; ++i) {
      const int j = 1 << je, l = i ^ j;
      if (l > i) cswap_desc(a[i], a[l]);
    }
}
DI void phase9(KP p, char* smem) {
  const int tid = tidx();
  const bf16_t* QP = (const bf16_t*)(p->ws + OFF_QPEER);
  const bf16_t* KEYS = (const bf16_t*)(p->ws + OFF_KEYS);
  int* IDX = (int*)(p->ws + OFF_IDX);
  float* GSM = (float*)(p->ws + OFF_GSM);
  float* sc = (float*)smem;
  unsigned* mrg = (unsigned*)smem;
  const int row = tid >> 1, half = tid & 1;
  for (int item = blockIdx.x; item < 136 * 8; item += gridDim.x) {
    const int mt = item >> 3, hd = item & 7;
    const int m0 = mt * 128;
    unsigned kc[2][16];
#pragma unroll
    for (int c = 0; c < 2; ++c) {
      f32x16 acc[2][2];
      gemm128<false>(QP + (size_t)m0 * 2048 + (hd * 2 + c) * 128, 2048, KEYS + (size_t)(hd * 2 + c) * 16384, 128, 128, acc, smem);
      __syncthreads();
      epi_each(acc, [&](int rr, int cc, float v) { sc[rr * 129 + cc] = v; });
      __syncthreads();
      unsigned lst[16];
#pragma unroll
      for (int gi = 0; gi < 4; ++gi) {
        unsigned grp[16];
#pragma unroll
        for (int i = 0; i < 16; ++i) {
          const int col = half * 64 + gi * 16 + i;
          grp[i] = (sortkey(sc[row * 129 + col]) & ~127u) | (unsigned)(127 - col);
        }
        bsort16(grp);
        if (gi == 0) {
#pragma unroll
          for (int i = 0; i < 16; ++i) lst[i] = grp[i];
        } else {
          bmerge16(lst, grp);
        }
      }
      __syncthreads();
      if (half) {
#pragma unroll
        for (int i = 0; i < 16; ++i) mrg[row * 16 + i] = lst[i];
      }
      __syncthreads();
      if (!half) {
        unsigned grp[16];
#pragma unroll
        for (int i = 0; i < 16; ++i) grp[i] = mrg[row * 16 + i];
        bmerge16(lst, grp);
      }
#pragma unroll
      for (int i = 0; i < 16; ++i) kc[c][i] = lst[i];
    }
    if (!half) {
      float sv0[16], sv1[16];
#pragma unroll
      for (int i = 0; i < 16; ++i) { sv0[i] = unsortkey(kc[0][i] & ~127u); sv1[i] = unsortkey(kc[1][i] & ~127u); }
      unsigned cl[16];
#pragma unroll
      for (int i = 0; i < 16; ++i) cl[i] = 0u;
#pragma unroll
      for (int a = 0; a < 16; ++a)
#pragma unroll
        for (int b = 0; b < 16 / (a + 1); ++b)
          ins16(cl, (sortkey(sv0[a] + sv1[b]) & ~255u) | (unsigned)(255 - (a * 16 + b)));
      float ex[16];
      float sum = 0.f;
      const float mx = unsortkey(cl[0] & ~255u);
#pragma unroll
      for (int i = 0; i < 16; ++i) { ex[i] = __expf(unsortkey(cl[i] & ~255u) - mx); sum += ex[i]; }
      const float inv = 1.f / sum;
      int eo[16];
#pragma unroll
      for (int i = 0; i < 16; ++i) {
        const int ci = 255 - (int)(cl[i] & 255u);
        const int a = ci >> 4, b = ci & 15;
        int i0 = 0, i1 = 0;
#pragma unroll
        for (int k = 0; k < 16; ++k) {
          i0 = (a == k) ? (127 - (int)(kc[0][k] & 127u)) : i0;
          i1 = (b == k) ? (127 - (int)(kc[1][k] & 127u)) : i1;
        }
        eo[i] = i0 * 128 + i1;
        ex[i] *= inv;
      }
      const size_t o = ((size_t)(m0 + row) * 8 + hd) * 16;
#pragma unroll
      for (int qd = 0; qd < 4; ++qd) {
        *(int4*)(IDX + o + qd * 4) = make_int4(eo[qd * 4], eo[qd * 4 + 1], eo[qd * 4 + 2], eo[qd * 4 + 3]);
        *(float4*)(GSM + o + qd * 4) = make_float4(ex[qd * 4], ex[qd * 4 + 1], ex[qd * 4 + 2], ex[qd * 4 + 3]);
      }
    }
  }
}

#define UB0(u) ((float)((u) & 0xffu))
#define UB1(u) ((float)(((u) >> 8) & 0xffu))
#define UB2(u) ((float)(((u) >> 16) & 0xffu))
#define UB3(u) ((float)((u) >> 24))
DI void phase10(KP p) {
  const int lane = tidx() & 63, w = tidx() >> 6;
  const int g = lane >> 4, l16 = lane & 15;
  bf16_t* ACT = (bf16_t*)(p->ws + OFF_ACT);
  const unsigned char* UB = (const unsigned char*)(p->ws + OFF_TAB);
  const unsigned char* VB = UB + TAB_V8;
  const float* USC = (const float*)(p->ws + OFF_TAB + TAB_SC);
  const float* VSC = USC + 16384;
  const int* IDX = (const int*)(p->ws + OFF_IDX);
  const float* GSM = (const float*)(p->ws + OFF_GSM);
  const float* pn = p->in[26];
  for (int t = blockIdx.x * 4 + w; t < T; t += gridDim.x * 4) {
    bf16_t* act = ACT + (size_t)t * 1024;
    float xf[64];
    float xsum = 0.f;
#pragma unroll
    for (int s = 0; s < 4; ++s) {
      const uint4 x0 = *(const uint4*)(act + s * 256 + l16 * 16);
      const uint4 x1 = *(const uint4*)(act + s * 256 + l16 * 16 + 8);
      const unsigned xx[8] = {x0.x, x0.y, x0.z, x0.w, x1.x, x1.y, x1.z, x1.w};
#pragma unroll
      for (int q = 0; q < 8; ++q) { xf[s * 16 + 2 * q] = lo2f(xx[q]); xf[s * 16 + 2 * q + 1] = hi2f(xx[q]); }
    }
#pragma unroll
    for (int k = 0; k < 64; ++k) xsum += xf[k];
    const int id0 = IDX[(size_t)t * 128 + lane], id1 = IDX[(size_t)t * 128 + 64 + lane];
    const float gs0 = GSM[(size_t)t * 128 + lane], gs1 = GSM[(size_t)t * 128 + 64 + lane];
    float acc[64];
#pragma unroll
    for (int k = 0; k < 64; ++k) acc[k] = 0.f;
    float csum = 0.f;
    for (int it = 0; it < 32; ++it) {
      const int n = (it * 4 + g) & 63;
      const int e = __shfl((it < 16) ? id0 : id1, n);
      const float gw = __shfl((it < 16) ? gs0 : gs1, n);
      const unsigned char* ur = UB + (size_t)e * 1024 + l16 * 16;
      const unsigned char* vr = VB + (size_t)e * 1024 + l16 * 16;
      uint4 uu[4], vv[4];
#pragma unroll
      for (int s = 0; s < 4; ++s) uu[s] = *(const uint4*)(ur + s * 256);
#pragma unroll
      for (int s = 0; s < 4; ++s) vv[s] = *(const uint4*)(vr + s * 256);
      const float su = USC[e], sv = VSC[e];
      float hv = 0.f;
#pragma unroll
      for (int s = 0; s < 4; ++s) {
        const unsigned ww[4] = {uu[s].x, uu[s].y, uu[s].z, uu[s].w};
#pragma unroll
        for (int q = 0; q < 4; ++q) {
          hv = fmaf(xf[s * 16 + q * 4 + 0], UB0(ww[q]), hv);
          hv = fmaf(xf[s * 16 + q * 4 + 1], UB1(ww[q]), hv);
          hv = fmaf(xf[s * 16 + q * 4 + 2], UB2(ww[q]), hv);
          hv = fmaf(xf[s * 16 + q * 4 + 3], UB3(ww[q]), hv);
        }
      }
      hv = fmaf(-128.f, xsum, hv);
      hv = allreduce16(hv) * su;
      const float c = 0.5f * hv * (1.f + erff(hv * 0.70710678118f)) * gw * sv;
      csum += c;
#pragma unroll
      for (int s = 0; s < 4; ++s) {
        const unsigned ww[4] = {vv[s].x, vv[s].y, vv[s].z, vv[s].w};
#pragma unroll
        for (int q = 0; q < 4; ++q) {
          acc[s * 16 + q * 4 + 0] = fmaf(c, UB0(ww[q]), acc[s * 16 + q * 4 + 0]);
          acc[s * 16 + q * 4 + 1] = fmaf(c, UB1(ww[q]), acc[s * 16 + q * 4 + 1]);
          acc[s * 16 + q * 4 + 2] = fmaf(c, UB2(ww[q]), acc[s * 16 + q * 4 + 2]);
          acc[s * 16 + q * 4 + 3] = fmaf(c, UB3(ww[q]), acc[s * 16 + q * 4 + 3]);
        }
      }
    }
    const float cs128 = 128.f * csum;
#pragma unroll
    for (int k = 0; k < 64; ++k) {
      acc[k] -= cs128;
      acc[k] += __shfl_xor(acc[k], 16);
      acc[k] += __shfl_xor(acc[k], 32);
    }
    float* hrow = p->out + (size_t)t * 1024;
    float hvv[16];
#pragma unroll
    for (int s = 0; s < 4; ++s) {
      if (s == g) {
        float* hp = hrow + s * 256 + l16 * 16;
#pragma unroll
        for (int q = 0; q < 4; ++q) {
          float4 h0 = *(float4*)(hp + q * 4);
          h0.x += acc[s * 16 + q * 4 + 0]; h0.y += acc[s * 16 + q * 4 + 1]; h0.z += acc[s * 16 + q * 4 + 2]; h0.w += acc[s * 16 + q * 4 + 3];
          *(float4*)(hp + q * 4) = h0;
          hvv[q * 4 + 0] = h0.x; hvv[q * 4 + 1] = h0.y; hvv[q * 4 + 2] = h0.z; hvv[q * 4 + 3] = h0.w;
        }
      }
    }
    float ss = 0.f;
#pragma unroll
    for (int k = 0; k < 16; ++k) ss += hvv[k] * hvv[k];
    ss = wave_sum(ss);
    const float scl = rsqrtf(ss * (1.f / 1024.f) + 1e-6f);
    {
      const int col = g * 256 + l16 * 16;
      unsigned o8[8];
#pragma unroll
      for (int q = 0; q < 4; ++q) {
        const float4 g0 = *(const float4*)(pn + col + q * 4);
        o8[q * 2] = pack2(hvv[q * 4 + 0] * scl * g0.x, hvv[q * 4 + 1] * scl * g0.y);
        o8[q * 2 + 1] = pack2(hvv[q * 4 + 2] * scl * g0.z, hvv[q * 4 + 3] * scl * g0.w);
      }
      *(uint4*)(act + col) = make_uint4(o8[0], o8[1], o8[2], o8[3]);
      *(uint4*)(act + col + 8) = make_uint4(o8[4], o8[5], o8[6], o8[7]);
    }
  }
}

DI void phase11(KP p, char* smem) {
  for (int tile = blockIdx.x; tile < 136 * 8; tile += gridDim.x) {
    const int mt = tile >> 3, nt = tile & 7;
    const int m0 = mt * 128, n0 = nt * 128;
    f32x16 acc[2][2];
    unsigned ppk[2][2][8];
    const float* pa = (m0 < TP) ? p->in[5] + (size_t)m0 * 256 : p->in[6] + (size_t)(m0 - TP) * 256;
    gemm128<true>(pa, 256, (const bf16_t*)(p->ws + OFF_PP) + (size_t)n0 * 256, 256, 256, acc, smem);
#pragma unroll
    for (int mi = 0; mi < 2; ++mi)
#pragma unroll
      for (int ni = 0; ni < 2; ++ni)
#pragma unroll
        for (int i = 0; i < 8; ++i) ppk[mi][ni][i] = pack2(acc[mi][ni][2 * i], acc[mi][ni][2 * i + 1]);
    gemm128<false>((const bf16_t*)(p->ws + OFF_ACT) + (size_t)m0 * 1024, 1024,
                   (const bf16_t*)(p->ws + OFF_PG) + (size_t)n0 * 1024, 1024, 1024, acc, smem);
    const int lane = tidx() & 63, w = tidx() >> 6;
    const int wm = w >> 1, wn = w & 1, r = lane & 31, h = lane >> 5;
#pragma unroll
    for (int mi = 0; mi < 2; ++mi)
#pragma unroll
      for (int ni = 0; ni < 2; ++ni)
#pragma unroll
        for (int i = 0; i < 16; ++i) {
          const float pp = (i & 1) ? hi2f(ppk[mi][ni][i >> 1]) : lo2f(ppk[mi][ni][i >> 1]);
          acc[mi][ni][i] = sigmoidf_(acc[mi][ni][i]) * pp;
        }
#pragma unroll
    for (int mi = 0; mi < 2; ++mi) {
#pragma unroll
      for (int ni = 0; ni < 2; ++ni)
#pragma unroll
        for (int i = 0; i < 16; ++i)
          acc[mi][ni][i] += p->out[(size_t)(m0 + wm * 64 + mi * 32 + crow(i, h)) * 1024 + n0 + wn * 64 + ni * 32 + r];
#pragma unroll
      for (int ni = 0; ni < 2; ++ni)
#pragma unroll
        for (int i = 0; i < 16; ++i)
          p->out[(size_t)(m0 + wm * 64 + mi * 32 + crow(i, h)) * 1024 + n0 + wn * 64 + ni * 32 + r] = acc[mi][ni][i];
    }
  }
}

DI void phase12(KP p) {
  const int lane = tidx() & 63, w = tidx() >> 6;
  const float* g = p->in[29];
  for (int t = blockIdx.x * 4 + w; t < T; t += gridDim.x * 4) {
    float* x = p->out + (size_t)t * 1024;
    float4 v[4];
    float ss = 0.f;
#pragma unroll
    for (int i = 0; i < 4; ++i) {
      v[i] = ((const float4*)x)[i * 64 + lane];
      ss += v[i].x * v[i].x + v[i].y * v[i].y + v[i].z * v[i].z + v[i].w * v[i].w;
    }
    ss = wave_sum(ss);
    const float sc = rsqrtf(ss * (1.f / 1024.f) + 1e-6f);
#pragma unroll
    for (int i = 0; i < 4; ++i) {
      const float4 gg = ((const float4*)g)[i * 64 + lane];
      ((float4*)x)[i * 64 + lane] = make_float4(v[i].x * sc * gg.x, v[i].y * sc * gg.y, v[i].z * sc * gg.z, v[i].w * sc * gg.w);
    }
  }
}

DI void run_phase(int ph, char* smem) {
  KP p = getp();
  switch (ph) {
    case 0: phase0(p, smem); break;
    case 1: phase1(p, smem); break;
    case 2: phase2(p); break;
    case 3: phase3(p, smem); break;
    case 4: phase4(p, smem); break;
    case 5: phase5(p); break;
    case 6: phase6(p, smem); break;
    case 7: phase7(p); break;
    case 8: phase8(p, smem); break;
    case 9: phase9(p, smem); break;
    case 10: phase10(p); break;
    case 11: phase11(p, smem); break;
    case 12: phase12(p); break;
    default: break;
  }
}

template <int LO, int HI>
__global__ void __launch_bounds__(256, 2) mega_kernel(Params p) {
  __shared__ __attribute__((aligned(16))) char smem[SMEM_BYTES];
  __shared__ uint4 xb_words;
  if (gridDim.x == 0x7fffffffu) cg::this_grid().sync();
  XcdBarrier xb;
  if (HI - LO > 1) {
    if (threadIdx.x == 0) xb_words = make_uint4(0u, 0u, 0u, 0u);
    __syncthreads();
    xb = xcd_barrier_post((unsigned*)(getp()->ws + OFF_CTR), (volatile LAS unsigned*)&xb_words);
  }
#pragma unroll
  for (int ph = LO; ph < HI; ++ph) {
    run_phase(ph, smem);
    if (ph + 1 < HI) xcd_barrier(xb);
  }
}

template <int PH>
static void launch_phases(const Params& p, int grid, hipStream_t stream) {
  hipLaunchKernelGGL((mega_kernel<PH, PH + 1>), dim3(grid), dim3(256), 0, stream, p);
  if constexpr (PH + 1 < 13) launch_phases<PH + 1>(p, grid, stream);
}

extern "C" void kernel_launch(void* const* d_in, const int* in_sizes, int n_in, void* d_out, int out_size,
                              void* d_ws, size_t ws_size, hipStream_t stream) {
  static int grid_blocks = 0;
  if (!grid_blocks) {
    int dev = 0, cus = 0, per_cu = 0;
    (void)hipGetDevice(&dev);
    (void)hipDeviceGetAttribute(&cus, hipDeviceAttributeMultiprocessorCount, dev);
#if MK_MULTI
    per_cu = 2;
#else
    (void)hipOccupancyMaxActiveBlocksPerMultiprocessor(&per_cu, mega_kernel<0, 13>, 256, 0);
#endif
    if (per_cu < 1) per_cu = 1;
    if (per_cu > 2) per_cu = 2;
    grid_blocks = cus * per_cu;
  }
  Params p{};
  for (int i = 0; i < 30; ++i) p.in[i] = (const float*)d_in[i];
  p.out = (float*)d_out;
  p.ws = (char*)d_ws;
  if (ws_size < WS_END) { fprintf(stderr, "workspace too small: %zu < %zu\n", ws_size, (size_t)WS_END); return; }
  (void)hipMemsetAsync((char*)d_ws + OFF_CTR, 0, 32768, stream);
#if MK_MULTI
  launch_phases<0>(p, grid_blocks, stream);
#else
  void* args[] = {&p};
  hipError_t e = hipLaunchCooperativeKernel((void*)mega_kernel<0, 13>, dim3(grid_blocks), dim3(256), args, 0, stream);
  if (e != hipSuccess) fprintf(stderr, "cooperative launch failed: %s (grid %d)\n", hipGetErrorString(e), grid_blocks);
#endif
}
```

```cpp
#include <hip/hip_runtime.h>
#include <hip/hip_cooperative_groups.h>
#include <cstdio>
namespace cg = cooperative_groups;

#ifndef MK_MULTI
#define MK_MULTI 0
#endif

typedef unsigned short bf16_t;
typedef __attribute__((ext_vector_type(8))) short bf16x8;
typedef __attribute__((ext_vector_type(16))) float f32x16;
typedef __attribute__((ext_vector_type(2))) __bf16 bf2_t;
typedef __attribute__((ext_vector_type(2))) float f2_t;
#define DI __device__ __forceinline__

constexpr int T = 17408, TP = 16384;
constexpr int NPH = 14;

constexpr size_t O_RETP = (size_t)T * 1024;
constexpr size_t O_WKVP = O_RETP + 262144;
constexpr size_t O_SHP = O_WKVP + 262144;
constexpr size_t O_RETS = O_SHP + 14336;
constexpr size_t O_WKVS = O_RETS + 4194304;
constexpr size_t O_SHS = O_WKVS + 4194304;

constexpr size_t OFF_WIN = 0;
constexpr size_t OFF_WOUT = OFF_WIN + (size_t)3840 * 1024 * 2;
constexpr size_t OFF_WQ = OFF_WOUT + (size_t)1024 * 1024 * 2;
constexpr size_t OFF_KEYS = OFF_WQ + (size_t)2048 * 1024 * 2;
constexpr size_t OFF_PG = OFF_KEYS + (size_t)16 * 128 * 128 * 2;
constexpr size_t OFF_PP = OFF_PG + (size_t)1024 * 1024 * 2;
constexpr size_t OFF_W2 = OFF_PP + (size_t)1024 * 256 * 2;
constexpr size_t OFF_A2 = OFF_W2 + (size_t)512 * 64 * 2;
constexpr size_t OFF_G2 = OFF_A2 + (size_t)512 * 64 * 2;
constexpr size_t OFF_ROPE = OFF_G2 + (size_t)512 * 128 * 2;
constexpr size_t OFF_CTR = OFF_ROPE + (size_t)2056 * 32 * 2 * 4;
constexpr size_t OFF_ACT = OFF_CTR + 32768;
constexpr size_t OFF_TAB = OFF_ACT + (size_t)T * 1024 * 2;
constexpr size_t OFF_PREP = OFF_TAB + (size_t)2 * 16384 * 1024 * 2;
constexpr size_t SZ512 = (size_t)T * 512 * 2;
constexpr size_t OFF_R = OFF_PREP;
constexpr size_t OFF_K = OFF_R + SZ512;
constexpr size_t OFF_V = OFF_K + SZ512;
constexpr size_t OFF_KK = OFF_V + SZ512;
constexpr size_t OFF_BB = OFF_KK + SZ512;
constexpr size_t OFF_GATE = OFF_BB + SZ512;
constexpr size_t OFF_EW = OFF_GATE + SZ512;
constexpr size_t OFF_LORA = OFF_EW + (size_t)T * 512 * 4;
constexpr size_t OFF_INVN = OFF_LORA + (size_t)T * 256 * 2;
constexpr size_t WS_END = OFF_INVN + (size_t)T * 8 * 4;
constexpr size_t OFF_QPEER = OFF_PREP;
constexpr size_t OFF_IDX = OFF_QPEER + (size_t)T * 2048 * 2;
constexpr size_t OFF_GSM = OFF_IDX + (size_t)T * 128 * 4;

constexpr int SMEM_BYTES = 79872;

struct Params {
  const float* in[30];
  float* out;
  char* ws;
};

typedef const __attribute__((address_space(4))) Params* KP;
__device__ __forceinline__ KP getp() {
  KP q = (KP)__builtin_amdgcn_kernarg_segment_ptr();
  asm volatile("" : "+s"(q));
  return q;
}
DI int tidx() { int t = threadIdx.x; asm volatile("" : "+v"(t)); return t; }
DI bf16_t f2bf(float x) { unsigned u = __float_as_uint(x); u += 0x7fffu + ((u >> 16) & 1u); return (bf16_t)(u >> 16); }
DI float bf2f(bf16_t b) { return __uint_as_float(((unsigned)b) << 16); }
DI unsigned pack2(float a, float b) { return (unsigned)f2bf(a) | ((unsigned)f2bf(b) << 16); }
DI float lo2f(unsigned u) { return __uint_as_float(u << 16); }
DI float hi2f(unsigned u) { return __uint_as_float(u & 0xffff0000u); }
DI int crow(int reg, int h) { return (reg & 3) + 8 * (reg >> 2) + 4 * h; }
DI float wave_sum(float v) {
#pragma unroll
  for (int o = 32; o >= 1; o >>= 1) v += __shfl_xor(v, o);
  return v;
}
DI float allreduce16(float v) {
  v += __int_as_float(__builtin_amdgcn_update_dpp(0, __float_as_int(v), 0x128, 0xf, 0xf, false));
  v += __int_as_float(__builtin_amdgcn_update_dpp(0, __float_as_int(v), 0x124, 0xf, 0xf, false));
  v += __int_as_float(__builtin_amdgcn_update_dpp(0, __float_as_int(v), 0x122, 0xf, 0xf, false));
  v += __int_as_float(__builtin_amdgcn_update_dpp(0, __float_as_int(v), 0x121, 0xf, 0xf, false));
  return v;
}
#define DPP_ADD(v, ctrl) v += __int_as_float(__builtin_amdgcn_update_dpp(0, __float_as_int(v), ctrl, 0xf, 0xf, false))
DI void allreduce16x2(float& a, float& b) {
  DPP_ADD(a, 0x128); DPP_ADD(b, 0x128);
  DPP_ADD(a, 0x124); DPP_ADD(b, 0x124);
  DPP_ADD(a, 0x122); DPP_ADD(b, 0x122);
  DPP_ADD(a, 0x121); DPP_ADD(b, 0x121);
}
DI float allreduce8(float v) {
  v += __int_as_float(__builtin_amdgcn_update_dpp(0, __float_as_int(v), 0xB1, 0xf, 0xf, false));
  v += __int_as_float(__builtin_amdgcn_update_dpp(0, __float_as_int(v), 0x4E, 0xf, 0xf, false));
  v += __int_as_float(__builtin_amdgcn_update_dpp(0, __float_as_int(v), 0x141, 0xf, 0xf, false));
  return v;
}
DI void unpack8f(const uint4& u, float (&f)[8]) {
  f[0] = lo2f(u.x); f[1] = hi2f(u.x); f[2] = lo2f(u.y); f[3] = hi2f(u.y);
  f[4] = lo2f(u.z); f[5] = hi2f(u.z); f[6] = lo2f(u.w); f[7] = hi2f(u.w);
}
DI uint4 pack8f(const float (&f)[8]) {
  return make_uint4(pack2(f[0], f[1]), pack2(f[2], f[3]), pack2(f[4], f[5]), pack2(f[6], f[7]));
}
DI float sigmoidf_(float x) { return 1.f / (1.f + __expf(-x)); }
DI const float* xrow(KP p, int t) {
  return t < TP ? p->in[0] + (size_t)t * 1024 : p->in[1] + (size_t)(t - TP) * 1024;
}
struct TokInfo { int sample, b, l; };
DI TokInfo tokinfo(int t) {
  TokInfo ti;
  if (t >= TP) { ti.sample = 1; ti.b = (t - TP) >> 3; ti.l = (t - TP) & 7; }
  else { ti.sample = 0; ti.b = t >> 11; ti.l = t & 2047; }
  return ti;
}

#define XB_TMO      128
#define XB_XCNT(j)  (256  + 64 * (j))
#define XB_XSUB(j)  (1280 + 64 * (j))
#define XB_XGEN(j)  (2304 + 64 * (j))
#define XB_TOP      3328
#define XB_TOPGEN   3392
#define XCD_BAR_WORDS 3456
#define XB_SPIN_CAP (1u << 20)
#define LAS __attribute__((address_space(3)))
DI unsigned xb_ld(unsigned* p) { return __hip_atomic_load(p, __ATOMIC_RELAXED, __HIP_MEMORY_SCOPE_AGENT); }
DI unsigned xb_add(unsigned* p, unsigned v) { return __hip_atomic_fetch_add(p, v, __ATOMIC_RELAXED, __HIP_MEMORY_SCOPE_AGENT); }
DI unsigned xb_xcc_id() { return (unsigned)__builtin_amdgcn_s_getreg((3 << 11) | 20) & 0xFu; }
#define XB_SPIN(cond, bar) do { unsigned _sp = 0; while (cond) { __builtin_amdgcn_s_sleep(1); \
    if ((++_sp & 255u) == 0u) { if (xb_ld(&(bar)[XB_TMO])) break; if (_sp > XB_SPIN_CAP) { atomicAdd(&(bar)[XB_TMO], 1u); break; } } } } while (0)
struct XcdBarrier { unsigned* bar; unsigned x; volatile LAS unsigned* st; };
DI XcdBarrier xcd_barrier_post(unsigned* bar, volatile LAS unsigned* st) {
  XcdBarrier b; b.bar = bar; b.x = xb_xcc_id(); b.st = st;
  if (threadIdx.x == 0) (void)xb_add(&bar[XB_XCNT(b.x)], 1u);
  return b;
}
DI void xcd_barrier_complete(unsigned* bar, unsigned x, unsigned& nloc, unsigned& nx) {
  const unsigned G = gridDim.x * gridDim.y * gridDim.z;
  unsigned sum, cnt, mine, sp = 0u;
  for (;;) {
    sum = 0u; cnt = 0u; mine = 0u;
#pragma unroll
    for (unsigned j = 0; j < 16; ++j) { const unsigned c = xb_ld(&bar[XB_XCNT(j)]); sum += c; cnt += (c > 0u) ? 1u : 0u; mine = (j == x) ? c : mine; }
    if (sum == G) break;
    __builtin_amdgcn_s_sleep(1);
    if ((++sp & 255u) == 0u) { if (xb_ld(&bar[XB_TMO])) break; if (sp > XB_SPIN_CAP) { atomicAdd(&bar[XB_TMO], 1u); break; } }
  }
  nloc = mine > 0u ? mine : 1u; nx = cnt > 0u ? cnt : 1u;
}
DI void xcd_barrier(const XcdBarrier& b) {
  asm volatile("s_waitcnt vmcnt(0)" ::: "memory");
  __syncthreads();
  if (threadIdx.x == 0) {
    unsigned* bar = b.bar;
    __builtin_amdgcn_s_waitcnt(0);
    unsigned nloc = b.st[0], nx = b.st[1];
    if (nloc == 0u) { xcd_barrier_complete(bar, b.x, nloc, nx); b.st[0] = nloc; b.st[1] = nx; }
    const unsigned old = xb_add(&bar[XB_XSUB(b.x)], 1u);
    const unsigned gen = old / nloc;
    if (old + 1u == (gen + 1u) * nloc) {
      __builtin_amdgcn_fence(__ATOMIC_RELEASE, "agent");
      asm volatile("s_waitcnt vmcnt(0)" ::: "memory");
      const unsigned og = xb_add(&bar[XB_TOP], 1u);
      const unsigned tg = og / nx;
      if (og + 1u == (tg + 1u) * nx) xb_add(&bar[XB_TOPGEN], 1u);
      else XB_SPIN(xb_ld(&bar[XB_TOPGEN]) == tg, bar);
      __builtin_amdgcn_fence(__ATOMIC_ACQUIRE, "agent");
      xb_add(&bar[XB_XGEN(b.x)], 1u);
      asm volatile("s_waitcnt vmcnt(0)" ::: "memory");
    } else {
      XB_SPIN(xb_ld(&bar[XB_XGEN(b.x)]) == gen, bar);
      __builtin_amdgcn_fence(__ATOMIC_ACQUIRE, "agent");
      asm volatile("s_waitcnt vmcnt(0)" ::: "memory");
    }
  }
  __syncthreads();
}

constexpr int LDT = 72;
constexpr int GBUF = 2 * 128 * LDT;
template <bool AF32>
DI void gemm128(const void* __restrict__ Ap, int lda, const bf16_t* __restrict__ Bt, int ldb, int K,
                f32x16 (&acc)[2][2], char* smem) {
  bf16_t* S0 = (bf16_t*)smem;
  const int tid = tidx(), lane = tid & 63, w = tid >> 6;
  const int wm = w >> 1, wn = w & 1, r = lane & 31, h = lane >> 5;
  const int lrow = tid >> 3, lch = tid & 7;
#pragma unroll
  for (int i = 0; i < 2; ++i)
#pragma unroll
    for (int j = 0; j < 2; ++j)
#pragma unroll
      for (int e = 0; e < 16; ++e) acc[i][j][e] = 0.f;
  uint4 ra0, ra1, ra2, ra3, rb0, rb1, rb2, rb3;
  const bf16_t* Ab = (const bf16_t*)Ap + (size_t)lrow * lda + lch * 8;
  const float* Af = (const float*)Ap + (size_t)lrow * lda + lch * 8;
  const bf16_t* Bb = Bt + (size_t)lrow * ldb + lch * 8;
  const size_t a32 = (size_t)32 * lda, b32 = (size_t)32 * ldb;
#define GEMM_LDA(dst, q, k0)                                                                          \
  if constexpr (AF32) {                                                                               \
    const float4 f0 = *(const float4*)(Af + (q) * a32 + (k0));                                        \
    const float4 f1 = *(const float4*)(Af + (q) * a32 + (k0) + 4);                                    \
    dst = make_uint4(pack2(f0.x, f0.y), pack2(f0.z, f0.w), pack2(f1.x, f1.y), pack2(f1.z, f1.w));     \
  } else {                                                                                            \
    dst = *(const uint4*)(Ab + (q) * a32 + (k0));                                                     \
  }
#define GEMM_LOADG(k0)                                                                                \
  {                                                                                                   \
    GEMM_LDA(ra0, 0, k0) GEMM_LDA(ra1, 1, k0) GEMM_LDA(ra2, 2, k0) GEMM_LDA(ra3, 3, k0)               \
    rb0 = *(const uint4*)(Bb + (k0));                                                                 \
    rb1 = *(const uint4*)(Bb + b32 + (k0));                                                           \
    rb2 = *(const uint4*)(Bb + 2 * b32 + (k0));                                                       \
    rb3 = *(const uint4*)(Bb + 3 * b32 + (k0));                                                       \
  }
#define GEMM_STORE(buf)                                                                               \
  {                                                                                                   \
    bf16_t* ad = S0 + (buf) * GBUF + lrow * LDT + lch * 8;                                            \
    bf16_t* bd = ad + 128 * LDT;                                                                      \
    *(uint4*)(ad) = ra0; *(uint4*)(ad + 32 * LDT) = ra1; *(uint4*)(ad + 64 * LDT) = ra2; *(uint4*)(ad + 96 * LDT) = ra3; \
    *(uint4*)(bd) = rb0; *(uint4*)(bd + 32 * LDT) = rb1; *(uint4*)(bd + 64 * LDT) = rb2; *(uint4*)(bd + 96 * LDT) = rb3; \
  }
  const int nk = K >> 6;
  GEMM_LOADG(0)
  GEMM_STORE(0)
  if (nk > 1) GEMM_LOADG(64)
  __syncthreads();
  for (int kt = 0; kt < nk; ++kt) {
    if (kt + 1 < nk) GEMM_STORE((kt + 1) & 1)
    if (kt + 2 < nk) GEMM_LOADG((kt + 2) << 6)
    __builtin_amdgcn_sched_barrier(0);
    const bf16_t* As = S0 + (kt & 1) * GBUF;
    const bf16_t* Bs = As + 128 * LDT;
#pragma unroll
    for (int ks = 0; ks < 4; ++ks) {
      bf16x8 a0 = *(const bf16x8*)(As + (wm * 64 + r) * LDT + ks * 16 + h * 8);
      bf16x8 a1 = *(const bf16x8*)(As + (wm * 64 + 32 + r) * LDT + ks * 16 + h * 8);
      bf16x8 b0 = *(const bf16x8*)(Bs + (wn * 64 + r) * LDT + ks * 16 + h * 8);
      bf16x8 b1 = *(const bf16x8*)(Bs + (wn * 64 + 32 + r) * LDT + ks * 16 + h * 8);
      acc[0][0] = __builtin_amdgcn_mfma_f32_32x32x16_bf16(a0, b0, acc[0][0], 0, 0, 0);
      acc[0][1] = __builtin_amdgcn_mfma_f32_32x32x16_bf16(a0, b1, acc[0][1], 0, 0, 0);
      acc[1][0] = __builtin_amdgcn_mfma_f32_32x32x16_bf16(a1, b0, acc[1][0], 0, 0, 0);
      acc[1][1] = __builtin_amdgcn_mfma_f32_32x32x16_bf16(a1, b1, acc[1][1], 0, 0, 0);
    }
    __syncthreads();
  }
}
template <class F>
DI void epi_each(f32x16 (&acc)[2][2], F f) {
  const int lane = tidx() & 63, w = tidx() >> 6;
  const int wm = w >> 1, wn = w & 1, r = lane & 31, h = lane >> 5;
#pragma unroll
  for (int mi = 0; mi < 2; ++mi)
#pragma unroll
    for (int ni = 0; ni < 2; ++ni)
#pragma unroll
      for (int i = 0; i < 16; ++i) f(wm * 64 + mi * 32 + crow(i, h), wn * 64 + ni * 32 + r, acc[mi][ni][i]);
}

DI void transpose_tile(const float* __restrict__ src, bf16_t* __restrict__ dst, int K, int N, int kt, int nt, float* sm) {
  const int tid = tidx();
  const int k0 = kt * 64, n0 = nt * 64;
#pragma unroll
  for (int i = 0; i < 16; ++i) {
    int k = i * 4 + (tid >> 6), n = tid & 63;
    sm[k * 65 + n] = src[(size_t)(k0 + k) * N + n0 + n];
  }
  __syncthreads();
  int n = tid >> 2, ks = (tid & 3) * 16;
  unsigned pk[8];
#pragma unroll
  for (int j = 0; j < 8; ++j) pk[j] = pack2(sm[(ks + 2 * j) * 65 + n], sm[(ks + 2 * j + 1) * 65 + n]);
  uint4* d = (uint4*)(dst + (size_t)(n0 + n) * K + k0 + ks);
  d[0] = make_uint4(pk[0], pk[1], pk[2], pk[3]);
  d[1] = make_uint4(pk[4], pk[5], pk[6], pk[7]);
  __syncthreads();
}
DI void rmsnorm_row_bf(const float* __restrict__ x, const float* __restrict__ g, bf16_t* __restrict__ o, int lane) {
  float4 v[4];
  float ss = 0.f;
#pragma unroll
  for (int i = 0; i < 4; ++i) {
    v[i] = ((const float4*)x)[i * 64 + lane];
    ss += v[i].x * v[i].x + v[i].y * v[i].y + v[i].z * v[i].z + v[i].w * v[i].w;
  }
  ss = wave_sum(ss);
  float sc = rsqrtf(ss * (1.f / 1024.f) + 1e-6f);
#pragma unroll
  for (int i = 0; i < 4; ++i) {
    float4 gg = ((const float4*)g)[i * 64 + lane];
    uint2 pk = make_uint2(pack2(v[i].x * sc * gg.x, v[i].y * sc * gg.y), pack2(v[i].z * sc * gg.z, v[i].w * sc * gg.w));
    ((uint2*)o)[i * 64 + lane] = pk;
  }
}

#define TJ(IDX, OFF, KK_, NN_)                                                                             \
  {                                                                                                        \
    const int ntl = ((KK_) / 64) * ((NN_) / 64);                                                           \
    if (it < ntl) {                                                                                        \
      transpose_tile(p->in[IDX], (bf16_t*)(p->ws + (OFF)), (KK_), (NN_), it / ((NN_) / 64), it % ((NN_) / 64), (float*)smem); \
      continue;                                                                                            \
    }                                                                                                      \
    it -= ntl;                                                                                             \
  }

DI void phase0(KP p, char* smem) {
  const int tid = tidx(), lane = tid & 63, w = tid >> 6;
  constexpr int N_TR = 960 + 8 + 8 + 16;
  constexpr int N_KEYS = 128, N_ROPE = 257, N_NORM = T / 4;
  for (int item = blockIdx.x; item < N_TR + N_KEYS + N_ROPE + N_NORM; item += gridDim.x) {
    int it = item;
    TJ(8, OFF_WIN, 1024, 3840)
    TJ(11, OFF_W2, 64, 512)
    TJ(13, OFF_A2, 64, 512)
    TJ(14, OFF_G2, 128, 512)
    if (it < N_KEYS) {
      const float* src = p->in[23] + (size_t)it * 2048 + tid * 8;
      float4 f0 = *(const float4*)src, f1 = *(const float4*)(src + 4);
      *(uint4*)((bf16_t*)(p->ws + OFF_KEYS) + (size_t)it * 2048 + tid * 8) =
          make_uint4(pack2(f0.x, f0.y), pack2(f0.z, f0.w), pack2(f1.x, f1.y), pack2(f1.z, f1.w));
      continue;
    }
    it -= N_KEYS;
    if (it < N_ROPE) {
      int e = it * 256 + tid;
      int pidx = e >> 5, f = e & 31;
      if (pidx < 2056) {
        const float pos = (pidx < 2048) ? (float)pidx : (float)(16384 + pidx - 2048);
        const float inv = exp2f(-(float)f * 0.41524101186092f);
        const float ang = pos * inv;
        const float kq = rintf(ang * 0.15915494309189535f);
        float rr = fmaf(-kq, 6.28125f, ang);
        rr = fmaf(-kq, 1.9353071795864769e-3f, rr);
        float* rt = (float*)(p->ws + OFF_ROPE);
        rt[e * 2] = cosf(rr);
        rt[e * 2 + 1] = sinf(rr);
      }
      continue;
    }
    it -= N_ROPE;
    {
      int t = it * 4 + w;
      rmsnorm_row_bf(xrow(p, t), p->in[7], (bf16_t*)(p->ws + OFF_ACT) + (size_t)t * 1024, lane);
    }
  }
}

DI void phase1(KP p, char* smem) {
  const int lane = tidx() & 63, w = tidx() >> 6;
  const int wm = w >> 1, wn = w & 1, r = lane & 31, h = lane >> 5;
  bf16_t* RET = (bf16_t*)p->out;
  bf16_t* RWP = (bf16_t*)(p->ws + OFF_TAB);
  const float2* rope = (const float2*)(p->ws + OFF_ROPE);
  for (int tile = blockIdx.x; tile < 136 * 30; tile += gridDim.x) {
    const int mt = tile / 30, nt = tile % 30;
    const int m0 = mt * 128, n0 = nt * 128;
    f32x16 acc[2][2];
    gemm128<false>((const bf16_t*)(p->ws + OFF_ACT) + (size_t)m0 * 1024, 1024,
                   (const bf16_t*)(p->ws + OFF_WIN) + (size_t)n0 * 1024, 1024, 1024, acc, smem);
    const int nb = n0 + wn * 64;
    if (nb < 1024) {
      float2 cs[2][16];
#pragma unroll
      for (int mi = 0; mi < 2; ++mi)
#pragma unroll
        for (int i = 0; i < 16; ++i) {
          const TokInfo ti = tokinfo(m0 + wm * 64 + mi * 32 + crow(i, h));
          cs[mi][i] = rope[(ti.sample ? 2048 + ti.l : ti.l) * 32 + r];
        }
      const float scl = (nb >= 512) ? 0.125f : 1.f;
#pragma unroll
      for (int mi = 0; mi < 2; ++mi)
#pragma unroll
        for (int i = 0; i < 16; ++i) {
          const float v0 = acc[mi][0][i], v1 = acc[mi][1][i];
          acc[mi][0][i] = (v0 * cs[mi][i].x - v1 * cs[mi][i].y) * scl;
          acc[mi][1][i] = (v1 * cs[mi][i].x + v0 * cs[mi][i].y) * scl;
        }
    }
#pragma unroll
    for (int mi = 0; mi < 2; ++mi)
#pragma unroll
      for (int i = 0; i < 16; ++i) {
        const int t = m0 + wm * 64 + mi * 32 + crow(i, h);
        const float v0 = acc[mi][0][i], v1 = acc[mi][1][i];
        if (nb < 2048) {
          RET[(size_t)t * 2048 + nb + r] = f2bf(v0);
          RET[(size_t)t * 2048 + nb + 32 + r] = f2bf(v1);
        } else {
          const TokInfo ti = tokinfo(t);
          const int c = nb - 2048 + r;
          RWP[(size_t)t * 1792 + c] = f2bf(v0);
          RWP[(size_t)t * 1792 + c + 32] = f2bf(v1);
          if (ti.sample) {
            if (ti.l == 7) { p->out[O_SHS + ti.b * 1792 + c] = v0; p->out[O_SHS + ti.b * 1792 + c + 32] = v1; }
          } else {
            if (ti.l == 2047) { p->out[O_SHP + ti.b * 1792 + c] = v0; p->out[O_SHP + ti.b * 1792 + c + 32] = v1; }
          }
        }
      }
  }
}

DI void phase2(KP p) {
  const int lane = tidx() & 63, w = tidx() >> 6;
  const bf16_t* RWP = (const bf16_t*)(p->ws + OFF_TAB);
  bf16_t* Rb = (bf16_t*)(p->ws + OFF_R);
  bf16_t* Kb = (bf16_t*)(p->ws + OFF_K);
  bf16_t* Vb = (bf16_t*)(p->ws + OFF_V);
  bf16_t* LA = (bf16_t*)(p->ws + OFF_LORA);
  float* INVN = (float*)(p->ws + OFF_INVN);
  const float* mu = p->in[9];
  const float* kkw = p->in[15];
  for (int t = blockIdx.x * 4 + w; t < T; t += gridDim.x * 4) {
    const TokInfo ti = tokinfo(t);
    const bf16_t* cur = RWP + (size_t)t * 1792;
    const bf16_t* prv = cur - 1792;
    const float* sh = p->in[4] + (size_t)ti.b * 1792;
    float f[4][8];
#pragma unroll
    for (int i = 0; i < 4; ++i) {
      const int c8 = (lane + 64 * i) * 8;
      if (i < 3 || lane < 32) {
        float cv[8], pv[8];
        unpack8f(*(const uint4*)(cur + c8), cv);
        if (ti.l > 0) unpack8f(*(const uint4*)(prv + c8), pv);
        else if (ti.sample) {
          const float4 s0 = *(const float4*)(sh + c8), s1 = *(const float4*)(sh + c8 + 4);
          pv[0] = s0.x; pv[1] = s0.y; pv[2] = s0.z; pv[3] = s0.w; pv[4] = s1.x; pv[5] = s1.y; pv[6] = s1.z; pv[7] = s1.w;
        } else {
#pragma unroll
          for (int k = 0; k < 8; ++k) pv[k] = 0.f;
        }
        const float4 m0 = *(const float4*)(mu + c8), m1 = *(const float4*)(mu + c8 + 4);
        const float mm[8] = {m0.x, m0.y, m0.z, m0.w, m1.x, m1.y, m1.z, m1.w};
#pragma unroll
        for (int k = 0; k < 8; ++k) f[i][k] = cv[k] + (pv[k] - cv[k]) * mm[k];
      } else {
#pragma unroll
        for (int k = 0; k < 8; ++k) f[i][k] = 0.f;
      }
    }
    *(uint4*)(Rb + (size_t)t * 512 + lane * 8) = pack8f(f[0]);
    {
      const uint4 kb = pack8f(f[1]);
      *(uint4*)(Kb + (size_t)t * 512 + lane * 8) = kb;
      float kr[8];
      unpack8f(kb, kr);
      const float4 q0 = *(const float4*)(kkw + lane * 8), q1 = *(const float4*)(kkw + lane * 8 + 4);
      const float qq[8] = {q0.x, q0.y, q0.z, q0.w, q1.x, q1.y, q1.z, q1.w};
      float ss = 0.f;
#pragma unroll
      for (int k = 0; k < 8; ++k) { const float kq = kr[k] * qq[k]; ss += kq * kq; }
      ss = allreduce8(ss);
      if ((lane & 7) == 0) INVN[t * 8 + (lane >> 3)] = 1.f / fmaxf(sqrtf(ss), 1e-12f);
    }
    *(uint4*)(Vb + (size_t)t * 512 + lane * 8) = pack8f(f[2]);
    if (lane < 32) {
      float o[8];
#pragma unroll
      for (int k = 0; k < 8; ++k) {
        const float x = f[3][k];
        o[k] = (lane < 8) ? tanhf(x) : ((lane < 16) ? x : 1.f / (1.f + expf(-x)));
      }
      *(uint4*)(LA + (size_t)t * 256 + lane * 8) = pack8f(o);
    }
  }
}

DI void phase3(KP p, char* smem) {
  const bf16_t* LA = (const bf16_t*)(p->ws + OFF_LORA);
  bf16_t* Kb = (bf16_t*)(p->ws + OFF_K);
  bf16_t* KKb = (bf16_t*)(p->ws + OFF_KK);
  bf16_t* BBb = (bf16_t*)(p->ws + OFF_BB);
  bf16_t* GTb = (bf16_t*)(p->ws + OFF_GATE);
  float* EW = (float*)(p->ws + OFF_EW);
  const float* INVN = (const float*)(p->ws + OFF_INVN);
  const float* w0 = p->in[10];
  const float* a0 = p->in[12];
  const float* kkw = p->in[15];
  const float* kaw = p->in[16];
  for (int item = blockIdx.x; item < 136 * 12; item += gridDim.x) {
    const int mt = item / 12, rem = item % 12, kind = rem >> 2, nt = rem & 3;
    const int m0 = mt * 128, n0 = nt * 128;
    f32x16 acc[2][2];
    if (kind == 0) {
      gemm128<false>(LA + (size_t)m0 * 256, 256, (const bf16_t*)(p->ws + OFF_W2) + n0 * 64, 64, 64, acc, smem);
      epi_each(acc, [&](int rr, int cc, float v) {
        const int t = m0 + rr, c = n0 + cc;
        const float x = v + w0[c];
        const float z = -x;
        const float sp = fmaxf(z, 0.f) + log1pf(expf(-fabsf(z)));
        const float ww = -sp - 0.5f;
        EW[(size_t)t * 512 + c] = expf(-expf(ww));
      });
    } else if (kind == 1) {
      gemm128<false>(LA + (size_t)m0 * 256 + 64, 256, (const bf16_t*)(p->ws + OFF_A2) + n0 * 64, 64, 64, acc, smem);
      {
        const int lane = tidx() & 63, w = tidx() >> 6;
        const int wm = w >> 1, wn = w & 1, r = lane & 31, h = lane >> 5;
#pragma unroll 1
        for (int mi = 0; mi < 2; ++mi) {
          const int tb = m0 + wm * 64 + mi * 32;
          float inv[16];
#pragma unroll
          for (int i = 0; i < 16; ++i) inv[i] = INVN[(tb + crow(i, h)) * 8 + ((n0 + wn * 64) >> 6)];
#pragma unroll
          for (int ni = 0; ni < 2; ++ni) {
            const int c = n0 + wn * 64 + ni * 32 + r;
            const float a0c = a0[c], kkc = kkw[c], kac = kaw[c];
            float k7v[16];
#pragma unroll
            for (int i = 0; i < 16; ++i) k7v[i] = bf2f(Kb[(size_t)(tb + crow(i, h)) * 512 + c]);
#pragma unroll
            for (int i = 0; i < 16; ++i) {
              const float av = (mi == 0) ? acc[0][ni][i] : acc[1][ni][i];
              const float a = 1.f / (1.f + expf(-(av + a0c)));
              const size_t o = (size_t)(tb + crow(i, h)) * 512 + c;
              const float kkv = k7v[i] * kkc * inv[i];
              Kb[o] = f2bf(k7v[i] * (1.f + (a - 1.f) * kac));
              KKb[o] = f2bf(kkv);
              BBb[o] = f2bf(kkv * a);
            }
          }
        }
      }
    } else {
      gemm128<false>(LA + (size_t)m0 * 256 + 128, 256, (const bf16_t*)(p->ws + OFF_G2) + n0 * 128, 128, 128, acc, smem);
      epi_each(acc, [&](int rr, int cc, float v) { GTb[(size_t)(m0 + rr) * 512 + n0 + cc] = f2bf(v); });
    }
  }
}

DI void rwkv_scan(KP p, int tok0, int hd, int q, int nsteps, const float* __restrict__ S0, float* __restrict__ Sout, char* smem) {
  const int tid = tidx(), lane = tid & 63, w = tid >> 6, g = lane >> 4, l16 = lane & 15;
  const int rl = w * 4 + g;
  const int row = q * 16 + rl;
  const int j0 = l16 * 4;
  const bf16_t* Rb = (const bf16_t*)(p->ws + OFF_R);
  const bf16_t* Kb = (const bf16_t*)(p->ws + OFF_K);
  const bf16_t* Vb = (const bf16_t*)(p->ws + OFF_V);
  const bf16_t* KKb = (const bf16_t*)(p->ws + OFF_KK);
  const bf16_t* BBb = (const bf16_t*)(p->ws + OFF_BB);
  const float* EW = (const float*)(p->ws + OFF_EW);
  bf16_t* ACT = (bf16_t*)(p->ws + OFF_ACT);
  float* ew_s = (float*)smem;
  float* kk_s = ew_s + 2048;
  float* bb_s = kk_s + 2048;
  float* kp_s = bb_s + 2048;
  float* r_s = kp_s + 2048;
  float* v_s = r_s + 2048;
  float* y_s = v_s + 512;
  f2_t s01 = (f2_t){0.f, 0.f}, s23 = (f2_t){0.f, 0.f};
  if (S0) { const float4 t4 = *(const float4*)(S0 + row * 64 + j0); s01 = (f2_t){t4.x, t4.y}; s23 = (f2_t){t4.z, t4.w}; }
  uint4 rg_r = make_uint4(0, 0, 0, 0), rg_k = rg_r, rg_kk = rg_r, rg_bb = rg_r, rg_v = rg_r;
  float4 rg_e0 = make_float4(0, 0, 0, 0), rg_e1 = rg_e0;
  const int st_l = tid >> 3, c8 = (tid & 7) * 8;
  auto gload = [&](int sb) {
    if (sb + st_l < nsteps) {
      const size_t o = (size_t)(tok0 + sb + st_l) * 512 + hd * 64 + c8;
      rg_r = *(const uint4*)(Rb + o);
      rg_k = *(const uint4*)(Kb + o);
      rg_kk = *(const uint4*)(KKb + o);
      rg_bb = *(const uint4*)(BBb + o);
      rg_e0 = *(const float4*)(EW + o);
      rg_e1 = *(const float4*)(EW + o + 4);
    }
    if (tid < 64) {
      const int sv = tid >> 1;
      if (sb + sv < nsteps) rg_v = *(const uint4*)(Vb + (size_t)(tok0 + sb + sv) * 512 + hd * 64 + q * 16 + (tid & 1) * 8);
    }
  };
  auto unpack8 = [&](float* d, const uint4& u) {
    *(float4*)d = make_float4(lo2f(u.x), hi2f(u.x), lo2f(u.y), hi2f(u.y));
    *(float4*)(d + 4) = make_float4(lo2f(u.z), hi2f(u.z), lo2f(u.w), hi2f(u.w));
  };
  auto sstore = [&]() {
    const int o = st_l * 64 + c8;
    unpack8(r_s + o, rg_r);
    unpack8(kp_s + o, rg_k);
    unpack8(kk_s + o, rg_kk);
    unpack8(bb_s + o, rg_bb);
    *(float4*)(ew_s + o) = rg_e0;
    *(float4*)(ew_s + o + 4) = rg_e1;
    if (tid < 64) unpack8(v_s + (tid >> 1) * 16 + (tid & 1) * 8, rg_v);
  };
  gload(0);
  for (int sb = 0; sb < nsteps; sb += 32) {
    __syncthreads();
    sstore();
    __syncthreads();
    if (sb + 32 < nsteps) gload(sb + 32);
    const int tc = min(32, nsteps - sb);
#define SC_LD(X, st)                                              \
  {                                                               \
    const float* b_ = ew_s + (st) * 64 + j0;                      \
    X##e = *(const float4*)(b_);                                  \
    X##q = *(const float4*)(b_ + 2048);                           \
    X##b = *(const float4*)(b_ + 4096);                           \
    X##k = *(const float4*)(b_ + 6144);                           \
    X##r = *(const float4*)(b_ + 8192);                           \
    X##v = v_s[(st) * 16 + rl];                                   \
  }
#define SC_STEP(X, st)                                                                     \
  {                                                                                        \
    const f2_t p2 = s01 * (f2_t){X##q.x, X##q.y} + s23 * (f2_t){X##q.z, X##q.w};           \
    float pdp = p2.x + p2.y;                                                               \
      \
    const f2_t vk01 = (f2_t){X##k.x, X##k.y} * X##v, vk23 = (f2_t){X##k.z, X##k.w} * X##v; \
    const f2_t base01 = s01 * (f2_t){X##e.x, X##e.y} + vk01;                               \
    const f2_t base23 = s23 * (f2_t){X##e.z, X##e.w} + vk23;                               \
    allreduce16x2(pdp, ypart);     \
    if (l16 == 0 && (st) > 0) y_s[((st) - 1) * 16 + rl] = ypart;                           \
    s01 = base01 - (f2_t){X##b.x, X##b.y} * pdp;                              \
    s23 = base23 - (f2_t){X##b.z, X##b.w} * pdp;                                           \
    const f2_t y2 = s01 * (f2_t){X##r.x, X##r.y} + s23 * (f2_t){X##r.z, X##r.w};           \
    ypart = y2.x + y2.y;                                                                   \
  }
    {
      float4 Ae, Aq, Ab, Ak, Ar, Be, Bq, Bb, Bk, Br;
      float Av, Bv;
      float ypart = 0.f;
      SC_LD(A, 0)
      for (int st = 0; st < tc; st += 2) {
        SC_LD(B, st + 1)
        SC_STEP(A, st)
        SC_LD(A, min(st + 2, tc - 1))
        SC_STEP(B, st + 1)
      }
      ypart = allreduce16(ypart);
      if (l16 == 0) y_s[(tc - 1) * 16 + rl] = ypart;
    }
    __syncthreads();
    if (tid < tc * 8) {
      const int st = tid >> 3, pr = tid & 7;
      const unsigned pk = pack2(y_s[st * 16 + 2 * pr], y_s[st * 16 + 2 * pr + 1]);
      *(unsigned*)(ACT + (size_t)(tok0 + sb + st) * 1024 + 512 + hd * 64 + q * 16 + 2 * pr) = pk;
    }
  }
  *(float4*)(Sout + row * 64 + j0) = make_float4(s01.x, s01.y, s23.x, s23.y);
}

constexpr int RL = 136;
DI void ret_prompt(KP p, int b, int hd, char* smem) {
  const int tid = tidx(), lane = tid & 63, w = tid >> 6, r = lane & 31, h = lane >> 5;
  const bf16_t* RET = (const bf16_t*)p->out;
  bf16_t* ACT = (bf16_t*)(p->ws + OFF_ACT);
  bf16_t* Vt = (bf16_t*)smem;
  bf16_t* Kzt = (bf16_t*)(smem + 17408);
  bf16_t* St = (bf16_t*)(smem + 34816);
  bf16_t* Sc = (bf16_t*)(smem + 44032);
  float* Of = (float*)(smem + 44032);
  float* dec = (float*)(smem + 78848);
  const float lg = log1pf(-exp2f(-5.f - (float)hd));
  if (tid < 129) dec[tid] = expf((float)tid * lg);
  for (int e = tid; e < 64 * 72; e += 256) St[e] = 0;
  __syncthreads();
  const float g128 = dec[128];
  f32x16 Sacc;
#pragma unroll
  for (int e = 0; e < 16; ++e) Sacc[e] = 0.f;
  const int vt = w >> 1, dt = w & 1;
  for (int c = 0; c < 16; ++c) {
    const int tokc = b * 2048 + c * 128;
    {
      const int j = tid >> 1, hf = tid & 1;
      const bf16_t* vsrc = RET + (size_t)(tokc + j) * 2048 + 1024 + hd * 64 + hf * 32;
      const bf16_t* ksrc = RET + (size_t)(tokc + j) * 2048 + 512 + hd * 64 + hf * 32;
      const float zj = dec[127 - j];
#pragma unroll
      for (int qd = 0; qd < 4; ++qd) {
        const uint4 uv = *(const uint4*)(vsrc + qd * 8);
        const uint4 uk = *(const uint4*)(ksrc + qd * 8);
        const unsigned vv[4] = {uv.x, uv.y, uv.z, uv.w};
        const unsigned kk[4] = {uk.x, uk.y, uk.z, uk.w};
#pragma unroll
        for (int e = 0; e < 4; ++e) {
          const int col = hf * 32 + qd * 8 + e * 2;
          Vt[col * RL + j] = (bf16_t)(vv[e] & 0xffffu);
          Vt[(col + 1) * RL + j] = (bf16_t)(vv[e] >> 16);
          Kzt[col * RL + j] = f2bf(lo2f(kk[e]) * zj);
          Kzt[(col + 1) * RL + j] = f2bf(hi2f(kk[e]) * zj);
        }
      }
    }
    bf16x8 qf[4];
    {
      const bf16_t* qsrc = RET + (size_t)(tokc + 32 * w + r) * 2048 + hd * 64 + h * 8;
#pragma unroll
      for (int ks = 0; ks < 4; ++ks) qf[ks] = *(const bf16x8*)(qsrc + ks * 16);
    }
#pragma unroll
    for (int jb = 0; jb < 2; ++jb) {
      bf16x8 kf[2][4];
#pragma unroll
      for (int jj = 0; jj < 2; ++jj) {
        const int jt = jb * 2 + jj;
        if (jt <= w) {
          const bf16_t* ksrc = RET + (size_t)(tokc + 32 * jt + r) * 2048 + 512 + hd * 64 + h * 8;
#pragma unroll
          for (int ks = 0; ks < 4; ++ks) kf[jj][ks] = *(const bf16x8*)(ksrc + ks * 16);
        }
      }
#pragma unroll
      for (int jj = 0; jj < 2; ++jj) {
        const int jt = jb * 2 + jj;
        if (jt <= w) {
          f32x16 sc;
#pragma unroll
          for (int e = 0; e < 16; ++e) sc[e] = 0.f;
#pragma unroll
          for (int ks = 0; ks < 4; ++ks) sc = __builtin_amdgcn_mfma_f32_32x32x16_bf16(qf[ks], kf[jj][ks], sc, 0, 0, 0);
#pragma unroll
          for (int e = 0; e < 16; ++e) {
            const int i = 32 * w + crow(e, h), j = 32 * jt + r;
            const int d = i - j;
            const float val = (d >= 0) ? sc[e] * dec[d >= 0 ? d : 0] : 0.f;
            Sc[i * RL + j] = f2bf(val);
          }
        }
      }
    }
    __syncthreads();
    f32x16 oacc[2];
#pragma unroll
    for (int nt = 0; nt < 2; ++nt) {
#pragma unroll
      for (int e = 0; e < 16; ++e) oacc[nt][e] = 0.f;
#pragma unroll
      for (int ks = 0; ks < 4; ++ks) {
        const bf16x8 sf = *(const bf16x8*)(St + (nt * 32 + r) * 72 + ks * 16 + h * 8);
        oacc[nt] = __builtin_amdgcn_mfma_f32_32x32x16_bf16(qf[ks], sf, oacc[nt], 0, 0, 0);
      }
#pragma unroll
      for (int e = 0; e < 16; ++e) oacc[nt][e] *= dec[32 * w + crow(e, h) + 1];
    }
    for (int ks = 0; ks < 2 * (w + 1); ++ks) {
      const bf16x8 af = *(const bf16x8*)(Sc + (32 * w + r) * RL + ks * 16 + h * 8);
#pragma unroll
      for (int nt = 0; nt < 2; ++nt) {
        const bf16x8 vf = *(const bf16x8*)(Vt + (nt * 32 + r) * RL + ks * 16 + h * 8);
        oacc[nt] = __builtin_amdgcn_mfma_f32_32x32x16_bf16(af, vf, oacc[nt], 0, 0, 0);
      }
    }
#pragma unroll
    for (int e = 0; e < 16; ++e) Sacc[e] *= g128;
#pragma unroll
    for (int ks = 0; ks < 8; ++ks) {
      const bf16x8 af = *(const bf16x8*)(Vt + (vt * 32 + r) * RL + ks * 16 + h * 8);
      const bf16x8 bf = *(const bf16x8*)(Kzt + (dt * 32 + r) * RL + ks * 16 + h * 8);
      Sacc = __builtin_amdgcn_mfma_f32_32x32x16_bf16(af, bf, Sacc, 0, 0, 0);
    }
    __syncthreads();
#pragma unroll
    for (int nt = 0; nt < 2; ++nt)
#pragma unroll
      for (int e = 0; e < 16; ++e) Of[(32 * w + crow(e, h)) * 66 + nt * 32 + r] = oacc[nt][e];
#pragma unroll
    for (int e = 0; e < 16; ++e) St[(vt * 32 + crow(e, h)) * 72 + dt * 32 + r] = f2bf(Sacc[e]);
    __syncthreads();
    {
      const int i = tid >> 1, hf = tid & 1;
      const int t = tokc + i;
      float vals[32];
      float sm = 0.f;
#pragma unroll
      for (int k = 0; k < 32; ++k) { vals[k] = Of[i * 66 + hf * 32 + k]; sm += vals[k]; }
      sm += __shfl_xor(sm, 1);
      const float mean = sm * (1.f / 64.f);
      float vs = 0.f;
#pragma unroll
      for (int k = 0; k < 32; ++k) { vals[k] -= mean; vs += vals[k] * vals[k]; }
      vs += __shfl_xor(vs, 1);
      const float rs = rsqrtf(vs * (1.f / 64.f) + 1e-5f);
      const bf16_t* gsrc = RET + (size_t)t * 2048 + 1536 + hd * 64 + hf * 32;
      bf16_t* dst = ACT + (size_t)t * 1024 + hd * 64 + hf * 32;
#pragma unroll
      for (int qd = 0; qd < 4; ++qd) {
        const uint4 ug = *(const uint4*)(gsrc + qd * 8);
        const unsigned gg[4] = {ug.x, ug.y, ug.z, ug.w};
        unsigned o4[4];
#pragma unroll
        for (int e = 0; e < 4; ++e) {
          const float g0 = lo2f(gg[e]), g1 = hi2f(gg[e]);
          const float a0 = vals[qd * 8 + 2 * e] * rs * (g0 / (1.f + __expf(-g0)));
          const float a1 = vals[qd * 8 + 2 * e + 1] * rs * (g1 / (1.f + __expf(-g1)));
          o4[e] = pack2(a0, a1);
        }
        *(uint4*)(dst + qd * 8) = make_uint4(o4[0], o4[1], o4[2], o4[3]);
      }
    }
    __syncthreads();
  }
  float* so = p->out + O_RETP + (size_t)(b * 8 + hd) * 4096;
#pragma unroll
  for (int gq = 0; gq < 4; ++gq)
    *(float4*)(so + (dt * 32 + r) * 64 + vt * 32 + 8 * gq + 4 * h) =
        make_float4(Sacc[4 * gq], Sacc[4 * gq + 1], Sacc[4 * gq + 2], Sacc[4 * gq + 3]);
}

DI void ret_sample(KP p, int b, int hd, char* smem) {
  const int tid = tidx();
  const bf16_t* RET = (const bf16_t*)p->out;
  bf16_t* ACT = (bf16_t*)(p->ws + OFF_ACT);
  float* q_s = (float*)smem;
  float* k_s = q_s + 512;
  float* v_s = k_s + 512;
  float* A_s = v_s + 512;
  float* part = A_s + 64;
  const int tok0 = TP + b * 8;
  const float lg = log1pf(-exp2f(-5.f - (float)hd));
  __syncthreads();
  {
    const int e = tid * 2, rw = e >> 6, cl = e & 63;
    const bf16_t* base = RET + (size_t)(tok0 + rw) * 2048 + hd * 64 + cl;
    const unsigned uq = *(const unsigned*)(base), uk = *(const unsigned*)(base + 512), uv = *(const unsigned*)(base + 1024);
    q_s[e] = lo2f(uq); q_s[e + 1] = hi2f(uq);
    k_s[e] = lo2f(uk); k_s[e + 1] = hi2f(uk);
    v_s[e] = lo2f(uv); v_s[e + 1] = hi2f(uv);
  }
  __syncthreads();
  if (tid < 64) {
    const int i = tid >> 3, j = tid & 7;
    float a = 0.f;
    if (i >= j) {
#pragma unroll 4
      for (int d = 0; d < 64; ++d) a = fmaf(q_s[i * 64 + d], k_s[j * 64 + d], a);
      a *= expf((float)(i - j) * lg);
    }
    A_s[tid] = a;
  }
  {
    const int dg = tid >> 6, v = tid & 63;
    const float* S0 = p->in[2] + (size_t)(b * 8 + hd) * 4096;
    float* So = p->out + O_RETS + (size_t)(b * 8 + hd) * 4096;
    float oi[8];
#pragma unroll
    for (int i = 0; i < 8; ++i) oi[i] = 0.f;
    const float g8 = expf(8.f * lg);
    float kv[8];
#pragma unroll
    for (int j = 0; j < 8; ++j) kv[j] = v_s[j * 64 + v] * expf((float)(7 - j) * lg);
#pragma unroll 1
    for (int hb = 0; hb < 2; ++hb) {
      float sv[8];
#pragma unroll
      for (int dd = 0; dd < 8; ++dd) sv[dd] = S0[(dg * 16 + hb * 8 + dd) * 64 + v];
#pragma unroll
      for (int dd = 0; dd < 8; ++dd) {
        const int d = dg * 16 + hb * 8 + dd;
        const float s = sv[dd];
        float sn = s * g8;
#pragma unroll
        for (int j = 0; j < 8; ++j) sn = fmaf(k_s[j * 64 + d], kv[j], sn);
        So[d * 64 + v] = sn;
#pragma unroll
        for (int i = 0; i < 8; ++i) oi[i] = fmaf(q_s[i * 64 + d], s, oi[i]);
      }
    }
#pragma unroll
    for (int i = 0; i < 8; ++i) part[(dg * 8 + i) * 64 + v] = oi[i];
  }
  __syncthreads();
#pragma unroll
  for (int rep = 0; rep < 2; ++rep) {
    const int i = (tid >> 6) + 4 * rep, v = tid & 63;
    float o = part[(0 * 8 + i) * 64 + v] + part[(1 * 8 + i) * 64 + v] + part[(2 * 8 + i) * 64 + v] + part[(3 * 8 + i) * 64 + v];
    o *= expf((float)(i + 1) * lg);
    for (int j = 0; j <= i; ++j) o = fmaf(A_s[i * 8 + j], v_s[j * 64 + v], o);
    const float mean = wave_sum(o) * (1.f / 64.f);
    const float dv = o - mean;
    const float var = wave_sum(dv * dv) * (1.f / 64.f);
    const int t = tok0 + i;
    const float gt = bf2f(RET[(size_t)t * 2048 + 1536 + hd * 64 + v]);
    ACT[(size_t)t * 1024 + hd * 64 + v] = f2bf(dv * rsqrtf(var + 1e-5f) * (gt / (1.f + __expf(-gt))));
  }
}

constexpr size_t TAB_V8 = (size_t)16384 * 1024;
constexpr size_t TAB_SC = (size_t)2 * 16384 * 1024;
DI void convert_tab(KP p, int it) {
  const int tid = tidx(), lane = tid & 63, w = tid >> 6;
  const int row0 = it * 8 + w * 2;
  const float* src = (row0 < 16384) ? p->in[24] + (size_t)row0 * 1024 : p->in[25] + (size_t)(row0 - 16384) * 1024;
  float4 v[2][4];
#pragma unroll
  for (int rr = 0; rr < 2; ++rr)
#pragma unroll
    for (int i = 0; i < 4; ++i) v[rr][i] = *(const float4*)(src + rr * 1024 + i * 256 + lane * 4);
#pragma unroll
  for (int rr = 0; rr < 2; ++rr) {
    float am = 0.f;
#pragma unroll
    for (int i = 0; i < 4; ++i)
      am = fmaxf(am, fmaxf(fmaxf(fabsf(v[rr][i].x), fabsf(v[rr][i].y)), fmaxf(fabsf(v[rr][i].z), fabsf(v[rr][i].w))));
#pragma unroll
    for (int o = 32; o >= 1; o >>= 1) am = fmaxf(am, __shfl_xor(am, o));
    am = fmaxf(am, 1e-30f);
    const float inv = 127.f / am;
    unsigned char* dst = (unsigned char*)(p->ws + OFF_TAB) + (size_t)(row0 + rr) * 1024;
#pragma unroll
    for (int i = 0; i < 4; ++i) {
      const unsigned q0 = (unsigned)((int)rintf(v[rr][i].x * inv) + 128);
      const unsigned q1 = (unsigned)((int)rintf(v[rr][i].y * inv) + 128);
      const unsigned q2 = (unsigned)((int)rintf(v[rr][i].z * inv) + 128);
      const unsigned q3 = (unsigned)((int)rintf(v[rr][i].w * inv) + 128);
      *(unsigned*)(dst + i * 256 + lane * 4) = q0 | (q1 << 8) | (q2 << 16) | (q3 << 24);
    }
    if (lane == 0) ((float*)(p->ws + OFF_TAB + TAB_SC))[row0 + rr] = am * (1.f / 127.f);
  }
}

DI void phase4_other(KP p, int it, char* smem) {
  if (it < 64) { ret_prompt(p, it >> 3, it & 7, smem); return; }
  it -= 64;
  if (it < 4096) {
    const int bh = it >> 2, q = it & 3, b = bh >> 3, hd = bh & 7;
    rwkv_scan(p, TP + b * 8, hd, q, 8, p->in[3] + (size_t)bh * 4096, p->out + O_WKVS + (size_t)bh * 4096, smem);
    return;
  }
  it -= 4096;
  if (it < 1024) { ret_sample(p, it >> 3, it & 7, smem); return; }
  it -= 1024;
  if (it < 4096) { convert_tab(p, it); return; }
  it -= 4096;
#define TJ4(IDX, OFF, KK_, NN_)                                                                            \
  {                                                                                                        \
    const int ntl = ((KK_) / 64) * ((NN_) / 64);                                                           \
    if (it < ntl) {                                                                                        \
      transpose_tile(p->in[IDX], (bf16_t*)(p->ws + (OFF)), (KK_), (NN_), it / ((NN_) / 64), it % ((NN_) / 64), (float*)smem); \
      return;                                                                                              \
    }                                                                                                      \
    it -= ntl;                                                                                             \
  }
  TJ4(20, OFF_WOUT, 1024, 1024)
  TJ4(22, OFF_WQ, 1024, 2048)
  TJ4(27, OFF_PG, 1024, 1024)
  TJ4(28, OFF_PP, 256, 1024)
}
DI void phase4(KP p, char* smem) {
  constexpr int N_OTHER = 64 + 4096 + 1024 + 4096 + (256 + 512 + 256 + 64);
  int* s_item = (int*)(smem + SMEM_BYTES - 16);
  unsigned* ctr = (unsigned*)(p->ws + OFF_CTR);
  unsigned* cukey = (unsigned*)(p->ws + OFF_CTR + 16384);
  __syncthreads();
  if (tidx() == 0) {
    const unsigned hw = (unsigned)__builtin_amdgcn_s_getreg((7 << 11) | (8 << 6) | 4);
    const unsigned key = (xb_xcc_id() << 8) | (hw & 0xffu);
    const unsigned old = atomicAdd(&cukey[key], 1u);
    int it = -1;
    if (old == 0u) { const unsigned q = atomicAdd(&ctr[1], 1u); if (q < 256u) it = (int)q; }
    *s_item = it;
  }
  __syncthreads();
  {
    const int it = *s_item;
    if (it >= 0) {
      const int bh = it >> 2, q = it & 3, b = bh >> 3, hd = bh & 7;
      __builtin_amdgcn_s_setprio(3);
      rwkv_scan(p, b * 2048, hd, q, 2048, nullptr, p->out + O_WKVP + (size_t)bh * 4096, smem);
      __builtin_amdgcn_s_setprio(0);
    }
  }
  for (;;) {
    __syncthreads();
    if (tidx() == 0) *s_item = (int)atomicAdd(&ctr[0], 1u);
    __syncthreads();
    const int it = *s_item;
    if (it >= N_OTHER) break;
    phase4_other(p, it, smem);
  }
  for (;;) {
    __syncthreads();
    if (tidx() == 0) *s_item = (int)atomicAdd(&ctr[1], 1u);
    __syncthreads();
    const int it = *s_item;
    if (it >= 256) break;
    const int bh = it >> 2, q = it & 3, b = bh >> 3, hd = bh & 7;
    rwkv_scan(p, b * 2048, hd, q, 2048, nullptr, p->out + O_WKVP + (size_t)bh * 4096, smem);
  }
}

DI void phase5(KP p) {
  const int lane = tidx() & 63, w = tidx() >> 6;
  bf16_t* ACT = (bf16_t*)(p->ws + OFF_ACT);
  const bf16_t* Rb = (const bf16_t*)(p->ws + OFF_R);
  const bf16_t* Kb = (const bf16_t*)(p->ws + OFF_K);
  const bf16_t* Vb = (const bf16_t*)(p->ws + OFF_V);
  const bf16_t* GTb = (const bf16_t*)(p->ws + OFF_GATE);
  const int c8 = lane * 8;
  float rk8[8], lg8[8], lb8[8];
  {
    const float4 a0 = *(const float4*)(p->in[17] + c8), a1 = *(const float4*)(p->in[17] + c8 + 4);
    const float4 b0 = *(const float4*)(p->in[18] + c8), b1 = *(const float4*)(p->in[18] + c8 + 4);
    const float4 d0 = *(const float4*)(p->in[19] + c8), d1 = *(const float4*)(p->in[19] + c8 + 4);
    rk8[0] = a0.x; rk8[1] = a0.y; rk8[2] = a0.z; rk8[3] = a0.w; rk8[4] = a1.x; rk8[5] = a1.y; rk8[6] = a1.z; rk8[7] = a1.w;
    lg8[0] = b0.x; lg8[1] = b0.y; lg8[2] = b0.z; lg8[3] = b0.w; lg8[4] = b1.x; lg8[5] = b1.y; lg8[6] = b1.z; lg8[7] = b1.w;
    lb8[0] = d0.x; lb8[1] = d0.y; lb8[2] = d0.z; lb8[3] = d0.w; lb8[4] = d1.x; lb8[5] = d1.y; lb8[6] = d1.z; lb8[7] = d1.w;
  }
  for (int t = blockIdx.x * 4 + w; t < T; t += gridDim.x * 4) {
    const size_t o = (size_t)t * 512 + c8;
    bf16_t* yp = ACT + (size_t)t * 1024 + 512 + c8;
    const uint4 uy = *(const uint4*)yp, ur = *(const uint4*)(Rb + o), uk = *(const uint4*)(Kb + o),
                uv = *(const uint4*)(Vb + o), ug = *(const uint4*)(GTb + o);
    float y[8], r[8], k[8], v[8], g[8];
    unpack8f(uy, y); unpack8f(ur, r); unpack8f(uk, k); unpack8f(uv, v); unpack8f(ug, g);
    float sm = 0.f, rk = 0.f;
#pragma unroll
    for (int e = 0; e < 8; ++e) { sm += y[e]; rk = fmaf(r[e] * k[e], rk8[e], rk); }
    sm = allreduce8(sm);
    rk = allreduce8(rk);
    const float mean = sm * (1.f / 64.f);
    float vs = 0.f;
#pragma unroll
    for (int e = 0; e < 8; ++e) { y[e] -= mean; vs += y[e] * y[e]; }
    vs = allreduce8(vs);
    const float rs = rsqrtf(vs * (1.f / 64.f) + 64e-5f);
    float ov[8];
#pragma unroll
    for (int e = 0; e < 8; ++e) ov[e] = (y[e] * rs * lg8[e] + lb8[e] + rk * v[e]) * g[e];
    *(uint4*)yp = pack8f(ov);
  }
}

DI void phase6(KP p, char* smem) {
  for (int tile = blockIdx.x; tile < 136 * 8; tile += gridDim.x) {
    const int mt = tile >> 3, nt = tile & 7;
    const int m0 = mt * 128, n0 = nt * 128;
    f32x16 acc[2][2];
    gemm128<false>((const bf16_t*)(p->ws + OFF_ACT) + (size_t)m0 * 1024, 1024,
                   (const bf16_t*)(p->ws + OFF_WOUT) + (size_t)n0 * 1024, 1024, 1024, acc, smem);
    {
      const int lane = tidx() & 63, w = tidx() >> 6;
      const int wm = w >> 1, wn = w & 1, r = lane & 31, h = lane >> 5;
      const float* xb = (m0 < TP) ? p->in[0] + (size_t)m0 * 1024 : p->in[1] + (size_t)(m0 - TP) * 1024;
#pragma unroll
      for (int mi = 0; mi < 2; ++mi)
#pragma unroll
        for (int ni = 0; ni < 2; ++ni)
#pragma unroll
          for (int i = 0; i < 16; ++i)
            acc[mi][ni][i] += xb[(size_t)(wm * 64 + mi * 32 + crow(i, h)) * 1024 + n0 + wn * 64 + ni * 32 + r];
#pragma unroll
      for (int mi = 0; mi < 2; ++mi)
#pragma unroll
        for (int ni = 0; ni < 2; ++ni)
#pragma unroll
          for (int i = 0; i < 16; ++i)
            p->out[(size_t)(m0 + wm * 64 + mi * 32 + crow(i, h)) * 1024 + n0 + wn * 64 + ni * 32 + r] = acc[mi][ni][i];
    }
  }
}

DI void phase7(KP p) {
  const int lane = tidx() & 63, w = tidx() >> 6;
  for (int t = blockIdx.x * 4 + w; t < T; t += gridDim.x * 4)
    rmsnorm_row_bf(p->out + (size_t)t * 1024, p->in[21], (bf16_t*)(p->ws + OFF_ACT) + (size_t)t * 1024, lane);
}

DI void phase8(KP p, char* smem) {
  bf16_t* QP = (bf16_t*)(p->ws + OFF_QPEER);
  for (int tile = blockIdx.x; tile < 136 * 16; tile += gridDim.x) {
    const int mt = tile >> 4, nt = tile & 15;
    const int m0 = mt * 128, n0 = nt * 128;
    f32x16 acc[2][2];
    gemm128<false>((const bf16_t*)(p->ws + OFF_ACT) + (size_t)m0 * 1024, 1024,
                   (const bf16_t*)(p->ws + OFF_WQ) + (size_t)n0 * 1024, 1024, 1024, acc, smem);
    epi_each(acc, [&](int rr, int cc, float v) { QP[(size_t)(m0 + rr) * 2048 + n0 + cc] = f2bf(v); });
  }
}

DI unsigned sortkey(float f) { unsigned u = __float_as_uint(f); return (u & 0x80000000u) ? ~u : (u | 0x80000000u); }
DI float unsortkey(unsigned k) { unsigned u = (k & 0x80000000u) ? (k ^ 0x80000000u) : ~k; return __uint_as_float(u); }
DI void ins16(unsigned (&l)[16], unsigned x) {
#pragma unroll
  for (int i = 0; i < 16; ++i) { const unsigned hi = max(l[i], x); x = min(l[i], x); l[i] = hi; }
}
DI void cswap_desc(unsigned& a, unsigned& b) { const unsigned hi = max(a, b), lo = min(a, b); a = hi; b = lo; }
DI void bsort16(unsigned (&v)[16]) {
#pragma unroll
  for (int ke = 1; ke <= 4; ++ke)
#pragma unroll
    for (int je = ke - 1; je >= 0; --je)
#pragma unroll
      for (int i = 0; i < 16; ++i) {
        const int k = 1 << ke, j = 1 << je, l = i ^ j;
        if (l > i) { if ((i & k) == 0) cswap_desc(v[i], v[l]); else cswap_desc(v[l], v[i]); }
      }
}
DI void bmerge16(unsigned (&a)[16], const unsigned (&b)[16]) {
#pragma unroll
  for (int i = 0; i < 16; ++i) a[i] = max(a[i], b[15 - i]);
#pragma unroll
  for (int je = 3; je >= 0; --je)
#pragma unroll
    for (int i = 0; i < 16; ++i) {
      const int j = 1 << je, l = i ^ j;
      if (l > i) cswap_desc(a[i], a[l]);
    }
}
DI void phase9(KP p, char* smem) {
  const int tid = tidx();
  const bf16_t* QP = (const bf16_t*)(p->ws + OFF_QPEER);
  const bf16_t* KEYS = (const bf16_t*)(p->ws + OFF_KEYS);
  int* IDX = (int*)(p->ws + OFF_IDX);
  float* GSM = (float*)(p->ws + OFF_GSM);
  float* sc = (float*)smem;
  unsigned* mrg = (unsigned*)smem;
  const int row = tid >> 1, half = tid & 1;
  for (int item = blockIdx.x; item < 136 * 8; item += gridDim.x) {
    const int mt = item >> 3, hd = item & 7;
    const int m0 = mt * 128;
    unsigned kc[2][16];
#pragma unroll
    for (int c = 0; c < 2; ++c) {
      f32x16 acc[2][2];
      gemm128<false>(QP + (size_t)m0 * 2048 + (hd * 2 + c) * 128, 2048, KEYS + (size_t)(hd * 2 + c) * 16384, 128, 128, acc, smem);
      __syncthreads();
      epi_each(acc, [&](int rr, int cc, float v) { sc[rr * 129 + cc] = v; });
      __syncthreads();
      unsigned lst[16];
#pragma unroll
      for (int gi = 0; gi < 4; ++gi) {
        unsigned grp[16];
#pragma unroll
        for (int i = 0; i < 16; ++i) {
          const int col = half * 64 + gi * 16 + i;
          grp[i] = (sortkey(sc[row * 129 + col]) & ~127u) | (unsigned)(127 - col);
        }
        bsort16(grp);
        if (gi == 0) {
#pragma unroll
          for (int i = 0; i < 16; ++i) lst[i] = grp[i];
        } else {
          bmerge16(lst, grp);
        }
      }
      __syncthreads();
      if (half) {
#pragma unroll
        for (int i = 0; i < 16; ++i) mrg[row * 16 + i] = lst[i];
      }
      __syncthreads();
      if (!half) {
        unsigned grp[16];
#pragma unroll
        for (int i = 0; i < 16; ++i) grp[i] = mrg[row * 16 + i];
        bmerge16(lst, grp);
      }
#pragma unroll
      for (int i = 0; i < 16; ++i) kc[c][i] = lst[i];
    }
    if (!half) {
      float sv0[16], sv1[16];
#pragma unroll
      for (int i = 0; i < 16; ++i) { sv0[i] = unsortkey(kc[0][i] & ~127u); sv1[i] = unsortkey(kc[1][i] & ~127u); }
      unsigned cl[16];
#pragma unroll
      for (int i = 0; i < 16; ++i) cl[i] = 0u;
#pragma unroll
      for (int a = 0; a < 16; ++a)
#pragma unroll
        for (int b = 0; b < 16 / (a + 1); ++b)
          ins16(cl, (sortkey(sv0[a] + sv1[b]) & ~255u) | (unsigned)(255 - (a * 16 + b)));
      float ex[16];
      float sum = 0.f;
      const float mx = unsortkey(cl[0] & ~255u);
#pragma unroll
      for (int i = 0; i < 16; ++i) { ex[i] = __expf(unsortkey(cl[i] & ~255u) - mx); sum += ex[i]; }
      const float inv = 1.f / sum;
      int eo[16];
#pragma unroll
      for (int i = 0; i < 16; ++i) {
        const int ci = 255 - (int)(cl[i] & 255u);
        const int a = ci >> 4, b = ci & 15;
        int i0 = 0, i1 = 0;
#pragma unroll
        for (int k = 0; k < 16; ++k) {
          i0 = (a == k) ? (127 - (int)(kc[0][k] & 127u)) : i0;
          i1 = (b == k) ? (127 - (int)(kc[1][k] & 127u)) : i1;
        }
        eo[i] = i0 * 128 + i1;
        ex[i] *= inv;
      }
      const size_t o = ((size_t)(m0 + row) * 8 + hd) * 16;
#pragma unroll
      for (int qd = 0; qd < 4; ++qd) {
        *(int4*)(IDX + o + qd * 4) = make_int4(eo[qd * 4], eo[qd * 4 + 1], eo[qd * 4 + 2], eo[qd * 4 + 3]);
        *(float4*)(GSM + o + qd * 4) = make_float4(ex[qd * 4], ex[qd * 4 + 1], ex[qd * 4 + 2], ex[qd * 4 + 3]);
      }
    }
  }
}

#define UB0(u) ((float)((u) & 0xffu))
#define UB1(u) ((float)(((u) >> 8) & 0xffu))
#define UB2(u) ((float)(((u) >> 16) & 0xffu))
#define UB3(u) ((float)((u) >> 24))
DI void phase10(KP p) {
  const int lane = tidx() & 63, w = tidx() >> 6;
  const int g = lane >> 4, l16 = lane & 15;
  bf16_t* ACT = (bf16_t*)(p->ws + OFF_ACT);
  const unsigned char* UB = (const unsigned char*)(p->ws + OFF_TAB);
  const unsigned char* VB = UB + TAB_V8;
  const float* USC = (const float*)(p->ws + OFF_TAB + TAB_SC);
  const float* VSC = USC + 16384;
  const int* IDX = (const int*)(p->ws + OFF_IDX);
  const float* GSM = (const float*)(p->ws + OFF_GSM);
  const float* pn = p->in[26];
  for (int t = blockIdx.x * 4 + w; t < T; t += gridDim.x * 4) {
    bf16_t* act = ACT + (size_t)t * 1024;
    float xf[64];
    float xsum = 0.f;
#pragma unroll
    for (int s = 0; s < 4; ++s) {
      const uint4 x0 = *(const uint4*)(act + s * 256 + l16 * 16);
      const uint4 x1 = *(const uint4*)(act + s * 256 + l16 * 16 + 8);
      const unsigned xx[8] = {x0.x, x0.y, x0.z, x0.w, x1.x, x1.y, x1.z, x1.w};
#pragma unroll
      for (int q = 0; q < 8; ++q) { xf[s * 16 + 2 * q] = lo2f(xx[q]); xf[s * 16 + 2 * q + 1] = hi2f(xx[q]); }
    }
#pragma unroll
    for (int k = 0; k < 64; ++k) xsum += xf[k];
    const int id0 = IDX[(size_t)t * 128 + lane], id1 = IDX[(size_t)t * 128 + 64 + lane];
    const float gs0 = GSM[(size_t)t * 128 + lane], gs1 = GSM[(size_t)t * 128 + 64 + lane];
    float acc[64];
#pragma unroll
    for (int k = 0; k < 64; ++k) acc[k] = 0.f;
    float csum = 0.f;
    for (int it = 0; it < 32; ++it) {
      const int n = (it * 4 + g) & 63;
      const int e = __shfl((it < 16) ? id0 : id1, n);
      const float gw = __shfl((it < 16) ? gs0 : gs1, n);
      const unsigned char* ur = UB + (size_t)e * 1024 + l16 * 16;
      const unsigned char* vr = VB + (size_t)e * 1024 + l16 * 16;
      uint4 uu[4], vv[4];
#pragma unroll
      for (int s = 0; s < 4; ++s) uu[s] = *(const uint4*)(ur + s * 256);
#pragma unroll
      for (int s = 0; s < 4; ++s) vv[s] = *(const uint4*)(vr + s * 256);
      const float su = USC[e], sv = VSC[e];
      float hv = 0.f;
#pragma unroll
      for (int s = 0; s < 4; ++s) {
        const unsigned ww[4] = {uu[s].x, uu[s].y, uu[s].z, uu[s].w};
#pragma unroll
        for (int q = 0; q < 4; ++q) {
          hv = fmaf(xf[s * 16 + q * 4 + 0], UB0(ww[q]), hv);
          hv = fmaf(xf[s * 16 + q * 4 + 1], UB1(ww[q]), hv);
          hv = fmaf(xf[s * 16 + q * 4 + 2], UB2(ww[q]), hv);
          hv = fmaf(xf[s * 16 + q * 4 + 3], UB3(ww[q]), hv);
        }
      }
      hv = fmaf(-128.f, xsum, hv);
      hv = allreduce16(hv) * su;
      const float c = 0.5f * hv * (1.f + erff(hv * 0.70710678118f)) * gw * sv;
      csum += c;
#pragma unroll
      for (int s = 0; s < 4; ++s) {
        const unsigned ww[4] = {vv[s].x, vv[s].y, vv[s].z, vv[s].w};
#pragma unroll
        for (int q = 0; q < 4; ++q) {
          acc[s * 16 + q * 4 + 0] = fmaf(c, UB0(ww[q]), acc[s * 16 + q * 4 + 0]);
          acc[s * 16 + q * 4 + 1] = fmaf(c, UB1(ww[q]), acc[s * 16 + q * 4 + 1]);
          acc[s * 16 + q * 4 + 2] = fmaf(c, UB2(ww[q]), acc[s * 16 + q * 4 + 2]);
          acc[s * 16 + q * 4 + 3] = fmaf(c, UB3(ww[q]), acc[s * 16 + q * 4 + 3]);
        }
      }
    }
    const float cs128 = 128.f * csum;
#pragma unroll
    for (int k = 0; k < 64; ++k) {
      acc[k] -= cs128;
      acc[k] += __shfl_xor(acc[k], 16);
      acc[k] += __shfl_xor(acc[k], 32);
    }
    float* hrow = p->out + (size_t)t * 1024;
    float hvv[16];
#pragma unroll
    for (int s = 0; s < 4; ++s) {
      if (s == g) {
        float* hp = hrow + s * 256 + l16 * 16;
#pragma unroll
        for (int q = 0; q < 4; ++q) {
          float4 h0 = *(float4*)(hp + q * 4);
          h0.x += acc[s * 16 + q * 4 + 0]; h0.y += acc[s * 16 + q * 4 + 1]; h0.z += acc[s * 16 + q * 4 + 2]; h0.w += acc[s * 16 + q * 4 + 3];
          *(float4*)(hp + q * 4) = h0;
          hvv[q * 4 + 0] = h0.x; hvv[q * 4 + 1] = h0.y; hvv[q * 4 + 2] = h0.z; hvv[q * 4 + 3] = h0.w;
        }
      }
    }
    float ss = 0.f;
#pragma unroll
    for (int k = 0; k < 16; ++k) ss += hvv[k] * hvv[k];
    ss = wave_sum(ss);
    const float scl = rsqrtf(ss * (1.f / 1024.f) + 1e-6f);
    {
      const int col = g * 256 + l16 * 16;
      unsigned o8[8];
#pragma unroll
      for (int q = 0; q < 4; ++q) {
        const float4 g0 = *(const float4*)(pn + col + q * 4);
        o8[q * 2] = pack2(hvv[q * 4 + 0] * scl * g0.x, hvv[q * 4 + 1] * scl * g0.y);
        o8[q * 2 + 1] = pack2(hvv[q * 4 + 2] * scl * g0.z, hvv[q * 4 + 3] * scl * g0.w);
      }
      *(uint4*)(act + col) = make_uint4(o8[0], o8[1], o8[2], o8[3]);
      *(uint4*)(act + col + 8) = make_uint4(o8[4], o8[5], o8[6], o8[7]);
    }
  }
}

DI void phase11(KP p, char* smem) {
  for (int tile = blockIdx.x; tile < 136 * 8; tile += gridDim.x) {
    const int mt = tile >> 3, nt = tile & 7;
    const int m0 = mt * 128, n0 = nt * 128;
    f32x16 acc[2][2];
    unsigned ppk[2][2][8];
    const float* pa = (m0 < TP) ? p->in[5] + (size_t)m0 * 256 : p->in[6] + (size_t)(m0 - TP) * 256;
    gemm128<true>(pa, 256, (const bf16_t*)(p->ws + OFF_PP) + (size_t)n0 * 256, 256, 256, acc, smem);
#pragma unroll
    for (int mi = 0; mi < 2; ++mi)
#pragma unroll
      for (int ni = 0; ni < 2; ++ni)
#pragma unroll
        for (int i = 0; i < 8; ++i) ppk[mi][ni][i] = pack2(acc[mi][ni][2 * i], acc[mi][ni][2 * i + 1]);
    gemm128<false>((const bf16_t*)(p->ws + OFF_ACT) + (size_t)m0 * 1024, 1024,
                   (const bf16_t*)(p->ws + OFF_PG) + (size_t)n0 * 1024, 1024, 1024, acc, smem);
    const int lane = tidx() & 63, w = tidx() >> 6;
    const int wm = w >> 1, wn = w & 1, r = lane & 31, h = lane >> 5;
#pragma unroll
    for (int mi = 0; mi < 2; ++mi)
#pragma unroll
      for (int ni = 0; ni < 2; ++ni)
#pragma unroll
        for (int i = 0; i < 16; ++i) {
          const float pp = (i & 1) ? hi2f(ppk[mi][ni][i >> 1]) : lo2f(ppk[mi][ni][i >> 1]);
          acc[mi][ni][i] = sigmoidf_(acc[mi][ni][i]) * pp;
        }
#pragma unroll
    for (int mi = 0; mi < 2; ++mi) {
#pragma unroll
      for (int ni = 0; ni < 2; ++ni)
#pragma unroll
        for (int i = 0; i < 16; ++i)
          acc[mi][ni][i] += p->out[(size_t)(m0 + wm * 64 + mi * 32 + crow(i, h)) * 1024 + n0 + wn * 64 + ni * 32 + r];
#pragma unroll
      for (int ni = 0; ni < 2; ++ni)
#pragma unroll
        for (int i = 0; i < 16; ++i)
          p->out[(size_t)(m0 + wm * 64 + mi * 32 + crow(i, h)) * 1024 + n0 + wn * 64 + ni * 32 + r] = acc[mi][ni][i];
    }
  }
}

DI void phase12(KP p) {
  const int lane = tidx() & 63, w = tidx() >> 6;
  const float* g = p->in[29];
  for (int t = blockIdx.x * 4 + w; t < T; t += gridDim.x * 4) {
    float* x = p->out + (size_t)t * 1024;
    float4 v[4];
    float ss = 0.f;
#pragma unroll
    for (int i = 0; i < 4; ++i) {
      v[i] = ((const float4*)x)[i * 64 + lane];
      ss += v[i].x * v[i].x + v[i].y * v[i].y + v[i].z * v[i].z + v[i].w * v[i].w;
    }
    ss = wave_sum(ss);
    const float sc = rsqrtf(ss * (1.f / 1024.f) + 1e-6f);
#pragma unroll
    for (int i = 0; i < 4; ++i) {
      const float4 gg = ((const float4*)g)[i * 64 + lane];
      ((float4*)x)[i * 64 + lane] = make_float4(v[i].x * sc * gg.x, v[i].y * sc * gg.y, v[i].z * sc * gg.z, v[i].w * sc * gg.w);
    }
  }
}

DI void run_phase(int ph, char* smem) {
  KP p = getp();
  switch (ph) {
    case 0: phase0(p, smem); break;
    case 1: phase1(p, smem); break;
    case 2: phase2(p); break;
    case 3: phase3(p, smem); break;
    case 4: phase4(p, smem); break;
    case 5: phase5(p); break;
    case 6: phase6(p, smem); break;
    case 7: phase7(p); break;
    case 8: phase8(p, smem); break;
    case 9: phase9(p, smem); break;
    case 10: phase10(p); break;
    case 11: phase11(p, smem); break;
    case 12: phase12(p); break;
    default: break;
  }
}

template <int LO, int HI>
__global__ void __launch_bounds__(256, 2) mega_kernel(Params p) {
  __shared__ __attribute__((aligned(16))) char smem[SMEM_BYTES];
  __shared__ uint4 xb_words;
  if (gridDim.x == 0x7fffffffu) cg::this_grid().sync();
  XcdBarrier xb;
  if (HI - LO > 1) {
    if (threadIdx.x == 0) xb_words = make_uint4(0u, 0u, 0u, 0u);
    __syncthreads();
    xb = xcd_barrier_post((unsigned*)(getp()->ws + OFF_CTR), (volatile LAS unsigned*)&xb_words);
  }
#pragma unroll
  for (int ph = LO; ph < HI; ++ph) {
    run_phase(ph, smem);
    if (ph + 1 < HI) xcd_barrier(xb);
  }
}

template <int PH>
static void launch_phases(const Params& p, int grid, hipStream_t stream) {
  hipLaunchKernelGGL((mega_kernel<PH, PH + 1>), dim3(grid), dim3(256), 0, stream, p);
  if constexpr (PH + 1 < 13) launch_phases<PH + 1>(p, grid, stream);
}

extern "C" void kernel_launch(void* const* d_in, const int* in_sizes, int n_in, void* d_out, int out_size,
                              void* d_ws, size_t ws_size, hipStream_t stream) {
  static int grid_blocks = 0;
  if (!grid_blocks) {
    int dev = 0, cus = 0, per_cu = 0;
    (void)hipGetDevice(&dev);
    (void)hipDeviceGetAttribute(&cus, hipDeviceAttributeMultiprocessorCount, dev);
#if MK_MULTI
    per_cu = 2;
#else
    (void)hipOccupancyMaxActiveBlocksPerMultiprocessor(&per_cu, mega_kernel<0, 13>, 256, 0);
#endif
    if (per_cu < 1) per_cu = 1;
    if (per_cu > 2) per_cu = 2;
    grid_blocks = cus * per_cu;
  }
  Params p{};
  for (int i = 0; i < 30; ++i) p.in[i] = (const float*)d_in[i];
  p.out = (float*)d_out;
  p.ws = (char*)d_ws;
  if (ws_size < WS_END) { fprintf(stderr, "workspace too small: %zu < %zu\n", ws_size, (size_t)WS_END); return; }
  (void)hipMemsetAsync((char*)d_ws + OFF_CTR, 0, 32768, stream);
#if MK_MULTI
  launch_phases<0>(p, grid_blocks, stream);
#else
  void* args[] = {&p};
  hipError_t e = hipLaunchCooperativeKernel((void*)mega_kernel<0, 13>, dim3(grid_blocks), dim3(256), args, 0, stream);
  if (e != hipSuccess) fprintf(stderr, "cooperative launch failed: %s (grid %d)\n", hipGetErrorString(e), grid_blocks);
#endif
}
```

```cpp
#include <hip/hip_runtime.h>
#include <hip/hip_cooperative_groups.h>
#include <cstdio>
namespace cg = cooperative_groups;

#ifndef MK_MULTI
#define MK_MULTI 0
#endif

typedef unsigned short bf16_t;
typedef __attribute__((ext_vector_type(8))) short bf16x8;
typedef __attribute__((ext_vector_type(16))) float f32x16;
typedef __attribute__((ext_vector_type(2))) __bf16 bf2_t;
typedef __attribute__((ext_vector_type(2))) float f2_t;
#define DI __device__ __forceinline__

constexpr int T = 17408, TP = 16384;
constexpr int NPH = 14;

constexpr size_t O_RETP = (size_t)T * 1024;
constexpr size_t O_WKVP = O_RETP + 262144;
constexpr size_t O_SHP = O_WKVP + 262144;
constexpr size_t O_RETS = O_SHP + 14336;
constexpr size_t O_WKVS = O_RETS + 4194304;
constexpr size_t O_SHS = O_WKVS + 4194304;

constexpr size_t OFF_WIN = 0;
constexpr size_t OFF_WOUT = OFF_WIN + (size_t)3840 * 1024 * 2;
constexpr size_t OFF_WQ = OFF_WOUT + (size_t)1024 * 1024 * 2;
constexpr size_t OFF_KEYS = OFF_WQ + (size_t)2048 * 1024 * 2;
constexpr size_t OFF_PG = OFF_KEYS + (size_t)16 * 128 * 128 * 2;
constexpr size_t OFF_PP = OFF_PG + (size_t)1024 * 1024 * 2;
constexpr size_t OFF_W2 = OFF_PP + (size_t)1024 * 256 * 2;
constexpr size_t OFF_A2 = OFF_W2 + (size_t)512 * 64 * 2;
constexpr size_t OFF_G2 = OFF_A2 + (size_t)512 * 64 * 2;
constexpr size_t OFF_ROPE = OFF_G2 + (size_t)512 * 128 * 2;
constexpr size_t OFF_CTR = OFF_ROPE + (size_t)2056 * 32 * 2 * 4;
constexpr size_t OFF_ACT = OFF_CTR + 32768;
constexpr size_t OFF_TAB = OFF_ACT + (size_t)T * 1024 * 2;
constexpr size_t OFF_PREP = OFF_TAB + (size_t)2 * 16384 * 1024 * 2;
constexpr size_t SZ512 = (size_t)T * 512 * 2;
constexpr size_t OFF_R = OFF_PREP;
constexpr size_t OFF_K = OFF_R + SZ512;
constexpr size_t OFF_V = OFF_K + SZ512;
constexpr size_t OFF_KK = OFF_V + SZ512;
constexpr size_t OFF_BB = OFF_KK + SZ512;
constexpr size_t OFF_GATE = OFF_BB + SZ512;
constexpr size_t OFF_EW = OFF_GATE + SZ512;
constexpr size_t OFF_LORA = OFF_EW + (size_t)T * 512 * 4;
constexpr size_t OFF_INVN = OFF_LORA + (size_t)T * 256 * 2;
constexpr size_t WS_END = OFF_INVN + (size_t)T * 8 * 4;
constexpr size_t OFF_QPEER = OFF_PREP;
constexpr size_t OFF_IDX = OFF_QPEER + (size_t)T * 2048 * 2;
constexpr size_t OFF_GSM = OFF_IDX + (size_t)T * 128 * 4;

constexpr int SMEM_BYTES = 79872;

struct Params {
  const float* in[30];
  float* out;
  char* ws;
};

typedef const __attribute__((address_space(4))) Params* KP;
__device__ __forceinline__ KP getp() {
  KP q = (KP)__builtin_amdgcn_kernarg_segment_ptr();
  asm volatile("" : "+s"(q));
  return q;
}
DI int tidx() { int t = threadIdx.x; asm volatile("" : "+v"(t)); return t; }
DI bf16_t f2bf(float x) { unsigned u = __float_as_uint(x); u += 0x7fffu + ((u >> 16) & 1u); return (bf16_t)(u >> 16); }
DI float bf2f(bf16_t b) { return __uint_as_float(((unsigned)b) << 16); }
DI unsigned pack2(float a, float b) { return (unsigned)f2bf(a) | ((unsigned)f2bf(b) << 16); }
DI float lo2f(unsigned u) { return __uint_as_float(u << 16); }
DI float hi2f(unsigned u) { return __uint_as_float(u & 0xffff0000u); }
DI int crow(int reg, int h) { return (reg & 3) + 8 * (reg >> 2) + 4 * h; }
DI float wave_sum(float v) {
#pragma unroll
  for (int o = 32; o >= 1; o >>= 1) v += __shfl_xor(v, o);
  return v;
}
DI float allreduce16(float v) {
  v += __int_as_float(__builtin_amdgcn_update_dpp(0, __float_as_int(v), 0x128, 0xf, 0xf, false));
  v += __int_as_float(__builtin_amdgcn_update_dpp(0, __float_as_int(v), 0x124, 0xf, 0xf, false));
  v += __int_as_float(__builtin_amdgcn_update_dpp(0, __float_as_int(v), 0x122, 0xf, 0xf, false));
  v += __int_as_float(__builtin_amdgcn_update_dpp(0, __float_as_int(v), 0x121, 0xf, 0xf, false));
  return v;
}
#define DPP_ADD(v, ctrl) v += __int_as_float(__builtin_amdgcn_update_dpp(0, __float_as_int(v), ctrl, 0xf, 0xf, false))
DI void allreduce16x2(float& a, float& b) {
  DPP_ADD(a, 0x128); DPP_ADD(b, 0x128);
  DPP_ADD(a, 0x124); DPP_ADD(b, 0x124);
  DPP_ADD(a, 0x122); DPP_ADD(b, 0x122);
  DPP_ADD(a, 0x121); DPP_ADD(b, 0x121);
}
DI float allreduce8(float v) {
  v += __int_as_float(__builtin_amdgcn_update_dpp(0, __float_as_int(v), 0xB1, 0xf, 0xf, false));
  v += __int_as_float(__builtin_amdgcn_update_dpp(0, __float_as_int(v), 0x4E, 0xf, 0xf, false));
  v += __int_as_float(__builtin_amdgcn_update_dpp(0, __float_as_int(v), 0x141, 0xf, 0xf, false));
  return v;
}
DI void unpack8f(const uint4& u, float (&f)[8]) {
  f[0] = lo2f(u.x); f[1] = hi2f(u.x); f[2] = lo2f(u.y); f[3] = hi2f(u.y);
  f[4] = lo2f(u.z); f[5] = hi2f(u.z); f[6] = lo2f(u.w); f[7] = hi2f(u.w);
}
DI uint4 pack8f(const float (&f)[8]) {
  return make_uint4(pack2(f[0], f[1]), pack2(f[2], f[3]), pack2(f[4], f[5]), pack2(f[6], f[7]));
}
DI float sigmoidf_(float x) { return 1.f / (1.f + __expf(-x)); }
DI const float* xrow(KP p, int t) {
  return t < TP ? p->in[0] + (size_t)t * 1024 : p->in[1] + (size_t)(t - TP) * 1024;
}
struct TokInfo { int sample, b, l; };
DI TokInfo tokinfo(int t) {
  TokInfo ti;
  if (t >= TP) { ti.sample = 1; ti.b = (t - TP) >> 3; ti.l = (t - TP) & 7; }
  else { ti.sample = 0; ti.b = t >> 11; ti.l = t & 2047; }
  return ti;
}

#define XB_TMO      128
#define XB_XCNT(j)  (256  + 64 * (j))
#define XB_XSUB(j)  (1280 + 64 * (j))
#define XB_XGEN(j)  (2304 + 64 * (j))
#define XB_TOP      3328
#define XB_TOPGEN   3392
#define XCD_BAR_WORDS 3456
#define XB_SPIN_CAP (1u << 20)
#define LAS __attribute__((address_space(3)))
DI unsigned xb_ld(unsigned* p) { return __hip_atomic_load(p, __ATOMIC_RELAXED, __HIP_MEMORY_SCOPE_AGENT); }
DI unsigned xb_add(unsigned* p, unsigned v) { return __hip_atomic_fetch_add(p, v, __ATOMIC_RELAXED, __HIP_MEMORY_SCOPE_AGENT); }
DI unsigned xb_xcc_id() { return (unsigned)__builtin_amdgcn_s_getreg((3 << 11) | 20) & 0xFu; }
#define XB_SPIN(cond, bar) do { unsigned _sp = 0; while (cond) { __builtin_amdgcn_s_sleep(1); \
    if ((++_sp & 255u) == 0u) { if (xb_ld(&(bar)[XB_TMO])) break; if (_sp > XB_SPIN_CAP) { atomicAdd(&(bar)[XB_TMO], 1u); break; } } } } while (0)
struct XcdBarrier { unsigned* bar; unsigned x; volatile LAS unsigned* st; };
DI XcdBarrier xcd_barrier_post(unsigned* bar, volatile LAS unsigned* st) {
  XcdBarrier b; b.bar = bar; b.x = xb_xcc_id(); b.st = st;
  if (threadIdx.x == 0) (void)xb_add(&bar[XB_XCNT(b.x)], 1u);
  return b;
}
DI void xcd_barrier_complete(unsigned* bar, unsigned x, unsigned& nloc, unsigned& nx) {
  const unsigned G = gridDim.x * gridDim.y * gridDim.z;
  unsigned sum, cnt, mine, sp = 0u;
  for (;;) {
    sum = 0u; cnt = 0u; mine = 0u;
#pragma unroll
    for (unsigned j = 0; j < 16; ++j) { const unsigned c = xb_ld(&bar[XB_XCNT(j)]); sum += c; cnt += (c > 0u) ? 1u : 0u; mine = (j == x) ? c : mine; }
    if (sum == G) break;
    __builtin_amdgcn_s_sleep(1);
    if ((++sp & 255u) == 0u) { if (xb_ld(&bar[XB_TMO])) break; if (sp > XB_SPIN_CAP) { atomicAdd(&bar[XB_TMO], 1u); break; } }
  }
  nloc = mine > 0u ? mine : 1u; nx = cnt > 0u ? cnt : 1u;
}
DI void xcd_barrier(const XcdBarrier& b) {
  asm volatile("s_waitcnt vmcnt(0)" ::: "memory");
  __syncthreads();
  if (threadIdx.x == 0) {
    unsigned* bar = b.bar;
    __builtin_amdgcn_s_waitcnt(0);
    unsigned nloc = b.st[0], nx = b.st[1];
    if (nloc == 0u) { xcd_barrier_complete(bar, b.x, nloc, nx); b.st[0] = nloc; b.st[1] = nx; }
    const unsigned old = xb_add(&bar[XB_XSUB(b.x)], 1u);
    const unsigned gen = old / nloc;
    if (old + 1u == (gen + 1u) * nloc) {
      __builtin_amdgcn_fence(__ATOMIC_RELEASE, "agent");
      asm volatile("s_waitcnt vmcnt(0)" ::: "memory");
      const unsigned og = xb_add(&bar[XB_TOP], 1u);
      const unsigned tg = og / nx;
      if (og + 1u == (tg + 1u) * nx) xb_add(&bar[XB_TOPGEN], 1u);
      else XB_SPIN(xb_ld(&bar[XB_TOPGEN]) == tg, bar);
      __builtin_amdgcn_fence(__ATOMIC_ACQUIRE, "agent");
      xb_add(&bar[XB_XGEN(b.x)], 1u);
      asm volatile("s_waitcnt vmcnt(0)" ::: "memory");
    } else {
      XB_SPIN(xb_ld(&bar[XB_XGEN(b.x)]) == gen, bar);
      __builtin_amdgcn_fence(__ATOMIC_ACQUIRE, "agent");
      asm volatile("s_waitcnt vmcnt(0)" ::: "memory");
    }
  }
  __syncthreads();
}

constexpr int LDT = 72;
constexpr int GBUF = 2 * 128 * LDT;
template <bool AF32>
DI void gemm128(const void* __restrict__ Ap, int lda, const bf16_t* __restrict__ Bt, int ldb, int K,
                f32x16 (&acc)[2][2], char* smem) {
  bf16_t* S0 = (bf16_t*)smem;
  const int tid = tidx(), lane = tid & 63, w = tid >> 6;
  const int wm = w >> 1, wn = w & 1, r = lane & 31, h = lane >> 5;
  const int lrow = tid >> 3, lch = tid & 7;
#pragma unroll
  for (int i = 0; i < 2; ++i)
#pragma unroll
    for (int j = 0; j < 2; ++j)
#pragma unroll
      for (int e = 0; e < 16; ++e) acc[i][j][e] = 0.f;
  uint4 ra0, ra1, ra2, ra3, rb0, rb1, rb2, rb3;
  const bf16_t* Ab = (const bf16_t*)Ap + (size_t)lrow * lda + lch * 8;
  const float* Af = (const float*)Ap + (size_t)lrow * lda + lch * 8;
  const bf16_t* Bb = Bt + (size_t)lrow * ldb + lch * 8;
  const size_t a32 = (size_t)32 * lda, b32 = (size_t)32 * ldb;
#define GEMM_LDA(dst, q, k0)                                                                          \
  if constexpr (AF32) {                                                                               \
    const float4 f0 = *(const float4*)(Af + (q) * a32 + (k0));                                        \
    const float4 f1 = *(const float4*)(Af + (q) * a32 + (k0) + 4);                                    \
    dst = make_uint4(pack2(f0.x, f0.y), pack2(f0.z, f0.w), pack2(f1.x, f1.y), pack2(f1.z, f1.w));     \
  } else {                                                                                            \
    dst = *(const uint4*)(Ab + (q) * a32 + (k0));                                                     \
  }
#define GEMM_LOADG(k0)                                                                                \
  {                                                                                                   \
    GEMM_LDA(ra0, 0, k0) GEMM_LDA(ra1, 1, k0) GEMM_LDA(ra2, 2, k0) GEMM_LDA(ra3, 3, k0)               \
    rb0 = *(const uint4*)(Bb + (k0));                                                                 \
    rb1 = *(const uint4*)(Bb + b32 + (k0));                                                           \
    rb2 = *(const uint4*)(Bb + 2 * b32 + (k0));                                                       \
    rb3 = *(const uint4*)(Bb + 3 * b32 + (k0));                                                       \
  }
#define GEMM_STORE(buf)                                                                               \
  {                                                                                                   \
    bf16_t* ad = S0 + (buf) * GBUF + lrow * LDT + lch * 8;                                            \
    bf16_t* bd = ad + 128 * LDT;                                                                      \
    *(uint4*)(ad) = ra0; *(uint4*)(ad + 32 * LDT) = ra1; *(uint4*)(ad + 64 * LDT) = ra2; *(uint4*)(ad + 96 * LDT) = ra3; \
    *(uint4*)(bd) = rb0; *(uint4*)(bd + 32 * LDT) = rb1; *(uint4*)(bd + 64 * LDT) = rb2; *(uint4*)(bd + 96 * LDT) = rb3; \
  }
  const int nk = K >> 6;
  GEMM_LOADG(0)
  GEMM_STORE(0)
  if (nk > 1) GEMM_LOADG(64)
  __syncthreads();
  for (int kt = 0; kt < nk; ++kt) {
    if (kt + 1 < nk) GEMM_STORE((kt + 1) & 1)
    if (kt + 2 < nk) GEMM_LOADG((kt + 2) << 6)
    __builtin_amdgcn_sched_barrier(0);
    const bf16_t* As = S0 + (kt & 1) * GBUF;
    const bf16_t* Bs = As + 128 * LDT;
#pragma unroll
    for (int ks = 0; ks < 4; ++ks) {
      bf16x8 a0 = *(const bf16x8*)(As + (wm * 64 + r) * LDT + ks * 16 + h * 8);
      bf16x8 a1 = *(const bf16x8*)(As + (wm * 64 + 32 + r) * LDT + ks * 16 + h * 8);
      bf16x8 b0 = *(const bf16x8*)(Bs + (wn * 64 + r) * LDT + ks * 16 + h * 8);
      bf16x8 b1 = *(const bf16x8*)(Bs + (wn * 64 + 32 + r) * LDT + ks * 16 + h * 8);
      acc[0][0] = __builtin_amdgcn_mfma_f32_32x32x16_bf16(a0, b0, acc[0][0], 0, 0, 0);
      acc[0][1] = __builtin_amdgcn_mfma_f32_32x32x16_bf16(a0, b1, acc[0][1], 0, 0, 0);
      acc[1][0] = __builtin_amdgcn_mfma_f32_32x32x16_bf16(a1, b0, acc[1][0], 0, 0, 0);
      acc[1][1] = __builtin_amdgcn_mfma_f32_32x32x16_bf16(a1, b1, acc[1][1], 0, 0, 0);
    }
    __syncthreads();
  }
}
template <class F>
DI void epi_each(f32x16 (&acc)[2][2], F f) {
  const int lane = tidx() & 63, w = tidx() >> 6;
  const int wm = w >> 1, wn = w & 1, r = lane & 31, h = lane >> 5;
#pragma unroll
  for (int mi = 0; mi < 2; ++mi)
#pragma unroll
    for (int ni = 0; ni < 2; ++ni)
#pragma unroll
      for (int i = 0; i < 16; ++i) f(wm * 64 + mi * 32 + crow(i, h), wn * 64 + ni * 32 + r, acc[mi][ni][i]);
}

DI void transpose_tile(const float* __restrict__ src, bf16_t* __restrict__ dst, int K, int N, int kt, int nt, float* sm) {
  const int tid = tidx();
  const int k0 = kt * 64, n0 = nt * 64;
#pragma unroll
  for (int i = 0; i < 16; ++i) {
    int k = i * 4 + (tid >> 6), n = tid & 63;
    sm[k * 65 + n] = src[(size_t)(k0 + k) * N + n0 + n];
  }
  __syncthreads();
  int n = tid >> 2, ks = (tid & 3) * 16;
  unsigned pk[8];
#pragma unroll
  for (int j = 0; j < 8; ++j) pk[j] = pack2(sm[(ks + 2 * j) * 65 + n], sm[(ks + 2 * j + 1) * 65 + n]);
  uint4* d = (uint4*)(dst + (size_t)(n0 + n) * K + k0 + ks);
  d[0] = make_uint4(pk[0], pk[1], pk[2], pk[3]);
  d[1] = make_uint4(pk[4], pk[5], pk[6], pk[7]);
  __syncthreads();
}
DI void rmsnorm_row_bf(const float* __restrict__ x, const float* __restrict__ g, bf16_t* __restrict__ o, int lane) {
  float4 v[4];
  float ss = 0.f;
#pragma unroll
  for (int i = 0; i < 4; ++i) {
    v[i] = ((const float4*)x)[i * 64 + lane];
    ss += v[i].x * v[i].x + v[i].y * v[i].y + v[i].z * v[i].z + v[i].w * v[i].w;
  }
  ss = wave_sum(ss);
  float sc = rsqrtf(ss * (1.f / 1024.f) + 1e-6f);
#pragma unroll
  for (int i = 0; i < 4; ++i) {
    float4 gg = ((const float4*)g)[i * 64 + lane];
    uint2 pk = make_uint2(pack2(v[i].x * sc * gg.x, v[i].y * sc * gg.y), pack2(v[i].z * sc * gg.z, v[i].w * sc * gg.w));
    ((uint2*)o)[i * 64 + lane] = pk;
  }
}

#define TJ(IDX, OFF, KK_, NN_)                                                                             \
  {                                                                                                        \
    const int ntl = ((KK_) / 64) * ((NN_) / 64);                                                           \
    if (it < ntl) {                                                                                        \
      transpose_tile(p->in[IDX], (bf16_t*)(p->ws + (OFF)), (KK_), (NN_), it / ((NN_) / 64), it % ((NN_) / 64), (float*)smem); \
      continue;                                                                                            \
    }                                                                                                      \
    it -= ntl;                                                                                             \
  }

DI void phase0(KP p, char* smem) {
  const int tid = tidx(), lane = tid & 63, w = tid >> 6;
  constexpr int N_TR = 960 + 8 + 8 + 16;
  constexpr int N_KEYS = 128, N_ROPE = 257, N_NORM = T / 4;
  for (int item = blockIdx.x; item < N_TR + N_KEYS + N_ROPE + N_NORM; item += gridDim.x) {
    int it = item;
    TJ(8, OFF_WIN, 1024, 3840)
    TJ(11, OFF_W2, 64, 512)
    TJ(13, OFF_A2, 64, 512)
    TJ(14, OFF_G2, 128, 512)
    if (it < N_KEYS) {
      const float* src = p->in[23] + (size_t)it * 2048 + tid * 8;
      float4 f0 = *(const float4*)src, f1 = *(const float4*)(src + 4);
      *(uint4*)((bf16_t*)(p->ws + OFF_KEYS) + (size_t)it * 2048 + tid * 8) =
          make_uint4(pack2(f0.x, f0.y), pack2(f0.z, f0.w), pack2(f1.x, f1.y), pack2(f1.z, f1.w));
      continue;
    }
    it -= N_KEYS;
    if (it < N_ROPE) {
      int e = it * 256 + tid;
      int pidx = e >> 5, f = e & 31;
      if (pidx < 2056) {
        const float pos = (pidx < 2048) ? (float)pidx : (float)(16384 + pidx - 2048);
        const float inv = exp2f(-(float)f * 0.41524101186092f);
        const float ang = pos * inv;
        const float kq = rintf(ang * 0.15915494309189535f);
        float rr = fmaf(-kq, 6.28125f, ang);
        rr = fmaf(-kq, 1.9353071795864769e-3f, rr);
        float* rt = (float*)(p->ws + OFF_ROPE);
        rt[e * 2] = cosf(rr);
        rt[e * 2 + 1] = sinf(rr);
      }
      continue;
    }
    it -= N_ROPE;
    {
      int t = it * 4 + w;
      rmsnorm_row_bf(xrow(p, t), p->in[7], (bf16_t*)(p->ws + OFF_ACT) + (size_t)t * 1024, lane);
    }
  }
}

DI void phase1(KP p, char* smem) {
  const int lane = tidx() & 63, w = tidx() >> 6;
  const int wm = w >> 1, wn = w & 1, r = lane & 31, h = lane >> 5;
  bf16_t* RET = (bf16_t*)p->out;
  bf16_t* RWP = (bf16_t*)(p->ws + OFF_TAB);
  const float2* rope = (const float2*)(p->ws + OFF_ROPE);
  for (int tile = blockIdx.x; tile < 136 * 30; tile += gridDim.x) {
    const int mt = tile / 30, nt = tile % 30;
    const int m0 = mt * 128, n0 = nt * 128;
    f32x16 acc[2][2];
    gemm128<false>((const bf16_t*)(p->ws + OFF_ACT) + (size_t)m0 * 1024, 1024,
                   (const bf16_t*)(p->ws + OFF_WIN) + (size_t)n0 * 1024, 1024, 1024, acc, smem);
    const int nb = n0 + wn * 64;
    if (nb < 1024) {
      float2 cs[2][16];
#pragma unroll
      for (int mi = 0; mi < 2; ++mi)
#pragma unroll
        for (int i = 0; i < 16; ++i) {
          const TokInfo ti = tokinfo(m0 + wm * 64 + mi * 32 + crow(i, h));
          cs[mi][i] = rope[(ti.sample ? 2048 + ti.l : ti.l) * 32 + r];
        }
      const float scl = (nb >= 512) ? 0.125f : 1.f;
#pragma unroll
      for (int mi = 0; mi < 2; ++mi)
#pragma unroll
        for (int i = 0; i < 16; ++i) {
          const float v0 = acc[mi][0][i], v1 = acc[mi][1][i];
          acc[mi][0][i] = (v0 * cs[mi][i].x - v1 * cs[mi][i].y) * scl;
          acc[mi][1][i] = (v1 * cs[mi][i].x + v0 * cs[mi][i].y) * scl;
        }
    }
#pragma unroll
    for (int mi = 0; mi < 2; ++mi)
#pragma unroll
      for (int i = 0; i < 16; ++i) {
        const int t = m0 + wm * 64 + mi * 32 + crow(i, h);
        const float v0 = acc[mi][0][i], v1 = acc[mi][1][i];
        if (nb < 2048) {
          RET[(size_t)t * 2048 + nb + r] = f2bf(v0);
          RET[(size_t)t * 2048 + nb + 32 + r] = f2bf(v1);
        } else {
          const TokInfo ti = tokinfo(t);
          const int c = nb - 2048 + r;
          RWP[(size_t)t * 1792 + c] = f2bf(v0);
          RWP[(size_t)t * 1792 + c + 32] = f2bf(v1);
          if (ti.sample) {
            if (ti.l == 7) { p->out[O_SHS + ti.b * 1792 + c] = v0; p->out[O_SHS + ti.b * 1792 + c + 32] = v1; }
          } else {
            if (ti.l == 2047) { p->out[O_SHP + ti.b * 1792 + c] = v0; p->out[O_SHP + ti.b * 1792 + c + 32] = v1; }
          }
        }
      }
  }
}

DI void phase2(KP p) {
  const int lane = tidx() & 63, w = tidx() >> 6;
  const bf16_t* RWP = (const bf16_t*)(p->ws + OFF_TAB);
  bf16_t* Rb = (bf16_t*)(p->ws + OFF_R);
  bf16_t* Kb = (bf16_t*)(p->ws + OFF_K);
  bf16_t* Vb = (bf16_t*)(p->ws + OFF_V);
  bf16_t* LA = (bf16_t*)(p->ws + OFF_LORA);
  float* INVN = (float*)(p->ws + OFF_INVN);
  const float* mu = p->in[9];
  const float* kkw = p->in[15];
  for (int t = blockIdx.x * 4 + w; t < T; t += gridDim.x * 4) {
    const TokInfo ti = tokinfo(t);
    const bf16_t* cur = RWP + (size_t)t * 1792;
    const bf16_t* prv = cur - 1792;
    const float* sh = p->in[4] + (size_t)ti.b * 1792;
    float f[4][8];
#pragma unroll
    for (int i = 0; i < 4; ++i) {
      const int c8 = (lane + 64 * i) * 8;
      if (i < 3 || lane < 32) {
        float cv[8], pv[8];
        unpack8f(*(const uint4*)(cur + c8), cv);
        if (ti.l > 0) unpack8f(*(const uint4*)(prv + c8), pv);
        else if (ti.sample) {
          const float4 s0 = *(const float4*)(sh + c8), s1 = *(const float4*)(sh + c8 + 4);
          pv[0] = s0.x; pv[1] = s0.y; pv[2] = s0.z; pv[3] = s0.w; pv[4] = s1.x; pv[5] = s1.y; pv[6] = s1.z; pv[7] = s1.w;
        } else {
#pragma unroll
          for (int k = 0; k < 8; ++k) pv[k] = 0.f;
        }
        const float4 m0 = *(const float4*)(mu + c8), m1 = *(const float4*)(mu + c8 + 4);
        const float mm[8] = {m0.x, m0.y, m0.z, m0.w, m1.x, m1.y, m1.z, m1.w};
#pragma unroll
        for (int k = 0; k < 8; ++k) f[i][k] = cv[k] + (pv[k] - cv[k]) * mm[k];
      } else {
#pragma unroll
        for (int k = 0; k < 8; ++k) f[i][k] = 0.f;
      }
    }
    *(uint4*)(Rb + (size_t)t * 512 + lane * 8) = pack8f(f[0]);
    {
      const uint4 kb = pack8f(f[1]);
      *(uint4*)(Kb + (size_t)t * 512 + lane * 8) = kb;
      float kr[8];
      unpack8f(kb, kr);
      const float4 q0 = *(const float4*)(kkw + lane * 8), q1 = *(const float4*)(kkw + lane * 8 + 4);
      const float qq[8] = {q0.x, q0.y, q0.z, q0.w, q1.x, q1.y, q1.z, q1.w};
      float ss = 0.f;
#pragma unroll
      for (int k = 0; k < 8; ++k) { const float kq = kr[k] * qq[k]; ss += kq * kq; }
      ss = allreduce8(ss);
      if ((lane & 7) == 0) INVN[t * 8 + (lane >> 3)] = 1.f / fmaxf(sqrtf(ss), 1e-12f);
    }
    *(uint4*)(Vb + (size_t)t * 512 + lane * 8) = pack8f(f[2]);
    if (lane < 32) {
      float o[8];
#pragma unroll
      for (int k = 0; k < 8; ++k) {
        const float x = f[3][k];
        o[k] = (lane < 8) ? tanhf(x) : ((lane < 16) ? x : 1.f / (1.f + expf(-x)));
      }
      *(uint4*)(LA + (size_t)t * 256 + lane * 8) = pack8f(o);
    }
  }
}

DI void phase3(KP p, char* smem) {
  const bf16_t* LA = (const bf16_t*)(p->ws + OFF_LORA);
  bf16_t* Kb = (bf16_t*)(p->ws + OFF_K);
  bf16_t* KKb = (bf16_t*)(p->ws + OFF_KK);
  bf16_t* BBb = (bf16_t*)(p->ws + OFF_BB);
  bf16_t* GTb = (bf16_t*)(p->ws + OFF_GATE);
  float* EW = (float*)(p->ws + OFF_EW);
  const float* INVN = (const float*)(p->ws + OFF_INVN);
  const float* w0 = p->in[10];
  const float* a0 = p->in[12];
  const float* kkw = p->in[15];
  const float* kaw = p->in[16];
  for (int item = blockIdx.x; item < 136 * 12; item += gridDim.x) {
    const int mt = item / 12, rem = item % 12, kind = rem >> 2, nt = rem & 3;
    const int m0 = mt * 128, n0 = nt * 128;
    f32x16 acc[2][2];
    if (kind == 0) {
      gemm128<false>(LA + (size_t)m0 * 256, 256, (const bf16_t*)(p->ws + OFF_W2) + n0 * 64, 64, 64, acc, smem);
      epi_each(acc, [&](int rr, int cc, float v) {
        const int t = m0 + rr, c = n0 + cc;
        const float x = v + w0[c];
        const float z = -x;
        const float sp = fmaxf(z, 0.f) + __logf(1.f + __expf(-fabsf(z)));
        const float ww = -sp - 0.5f;
        EW[(size_t)t * 512 + c] = __expf(-__expf(ww));
      });
    } else if (kind == 1) {
      gemm128<false>(LA + (size_t)m0 * 256 + 64, 256, (const bf16_t*)(p->ws + OFF_A2) + n0 * 64, 64, 64, acc, smem);
      {
        const int lane = tidx() & 63, w = tidx() >> 6;
        const int wm = w >> 1, wn = w & 1, r = lane & 31, h = lane >> 5;
#pragma unroll 1
        for (int mi = 0; mi < 2; ++mi) {
          const int tb = m0 + wm * 64 + mi * 32;
          float inv[16];
#pragma unroll
          for (int i = 0; i < 16; ++i) inv[i] = INVN[(tb + crow(i, h)) * 8 + ((n0 + wn * 64) >> 6)];
#pragma unroll
          for (int ni = 0; ni < 2; ++ni) {
            const int c = n0 + wn * 64 + ni * 32 + r;
            const float a0c = a0[c], kkc = kkw[c], kac = kaw[c];
            float k7v[16];
#pragma unroll
            for (int i = 0; i < 16; ++i) k7v[i] = bf2f(Kb[(size_t)(tb + crow(i, h)) * 512 + c]);
#pragma unroll
            for (int i = 0; i < 16; ++i) {
              const float av = (mi == 0) ? acc[0][ni][i] : acc[1][ni][i];
              const float a = 1.f / (1.f + __expf(-(av + a0c)));
              const size_t o = (size_t)(tb + crow(i, h)) * 512 + c;
              const float kkv = k7v[i] * kkc * inv[i];
              Kb[o] = f2bf(k7v[i] * (1.f + (a - 1.f) * kac));
              KKb[o] = f2bf(kkv);
              BBb[o] = f2bf(kkv * a);
            }
          }
        }
      }
    } else {
      gemm128<false>(LA + (size_t)m0 * 256 + 128, 256, (const bf16_t*)(p->ws + OFF_G2) + n0 * 128, 128, 128, acc, smem);
      epi_each(acc, [&](int rr, int cc, float v) { GTb[(size_t)(m0 + rr) * 512 + n0 + cc] = f2bf(v); });
    }
  }
}

DI void rwkv_scan(KP p, int tok0, int hd, int q, int nsteps, const float* __restrict__ S0, float* __restrict__ Sout, char* smem) {
  const int tid = tidx(), lane = tid & 63, w = tid >> 6, g = lane >> 4, l16 = lane & 15;
  const int rl = w * 4 + g;
  const int row = q * 16 + rl;
  const int j0 = l16 * 4;
  const bf16_t* Rb = (const bf16_t*)(p->ws + OFF_R);
  const bf16_t* Kb = (const bf16_t*)(p->ws + OFF_K);
  const bf16_t* Vb = (const bf16_t*)(p->ws + OFF_V);
  const bf16_t* KKb = (const bf16_t*)(p->ws + OFF_KK);
  const bf16_t* BBb = (const bf16_t*)(p->ws + OFF_BB);
  const float* EW = (const float*)(p->ws + OFF_EW);
  bf16_t* ACT = (bf16_t*)(p->ws + OFF_ACT);
  float* ew_s = (float*)smem;
  float* kk_s = ew_s + 2048;
  float* bb_s = kk_s + 2048;
  float* kp_s = bb_s + 2048;
  float* r_s = kp_s + 2048;
  float* v_s = r_s + 2048;
  float* y_s = v_s + 512;
  f2_t s01 = (f2_t){0.f, 0.f}, s23 = (f2_t){0.f, 0.f};
  if (S0) { const float4 t4 = *(const float4*)(S0 + row * 64 + j0); s01 = (f2_t){t4.x, t4.y}; s23 = (f2_t){t4.z, t4.w}; }
  uint4 rg_r = make_uint4(0, 0, 0, 0), rg_k = rg_r, rg_kk = rg_r, rg_bb = rg_r, rg_v = rg_r;
  float4 rg_e0 = make_float4(0, 0, 0, 0), rg_e1 = rg_e0;
  const int st_l = tid >> 3, c8 = (tid & 7) * 8;
  auto gload = [&](int sb) {
    if (sb + st_l < nsteps) {
      const size_t o = (size_t)(tok0 + sb + st_l) * 512 + hd * 64 + c8;
      rg_r = *(const uint4*)(Rb + o);
      rg_k = *(const uint4*)(Kb + o);
      rg_kk = *(const uint4*)(KKb + o);
      rg_bb = *(const uint4*)(BBb + o);
      rg_e0 = *(const float4*)(EW + o);
      rg_e1 = *(const float4*)(EW + o + 4);
    }
    if (tid < 64) {
      const int sv = tid >> 1;
      if (sb + sv < nsteps) rg_v = *(const uint4*)(Vb + (size_t)(tok0 + sb + sv) * 512 + hd * 64 + q * 16 + (tid & 1) * 8);
    }
  };
  auto unpack8 = [&](float* d, const uint4& u) {
    *(float4*)d = make_float4(lo2f(u.x), hi2f(u.x), lo2f(u.y), hi2f(u.y));
    *(float4*)(d + 4) = make_float4(lo2f(u.z), hi2f(u.z), lo2f(u.w), hi2f(u.w));
  };
  auto sstore = [&]() {
    const int o = st_l * 64 + c8;
    unpack8(r_s + o, rg_r);
    unpack8(kp_s + o, rg_k);
    unpack8(kk_s + o, rg_kk);
    unpack8(bb_s + o, rg_bb);
    *(float4*)(ew_s + o) = rg_e0;
    *(float4*)(ew_s + o + 4) = rg_e1;
    if (tid < 64) unpack8(v_s + (tid >> 1) * 16 + (tid & 1) * 8, rg_v);
  };
  gload(0);
  for (int sb = 0; sb < nsteps; sb += 32) {
    __syncthreads();
    sstore();
    __syncthreads();
    if (sb + 32 < nsteps) gload(sb + 32);
    const int tc = min(32, nsteps - sb);
#define SC_LD(X, st)                                              \
  {                                                               \
    const float* b_ = ew_s + (st) * 64 + j0;                      \
    X##e = *(const float4*)(b_);                                  \
    X##q = *(const float4*)(b_ + 2048);                           \
    X##b = *(const float4*)(b_ + 4096);                           \
    X##k = *(const float4*)(b_ + 6144);                           \
    X##r = *(const float4*)(b_ + 8192);                           \
    X##v = v_s[(st) * 16 + rl];                                   \
  }
#define SC_STEP(X, st)                                                                     \
  {                                                                                        \
    const f2_t p2 = s01 * (f2_t){X##q.x, X##q.y} + s23 * (f2_t){X##q.z, X##q.w};           \
    float pdp = p2.x + p2.y;                                                               \
      \
    const f2_t vk01 = (f2_t){X##k.x, X##k.y} * X##v, vk23 = (f2_t){X##k.z, X##k.w} * X##v; \
    const f2_t base01 = s01 * (f2_t){X##e.x, X##e.y} + vk01;                               \
    const f2_t base23 = s23 * (f2_t){X##e.z, X##e.w} + vk23;                               \
    allreduce16x2(pdp, ypart);     \
    if (l16 == 0 && (st) > 0) y_s[((st) - 1) * 16 + rl] = ypart;                           \
    s01 = base01 - (f2_t){X##b.x, X##b.y} * pdp;                              \
    s23 = base23 - (f2_t){X##b.z, X##b.w} * pdp;                                           \
    const f2_t y2 = s01 * (f2_t){X##r.x, X##r.y} + s23 * (f2_t){X##r.z, X##r.w};           \
    ypart = y2.x + y2.y;                                                                   \
  }
    {
      float4 Ae, Aq, Ab, Ak, Ar, Be, Bq, Bb, Bk, Br;
      float Av, Bv;
      float ypart = 0.f;
      SC_LD(A, 0)
      for (int st = 0; st < tc; st += 2) {
        SC_LD(B, st + 1)
        SC_STEP(A, st)
        SC_LD(A, min(st + 2, tc - 1))
        SC_STEP(B, st + 1)
      }
      ypart = allreduce16(ypart);
      if (l16 == 0) y_s[(tc - 1) * 16 + rl] = ypart;
    }
    __syncthreads();
    if (tid < tc * 8) {
      const int st = tid >> 3, pr = tid & 7;
      const unsigned pk = pack2(y_s[st * 16 + 2 * pr], y_s[st * 16 + 2 * pr + 1]);
      *(unsigned*)(ACT + (size_t)(tok0 + sb + st) * 1024 + 512 + hd * 64 + q * 16 + 2 * pr) = pk;
    }
  }
  *(float4*)(Sout + row * 64 + j0) = make_float4(s01.x, s01.y, s23.x, s23.y);
}

constexpr int RL = 136;
DI void ret_prompt(KP p, int b, int hd, char* smem) {
  const int tid = tidx(), lane = tid & 63, w = tid >> 6, r = lane & 31, h = lane >> 5;
  const bf16_t* RET = (const bf16_t*)p->out;
  bf16_t* ACT = (bf16_t*)(p->ws + OFF_ACT);
  bf16_t* Vt = (bf16_t*)smem;
  bf16_t* Kzt = (bf16_t*)(smem + 17408);
  bf16_t* St = (bf16_t*)(smem + 34816);
  bf16_t* Sc = (bf16_t*)(smem + 44032);
  float* Of = (float*)(smem + 44032);
  float* dec = (float*)(smem + 78848);
  const float lg = log1pf(-exp2f(-5.f - (float)hd));
  if (tid < 129) dec[tid] = expf((float)tid * lg);
  for (int e = tid; e < 64 * 72; e += 256) St[e] = 0;
  __syncthreads();
  const float g128 = dec[128];
  f32x16 Sacc;
#pragma unroll
  for (int e = 0; e < 16; ++e) Sacc[e] = 0.f;
  const int vt = w >> 1, dt = w & 1;
  for (int c = 0; c < 16; ++c) {
    const int tokc = b * 2048 + c * 128;
    {
      const int j = tid >> 1, hf = tid & 1;
      const bf16_t* vsrc = RET + (size_t)(tokc + j) * 2048 + 1024 + hd * 64 + hf * 32;
      const bf16_t* ksrc = RET + (size_t)(tokc + j) * 2048 + 512 + hd * 64 + hf * 32;
      const float zj = dec[127 - j];
#pragma unroll
      for (int qd = 0; qd < 4; ++qd) {
        const uint4 uv = *(const uint4*)(vsrc + qd * 8);
        const uint4 uk = *(const uint4*)(ksrc + qd * 8);
        const unsigned vv[4] = {uv.x, uv.y, uv.z, uv.w};
        const unsigned kk[4] = {uk.x, uk.y, uk.z, uk.w};
#pragma unroll
        for (int e = 0; e < 4; ++e) {
          const int col = hf * 32 + qd * 8 + e * 2;
          Vt[col * RL + j] = (bf16_t)(vv[e] & 0xffffu);
          Vt[(col + 1) * RL + j] = (bf16_t)(vv[e] >> 16);
          Kzt[col * RL + j] = f2bf(lo2f(kk[e]) * zj);
          Kzt[(col + 1) * RL + j] = f2bf(hi2f(kk[e]) * zj);
        }
      }
    }
    bf16x8 qf[4];
    {
      const bf16_t* qsrc = RET + (size_t)(tokc + 32 * w + r) * 2048 + hd * 64 + h * 8;
#pragma unroll
      for (int ks = 0; ks < 4; ++ks) qf[ks] = *(const bf16x8*)(qsrc + ks * 16);
    }
#pragma unroll
    for (int jb = 0; jb < 2; ++jb) {
      bf16x8 kf[2][4];
#pragma unroll
      for (int jj = 0; jj < 2; ++jj) {
        const int jt = jb * 2 + jj;
        if (jt <= w) {
          const bf16_t* ksrc = RET + (size_t)(tokc + 32 * jt + r) * 2048 + 512 + hd * 64 + h * 8;
#pragma unroll
          for (int ks = 0; ks < 4; ++ks) kf[jj][ks] = *(const bf16x8*)(ksrc + ks * 16);
        }
      }
#pragma unroll
      for (int jj = 0; jj < 2; ++jj) {
        const int jt = jb * 2 + jj;
        if (jt <= w) {
          f32x16 sc;
#pragma unroll
          for (int e = 0; e < 16; ++e) sc[e] = 0.f;
#pragma unroll
          for (int ks = 0; ks < 4; ++ks) sc = __builtin_amdgcn_mfma_f32_32x32x16_bf16(qf[ks], kf[jj][ks], sc, 0, 0, 0);
#pragma unroll
          for (int e = 0; e < 16; ++e) {
            const int i = 32 * w + crow(e, h), j = 32 * jt + r;
            const int d = i - j;
            const float val = (d >= 0) ? sc[e] * dec[d >= 0 ? d : 0] : 0.f;
            Sc[i * RL + j] = f2bf(val);
          }
        }
      }
    }
    __syncthreads();
    f32x16 oacc[2];
#pragma unroll
    for (int nt = 0; nt < 2; ++nt) {
#pragma unroll
      for (int e = 0; e < 16; ++e) oacc[nt][e] = 0.f;
#pragma unroll
      for (int ks = 0; ks < 4; ++ks) {
        const bf16x8 sf = *(const bf16x8*)(St + (nt * 32 + r) * 72 + ks * 16 + h * 8);
        oacc[nt] = __builtin_amdgcn_mfma_f32_32x32x16_bf16(qf[ks], sf, oacc[nt], 0, 0, 0);
      }
#pragma unroll
      for (int e = 0; e < 16; ++e) oacc[nt][e] *= dec[32 * w + crow(e, h) + 1];
    }
    for (int ks = 0; ks < 2 * (w + 1); ++ks) {
      const bf16x8 af = *(const bf16x8*)(Sc + (32 * w + r) * RL + ks * 16 + h * 8);
#pragma unroll
      for (int nt = 0; nt < 2; ++nt) {
        const bf16x8 vf = *(const bf16x8*)(Vt + (nt * 32 + r) * RL + ks * 16 + h * 8);
        oacc[nt] = __builtin_amdgcn_mfma_f32_32x32x16_bf16(af, vf, oacc[nt], 0, 0, 0);
      }
    }
#pragma unroll
    for (int e = 0; e < 16; ++e) Sacc[e] *= g128;
#pragma unroll
    for (int ks = 0; ks < 8; ++ks) {
      const bf16x8 af = *(const bf16x8*)(Vt + (vt * 32 + r) * RL + ks * 16 + h * 8);
      const bf16x8 bf = *(const bf16x8*)(Kzt + (dt * 32 + r) * RL + ks * 16 + h * 8);
      Sacc = __builtin_amdgcn_mfma_f32_32x32x16_bf16(af, bf, Sacc, 0, 0, 0);
    }
    __syncthreads();
#pragma unroll
    for (int nt = 0; nt < 2; ++nt)
#pragma unroll
      for (int e = 0; e < 16; ++e) Of[(32 * w + crow(e, h)) * 66 + nt * 32 + r] = oacc[nt][e];
#pragma unroll
    for (int e = 0; e < 16; ++e) St[(vt * 32 + crow(e, h)) * 72 + dt * 32 + r] = f2bf(Sacc[e]);
    __syncthreads();
    {
      const int i = tid >> 1, hf = tid & 1;
      const int t = tokc + i;
      float vals[32];
      float sm = 0.f;
#pragma unroll
      for (int k = 0; k < 32; ++k) { vals[k] = Of[i * 66 + hf * 32 + k]; sm += vals[k]; }
      sm += __shfl_xor(sm, 1);
      const float mean = sm * (1.f / 64.f);
      float vs = 0.f;
#pragma unroll
      for (int k = 0; k < 32; ++k) { vals[k] -= mean; vs += vals[k] * vals[k]; }
      vs += __shfl_xor(vs, 1);
      const float rs = rsqrtf(vs * (1.f / 64.f) + 1e-5f);
      const bf16_t* gsrc = RET + (size_t)t * 2048 + 1536 + hd * 64 + hf * 32;
      bf16_t* dst = ACT + (size_t)t * 1024 + hd * 64 + hf * 32;
#pragma unroll
      for (int qd = 0; qd < 4; ++qd) {
        const uint4 ug = *(const uint4*)(gsrc + qd * 8);
        const unsigned gg[4] = {ug.x, ug.y, ug.z, ug.w};
        unsigned o4[4];
#pragma unroll
        for (int e = 0; e < 4; ++e) {
          const float g0 = lo2f(gg[e]), g1 = hi2f(gg[e]);
          const float a0 = vals[qd * 8 + 2 * e] * rs * (g0 / (1.f + __expf(-g0)));
          const float a1 = vals[qd * 8 + 2 * e + 1] * rs * (g1 / (1.f + __expf(-g1)));
          o4[e] = pack2(a0, a1);
        }
        *(uint4*)(dst + qd * 8) = make_uint4(o4[0], o4[1], o4[2], o4[3]);
      }
    }
    __syncthreads();
  }
  float* so = p->out + O_RETP + (size_t)(b * 8 + hd) * 4096;
#pragma unroll
  for (int gq = 0; gq < 4; ++gq)
    *(float4*)(so + (dt * 32 + r) * 64 + vt * 32 + 8 * gq + 4 * h) =
        make_float4(Sacc[4 * gq], Sacc[4 * gq + 1], Sacc[4 * gq + 2], Sacc[4 * gq + 3]);
}

DI void ret_sample(KP p, int b, int hd, char* smem) {
  const int tid = tidx();
  const bf16_t* RET = (const bf16_t*)p->out;
  bf16_t* ACT = (bf16_t*)(p->ws + OFF_ACT);
  float* q_s = (float*)smem;
  float* k_s = q_s + 512;
  float* v_s = k_s + 512;
  float* A_s = v_s + 512;
  float* part = A_s + 64;
  const int tok0 = TP + b * 8;
  const float lg = log1pf(-exp2f(-5.f - (float)hd));
  __syncthreads();
  {
    const int e = tid * 2, rw = e >> 6, cl = e & 63;
    const bf16_t* base = RET + (size_t)(tok0 + rw) * 2048 + hd * 64 + cl;
    const unsigned uq = *(const unsigned*)(base), uk = *(const unsigned*)(base + 512), uv = *(const unsigned*)(base + 1024);
    q_s[e] = lo2f(uq); q_s[e + 1] = hi2f(uq);
    k_s[e] = lo2f(uk); k_s[e + 1] = hi2f(uk);
    v_s[e] = lo2f(uv); v_s[e + 1] = hi2f(uv);
  }
  __syncthreads();
  if (tid < 64) {
    const int i = tid >> 3, j = tid & 7;
    float a = 0.f;
    if (i >= j) {
#pragma unroll 4
      for (int d = 0; d < 64; ++d) a = fmaf(q_s[i * 64 + d], k_s[j * 64 + d], a);
      a *= expf((float)(i - j) * lg);
    }
    A_s[tid] = a;
  }
  {
    const int dg = tid >> 6, v = tid & 63;
    const float* S0 = p->in[2] + (size_t)(b * 8 + hd) * 4096;
    float* So = p->out + O_RETS + (size_t)(b * 8 + hd) * 4096;
    float oi[8];
#pragma unroll
    for (int i = 0; i < 8; ++i) oi[i] = 0.f;
    const float g8 = expf(8.f * lg);
    float kv[8];
#pragma unroll
    for (int j = 0; j < 8; ++j) kv[j] = v_s[j * 64 + v] * expf((float)(7 - j) * lg);
#pragma unroll 1
    for (int hb = 0; hb < 2; ++hb) {
      float sv[8];
#pragma unroll
      for (int dd = 0; dd < 8; ++dd) sv[dd] = S0[(dg * 16 + hb * 8 + dd) * 64 + v];
#pragma unroll
      for (int dd = 0; dd < 8; ++dd) {
        const int d = dg * 16 + hb * 8 + dd;
        const float s = sv[dd];
        float sn = s * g8;
#pragma unroll
        for (int j = 0; j < 8; ++j) sn = fmaf(k_s[j * 64 + d], kv[j], sn);
        So[d * 64 + v] = sn;
#pragma unroll
        for (int i = 0; i < 8; ++i) oi[i] = fmaf(q_s[i * 64 + d], s, oi[i]);
      }
    }
#pragma unroll
    for (int i = 0; i < 8; ++i) part[(dg * 8 + i) * 64 + v] = oi[i];
  }
  __syncthreads();
#pragma unroll
  for (int rep = 0; rep < 2; ++rep) {
    const int i = (tid >> 6) + 4 * rep, v = tid & 63;
    float o = part[(0 * 8 + i) * 64 + v] + part[(1 * 8 + i) * 64 + v] + part[(2 * 8 + i) * 64 + v] + part[(3 * 8 + i) * 64 + v];
    o *= expf((float)(i + 1) * lg);
    for (int j = 0; j <= i; ++j) o = fmaf(A_s[i * 8 + j], v_s[j * 64 + v], o);
    const float mean = wave_sum(o) * (1.f / 64.f);
    const float dv = o - mean;
    const float var = wave_sum(dv * dv) * (1.f / 64.f);
    const int t = tok0 + i;
    const float gt = bf2f(RET[(size_t)t * 2048 + 1536 + hd * 64 + v]);
    ACT[(size_t)t * 1024 + hd * 64 + v] = f2bf(dv * rsqrtf(var + 1e-5f) * (gt / (1.f + __expf(-gt))));
  }
}

constexpr size_t TAB_V8 = (size_t)16384 * 1024;
constexpr size_t TAB_SC = (size_t)2 * 16384 * 1024;
DI void convert_tab(KP p, int it) {
  const int tid = tidx(), lane = tid & 63, w = tid >> 6;
  const int row0 = it * 8 + w * 2;
  const float* src = (row0 < 16384) ? p->in[24] + (size_t)row0 * 1024 : p->in[25] + (size_t)(row0 - 16384) * 1024;
  float4 v[2][4];
#pragma unroll
  for (int rr = 0; rr < 2; ++rr)
#pragma unroll
    for (int i = 0; i < 4; ++i) v[rr][i] = *(const float4*)(src + rr * 1024 + i * 256 + lane * 4);
#pragma unroll
  for (int rr = 0; rr < 2; ++rr) {
    float am = 0.f;
#pragma unroll
    for (int i = 0; i < 4; ++i)
      am = fmaxf(am, fmaxf(fmaxf(fabsf(v[rr][i].x), fabsf(v[rr][i].y)), fmaxf(fabsf(v[rr][i].z), fabsf(v[rr][i].w))));
#pragma unroll
    for (int o = 32; o >= 1; o >>= 1) am = fmaxf(am, __shfl_xor(am, o));
    am = fmaxf(am, 1e-30f);
    const float inv = 127.f / am;
    unsigned char* dst = (unsigned char*)(p->ws + OFF_TAB) + (size_t)(row0 + rr) * 1024;
#pragma unroll
    for (int i = 0; i < 4; ++i) {
      const unsigned q0 = (unsigned)((int)rintf(v[rr][i].x * inv) + 128);
      const unsigned q1 = (unsigned)((int)rintf(v[rr][i].y * inv) + 128);
      const unsigned q2 = (unsigned)((int)rintf(v[rr][i].z * inv) + 128);
      const unsigned q3 = (unsigned)((int)rintf(v[rr][i].w * inv) + 128);
      *(unsigned*)(dst + i * 256 + lane * 4) = q0 | (q1 << 8) | (q2 << 16) | (q3 << 24);
    }
    if (lane == 0) ((float*)(p->ws + OFF_TAB + TAB_SC))[row0 + rr] = am * (1.f / 127.f);
  }
}

DI void phase4_other(KP p, int it, char* smem) {
  if (it < 64) { ret_prompt(p, it >> 3, it & 7, smem); return; }
  it -= 64;
  if (it < 4096) {
    const int bh = it >> 2, q = it & 3, b = bh >> 3, hd = bh & 7;
    rwkv_scan(p, TP + b * 8, hd, q, 8, p->in[3] + (size_t)bh * 4096, p->out + O_WKVS + (size_t)bh * 4096, smem);
    return;
  }
  it -= 4096;
  if (it < 1024) { ret_sample(p, it >> 3, it & 7, smem); return; }
  it -= 1024;
  if (it < 4096) { convert_tab(p, it); return; }
  it -= 4096;
#define TJ4(IDX, OFF, KK_, NN_)                                                                            \
  {                                                                                                        \
    const int ntl = ((KK_) / 64) * ((NN_) / 64);                                                           \
    if (it < ntl) {                                                                                        \
      transpose_tile(p->in[IDX], (bf16_t*)(p->ws + (OFF)), (KK_), (NN_), it / ((NN_) / 64), it % ((NN_) / 64), (float*)smem); \
      return;                                                                                              \
    }                                                                                                      \
    it -= ntl;                                                                                             \
  }
  TJ4(20, OFF_WOUT, 1024, 1024)
  TJ4(22, OFF_WQ, 1024, 2048)
  TJ4(27, OFF_PG, 1024, 1024)
  TJ4(28, OFF_PP, 256, 1024)
}
DI void phase4(KP p, char* smem) {
  constexpr int N_OTHER = 64 + 4096 + 1024 + 4096 + (256 + 512 + 256 + 64);
  int* s_item = (int*)(smem + SMEM_BYTES - 16);
  unsigned* ctr = (unsigned*)(p->ws + OFF_CTR);
  unsigned* cukey = (unsigned*)(p->ws + OFF_CTR + 16384);
  __syncthreads();
  if (tidx() == 0) {
    const unsigned hw = (unsigned)__builtin_amdgcn_s_getreg((7 << 11) | (8 << 6) | 4);
    const unsigned key = (xb_xcc_id() << 8) | (hw & 0xffu);
    const unsigned old = atomicAdd(&cukey[key], 1u);
    int it = -1;
    if (old == 0u) { const unsigned q = atomicAdd(&ctr[1], 1u); if (q < 256u) it = (int)q; }
    *s_item = it;
  }
  __syncthreads();
  {
    const int it = *s_item;
    if (it >= 0) {
      const int bh = it >> 2, q = it & 3, b = bh >> 3, hd = bh & 7;
      __builtin_amdgcn_s_setprio(3);
      rwkv_scan(p, b * 2048, hd, q, 2048, nullptr, p->out + O_WKVP + (size_t)bh * 4096, smem);
      __builtin_amdgcn_s_setprio(0);
    }
  }
  for (;;) {
    __syncthreads();
    if (tidx() == 0) *s_item = (int)atomicAdd(&ctr[0], 1u);
    __syncthreads();
    const int it = *s_item;
    if (it >= N_OTHER) break;
    phase4_other(p, it, smem);
  }
  for (;;) {
    __syncthreads();
    if (tidx() == 0) *s_item = (int)atomicAdd(&ctr[1], 1u);
    __syncthreads();
    const int it = *s_item;
    if (it >= 256) break;
    const int bh = it >> 2, q = it & 3, b = bh >> 3, hd = bh & 7;
    rwkv_scan(p, b * 2048, hd, q, 2048, nullptr, p->out + O_WKVP + (size_t)bh * 4096, smem);
  }
}

DI void phase5(KP p) {
  const int lane = tidx() & 63, w = tidx() >> 6;
  bf16_t* ACT = (bf16_t*)(p->ws + OFF_ACT);
  const bf16_t* Rb = (const bf16_t*)(p->ws + OFF_R);
  const bf16_t* Kb = (const bf16_t*)(p->ws + OFF_K);
  const bf16_t* Vb = (const bf16_t*)(p->ws + OFF_V);
  const bf16_t* GTb = (const bf16_t*)(p->ws + OFF_GATE);
  const int c8 = lane * 8;
  float rk8[8], lg8[8], lb8[8];
  {
    const float4 a0 = *(const float4*)(p->in[17] + c8), a1 = *(const float4*)(p->in[17] + c8 + 4);
    const float4 b0 = *(const float4*)(p->in[18] + c8), b1 = *(const float4*)(p->in[18] + c8 + 4);
    const float4 d0 = *(const float4*)(p->in[19] + c8), d1 = *(const float4*)(p->in[19] + c8 + 4);
    rk8[0] = a0.x; rk8[1] = a0.y; rk8[2] = a0.z; rk8[3] = a0.w; rk8[4] = a1.x; rk8[5] = a1.y; rk8[6] = a1.z; rk8[7] = a1.w;
    lg8[0] = b0.x; lg8[1] = b0.y; lg8[2] = b0.z; lg8[3] = b0.w; lg8[4] = b1.x; lg8[5] = b1.y; lg8[6] = b1.z; lg8[7] = b1.w;
    lb8[0] = d0.x; lb8[1] = d0.y; lb8[2] = d0.z; lb8[3] = d0.w; lb8[4] = d1.x; lb8[5] = d1.y; lb8[6] = d1.z; lb8[7] = d1.w;
  }
  for (int t = blockIdx.x * 4 + w; t < T; t += gridDim.x * 4) {
    const size_t o = (size_t)t * 512 + c8;
    bf16_t* yp = ACT + (size_t)t * 1024 + 512 + c8;
    const uint4 uy = *(const uint4*)yp, ur = *(const uint4*)(Rb + o), uk = *(const uint4*)(Kb + o),
                uv = *(const uint4*)(Vb + o), ug = *(const uint4*)(GTb + o);
    float y[8], r[8], k[8], v[8], g[8];
    unpack8f(uy, y); unpack8f(ur, r); unpack8f(uk, k); unpack8f(uv, v); unpack8f(ug, g);
    float sm = 0.f, rk = 0.f;
#pragma unroll
    for (int e = 0; e < 8; ++e) { sm += y[e]; rk = fmaf(r[e] * k[e], rk8[e], rk); }
    sm = allreduce8(sm);
    rk = allreduce8(rk);
    const float mean = sm * (1.f / 64.f);
    float vs = 0.f;
#pragma unroll
    for (int e = 0; e < 8; ++e) { y[e] -= mean; vs += y[e] * y[e]; }
    vs = allreduce8(vs);
    const float rs = rsqrtf(vs * (1.f / 64.f) + 64e-5f);
    float ov[8];
#pragma unroll
    for (int e = 0; e < 8; ++e) ov[e] = (y[e] * rs * lg8[e] + lb8[e] + rk * v[e]) * g[e];
    *(uint4*)yp = pack8f(ov);
  }
}

DI void phase6(KP p, char* smem) {
  for (int tile = blockIdx.x; tile < 136 * 8; tile += gridDim.x) {
    const int mt = tile >> 3, nt = tile & 7;
    const int m0 = mt * 128, n0 = nt * 128;
    f32x16 acc[2][2];
    gemm128<false>((const bf16_t*)(p->ws + OFF_ACT) + (size_t)m0 * 1024, 1024,
                   (const bf16_t*)(p->ws + OFF_WOUT) + (size_t)n0 * 1024, 1024, 1024, acc, smem);
    {
      const int lane = tidx() & 63, w = tidx() >> 6;
      const int wm = w >> 1, wn = w & 1, r = lane & 31, h = lane >> 5;
      const float* xb = (m0 < TP) ? p->in[0] + (size_t)m0 * 1024 : p->in[1] + (size_t)(m0 - TP) * 1024;
#pragma unroll
      for (int mi = 0; mi < 2; ++mi)
#pragma unroll
        for (int ni = 0; ni < 2; ++ni)
#pragma unroll
          for (int i = 0; i < 16; ++i)
            acc[mi][ni][i] += xb[(size_t)(wm * 64 + mi * 32 + crow(i, h)) * 1024 + n0 + wn * 64 + ni * 32 + r];
#pragma unroll
      for (int mi = 0; mi < 2; ++mi)
#pragma unroll
        for (int ni = 0; ni < 2; ++ni)
#pragma unroll
          for (int i = 0; i < 16; ++i)
            p->out[(size_t)(m0 + wm * 64 + mi * 32 + crow(i, h)) * 1024 + n0 + wn * 64 + ni * 32 + r] = acc[mi][ni][i];
    }
  }
}

DI void phase7(KP p) {
  const int lane = tidx() & 63, w = tidx() >> 6;
  for (int t = blockIdx.x * 4 + w; t < T; t += gridDim.x * 4)
    rmsnorm_row_bf(p->out + (size_t)t * 1024, p->in[21], (bf16_t*)(p->ws + OFF_ACT) + (size_t)t * 1024, lane);
}

DI void phase8(KP p, char* smem) {
  bf16_t* QP = (bf16_t*)(p->ws + OFF_QPEER);
  for (int tile = blockIdx.x; tile < 136 * 16; tile += gridDim.x) {
    const int mt = tile >> 4, nt = tile & 15;
    const int m0 = mt * 128, n0 = nt * 128;
    f32x16 acc[2][2];
    gemm128<false>((const bf16_t*)(p->ws + OFF_ACT) + (size_t)m0 * 1024, 1024,
                   (const bf16_t*)(p->ws + OFF_WQ) + (size_t)n0 * 1024, 1024, 1024, acc, smem);
    epi_each(acc, [&](int rr, int cc, float v) { QP[(size_t)(m0 + rr) * 2048 + n0 + cc] = f2bf(v); });
  }
}

DI unsigned sortkey(float f) { unsigned u = __float_as_uint(f); return (u & 0x80000000u) ? ~u : (u | 0x80000000u); }
DI float unsortkey(unsigned k) { unsigned u = (k & 0x80000000u) ? (k ^ 0x80000000u) : ~k; return __uint_as_float(u); }
DI void ins16(unsigned (&l)[16], unsigned x) {
#pragma unroll
  for (int i = 0; i < 16; ++i) { const unsigned hi = max(l[i], x); x = min(l[i], x); l[i] = hi; }
}
DI void cswap_desc(unsigned& a, unsigned& b) { const unsigned hi = max(a, b), lo = min(a, b); a = hi; b = lo; }
DI void bsort16(unsigned (&v)[16]) {
#pragma unroll
  for (int ke = 1; ke <= 4; ++ke)
#pragma unroll
    for (int je = ke - 1; je >= 0; --je)
#pragma unroll
      for (int i = 0; i < 16; ++i) {
        const int k = 1 << ke, j = 1 << je, l = i ^ j;
        if (l > i) { if ((i & k) == 0) cswap_desc(v[i], v[l]); else cswap_desc(v[l], v[i]); }
      }
}
DI void bmerge16(unsigned (&a)[16], const unsigned (&b)[16]) {
#pragma unroll
  for (int i = 0; i < 16; ++i) a[i] = max(a[i], b[15 - i]);
#pragma unroll
  for (int je = 3; je >= 0; --je)
#pragma unroll
    for (int i = 0; i < 16; ++i) {
      const int j = 1 << je, l = i ^ j;
      if (l > i) cswap_desc(a[i], a[l]);
    }
}
DI void phase9(KP p, char* smem) {
  const int tid = tidx();
  const bf16_t* QP = (const bf16_t*)(p->ws + OFF_QPEER);
  const bf16_t* KEYS = (const bf16_t*)(p->ws + OFF_KEYS);
  int* IDX = (int*)(p->ws + OFF_IDX);
  float* GSM = (float*)(p->ws + OFF_GSM);
  float* sc = (float*)smem;
  unsigned* mrg = (unsigned*)smem;
  const int row = tid >> 1, half = tid & 1;
  for (int item = blockIdx.x; item < 136 * 8; item += gridDim.x) {
    const int mt = item >> 3, hd = item & 7;
    const int m0 = mt * 128;
    unsigned kc[2][16];
#pragma unroll
    for (int c = 0; c < 2; ++c) {
      f32x16 acc[2][2];
      gemm128<false>(QP + (size_t)m0 * 2048 + (hd * 2 + c) * 128, 2048, KEYS + (size_t)(hd * 2 + c) * 16384, 128, 128, acc, smem);
      __syncthreads();
      epi_each(acc, [&](int rr, int cc, float v) { sc[rr * 129 + cc] = v; });
      __syncthreads();
      unsigned lst[16];
#pragma unroll
      for (int gi = 0; gi < 4; ++gi) {
        unsigned grp[16];
#pragma unroll
        for (int i = 0; i < 16; ++i) {
          const int col = half * 64 + gi * 16 + i;
          grp[i] = (sortkey(sc[row * 129 + col]) & ~127u) | (unsigned)(127 - col);
        }
        bsort16(grp);
        if (gi == 0) {
#pragma unroll
          for (int i = 0; i < 16; ++i) lst[i] = grp[i];
        } else {
          bmerge16(lst, grp);
        }
      }
      __syncthreads();
      if (half) {
#pragma unroll
        for (int i = 0; i < 16; ++i) mrg[row * 16 + i] = lst[i];
      }
      __syncthreads();
      if (!half) {
        unsigned grp[16];
#pragma unroll
        for (int i = 0; i < 16; ++i) grp[i] = mrg[row * 16 + i];
        bmerge16(lst, grp);
      }
#pragma unroll
      for (int i = 0; i < 16; ++i) kc[c][i] = lst[i];
    }
    if (!half) {
      float sv0[16], sv1[16];
#pragma unroll
      for (int i = 0; i < 16; ++i) { sv0[i] = unsortkey(kc[0][i] & ~127u); sv1[i] = unsortkey(kc[1][i] & ~127u); }
      unsigned cl[16];
#pragma unroll
      for (int i = 0; i < 16; ++i) cl[i] = 0u;
#pragma unroll
      for (int a = 0; a < 16; ++a)
#pragma unroll
        for (int b = 0; b < 16 / (a + 1); ++b)
          ins16(cl, (sortkey(sv0[a] + sv1[b]) & ~255u) | (unsigned)(255 - (a * 16 + b)));
      float ex[16];
      float sum = 0.f;
      const float mx = unsortkey(cl[0] & ~255u);
#pragma unroll
      for (int i = 0; i < 16; ++i) { ex[i] = __expf(unsortkey(cl[i] & ~255u) - mx); sum += ex[i]; }
      const float inv = 1.f / sum;
      int eo[16];
#pragma unroll
      for (int i = 0; i < 16; ++i) {
        const int ci = 255 - (int)(cl[i] & 255u);
        const int a = ci >> 4, b = ci & 15;
        int i0 = 0, i1 = 0;
#pragma unroll
        for (int k = 0; k < 16; ++k) {
          i0 = (a == k) ? (127 - (int)(kc[0][k] & 127u)) : i0;
          i1 = (b == k) ? (127 - (int)(kc[1][k] & 127u)) : i1;
        }
        eo[i] = i0 * 128 + i1;
        ex[i] *= inv;
      }
      const size_t o = ((size_t)(m0 + row) * 8 + hd) * 16;
#pragma unroll
      for (int qd = 0; qd < 4; ++qd) {
        *(int4*)(IDX + o + qd * 4) = make_int4(eo[qd * 4], eo[qd * 4 + 1], eo[qd * 4 + 2], eo[qd * 4 + 3]);
        *(float4*)(GSM + o + qd * 4) = make_float4(ex[qd * 4], ex[qd * 4 + 1], ex[qd * 4 + 2], ex[qd * 4 + 3]);
      }
    }
  }
}

#define UB0(u) ((float)((u) & 0xffu))
#define UB1(u) ((float)(((u) >> 8) & 0xffu))
#define UB2(u) ((float)(((u) >> 16) & 0xffu))
#define UB3(u) ((float)((u) >> 24))
DI void phase10(KP p) {
  const int lane = tidx() & 63, w = tidx() >> 6;
  const int g = lane >> 4, l16 = lane & 15;
  bf16_t* ACT = (bf16_t*)(p->ws + OFF_ACT);
  const unsigned char* UB = (const unsigned char*)(p->ws + OFF_TAB);
  const unsigned char* VB = UB + TAB_V8;
  const float* USC = (const float*)(p->ws + OFF_TAB + TAB_SC);
  const float* VSC = USC + 16384;
  const int* IDX = (const int*)(p->ws + OFF_IDX);
  const float* GSM = (const float*)(p->ws + OFF_GSM);
  const float* pn = p->in[26];
  for (int t = blockIdx.x * 4 + w; t < T; t += gridDim.x * 4) {
    bf16_t* act = ACT + (size_t)t * 1024;
    float xf[64];
    float xsum = 0.f;
#pragma unroll
    for (int s = 0; s < 4; ++s) {
      const uint4 x0 = *(const uint4*)(act + s * 256 + l16 * 16);
      const uint4 x1 = *(const uint4*)(act + s * 256 + l16 * 16 + 8);
      const unsigned xx[8] = {x0.x, x0.y, x0.z, x0.w, x1.x, x1.y, x1.z, x1.w};
#pragma unroll
      for (int q = 0; q < 8; ++q) { xf[s * 16 + 2 * q] = lo2f(xx[q]); xf[s * 16 + 2 * q + 1] = hi2f(xx[q]); }
    }
#pragma unroll
    for (int k = 0; k < 64; ++k) xsum += xf[k];
    const int id0 = IDX[(size_t)t * 128 + lane], id1 = IDX[(size_t)t * 128 + 64 + lane];
    const float gs0 = GSM[(size_t)t * 128 + lane], gs1 = GSM[(size_t)t * 128 + 64 + lane];
    float acc[64];
#pragma unroll
    for (int k = 0; k < 64; ++k) acc[k] = 0.f;
    float csum = 0.f;
    for (int it = 0; it < 32; ++it) {
      const int n = (it * 4 + g) & 63;
      const int e = __shfl((it < 16) ? id0 : id1, n);
      const float gw = __shfl((it < 16) ? gs0 : gs1, n);
      const unsigned char* ur = UB + (size_t)e * 1024 + l16 * 16;
      const unsigned char* vr = VB + (size_t)e * 1024 + l16 * 16;
      uint4 uu[4], vv[4];
#pragma unroll
      for (int s = 0; s < 4; ++s) uu[s] = *(const uint4*)(ur + s * 256);
#pragma unroll
      for (int s = 0; s < 4; ++s) vv[s] = *(const uint4*)(vr + s * 256);
      const float su = USC[e], sv = VSC[e];
      float hv = 0.f;
#pragma unroll
      for (int s = 0; s < 4; ++s) {
        const unsigned ww[4] = {uu[s].x, uu[s].y, uu[s].z, uu[s].w};
#pragma unroll
        for (int q = 0; q < 4; ++q) {
          hv = fmaf(xf[s * 16 + q * 4 + 0], UB0(ww[q]), hv);
          hv = fmaf(xf[s * 16 + q * 4 + 1], UB1(ww[q]), hv);
          hv = fmaf(xf[s * 16 + q * 4 + 2], UB2(ww[q]), hv);
          hv = fmaf(xf[s * 16 + q * 4 + 3], UB3(ww[q]), hv);
        }
      }
      hv = fmaf(-128.f, xsum, hv);
      hv = allreduce16(hv) * su;
      const float c = 0.5f * hv * (1.f + erff(hv * 0.70710678118f)) * gw * sv;
      csum += c;
#pragma unroll
      for (int s = 0; s < 4; ++s) {
        const unsigned ww[4] = {vv[s].x, vv[s].y, vv[s].z, vv[s].w};
#pragma unroll
        for (int q = 0; q < 4; ++q) {
          acc[s * 16 + q * 4 + 0] = fmaf(c, UB0(ww[q]), acc[s * 16 + q * 4 + 0]);
          acc[s * 16 + q * 4 + 1] = fmaf(c, UB1(ww[q]), acc[s * 16 + q * 4 + 1]);
          acc[s * 16 + q * 4 + 2] = fmaf(c, UB2(ww[q]), acc[s * 16 + q * 4 + 2]);
          acc[s * 16 + q * 4 + 3] = fmaf(c, UB3(ww[q]), acc[s * 16 + q * 4 + 3]);
        }
      }
    }
    const float cs128 = 128.f * csum;
#pragma unroll
    for (int k = 0; k < 64; ++k) {
      acc[k] -= cs128;
      acc[k] += __shfl_xor(acc[k], 16);
      acc[k] += __shfl_xor(acc[k], 32);
    }
    float* hrow = p->out + (size_t)t * 1024;
    float hvv[16];
#pragma unroll
    for (int s = 0; s < 4; ++s) {
      if (s == g) {
        float* hp = hrow + s * 256 + l16 * 16;
#pragma unroll
        for (int q = 0; q < 4; ++q) {
          float4 h0 = *(float4*)(hp + q * 4);
          h0.x += acc[s * 16 + q * 4 + 0]; h0.y += acc[s * 16 + q * 4 + 1]; h0.z += acc[s * 16 + q * 4 + 2]; h0.w += acc[s * 16 + q * 4 + 3];
          *(float4*)(hp + q * 4) = h0;
          hvv[q * 4 + 0] = h0.x; hvv[q * 4 + 1] = h0.y; hvv[q * 4 + 2] = h0.z; hvv[q * 4 + 3] = h0.w;
        }
      }
    }
    float ss = 0.f;
#pragma unroll
    for (int k = 0; k < 16; ++k) ss += hvv[k] * hvv[k];
    ss = wave_sum(ss);
    const float scl = rsqrtf(ss * (1.f / 1024.f) + 1e-6f);
    {
      const int col = g * 256 + l16 * 16;
      unsigned o8[8];
#pragma unroll
      for (int q = 0; q < 4; ++q) {
        const float4 g0 = *(const float4*)(pn + col + q * 4);
        o8[q * 2] = pack2(hvv[q * 4 + 0] * scl * g0.x, hvv[q * 4 + 1] * scl * g0.y);
        o8[q * 2 + 1] = pack2(hvv[q * 4 + 2] * scl * g0.z, hvv[q * 4 + 3] * scl * g0.w);
      }
      *(uint4*)(act + col) = make_uint4(o8[0], o8[1], o8[2], o8[3]);
      *(uint4*)(act + col + 8) = make_uint4(o8[4], o8[5], o8[6], o8[7]);
    }
  }
}

DI void phase11(KP p, char* smem) {
  for (int tile = blockIdx.x; tile < 136 * 8; tile += gridDim.x) {
    const int mt = tile >> 3, nt = tile & 7;
    const int m0 = mt * 128, n0 = nt * 128;
    f32x16 acc[2][2];
    unsigned ppk[2][2][8];
    const float* pa = (m0 < TP) ? p->in[5] + (size_t)m0 * 256 : p->in[6] + (size_t)(m0 - TP) * 256;
    gemm128<true>(pa, 256, (const bf16_t*)(p->ws + OFF_PP) + (size_t)n0 * 256, 256, 256, acc, smem);
#pragma unroll
    for (int mi = 0; mi < 2; ++mi)
#pragma unroll
      for (int ni = 0; ni < 2; ++ni)
#pragma unroll
        for (int i = 0; i < 8; ++i) ppk[mi][ni][i] = pack2(acc[mi][ni][2 * i], acc[mi][ni][2 * i + 1]);
    gemm128<false>((const bf16_t*)(p->ws + OFF_ACT) + (size_t)m0 * 1024, 1024,
                   (const bf16_t*)(p->ws + OFF_PG) + (size_t)n0 * 1024, 1024, 1024, acc, smem);
    const int lane = tidx() & 63, w = tidx() >> 6;
    const int wm = w >> 1, wn = w & 1, r = lane & 31, h = lane >> 5;
#pragma unroll
    for (int mi = 0; mi < 2; ++mi)
#pragma unroll
      for (int ni = 0; ni < 2; ++ni)
#pragma unroll
        for (int i = 0; i < 16; ++i) {
          const float pp = (i & 1) ? hi2f(ppk[mi][ni][i >> 1]) : lo2f(ppk[mi][ni][i >> 1]);
          acc[mi][ni][i] = sigmoidf_(acc[mi][ni][i]) * pp;
        }
#pragma unroll
    for (int mi = 0; mi < 2; ++mi) {
#pragma unroll
      for (int ni = 0; ni < 2; ++ni)
#pragma unroll
        for (int i = 0; i < 16; ++i)
          acc[mi][ni][i] += p->out[(size_t)(m0 + wm * 64 + mi * 32 + crow(i, h)) * 1024 + n0 + wn * 64 + ni * 32 + r];
#pragma unroll
      for (int ni = 0; ni < 2; ++ni)
#pragma unroll
        for (int i = 0; i < 16; ++i)
          p->out[(size_t)(m0 + wm * 64 + mi * 32 + crow(i, h)) * 1024 + n0 + wn * 64 + ni * 32 + r] = acc[mi][ni][i];
    }
  }
}

DI void phase12(KP p) {
  const int lane = tidx() & 63, w = tidx() >> 6;
  const float* g = p->in[29];
  for (int t = blockIdx.x * 4 + w; t < T; t += gridDim.x * 4) {
    float* x = p->out + (size_t)t * 1024;
    float4 v[4];
    float ss = 0.f;
#pragma unroll
    for (int i = 0; i < 4; ++i) {
      v[i] = ((const float4*)x)[i * 64 + lane];
      ss += v[i].x * v[i].x + v[i].y * v[i].y + v[i].z * v[i].z + v[i].w * v[i].w;
    }
    ss = wave_sum(ss);
    const float sc = rsqrtf(ss * (1.f / 1024.f) + 1e-6f);
#pragma unroll
    for (int i = 0; i < 4; ++i) {
      const float4 gg = ((const float4*)g)[i * 64 + lane];
      ((float4*)x)[i * 64 + lane] = make_float4(v[i].x * sc * gg.x, v[i].y * sc * gg.y, v[i].z * sc * gg.z, v[i].w * sc * gg.w);
    }
  }
}

DI void run_phase(int ph, char* smem) {
  KP p = getp();
  switch (ph) {
    case 0: phase0(p, smem); break;
    case 1: phase1(p, smem); break;
    case 2: phase2(p); break;
    case 3: phase3(p, smem); break;
    case 4: phase4(p, smem); break;
    case 5: phase5(p); break;
    case 6: phase6(p, smem); break;
    case 7: phase7(p); break;
    case 8: phase8(p, smem); break;
    case 9: phase9(p, smem); break;
    case 10: phase10(p); break;
    case 11: phase11(p, smem); break;
    case 12: phase12(p); break;
    default: break;
  }
}

template <int LO, int HI>
__global__ void __launch_bounds__(256, 2) mega_kernel(Params p) {
  __shared__ __attribute__((aligned(16))) char smem[SMEM_BYTES];
  __shared__ uint4 xb_words;
  if (gridDim.x == 0x7fffffffu) cg::this_grid().sync();
  XcdBarrier xb;
  if (HI - LO > 1) {
    if (threadIdx.x == 0) xb_words = make_uint4(0u, 0u, 0u, 0u);
    __syncthreads();
    xb = xcd_barrier_post((unsigned*)(getp()->ws + OFF_CTR), (volatile LAS unsigned*)&xb_words);
  }
#pragma unroll
  for (int ph = LO; ph < HI; ++ph) {
    run_phase(ph, smem);
    if (ph + 1 < HI) xcd_barrier(xb);
  }
}

template <int PH>
static void launch_phases(const Params& p, int grid, hipStream_t stream) {
  hipLaunchKernelGGL((mega_kernel<PH, PH + 1>), dim3(grid), dim3(256), 0, stream, p);
  if constexpr (PH + 1 < 13) launch_phases<PH + 1>(p, grid, stream);
}

extern "C" void kernel_launch(void* const* d_in, const int* in_sizes, int n_in, void* d_out, int out_size,
                              void* d_ws, size_t ws_size, hipStream_t stream) {
  static int grid_blocks = 0;
  if (!grid_blocks) {
    int dev = 0, cus = 0, per_cu = 0;
    (void)hipGetDevice(&dev);
    (void)hipDeviceGetAttribute(&cus, hipDeviceAttributeMultiprocessorCount, dev);
#if MK_MULTI
    per_cu = 2;
#else
    (void)hipOccupancyMaxActiveBlocksPerMultiprocessor(&per_cu, mega_kernel<0, 13>, 256, 0);
#endif
    if (per_cu < 1) per_cu = 1;
    if (per_cu > 2) per_cu = 2;
    grid_blocks = cus * per_cu;
  }
  Params p{};
  for (int i = 0; i < 30; ++i) p.in[i] = (const float*)d_in[i];
  p.out = (float*)d_out;
  p.ws = (char*)d_ws;
  if (ws_size < WS_END) { fprintf(stderr, "workspace too small: %zu < %zu\n", ws_size, (size_t)WS_END); return; }
  (void)hipMemsetAsync((char*)d_ws + OFF_CTR, 0, 32768, stream);
#if MK_MULTI
  launch_phases<0>(p, grid_blocks, stream);
#else
  void* args[] = {&p};
  hipError_t e = hipLaunchCooperativeKernel((void*)mega_kernel<0, 13>, dim3(grid_blocks), dim3(256), args, 0, stream);
  if (e != hipSuccess) fprintf(stderr, "cooperative launch failed: %s (grid %d)\n", hipGetErrorString(e), grid_blocks);
#endif
}
```

```cpp
#include <hip/hip_runtime.h>
#include <hip/hip_cooperative_groups.h>
#include <cstdio>
namespace cg = cooperative_groups;

#ifndef MK_MULTI
#define MK_MULTI 0
#endif

typedef unsigned short bf16_t;
typedef __attribute__((ext_vector_type(8))) short bf16x8;
typedef __attribute__((ext_vector_type(16))) float f32x16;
typedef __attribute__((ext_vector_type(2))) __bf16 bf2_t;
typedef __attribute__((ext_vector_type(2))) float f2_t;
#define DI __device__ __forceinline__

constexpr int T = 17408, TP = 16384;
constexpr int NPH = 14;

constexpr size_t O_RETP = (size_t)T * 1024;
constexpr size_t O_WKVP = O_RETP + 262144;
constexpr size_t O_SHP = O_WKVP + 262144;
constexpr size_t O_RETS = O_SHP + 14336;
constexpr size_t O_WKVS = O_RETS + 4194304;
constexpr size_t O_SHS = O_WKVS + 4194304;

constexpr size_t OFF_WIN = 0;
constexpr size_t OFF_WOUT = OFF_WIN + (size_t)3840 * 1024 * 2;
constexpr size_t OFF_WQ = OFF_WOUT + (size_t)1024 * 1024 * 2;
constexpr size_t OFF_KEYS = OFF_WQ + (size_t)2048 * 1024 * 2;
constexpr size_t OFF_PG = OFF_KEYS + (size_t)16 * 128 * 128 * 2;
constexpr size_t OFF_PP = OFF_PG + (size_t)1024 * 1024 * 2;
constexpr size_t OFF_W2 = OFF_PP + (size_t)1024 * 256 * 2;
constexpr size_t OFF_A2 = OFF_W2 + (size_t)512 * 64 * 2;
constexpr size_t OFF_G2 = OFF_A2 + (size_t)512 * 64 * 2;
constexpr size_t OFF_ROPE = OFF_G2 + (size_t)512 * 128 * 2;
constexpr size_t OFF_CTR = OFF_ROPE + (size_t)2056 * 32 * 2 * 4;
constexpr size_t OFF_ACT = OFF_CTR + 32768;
constexpr size_t OFF_TAB = OFF_ACT + (size_t)T * 1024 * 2;
constexpr size_t OFF_PREP = OFF_TAB + (size_t)2 * 16384 * 1024 * 2;
constexpr size_t SZ512 = (size_t)T * 512 * 2;
constexpr size_t OFF_R = OFF_PREP;
constexpr size_t OFF_K = OFF_R + SZ512;
constexpr size_t OFF_V = OFF_K + SZ512;
constexpr size_t OFF_KK = OFF_V + SZ512;
constexpr size_t OFF_BB = OFF_KK + SZ512;
constexpr size_t OFF_GATE = OFF_BB + SZ512;
constexpr size_t OFF_EW = OFF_GATE + SZ512;
constexpr size_t OFF_LORA = OFF_EW + (size_t)T * 512 * 4;
constexpr size_t OFF_INVN = OFF_LORA + (size_t)T * 256 * 2;
constexpr size_t WS_END = OFF_INVN + (size_t)T * 8 * 4;
constexpr size_t OFF_QPEER = OFF_PREP;
constexpr size_t OFF_IDX = OFF_QPEER + (size_t)T * 2048 * 2;
constexpr size_t OFF_GSM = OFF_IDX + (size_t)T * 128 * 4;

constexpr int SMEM_BYTES = 79872;

struct Params {
  const float* in[30];
  float* out;
  char* ws;
};

typedef const __attribute__((address_space(4))) Params* KP;
__device__ __forceinline__ KP getp() {
  KP q = (KP)__builtin_amdgcn_kernarg_segment_ptr();
  asm volatile("" : "+s"(q));
  return q;
}
DI int tidx() { int t = threadIdx.x; asm volatile("" : "+v"(t)); return t; }
DI bf16_t f2bf(float x) { return __builtin_bit_cast(bf16_t, (__bf16)x); }
DI float bf2f(bf16_t b) { return __uint_as_float(((unsigned)b) << 16); }
DI unsigned pack2(float a, float b) { const f2_t v = {a, b}; return __builtin_bit_cast(unsigned, __builtin_convertvector(v, bf2_t)); }
DI float lo2f(unsigned u) { return __uint_as_float(u << 16); }
DI float hi2f(unsigned u) { return __uint_as_float(u & 0xffff0000u); }
DI int crow(int reg, int h) { return (reg & 3) + 8 * (reg >> 2) + 4 * h; }
DI float wave_sum(float v) {
#pragma unroll
  for (int o = 32; o >= 1; o >>= 1) v += __shfl_xor(v, o);
  return v;
}
DI float allreduce16(float v) {
  v += __int_as_float(__builtin_amdgcn_update_dpp(0, __float_as_int(v), 0x128, 0xf, 0xf, false));
  v += __int_as_float(__builtin_amdgcn_update_dpp(0, __float_as_int(v), 0x124, 0xf, 0xf, false));
  v += __int_as_float(__builtin_amdgcn_update_dpp(0, __float_as_int(v), 0x122, 0xf, 0xf, false));
  v += __int_as_float(__builtin_amdgcn_update_dpp(0, __float_as_int(v), 0x121, 0xf, 0xf, false));
  return v;
}
#define DPP_ADD(v, ctrl) v += __int_as_float(__builtin_amdgcn_update_dpp(0, __float_as_int(v), ctrl, 0xf, 0xf, false))
DI void allreduce16x2(float& a, float& b) {
  DPP_ADD(a, 0x128); DPP_ADD(b, 0x128);
  DPP_ADD(a, 0x124); DPP_ADD(b, 0x124);
  DPP_ADD(a, 0x122); DPP_ADD(b, 0x122);
  DPP_ADD(a, 0x121); DPP_ADD(b, 0x121);
}
DI float allreduce8(float v) {
  v += __int_as_float(__builtin_amdgcn_update_dpp(0, __float_as_int(v), 0xB1, 0xf, 0xf, false));
  v += __int_as_float(__builtin_amdgcn_update_dpp(0, __float_as_int(v), 0x4E, 0xf, 0xf, false));
  v += __int_as_float(__builtin_amdgcn_update_dpp(0, __float_as_int(v), 0x141, 0xf, 0xf, false));
  return v;
}
DI void unpack8f(const uint4& u, float (&f)[8]) {
  f[0] = lo2f(u.x); f[1] = hi2f(u.x); f[2] = lo2f(u.y); f[3] = hi2f(u.y);
  f[4] = lo2f(u.z); f[5] = hi2f(u.z); f[6] = lo2f(u.w); f[7] = hi2f(u.w);
}
DI uint4 pack8f(const float (&f)[8]) {
  return make_uint4(pack2(f[0], f[1]), pack2(f[2], f[3]), pack2(f[4], f[5]), pack2(f[6], f[7]));
}
DI float sigmoidf_(float x) { return 1.f / (1.f + __expf(-x)); }
DI const float* xrow(KP p, int t) {
  return t < TP ? p->in[0] + (size_t)t * 1024 : p->in[1] + (size_t)(t - TP) * 1024;
}
struct TokInfo { int sample, b, l; };
DI TokInfo tokinfo(int t) {
  TokInfo ti;
  if (t >= TP) { ti.sample = 1; ti.b = (t - TP) >> 3; ti.l = (t - TP) & 7; }
  else { ti.sample = 0; ti.b = t >> 11; ti.l = t & 2047; }
  return ti;
}

#define XB_TMO      128
#define XB_XCNT(j)  (256  + 64 * (j))
#define XB_XSUB(j)  (1280 + 64 * (j))
#define XB_XGEN(j)  (2304 + 64 * (j))
#define XB_TOP      3328
#define XB_TOPGEN   3392
#define XCD_BAR_WORDS 3456
#define XB_SPIN_CAP (1u << 20)
#define LAS __attribute__((address_space(3)))
DI unsigned xb_ld(unsigned* p) { return __hip_atomic_load(p, __ATOMIC_RELAXED, __HIP_MEMORY_SCOPE_AGENT); }
DI unsigned xb_add(unsigned* p, unsigned v) { return __hip_atomic_fetch_add(p, v, __ATOMIC_RELAXED, __HIP_MEMORY_SCOPE_AGENT); }
DI unsigned xb_xcc_id() { return (unsigned)__builtin_amdgcn_s_getreg((3 << 11) | 20) & 0xFu; }
#define XB_SPIN(cond, bar) do { unsigned _sp = 0; while (cond) { __builtin_amdgcn_s_sleep(1); \
    if ((++_sp & 255u) == 0u) { if (xb_ld(&(bar)[XB_TMO])) break; if (_sp > XB_SPIN_CAP) { atomicAdd(&(bar)[XB_TMO], 1u); break; } } } } while (0)
struct XcdBarrier { unsigned* bar; unsigned x; volatile LAS unsigned* st; };
DI XcdBarrier xcd_barrier_post(unsigned* bar, volatile LAS unsigned* st) {
  XcdBarrier b; b.bar = bar; b.x = xb_xcc_id(); b.st = st;
  if (threadIdx.x == 0) (void)xb_add(&bar[XB_XCNT(b.x)], 1u);
  return b;
}
DI void xcd_barrier_complete(unsigned* bar, unsigned x, unsigned& nloc, unsigned& nx) {
  const unsigned G = gridDim.x * gridDim.y * gridDim.z;
  unsigned sum, cnt, mine, sp = 0u;
  for (;;) {
    sum = 0u; cnt = 0u; mine = 0u;
#pragma unroll
    for (unsigned j = 0; j < 16; ++j) { const unsigned c = xb_ld(&bar[XB_XCNT(j)]); sum += c; cnt += (c > 0u) ? 1u : 0u; mine = (j == x) ? c : mine; }
    if (sum == G) break;
    __builtin_amdgcn_s_sleep(1);
    if ((++sp & 255u) == 0u) { if (xb_ld(&bar[XB_TMO])) break; if (sp > XB_SPIN_CAP) { atomicAdd(&bar[XB_TMO], 1u); break; } }
  }
  nloc = mine > 0u ? mine : 1u; nx = cnt > 0u ? cnt : 1u;
}
DI void xcd_barrier(const XcdBarrier& b) {
  asm volatile("s_waitcnt vmcnt(0)" ::: "memory");
  __syncthreads();
  if (threadIdx.x == 0) {
    unsigned* bar = b.bar;
    __builtin_amdgcn_s_waitcnt(0);
    unsigned nloc = b.st[0], nx = b.st[1];
    if (nloc == 0u) { xcd_barrier_complete(bar, b.x, nloc, nx); b.st[0] = nloc; b.st[1] = nx; }
    const unsigned old = xb_add(&bar[XB_XSUB(b.x)], 1u);
    const unsigned gen = old / nloc;
    if (old + 1u == (gen + 1u) * nloc) {
      __builtin_amdgcn_fence(__ATOMIC_RELEASE, "agent");
      asm volatile("s_waitcnt vmcnt(0)" ::: "memory");
      const unsigned og = xb_add(&bar[XB_TOP], 1u);
      const unsigned tg = og / nx;
      if (og + 1u == (tg + 1u) * nx) xb_add(&bar[XB_TOPGEN], 1u);
      else XB_SPIN(xb_ld(&bar[XB_TOPGEN]) == tg, bar);
      __builtin_amdgcn_fence(__ATOMIC_ACQUIRE, "agent");
      xb_add(&bar[XB_XGEN(b.x)], 1u);
      asm volatile("s_waitcnt vmcnt(0)" ::: "memory");
    } else {
      XB_SPIN(xb_ld(&bar[XB_XGEN(b.x)]) == gen, bar);
      __builtin_amdgcn_fence(__ATOMIC_ACQUIRE, "agent");
      asm volatile("s_waitcnt vmcnt(0)" ::: "memory");
    }
  }
  __syncthreads();
}

constexpr int LDT = 72;
constexpr int GBUF = 2 * 128 * LDT;
template <bool AF32>
DI void gemm128(const void* __restrict__ Ap, int lda, const bf16_t* __restrict__ Bt, int ldb, int K,
                f32x16 (&acc)[2][2], char* smem) {
  bf16_t* S0 = (bf16_t*)smem;
  const int tid = tidx(), lane = tid & 63, w = tid >> 6;
  const int wm = w >> 1, wn = w & 1, r = lane & 31, h = lane >> 5;
  const int lrow = tid >> 3, lch = tid & 7;
#pragma unroll
  for (int i = 0; i < 2; ++i)
#pragma unroll
    for (int j = 0; j < 2; ++j)
#pragma unroll
      for (int e = 0; e < 16; ++e) acc[i][j][e] = 0.f;
  uint4 ra0, ra1, ra2, ra3, rb0, rb1, rb2, rb3;
  const bf16_t* Ab = (const bf16_t*)Ap + (size_t)lrow * lda + lch * 8;
  const float* Af = (const float*)Ap + (size_t)lrow * lda + lch * 8;
  const bf16_t* Bb = Bt + (size_t)lrow * ldb + lch * 8;
  const size_t a32 = (size_t)32 * lda, b32 = (size_t)32 * ldb;
#define GEMM_LDA(dst, q, k0)                                                                          \
  if constexpr (AF32) {                                                                               \
    const float4 f0 = *(const float4*)(Af + (q) * a32 + (k0));                                        \
    const float4 f1 = *(const float4*)(Af + (q) * a32 + (k0) + 4);                                    \
    dst = make_uint4(pack2(f0.x, f0.y), pack2(f0.z, f0.w), pack2(f1.x, f1.y), pack2(f1.z, f1.w));     \
  } else {                                                                                            \
    dst = *(const uint4*)(Ab + (q) * a32 + (k0));                                                     \
  }
#define GEMM_LOADG(k0)                                                                                \
  {                                                                                                   \
    GEMM_LDA(ra0, 0, k0) GEMM_LDA(ra1, 1, k0) GEMM_LDA(ra2, 2, k0) GEMM_LDA(ra3, 3, k0)               \
    rb0 = *(const uint4*)(Bb + (k0));                                                                 \
    rb1 = *(const uint4*)(Bb + b32 + (k0));                                                           \
    rb2 = *(const uint4*)(Bb + 2 * b32 + (k0));                                                       \
    rb3 = *(const uint4*)(Bb + 3 * b32 + (k0));                                                       \
  }
#define GEMM_STORE(buf)                                                                               \
  {                                                                                                   \
    bf16_t* ad = S0 + (buf) * GBUF + lrow * LDT + lch * 8;                                            \
    bf16_t* bd = ad + 128 * LDT;                                                                      \
    *(uint4*)(ad) = ra0; *(uint4*)(ad + 32 * LDT) = ra1; *(uint4*)(ad + 64 * LDT) = ra2; *(uint4*)(ad + 96 * LDT) = ra3; \
    *(uint4*)(bd) = rb0; *(uint4*)(bd + 32 * LDT) = rb1; *(uint4*)(bd + 64 * LDT) = rb2; *(uint4*)(bd + 96 * LDT) = rb3; \
  }
  const int nk = K >> 6;
  GEMM_LOADG(0)
  GEMM_STORE(0)
  if (nk > 1) GEMM_LOADG(64)
  __syncthreads();
  for (int kt = 0; kt < nk; ++kt) {
    if (kt + 1 < nk) GEMM_STORE((kt + 1) & 1)
    if (kt + 2 < nk) GEMM_LOADG((kt + 2) << 6)
    __builtin_amdgcn_sched_barrier(0);
    const bf16_t* As = S0 + (kt & 1) * GBUF;
    const bf16_t* Bs = As + 128 * LDT;
#pragma unroll
    for (int ks = 0; ks < 4; ++ks) {
      bf16x8 a0 = *(const bf16x8*)(As + (wm * 64 + r) * LDT + ks * 16 + h * 8);
      bf16x8 a1 = *(const bf16x8*)(As + (wm * 64 + 32 + r) * LDT + ks * 16 + h * 8);
      bf16x8 b0 = *(const bf16x8*)(Bs + (wn * 64 + r) * LDT + ks * 16 + h * 8);
      bf16x8 b1 = *(const bf16x8*)(Bs + (wn * 64 + 32 + r) * LDT + ks * 16 + h * 8);
      acc[0][0] = __builtin_amdgcn_mfma_f32_32x32x16_bf16(a0, b0, acc[0][0], 0, 0, 0);
      acc[0][1] = __builtin_amdgcn_mfma_f32_32x32x16_bf16(a0, b1, acc[0][1], 0, 0, 0);
      acc[1][0] = __builtin_amdgcn_mfma_f32_32x32x16_bf16(a1, b0, acc[1][0], 0, 0, 0);
      acc[1][1] = __builtin_amdgcn_mfma_f32_32x32x16_bf16(a1, b1, acc[1][1], 0, 0, 0);
    }
    __syncthreads();
  }
}
template <class F>
DI void epi_each(f32x16 (&acc)[2][2], F f) {
  const int lane = tidx() & 63, w = tidx() >> 6;
  const int wm = w >> 1, wn = w & 1, r = lane & 31, h = lane >> 5;
#pragma unroll
  for (int mi = 0; mi < 2; ++mi)
#pragma unroll
    for (int ni = 0; ni < 2; ++ni)
#pragma unroll
      for (int i = 0; i < 16; ++i) f(wm * 64 + mi * 32 + crow(i, h), wn * 64 + ni * 32 + r, acc[mi][ni][i]);
}

DI void transpose_tile(const float* __restrict__ src, bf16_t* __restrict__ dst, int K, int N, int kt, int nt, float* sm) {
  const int tid = tidx();
  const int k0 = kt * 64, n0 = nt * 64;
#pragma unroll
  for (int i = 0; i < 16; ++i) {
    int k = i * 4 + (tid >> 6), n = tid & 63;
    sm[k * 65 + n] = src[(size_t)(k0 + k) * N + n0 + n];
  }
  __syncthreads();
  int n = tid >> 2, ks = (tid & 3) * 16;
  unsigned pk[8];
#pragma unroll
  for (int j = 0; j < 8; ++j) pk[j] = pack2(sm[(ks + 2 * j) * 65 + n], sm[(ks + 2 * j + 1) * 65 + n]);
  uint4* d = (uint4*)(dst + (size_t)(n0 + n) * K + k0 + ks);
  d[0] = make_uint4(pk[0], pk[1], pk[2], pk[3]);
  d[1] = make_uint4(pk[4], pk[5], pk[6], pk[7]);
  __syncthreads();
}
DI void rmsnorm_row_bf(const float* __restrict__ x, const float* __restrict__ g, bf16_t* __restrict__ o, int lane) {
  float4 v[4];
  float ss = 0.f;
#pragma unroll
  for (int i = 0; i < 4; ++i) {
    v[i] = ((const float4*)x)[i * 64 + lane];
    ss += v[i].x * v[i].x + v[i].y * v[i].y + v[i].z * v[i].z + v[i].w * v[i].w;
  }
  ss = wave_sum(ss);
  float sc = rsqrtf(ss * (1.f / 1024.f) + 1e-6f);
#pragma unroll
  for (int i = 0; i < 4; ++i) {
    float4 gg = ((const float4*)g)[i * 64 + lane];
    uint2 pk = make_uint2(pack2(v[i].x * sc * gg.x, v[i].y * sc * gg.y), pack2(v[i].z * sc * gg.z, v[i].w * sc * gg.w));
    ((uint2*)o)[i * 64 + lane] = pk;
  }
}

#define TJ(IDX, OFF, KK_, NN_)                                                                             \
  {                                                                                                        \
    const int ntl = ((KK_) / 64) * ((NN_) / 64);                                                           \
    if (it < ntl) {                                                                                        \
      transpose_tile(p->in[IDX], (bf16_t*)(p->ws + (OFF)), (KK_), (NN_), it / ((NN_) / 64), it % ((NN_) / 64), (float*)smem); \
      continue;                                                                                            \
    }                                                                                                      \
    it -= ntl;                                                                                             \
  }

DI void phase0(KP p, char* smem) {
  const int tid = tidx(), lane = tid & 63, w = tid >> 6;
  constexpr int N_TR = 960 + 8 + 8 + 16;
  constexpr int N_KEYS = 128, N_ROPE = 257, N_NORM = T / 4;
  for (int item = blockIdx.x; item < N_TR + N_KEYS + N_ROPE + N_NORM; item += gridDim.x) {
    int it = item;
    TJ(8, OFF_WIN, 1024, 3840)
    TJ(11, OFF_W2, 64, 512)
    TJ(13, OFF_A2, 64, 512)
    TJ(14, OFF_G2, 128, 512)
    if (it < N_KEYS) {
      const float* src = p->in[23] + (size_t)it * 2048 + tid * 8;
      float4 f0 = *(const float4*)src, f1 = *(const float4*)(src + 4);
      *(uint4*)((bf16_t*)(p->ws + OFF_KEYS) + (size_t)it * 2048 + tid * 8) =
          make_uint4(pack2(f0.x, f0.y), pack2(f0.z, f0.w), pack2(f1.x, f1.y), pack2(f1.z, f1.w));
      continue;
    }
    it -= N_KEYS;
    if (it < N_ROPE) {
      int e = it * 256 + tid;
      int pidx = e >> 5, f = e & 31;
      if (pidx < 2056) {
        const float pos = (pidx < 2048) ? (float)pidx : (float)(16384 + pidx - 2048);
        const float inv = exp2f(-(float)f * 0.41524101186092f);
        const float ang = pos * inv;
        const float kq = rintf(ang * 0.15915494309189535f);
        float rr = fmaf(-kq, 6.28125f, ang);
        rr = fmaf(-kq, 1.9353071795864769e-3f, rr);
        float* rt = (float*)(p->ws + OFF_ROPE);
        rt[e * 2] = cosf(rr);
        rt[e * 2 + 1] = sinf(rr);
      }
      continue;
    }
    it -= N_ROPE;
    {
      int t = it * 4 + w;
      rmsnorm_row_bf(xrow(p, t), p->in[7], (bf16_t*)(p->ws + OFF_ACT) + (size_t)t * 1024, lane);
    }
  }
}

DI void phase1(KP p, char* smem) {
  const int lane = tidx() & 63, w = tidx() >> 6;
  const int wm = w >> 1, wn = w & 1, r = lane & 31, h = lane >> 5;
  bf16_t* RET = (bf16_t*)p->out;
  bf16_t* RWP = (bf16_t*)(p->ws + OFF_TAB);
  const float2* rope = (const float2*)(p->ws + OFF_ROPE);
  for (int tile = blockIdx.x; tile < 136 * 30; tile += gridDim.x) {
    const int mt = tile / 30, nt = tile % 30;
    const int m0 = mt * 128, n0 = nt * 128;
    f32x16 acc[2][2];
    gemm128<false>((const bf16_t*)(p->ws + OFF_ACT) + (size_t)m0 * 1024, 1024,
                   (const bf16_t*)(p->ws + OFF_WIN) + (size_t)n0 * 1024, 1024, 1024, acc, smem);
    const int nb = n0 + wn * 64;
    if (nb < 1024) {
      float2 cs[2][16];
#pragma unroll
      for (int mi = 0; mi < 2; ++mi)
#pragma unroll
        for (int i = 0; i < 16; ++i) {
          const TokInfo ti = tokinfo(m0 + wm * 64 + mi * 32 + crow(i, h));
          cs[mi][i] = rope[(ti.sample ? 2048 + ti.l : ti.l) * 32 + r];
        }
      const float scl = (nb >= 512) ? 0.125f : 1.f;
#pragma unroll
      for (int mi = 0; mi < 2; ++mi)
#pragma unroll
        for (int i = 0; i < 16; ++i) {
          const float v0 = acc[mi][0][i], v1 = acc[mi][1][i];
          acc[mi][0][i] = (v0 * cs[mi][i].x - v1 * cs[mi][i].y) * scl;
          acc[mi][1][i] = (v1 * cs[mi][i].x + v0 * cs[mi][i].y) * scl;
        }
    }
#pragma unroll
    for (int mi = 0; mi < 2; ++mi)
#pragma unroll
      for (int i = 0; i < 16; ++i) {
        const int t = m0 + wm * 64 + mi * 32 + crow(i, h);
        const float v0 = acc[mi][0][i], v1 = acc[mi][1][i];
        if (nb < 2048) {
          RET[(size_t)t * 2048 + nb + r] = f2bf(v0);
          RET[(size_t)t * 2048 + nb + 32 + r] = f2bf(v1);
        } else {
          const TokInfo ti = tokinfo(t);
          const int c = nb - 2048 + r;
          RWP[(size_t)t * 1792 + c] = f2bf(v0);
          RWP[(size_t)t * 1792 + c + 32] = f2bf(v1);
          if (ti.sample) {
            if (ti.l == 7) { p->out[O_SHS + ti.b * 1792 + c] = v0; p->out[O_SHS + ti.b * 1792 + c + 32] = v1; }
          } else {
            if (ti.l == 2047) { p->out[O_SHP + ti.b * 1792 + c] = v0; p->out[O_SHP + ti.b * 1792 + c + 32] = v1; }
          }
        }
      }
  }
}

DI void phase2(KP p) {
  const int lane = tidx() & 63, w = tidx() >> 6;
  const bf16_t* RWP = (const bf16_t*)(p->ws + OFF_TAB);
  bf16_t* Rb = (bf16_t*)(p->ws + OFF_R);
  bf16_t* Kb = (bf16_t*)(p->ws + OFF_K);
  bf16_t* Vb = (bf16_t*)(p->ws + OFF_V);
  bf16_t* LA = (bf16_t*)(p->ws + OFF_LORA);
  float* INVN = (float*)(p->ws + OFF_INVN);
  const float* mu = p->in[9];
  const float* kkw = p->in[15];
  for (int t = blockIdx.x * 4 + w; t < T; t += gridDim.x * 4) {
    const TokInfo ti = tokinfo(t);
    const bf16_t* cur = RWP + (size_t)t * 1792;
    const bf16_t* prv = cur - 1792;
    const float* sh = p->in[4] + (size_t)ti.b * 1792;
    float f[4][8];
#pragma unroll
    for (int i = 0; i < 4; ++i) {
      const int c8 = (lane + 64 * i) * 8;
      if (i < 3 || lane < 32) {
        float cv[8], pv[8];
        unpack8f(*(const uint4*)(cur + c8), cv);
        if (ti.l > 0) unpack8f(*(const uint4*)(prv + c8), pv);
        else if (ti.sample) {
          const float4 s0 = *(const float4*)(sh + c8), s1 = *(const float4*)(sh + c8 + 4);
          pv[0] = s0.x; pv[1] = s0.y; pv[2] = s0.z; pv[3] = s0.w; pv[4] = s1.x; pv[5] = s1.y; pv[6] = s1.z; pv[7] = s1.w;
        } else {
#pragma unroll
          for (int k = 0; k < 8; ++k) pv[k] = 0.f;
        }
        const float4 m0 = *(const float4*)(mu + c8), m1 = *(const float4*)(mu + c8 + 4);
        const float mm[8] = {m0.x, m0.y, m0.z, m0.w, m1.x, m1.y, m1.z, m1.w};
#pragma unroll
        for (int k = 0; k < 8; ++k) f[i][k] = cv[k] + (pv[k] - cv[k]) * mm[k];
      } else {
#pragma unroll
        for (int k = 0; k < 8; ++k) f[i][k] = 0.f;
      }
    }
    *(uint4*)(Rb + (size_t)t * 512 + lane * 8) = pack8f(f[0]);
    {
      const uint4 kb = pack8f(f[1]);
      *(uint4*)(Kb + (size_t)t * 512 + lane * 8) = kb;
      float kr[8];
      unpack8f(kb, kr);
      const float4 q0 = *(const float4*)(kkw + lane * 8), q1 = *(const float4*)(kkw + lane * 8 + 4);
      const float qq[8] = {q0.x, q0.y, q0.z, q0.w, q1.x, q1.y, q1.z, q1.w};
      float ss = 0.f;
#pragma unroll
      for (int k = 0; k < 8; ++k) { const float kq = kr[k] * qq[k]; ss += kq * kq; }
      ss = allreduce8(ss);
      if ((lane & 7) == 0) INVN[t * 8 + (lane >> 3)] = 1.f / fmaxf(sqrtf(ss), 1e-12f);
    }
    *(uint4*)(Vb + (size_t)t * 512 + lane * 8) = pack8f(f[2]);
    if (lane < 32) {
      float o[8];
#pragma unroll
      for (int k = 0; k < 8; ++k) {
        const float x = f[3][k];
        o[k] = (lane < 8) ? (1.f - 2.f / (1.f + __expf(2.f * x))) : ((lane < 16) ? x : 1.f / (1.f + __expf(-x)));
      }
      *(uint4*)(LA + (size_t)t * 256 + lane * 8) = pack8f(o);
    }
  }
}

DI void phase3(KP p, char* smem) {
  const bf16_t* LA = (const bf16_t*)(p->ws + OFF_LORA);
  bf16_t* Kb = (bf16_t*)(p->ws + OFF_K);
  bf16_t* KKb = (bf16_t*)(p->ws + OFF_KK);
  bf16_t* BBb = (bf16_t*)(p->ws + OFF_BB);
  bf16_t* GTb = (bf16_t*)(p->ws + OFF_GATE);
  float* EW = (float*)(p->ws + OFF_EW);
  const float* INVN = (const float*)(p->ws + OFF_INVN);
  const float* w0 = p->in[10];
  const float* a0 = p->in[12];
  const float* kkw = p->in[15];
  const float* kaw = p->in[16];
  for (int item = blockIdx.x; item < 136 * 12; item += gridDim.x) {
    const int mt = item / 12, rem = item % 12, kind = rem >> 2, nt = rem & 3;
    const int m0 = mt * 128, n0 = nt * 128;
    f32x16 acc[2][2];
    if (kind == 0) {
      gemm128<false>(LA + (size_t)m0 * 256, 256, (const bf16_t*)(p->ws + OFF_W2) + n0 * 64, 64, 64, acc, smem);
      epi_each(acc, [&](int rr, int cc, float v) {
        const int t = m0 + rr, c = n0 + cc;
        const float x = v + w0[c];
        const float z = -x;
        const float sp = fmaxf(z, 0.f) + __logf(1.f + __expf(-fabsf(z)));
        const float ww = -sp - 0.5f;
        EW[(size_t)t * 512 + c] = __expf(-__expf(ww));
      });
    } else if (kind == 1) {
      gemm128<false>(LA + (size_t)m0 * 256 + 64, 256, (const bf16_t*)(p->ws + OFF_A2) + n0 * 64, 64, 64, acc, smem);
      {
        const int lane = tidx() & 63, w = tidx() >> 6;
        const int wm = w >> 1, wn = w & 1, r = lane & 31, h = lane >> 5;
#pragma unroll 1
        for (int mi = 0; mi < 2; ++mi) {
          const int tb = m0 + wm * 64 + mi * 32;
          float inv[16];
#pragma unroll
          for (int i = 0; i < 16; ++i) inv[i] = INVN[(tb + crow(i, h)) * 8 + ((n0 + wn * 64) >> 6)];
#pragma unroll
          for (int ni = 0; ni < 2; ++ni) {
            const int c = n0 + wn * 64 + ni * 32 + r;
            const float a0c = a0[c], kkc = kkw[c], kac = kaw[c];
            float k7v[16];
#pragma unroll
            for (int i = 0; i < 16; ++i) k7v[i] = bf2f(Kb[(size_t)(tb + crow(i, h)) * 512 + c]);
#pragma unroll
            for (int i = 0; i < 16; ++i) {
              const float av = (mi == 0) ? acc[0][ni][i] : acc[1][ni][i];
              const float a = 1.f / (1.f + __expf(-(av + a0c)));
              const size_t o = (size_t)(tb + crow(i, h)) * 512 + c;
              const float kkv = k7v[i] * kkc * inv[i];
              Kb[o] = f2bf(k7v[i] * (1.f + (a - 1.f) * kac));
              KKb[o] = f2bf(kkv);
              BBb[o] = f2bf(kkv * a);
            }
          }
        }
      }
    } else {
      gemm128<false>(LA + (size_t)m0 * 256 + 128, 256, (const bf16_t*)(p->ws + OFF_G2) + n0 * 128, 128, 128, acc, smem);
      epi_each(acc, [&](int rr, int cc, float v) { GTb[(size_t)(m0 + rr) * 512 + n0 + cc] = f2bf(v); });
    }
  }
}

DI void rwkv_scan(KP p, int tok0, int hd, int q, int nsteps, const float* __restrict__ S0, float* __restrict__ Sout, char* smem) {
  const int tid = tidx(), lane = tid & 63, w = tid >> 6, g = lane >> 4, l16 = lane & 15;
  const int rl = w * 4 + g;
  const int row = q * 16 + rl;
  const int j0 = l16 * 4;
  const bf16_t* Rb = (const bf16_t*)(p->ws + OFF_R);
  const bf16_t* Kb = (const bf16_t*)(p->ws + OFF_K);
  const bf16_t* Vb = (const bf16_t*)(p->ws + OFF_V);
  const bf16_t* KKb = (const bf16_t*)(p->ws + OFF_KK);
  const bf16_t* BBb = (const bf16_t*)(p->ws + OFF_BB);
  const float* EW = (const float*)(p->ws + OFF_EW);
  bf16_t* ACT = (bf16_t*)(p->ws + OFF_ACT);
  float* ew_s = (float*)smem;
  float* kk_s = ew_s + 2048;
  float* bb_s = kk_s + 2048;
  float* kp_s = bb_s + 2048;
  float* r_s = kp_s + 2048;
  float* v_s = r_s + 2048;
  float* y_s = v_s + 512;
  f2_t s01 = (f2_t){0.f, 0.f}, s23 = (f2_t){0.f, 0.f};
  if (S0) { const float4 t4 = *(const float4*)(S0 + row * 64 + j0); s01 = (f2_t){t4.x, t4.y}; s23 = (f2_t){t4.z, t4.w}; }
  uint4 rg_r = make_uint4(0, 0, 0, 0), rg_k = rg_r, rg_kk = rg_r, rg_bb = rg_r, rg_v = rg_r;
  float4 rg_e0 = make_float4(0, 0, 0, 0), rg_e1 = rg_e0;
  const int st_l = tid >> 3, c8 = (tid & 7) * 8;
  auto gload = [&](int sb) {
    if (sb + st_l < nsteps) {
      const size_t o = (size_t)(tok0 + sb + st_l) * 512 + hd * 64 + c8;
      rg_r = *(const uint4*)(Rb + o);
      rg_k = *(const uint4*)(Kb + o);
      rg_kk = *(const uint4*)(KKb + o);
      rg_bb = *(const uint4*)(BBb + o);
      rg_e0 = *(const float4*)(EW + o);
      rg_e1 = *(const float4*)(EW + o + 4);
    }
    if (tid < 64) {
      const int sv = tid >> 1;
      if (sb + sv < nsteps) rg_v = *(const uint4*)(Vb + (size_t)(tok0 + sb + sv) * 512 + hd * 64 + q * 16 + (tid & 1) * 8);
    }
  };
  auto unpack8 = [&](float* d, const uint4& u) {
    *(float4*)d = make_float4(lo2f(u.x), hi2f(u.x), lo2f(u.y), hi2f(u.y));
    *(float4*)(d + 4) = make_float4(lo2f(u.z), hi2f(u.z), lo2f(u.w), hi2f(u.w));
  };
  auto sstore = [&]() {
    const int o = st_l * 64 + c8;
    unpack8(r_s + o, rg_r);
    unpack8(kp_s + o, rg_k);
    unpack8(kk_s + o, rg_kk);
    unpack8(bb_s + o, rg_bb);
    *(float4*)(ew_s + o) = rg_e0;
    *(float4*)(ew_s + o + 4) = rg_e1;
    if (tid < 64) unpack8(v_s + (tid >> 1) * 16 + (tid & 1) * 8, rg_v);
  };
  gload(0);
  for (int sb = 0; sb < nsteps; sb += 32) {
    __syncthreads();
    sstore();
    __syncthreads();
    if (sb + 32 < nsteps) gload(sb + 32);
    const int tc = min(32, nsteps - sb);
#define SC_LD(X, st)                                              \
  {                                                               \
    const float* b_ = ew_s + (st) * 64 + j0;                      \
    X##e = *(const float4*)(b_);                                  \
    X##q = *(const float4*)(b_ + 2048);                           \
    X##b = *(const float4*)(b_ + 4096);                           \
    X##k = *(const float4*)(b_ + 6144);                           \
    X##r = *(const float4*)(b_ + 8192);                           \
    X##v = v_s[(st) * 16 + rl];                                   \
  }
#define SC_STEP(X, st)                                                                     \
  {                                                                                        \
    const f2_t p2 = s01 * (f2_t){X##q.x, X##q.y} + s23 * (f2_t){X##q.z, X##q.w};           \
    float pdp = p2.x + p2.y;                                                               \
      \
    const f2_t vk01 = (f2_t){X##k.x, X##k.y} * X##v, vk23 = (f2_t){X##k.z, X##k.w} * X##v; \
    const f2_t base01 = s01 * (f2_t){X##e.x, X##e.y} + vk01;                               \
    const f2_t base23 = s23 * (f2_t){X##e.z, X##e.w} + vk23;                               \
    allreduce16x2(pdp, ypart);     \
    if (l16 == 0 && (st) > 0) y_s[((st) - 1) * 16 + rl] = ypart;                           \
    s01 = base01 - (f2_t){X##b.x, X##b.y} * pdp;                              \
    s23 = base23 - (f2_t){X##b.z, X##b.w} * pdp;                                           \
    const f2_t y2 = s01 * (f2_t){X##r.x, X##r.y} + s23 * (f2_t){X##r.z, X##r.w};           \
    ypart = y2.x + y2.y;                                                                   \
  }
    {
      float4 Ae, Aq, Ab, Ak, Ar, Be, Bq, Bb, Bk, Br;
      float Av, Bv;
      float ypart = 0.f;
      SC_LD(A, 0)
      for (int st = 0; st < tc; st += 2) {
        SC_LD(B, st + 1)
        SC_STEP(A, st)
        SC_LD(A, min(st + 2, tc - 1))
        SC_STEP(B, st + 1)
      }
      ypart = allreduce16(ypart);
      if (l16 == 0) y_s[(tc - 1) * 16 + rl] = ypart;
    }
    __syncthreads();
    if (tid < tc * 8) {
      const int st = tid >> 3, pr = tid & 7;
      const unsigned pk = pack2(y_s[st * 16 + 2 * pr], y_s[st * 16 + 2 * pr + 1]);
      *(unsigned*)(ACT + (size_t)(tok0 + sb + st) * 1024 + 512 + hd * 64 + q * 16 + 2 * pr) = pk;
    }
  }
  *(float4*)(Sout + row * 64 + j0) = make_float4(s01.x, s01.y, s23.x, s23.y);
}

constexpr int RL = 136;
DI void ret_prompt(KP p, int b, int hd, char* smem) {
  const int tid = tidx(), lane = tid & 63, w = tid >> 6, r = lane & 31, h = lane >> 5;
  const bf16_t* RET = (const bf16_t*)p->out;
  bf16_t* ACT = (bf16_t*)(p->ws + OFF_ACT);
  bf16_t* Vt = (bf16_t*)smem;
  bf16_t* Kzt = (bf16_t*)(smem + 17408);
  bf16_t* St = (bf16_t*)(smem + 34816);
  bf16_t* Sc = (bf16_t*)(smem + 44032);
  float* Of = (float*)(smem + 44032);
  float* dec = (float*)(smem + 78848);
  const float lg = log1pf(-exp2f(-5.f - (float)hd));
  if (tid < 129) dec[tid] = expf((float)tid * lg);
  for (int e = tid; e < 64 * 72; e += 256) St[e] = 0;
  __syncthreads();
  const float g128 = dec[128];
  f32x16 Sacc;
#pragma unroll
  for (int e = 0; e < 16; ++e) Sacc[e] = 0.f;
  const int vt = w >> 1, dt = w & 1;
  for (int c = 0; c < 16; ++c) {
    const int tokc = b * 2048 + c * 128;
    {
      const int j = tid >> 1, hf = tid & 1;
      const bf16_t* vsrc = RET + (size_t)(tokc + j) * 2048 + 1024 + hd * 64 + hf * 32;
      const bf16_t* ksrc = RET + (size_t)(tokc + j) * 2048 + 512 + hd * 64 + hf * 32;
      const float zj = dec[127 - j];
#pragma unroll
      for (int qd = 0; qd < 4; ++qd) {
        const uint4 uv = *(const uint4*)(vsrc + qd * 8);
        const uint4 uk = *(const uint4*)(ksrc + qd * 8);
        const unsigned vv[4] = {uv.x, uv.y, uv.z, uv.w};
        const unsigned kk[4] = {uk.x, uk.y, uk.z, uk.w};
#pragma unroll
        for (int e = 0; e < 4; ++e) {
          const int col = hf * 32 + qd * 8 + e * 2;
          Vt[col * RL + j] = (bf16_t)(vv[e] & 0xffffu);
          Vt[(col + 1) * RL + j] = (bf16_t)(vv[e] >> 16);
          Kzt[col * RL + j] = f2bf(lo2f(kk[e]) * zj);
          Kzt[(col + 1) * RL + j] = f2bf(hi2f(kk[e]) * zj);
        }
      }
    }
    bf16x8 qf[4];
    {
      const bf16_t* qsrc = RET + (size_t)(tokc + 32 * w + r) * 2048 + hd * 64 + h * 8;
#pragma unroll
      for (int ks = 0; ks < 4; ++ks) qf[ks] = *(const bf16x8*)(qsrc + ks * 16);
    }
#pragma unroll
    for (int jb = 0; jb < 2; ++jb) {
      bf16x8 kf[2][4];
#pragma unroll
      for (int jj = 0; jj < 2; ++jj) {
        const int jt = jb * 2 + jj;
        if (jt <= w) {
          const bf16_t* ksrc = RET + (size_t)(tokc + 32 * jt + r) * 2048 + 512 + hd * 64 + h * 8;
#pragma unroll
          for (int ks = 0; ks < 4; ++ks) kf[jj][ks] = *(const bf16x8*)(ksrc + ks * 16);
        }
      }
#pragma unroll
      for (int jj = 0; jj < 2; ++jj) {
        const int jt = jb * 2 + jj;
        if (jt <= w) {
          f32x16 sc;
#pragma unroll
          for (int e = 0; e < 16; ++e) sc[e] = 0.f;
#pragma unroll
          for (int ks = 0; ks < 4; ++ks) sc = __builtin_amdgcn_mfma_f32_32x32x16_bf16(qf[ks], kf[jj][ks], sc, 0, 0, 0);
#pragma unroll
          for (int e = 0; e < 16; ++e) {
            const int i = 32 * w + crow(e, h), j = 32 * jt + r;
            const int d = i - j;
            const float val = (d >= 0) ? sc[e] * dec[d >= 0 ? d : 0] : 0.f;
            Sc[i * RL + j] = f2bf(val);
          }
        }
      }
    }
    __syncthreads();
    f32x16 oacc[2];
#pragma unroll
    for (int nt = 0; nt < 2; ++nt) {
#pragma unroll
      for (int e = 0; e < 16; ++e) oacc[nt][e] = 0.f;
#pragma unroll
      for (int ks = 0; ks < 4; ++ks) {
        const bf16x8 sf = *(const bf16x8*)(St + (nt * 32 + r) * 72 + ks * 16 + h * 8);
        oacc[nt] = __builtin_amdgcn_mfma_f32_32x32x16_bf16(qf[ks], sf, oacc[nt], 0, 0, 0);
      }
#pragma unroll
      for (int e = 0; e < 16; ++e) oacc[nt][e] *= dec[32 * w + crow(e, h) + 1];
    }
    for (int ks = 0; ks < 2 * (w + 1); ++ks) {
      const bf16x8 af = *(const bf16x8*)(Sc + (32 * w + r) * RL + ks * 16 + h * 8);
#pragma unroll
      for (int nt = 0; nt < 2; ++nt) {
        const bf16x8 vf = *(const bf16x8*)(Vt + (nt * 32 + r) * RL + ks * 16 + h * 8);
        oacc[nt] = __builtin_amdgcn_mfma_f32_32x32x16_bf16(af, vf, oacc[nt], 0, 0, 0);
      }
    }
#pragma unroll
    for (int e = 0; e < 16; ++e) Sacc[e] *= g128;
#pragma unroll
    for (int ks = 0; ks < 8; ++ks) {
      const bf16x8 af = *(const bf16x8*)(Vt + (vt * 32 + r) * RL + ks * 16 + h * 8);
      const bf16x8 bf = *(const bf16x8*)(Kzt + (dt * 32 + r) * RL + ks * 16 + h * 8);
      Sacc = __builtin_amdgcn_mfma_f32_32x32x16_bf16(af, bf, Sacc, 0, 0, 0);
    }
    __syncthreads();
#pragma unroll
    for (int nt = 0; nt < 2; ++nt)
#pragma unroll
      for (int e = 0; e < 16; ++e) Of[(32 * w + crow(e, h)) * 66 + nt * 32 + r] = oacc[nt][e];
#pragma unroll
    for (int e = 0; e < 16; ++e) St[(vt * 32 + crow(e, h)) * 72 + dt * 32 + r] = f2bf(Sacc[e]);
    __syncthreads();
    {
      const int i = tid >> 1, hf = tid & 1;
      const int t = tokc + i;
      float vals[32];
      float sm = 0.f;
#pragma unroll
      for (int k = 0; k < 32; ++k) { vals[k] = Of[i * 66 + hf * 32 + k]; sm += vals[k]; }
      sm += __shfl_xor(sm, 1);
      const float mean = sm * (1.f / 64.f);
      float vs = 0.f;
#pragma unroll
      for (int k = 0; k < 32; ++k) { vals[k] -= mean; vs += vals[k] * vals[k]; }
      vs += __shfl_xor(vs, 1);
      const float rs = rsqrtf(vs * (1.f / 64.f) + 1e-5f);
      const bf16_t* gsrc = RET + (size_t)t * 2048 + 1536 + hd * 64 + hf * 32;
      bf16_t* dst = ACT + (size_t)t * 1024 + hd * 64 + hf * 32;
#pragma unroll
      for (int qd = 0; qd < 4; ++qd) {
        const uint4 ug = *(const uint4*)(gsrc + qd * 8);
        const unsigned gg[4] = {ug.x, ug.y, ug.z, ug.w};
        unsigned o4[4];
#pragma unroll
        for (int e = 0; e < 4; ++e) {
          const float g0 = lo2f(gg[e]), g1 = hi2f(gg[e]);
          const float a0 = vals[qd * 8 + 2 * e] * rs * (g0 / (1.f + __expf(-g0)));
          const float a1 = vals[qd * 8 + 2 * e + 1] * rs * (g1 / (1.f + __expf(-g1)));
          o4[e] = pack2(a0, a1);
        }
        *(uint4*)(dst + qd * 8) = make_uint4(o4[0], o4[1], o4[2], o4[3]);
      }
    }
    __syncthreads();
  }
  float* so = p->out + O_RETP + (size_t)(b * 8 + hd) * 4096;
#pragma unroll
  for (int gq = 0; gq < 4; ++gq)
    *(float4*)(so + (dt * 32 + r) * 64 + vt * 32 + 8 * gq + 4 * h) =
        make_float4(Sacc[4 * gq], Sacc[4 * gq + 1], Sacc[4 * gq + 2], Sacc[4 * gq + 3]);
}

DI void ret_sample(KP p, int b, int hd, char* smem) {
  const int tid = tidx();
  const bf16_t* RET = (const bf16_t*)p->out;
  bf16_t* ACT = (bf16_t*)(p->ws + OFF_ACT);
  float* q_s = (float*)smem;
  float* k_s = q_s + 512;
  float* v_s = k_s + 512;
  float* A_s = v_s + 512;
  float* part = A_s + 64;
  const int tok0 = TP + b * 8;
  const float lg = log1pf(-exp2f(-5.f - (float)hd));
  __syncthreads();
  {
    const int e = tid * 2, rw = e >> 6, cl = e & 63;
    const bf16_t* base = RET + (size_t)(tok0 + rw) * 2048 + hd * 64 + cl;
    const unsigned uq = *(const unsigned*)(base), uk = *(const unsigned*)(base + 512), uv = *(const unsigned*)(base + 1024);
    q_s[e] = lo2f(uq); q_s[e + 1] = hi2f(uq);
    k_s[e] = lo2f(uk); k_s[e + 1] = hi2f(uk);
    v_s[e] = lo2f(uv); v_s[e + 1] = hi2f(uv);
  }
  __syncthreads();
  if (tid < 64) {
    const int i = tid >> 3, j = tid & 7;
    float a = 0.f;
    if (i >= j) {
#pragma unroll 4
      for (int d = 0; d < 64; ++d) a = fmaf(q_s[i * 64 + d], k_s[j * 64 + d], a);
      a *= expf((float)(i - j) * lg);
    }
    A_s[tid] = a;
  }
  {
    const int dg = tid >> 6, v = tid & 63;
    const float* S0 = p->in[2] + (size_t)(b * 8 + hd) * 4096;
    float* So = p->out + O_RETS + (size_t)(b * 8 + hd) * 4096;
    float oi[8];
#pragma unroll
    for (int i = 0; i < 8; ++i) oi[i] = 0.f;
    const float g8 = expf(8.f * lg);
    float kv[8];
#pragma unroll
    for (int j = 0; j < 8; ++j) kv[j] = v_s[j * 64 + v] * expf((float)(7 - j) * lg);
#pragma unroll 1
    for (int hb = 0; hb < 2; ++hb) {
      float sv[8];
#pragma unroll
      for (int dd = 0; dd < 8; ++dd) sv[dd] = S0[(dg * 16 + hb * 8 + dd) * 64 + v];
#pragma unroll
      for (int dd = 0; dd < 8; ++dd) {
        const int d = dg * 16 + hb * 8 + dd;
        const float s = sv[dd];
        float sn = s * g8;
#pragma unroll
        for (int j = 0; j < 8; ++j) sn = fmaf(k_s[j * 64 + d], kv[j], sn);
        So[d * 64 + v] = sn;
#pragma unroll
        for (int i = 0; i < 8; ++i) oi[i] = fmaf(q_s[i * 64 + d], s, oi[i]);
      }
    }
#pragma unroll
    for (int i = 0; i < 8; ++i) part[(dg * 8 + i) * 64 + v] = oi[i];
  }
  __syncthreads();
#pragma unroll
  for (int rep = 0; rep < 2; ++rep) {
    const int i = (tid >> 6) + 4 * rep, v = tid & 63;
    float o = part[(0 * 8 + i) * 64 + v] + part[(1 * 8 + i) * 64 + v] + part[(2 * 8 + i) * 64 + v] + part[(3 * 8 + i) * 64 + v];
    o *= expf((float)(i + 1) * lg);
    for (int j = 0; j <= i; ++j) o = fmaf(A_s[i * 8 + j], v_s[j * 64 + v], o);
    const float mean = wave_sum(o) * (1.f / 64.f);
    const float dv = o - mean;
    const float var = wave_sum(dv * dv) * (1.f / 64.f);
    const int t = tok0 + i;
    const float gt = bf2f(RET[(size_t)t * 2048 + 1536 + hd * 64 + v]);
    ACT[(size_t)t * 1024 + hd * 64 + v] = f2bf(dv * rsqrtf(var + 1e-5f) * (gt / (1.f + __expf(-gt))));
  }
}

constexpr size_t TAB_V8 = (size_t)16384 * 1024;
constexpr size_t TAB_SC = (size_t)2 * 16384 * 1024;
DI void convert_tab(KP p, int it) {
  const int tid = tidx(), lane = tid & 63, w = tid >> 6;
  const int row0 = it * 8 + w * 2;
  const float* src = (row0 < 16384) ? p->in[24] + (size_t)row0 * 1024 : p->in[25] + (size_t)(row0 - 16384) * 1024;
  float4 v[2][4];
#pragma unroll
  for (int rr = 0; rr < 2; ++rr)
#pragma unroll
    for (int i = 0; i < 4; ++i) v[rr][i] = *(const float4*)(src + rr * 1024 + i * 256 + lane * 4);
#pragma unroll
  for (int rr = 0; rr < 2; ++rr) {
    float am = 0.f;
#pragma unroll
    for (int i = 0; i < 4; ++i)
      am = fmaxf(am, fmaxf(fmaxf(fabsf(v[rr][i].x), fabsf(v[rr][i].y)), fmaxf(fabsf(v[rr][i].z), fabsf(v[rr][i].w))));
#pragma unroll
    for (int o = 32; o >= 1; o >>= 1) am = fmaxf(am, __shfl_xor(am, o));
    am = fmaxf(am, 1e-30f);
    const float inv = 127.f / am;
    unsigned char* dst = (unsigned char*)(p->ws + OFF_TAB) + (size_t)(row0 + rr) * 1024;
#pragma unroll
    for (int i = 0; i < 4; ++i) {
      const unsigned q0 = (unsigned)((int)rintf(v[rr][i].x * inv) + 128);
      const unsigned q1 = (unsigned)((int)rintf(v[rr][i].y * inv) + 128);
      const unsigned q2 = (unsigned)((int)rintf(v[rr][i].z * inv) + 128);
      const unsigned q3 = (unsigned)((int)rintf(v[rr][i].w * inv) + 128);
      *(unsigned*)(dst + i * 256 + lane * 4) = q0 | (q1 << 8) | (q2 << 16) | (q3 << 24);
    }
    if (lane == 0) ((float*)(p->ws + OFF_TAB + TAB_SC))[row0 + rr] = am * (1.f / 127.f);
  }
}

DI void phase4_other(KP p, int it, char* smem) {
  if (it < 64) { ret_prompt(p, it >> 3, it & 7, smem); return; }
  it -= 64;
  if (it < 4096) {
    const int bh = it >> 2, q = it & 3, b = bh >> 3, hd = bh & 7;
    rwkv_scan(p, TP + b * 8, hd, q, 8, p->in[3] + (size_t)bh * 4096, p->out + O_WKVS + (size_t)bh * 4096, smem);
    return;
  }
  it -= 4096;
  if (it < 1024) { ret_sample(p, it >> 3, it & 7, smem); return; }
  it -= 1024;
  if (it < 4096) { convert_tab(p, it); return; }
  it -= 4096;
#define TJ4(IDX, OFF, KK_, NN_)                                                                            \
  {                                                                                                        \
    const int ntl = ((KK_) / 64) * ((NN_) / 64);                                                           \
    if (it < ntl) {                                                                                        \
      transpose_tile(p->in[IDX], (bf16_t*)(p->ws + (OFF)), (KK_), (NN_), it / ((NN_) / 64), it % ((NN_) / 64), (float*)smem); \
      return;                                                                                              \
    }                                                                                                      \
    it -= ntl;                                                                                             \
  }
  TJ4(20, OFF_WOUT, 1024, 1024)
  TJ4(22, OFF_WQ, 1024, 2048)
  TJ4(27, OFF_PG, 1024, 1024)
  TJ4(28, OFF_PP, 256, 1024)
}
DI void phase4(KP p, char* smem) {
  constexpr int N_OTHER = 64 + 4096 + 1024 + 4096 + (256 + 512 + 256 + 64);
  int* s_item = (int*)(smem + SMEM_BYTES - 16);
  unsigned* ctr = (unsigned*)(p->ws + OFF_CTR);
  unsigned* cukey = (unsigned*)(p->ws + OFF_CTR + 16384);
  __syncthreads();
  if (tidx() == 0) {
    const unsigned hw = (unsigned)__builtin_amdgcn_s_getreg((7 << 11) | (8 << 6) | 4);
    const unsigned key = (xb_xcc_id() << 8) | (hw & 0xffu);
    const unsigned old = atomicAdd(&cukey[key], 1u);
    int it = -1;
    if (old == 0u) { const unsigned q = atomicAdd(&ctr[1], 1u); if (q < 256u) it = (int)q; }
    *s_item = it;
  }
  __syncthreads();
  {
    const int it = *s_item;
    if (it >= 0) {
      const int bh = it >> 2, q = it & 3, b = bh >> 3, hd = bh & 7;
      __builtin_amdgcn_s_setprio(3);
      rwkv_scan(p, b * 2048, hd, q, 2048, nullptr, p->out + O_WKVP + (size_t)bh * 4096, smem);
      __builtin_amdgcn_s_setprio(0);
    }
  }
  for (;;) {
    __syncthreads();
    if (tidx() == 0) *s_item = (int)atomicAdd(&ctr[0], 1u);
    __syncthreads();
    const int it = *s_item;
    if (it >= N_OTHER) break;
    phase4_other(p, it, smem);
  }
  for (;;) {
    __syncthreads();
    if (tidx() == 0) *s_item = (int)atomicAdd(&ctr[1], 1u);
    __syncthreads();
    const int it = *s_item;
    if (it >= 256) break;
    const int bh = it >> 2, q = it & 3, b = bh >> 3, hd = bh & 7;
    rwkv_scan(p, b * 2048, hd, q, 2048, nullptr, p->out + O_WKVP + (size_t)bh * 4096, smem);
  }
}

DI void phase5(KP p) {
  const int lane = tidx() & 63, w = tidx() >> 6;
  bf16_t* ACT = (bf16_t*)(p->ws + OFF_ACT);
  const bf16_t* Rb = (const bf16_t*)(p->ws + OFF_R);
  const bf16_t* Kb = (const bf16_t*)(p->ws + OFF_K);
  const bf16_t* Vb = (const bf16_t*)(p->ws + OFF_V);
  const bf16_t* GTb = (const bf16_t*)(p->ws + OFF_GATE);
  const int c8 = lane * 8;
  float rk8[8], lg8[8], lb8[8];
  {
    const float4 a0 = *(const float4*)(p->in[17] + c8), a1 = *(const float4*)(p->in[17] + c8 + 4);
    const float4 b0 = *(const float4*)(p->in[18] + c8), b1 = *(const float4*)(p->in[18] + c8 + 4);
    const float4 d0 = *(const float4*)(p->in[19] + c8), d1 = *(const float4*)(p->in[19] + c8 + 4);
    rk8[0] = a0.x; rk8[1] = a0.y; rk8[2] = a0.z; rk8[3] = a0.w; rk8[4] = a1.x; rk8[5] = a1.y; rk8[6] = a1.z; rk8[7] = a1.w;
    lg8[0] = b0.x; lg8[1] = b0.y; lg8[2] = b0.z; lg8[3] = b0.w; lg8[4] = b1.x; lg8[5] = b1.y; lg8[6] = b1.z; lg8[7] = b1.w;
    lb8[0] = d0.x; lb8[1] = d0.y; lb8[2] = d0.z; lb8[3] = d0.w; lb8[4] = d1.x; lb8[5] = d1.y; lb8[6] = d1.z; lb8[7] = d1.w;
  }
  for (int t = blockIdx.x * 4 + w; t < T; t += gridDim.x * 4) {
    const size_t o = (size_t)t * 512 + c8;
    bf16_t* yp = ACT + (size_t)t * 1024 + 512 + c8;
    const uint4 uy = *(const uint4*)yp, ur = *(const uint4*)(Rb + o), uk = *(const uint4*)(Kb + o),
                uv = *(const uint4*)(Vb + o), ug = *(const uint4*)(GTb + o);
    float y[8], r[8], k[8], v[8], g[8];
    unpack8f(uy, y); unpack8f(ur, r); unpack8f(uk, k); unpack8f(uv, v); unpack8f(ug, g);
    float sm = 0.f, rk = 0.f;
#pragma unroll
    for (int e = 0; e < 8; ++e) { sm += y[e]; rk = fmaf(r[e] * k[e], rk8[e], rk); }
    sm = allreduce8(sm);
    rk = allreduce8(rk);
    const float mean = sm * (1.f / 64.f);
    float vs = 0.f;
#pragma unroll
    for (int e = 0; e < 8; ++e) { y[e] -= mean; vs += y[e] * y[e]; }
    vs = allreduce8(vs);
    const float rs = rsqrtf(vs * (1.f / 64.f) + 64e-5f);
    float ov[8];
#pragma unroll
    for (int e = 0; e < 8; ++e) ov[e] = (y[e] * rs * lg8[e] + lb8[e] + rk * v[e]) * g[e];
    *(uint4*)yp = pack8f(ov);
  }
}

DI void phase6(KP p, char* smem) {
  for (int tile = blockIdx.x; tile < 136 * 8; tile += gridDim.x) {
    const int mt = tile >> 3, nt = tile & 7;
    const int m0 = mt * 128, n0 = nt * 128;
    f32x16 acc[2][2];
    gemm128<false>((const bf16_t*)(p->ws + OFF_ACT) + (size_t)m0 * 1024, 1024,
                   (const bf16_t*)(p->ws + OFF_WOUT) + (size_t)n0 * 1024, 1024, 1024, acc, smem);
    {
      const int lane = tidx() & 63, w = tidx() >> 6;
      const int wm = w >> 1, wn = w & 1, r = lane & 31, h = lane >> 5;
      const float* xb = (m0 < TP) ? p->in[0] + (size_t)m0 * 1024 : p->in[1] + (size_t)(m0 - TP) * 1024;
#pragma unroll
      for (int mi = 0; mi < 2; ++mi)
#pragma unroll
        for (int ni = 0; ni < 2; ++ni)
#pragma unroll
          for (int i = 0; i < 16; ++i)
            acc[mi][ni][i] += xb[(size_t)(wm * 64 + mi * 32 + crow(i, h)) * 1024 + n0 + wn * 64 + ni * 32 + r];
#pragma unroll
      for (int mi = 0; mi < 2; ++mi)
#pragma unroll
        for (int ni = 0; ni < 2; ++ni)
#pragma unroll
          for (int i = 0; i < 16; ++i)
            p->out[(size_t)(m0 + wm * 64 + mi * 32 + crow(i, h)) * 1024 + n0 + wn * 64 + ni * 32 + r] = acc[mi][ni][i];
    }
  }
}

DI void phase7(KP p) {
  const int lane = tidx() & 63, w = tidx() >> 6;
  for (int t = blockIdx.x * 4 + w; t < T; t += gridDim.x * 4)
    rmsnorm_row_bf(p->out + (size_t)t * 1024, p->in[21], (bf16_t*)(p->ws + OFF_ACT) + (size_t)t * 1024, lane);
}

DI void phase8(KP p, char* smem) {
  bf16_t* QP = (bf16_t*)(p->ws + OFF_QPEER);
  for (int tile = blockIdx.x; tile < 136 * 16; tile += gridDim.x) {
    const int mt = tile >> 4, nt = tile & 15;
    const int m0 = mt * 128, n0 = nt * 128;
    f32x16 acc[2][2];
    gemm128<false>((const bf16_t*)(p->ws + OFF_ACT) + (size_t)m0 * 1024, 1024,
                   (const bf16_t*)(p->ws + OFF_WQ) + (size_t)n0 * 1024, 1024, 1024, acc, smem);
    epi_each(acc, [&](int rr, int cc, float v) { QP[(size_t)(m0 + rr) * 2048 + n0 + cc] = f2bf(v); });
  }
}

DI unsigned sortkey(float f) { unsigned u = __float_as_uint(f); return (u & 0x80000000u) ? ~u : (u | 0x80000000u); }
DI float unsortkey(unsigned k) { unsigned u = (k & 0x80000000u) ? (k ^ 0x80000000u) : ~k; return __uint_as_float(u); }
DI void ins16(unsigned (&l)[16], unsigned x) {
#pragma unroll
  for (int i = 0; i < 16; ++i) { const unsigned hi = max(l[i], x); x = min(l[i], x); l[i] = hi; }
}
DI void cswap_desc(unsigned& a, unsigned& b) { const unsigned hi = max(a, b), lo = min(a, b); a = hi; b = lo; }
DI void bsort16(unsigned (&v)[16]) {
#pragma unroll
  for (int ke = 1; ke <= 4; ++ke)
#pragma unroll
    for (int je = ke - 1; je >= 0; --je)
#pragma unroll
      for (int i = 0; i < 16; ++i) {
        const int k = 1 << ke, j = 1 << je, l = i ^ j;
        if (l > i) { if ((i & k) == 0) cswap_desc(v[i], v[l]); else cswap_desc(v[l], v[i]); }
      }
}
DI void bmerge16(unsigned (&a)[16], const unsigned (&b)[16]) {
#pragma unroll
  for (int i = 0; i < 16; ++i) a[i] = max(a[i], b[15 - i]);
#pragma unroll
  for (int je = 3; je >= 0; --je)
#pragma unroll
    for (int i = 0; i < 16; ++i) {
      const int j = 1 << je, l = i ^ j;
      if (l > i) cswap_desc(a[i], a[l]);
    }
}
DI void phase9(KP p, char* smem) {
  const int tid = tidx();
  const bf16_t* QP = (const bf16_t*)(p->ws + OFF_QPEER);
  const bf16_t* KEYS = (const bf16_t*)(p->ws + OFF_KEYS);
  int* IDX = (int*)(p->ws + OFF_IDX);
  float* GSM = (float*)(p->ws + OFF_GSM);
  float* sc = (float*)smem;
  unsigned* mrg = (unsigned*)smem;
  const int row = tid >> 1, half = tid & 1;
  for (int item = blockIdx.x; item < 136 * 8; item += gridDim.x) {
    const int mt = item >> 3, hd = item & 7;
    const int m0 = mt * 128;
    unsigned kc[2][16];
#pragma unroll
    for (int c = 0; c < 2; ++c) {
      f32x16 acc[2][2];
      gemm128<false>(QP + (size_t)m0 * 2048 + (hd * 2 + c) * 128, 2048, KEYS + (size_t)(hd * 2 + c) * 16384, 128, 128, acc, smem);
      __syncthreads();
      epi_each(acc, [&](int rr, int cc, float v) { sc[rr * 129 + cc] = v; });
      __syncthreads();
      unsigned lst[16];
#pragma unroll
      for (int gi = 0; gi < 4; ++gi) {
        unsigned grp[16];
#pragma unroll
        for (int i = 0; i < 16; ++i) {
          const int col = half * 64 + gi * 16 + i;
          grp[i] = (sortkey(sc[row * 129 + col]) & ~127u) | (unsigned)(127 - col);
        }
        bsort16(grp);
        if (gi == 0) {
#pragma unroll
          for (int i = 0; i < 16; ++i) lst[i] = grp[i];
        } else {
          bmerge16(lst, grp);
        }
      }
      __syncthreads();
      if (half) {
#pragma unroll
        for (int i = 0; i < 16; ++i) mrg[row * 16 + i] = lst[i];
      }
      __syncthreads();
      if (!half) {
        unsigned grp[16];
#pragma unroll
        for (int i = 0; i < 16; ++i) grp[i] = mrg[row * 16 + i];
        bmerge16(lst, grp);
      }
#pragma unroll
      for (int i = 0; i < 16; ++i) kc[c][i] = lst[i];
    }
    if (!half) {
      float sv0[16], sv1[16];
#pragma unroll
      for (int i = 0; i < 16; ++i) { sv0[i] = unsortkey(kc[0][i] & ~127u); sv1[i] = unsortkey(kc[1][i] & ~127u); }
      unsigned cl[16];
#pragma unroll
      for (int i = 0; i < 16; ++i) cl[i] = 0u;
#pragma unroll
      for (int a = 0; a < 16; ++a)
#pragma unroll
        for (int b = 0; b < 16 / (a + 1); ++b)
          ins16(cl, (sortkey(sv0[a] + sv1[b]) & ~255u) | (unsigned)(255 - (a * 16 + b)));
      float ex[16];
      float sum = 0.f;
      const float mx = unsortkey(cl[0] & ~255u);
#pragma unroll
      for (int i = 0; i < 16; ++i) { ex[i] = __expf(unsortkey(cl[i] & ~255u) - mx); sum += ex[i]; }
      const float inv = 1.f / sum;
      int eo[16];
#pragma unroll
      for (int i = 0; i < 16; ++i) {
        const int ci = 255 - (int)(cl[i] & 255u);
        const int a = ci >> 4, b = ci & 15;
        int i0 = 0, i1 = 0;
#pragma unroll
        for (int k = 0; k < 16; ++k) {
          i0 = (a == k) ? (127 - (int)(kc[0][k] & 127u)) : i0;
          i1 = (b == k) ? (127 - (int)(kc[1][k] & 127u)) : i1;
        }
        eo[i] = i0 * 128 + i1;
        ex[i] *= inv;
      }
      const size_t o = ((size_t)(m0 + row) * 8 + hd) * 16;
#pragma unroll
      for (int qd = 0; qd < 4; ++qd) {
        *(int4*)(IDX + o + qd * 4) = make_int4(eo[qd * 4], eo[qd * 4 + 1], eo[qd * 4 + 2], eo[qd * 4 + 3]);
        *(float4*)(GSM + o + qd * 4) = make_float4(ex[qd * 4], ex[qd * 4 + 1], ex[qd * 4 + 2], ex[qd * 4 + 3]);
      }
    }
  }
}

#define UB0(u) ((float)((u) & 0xffu))
#define UB1(u) ((float)(((u) >> 8) & 0xffu))
#define UB2(u) ((float)(((u) >> 16) & 0xffu))
#define UB3(u) ((float)((u) >> 24))
DI void phase10(KP p) {
  const int lane = tidx() & 63, w = tidx() >> 6;
  const int g = lane >> 4, l16 = lane & 15;
  bf16_t* ACT = (bf16_t*)(p->ws + OFF_ACT);
  const unsigned char* UB = (const unsigned char*)(p->ws + OFF_TAB);
  const unsigned char* VB = UB + TAB_V8;
  const float* USC = (const float*)(p->ws + OFF_TAB + TAB_SC);
  const float* VSC = USC + 16384;
  const int* IDX = (const int*)(p->ws + OFF_IDX);
  const float* GSM = (const float*)(p->ws + OFF_GSM);
  const float* pn = p->in[26];
  for (int t = blockIdx.x * 4 + w; t < T; t += gridDim.x * 4) {
    bf16_t* act = ACT + (size_t)t * 1024;
    float xf[64];
    float xsum = 0.f;
#pragma unroll
    for (int s = 0; s < 4; ++s) {
      const uint4 x0 = *(const uint4*)(act + s * 256 + l16 * 16);
      const uint4 x1 = *(const uint4*)(act + s * 256 + l16 * 16 + 8);
      const unsigned xx[8] = {x0.x, x0.y, x0.z, x0.w, x1.x, x1.y, x1.z, x1.w};
#pragma unroll
      for (int q = 0; q < 8; ++q) { xf[s * 16 + 2 * q] = lo2f(xx[q]); xf[s * 16 + 2 * q + 1] = hi2f(xx[q]); }
    }
#pragma unroll
    for (int k = 0; k < 64; ++k) xsum += xf[k];
    const int id0 = IDX[(size_t)t * 128 + lane], id1 = IDX[(size_t)t * 128 + 64 + lane];
    const float gs0 = GSM[(size_t)t * 128 + lane], gs1 = GSM[(size_t)t * 128 + 64 + lane];
    float acc[64];
#pragma unroll
    for (int k = 0; k < 64; ++k) acc[k] = 0.f;
    float csum = 0.f;
    for (int it = 0; it < 32; ++it) {
      const int n = (it * 4 + g) & 63;
      const int e = __shfl((it < 16) ? id0 : id1, n);
      const float gw = __shfl((it < 16) ? gs0 : gs1, n);
      const unsigned char* ur = UB + (size_t)e * 1024 + l16 * 16;
      const unsigned char* vr = VB + (size_t)e * 1024 + l16 * 16;
      uint4 uu[4], vv[4];
#pragma unroll
      for (int s = 0; s < 4; ++s) uu[s] = *(const uint4*)(ur + s * 256);
#pragma unroll
      for (int s = 0; s < 4; ++s) vv[s] = *(const uint4*)(vr + s * 256);
      const float su = USC[e], sv = VSC[e];
      float hv = 0.f;
#pragma unroll
      for (int s = 0; s < 4; ++s) {
        const unsigned ww[4] = {uu[s].x, uu[s].y, uu[s].z, uu[s].w};
#pragma unroll
        for (int q = 0; q < 4; ++q) {
          hv = fmaf(xf[s * 16 + q * 4 + 0], UB0(ww[q]), hv);
          hv = fmaf(xf[s * 16 + q * 4 + 1], UB1(ww[q]), hv);
          hv = fmaf(xf[s * 16 + q * 4 + 2], UB2(ww[q]), hv);
          hv = fmaf(xf[s * 16 + q * 4 + 3], UB3(ww[q]), hv);
        }
      }
      hv = fmaf(-128.f, xsum, hv);
      hv = allreduce16(hv) * su;
      const float c = 0.5f * hv * (1.f + erff(hv * 0.70710678118f)) * gw * sv;
      csum += c;
#pragma unroll
      for (int s = 0; s < 4; ++s) {
        const unsigned ww[4] = {vv[s].x, vv[s].y, vv[s].z, vv[s].w};
#pragma unroll
        for (int q = 0; q < 4; ++q) {
          acc[s * 16 + q * 4 + 0] = fmaf(c, UB0(ww[q]), acc[s * 16 + q * 4 + 0]);
          acc[s * 16 + q * 4 + 1] = fmaf(c, UB1(ww[q]), acc[s * 16 + q * 4 + 1]);
          acc[s * 16 + q * 4 + 2] = fmaf(c, UB2(ww[q]), acc[s * 16 + q * 4 + 2]);
          acc[s * 16 + q * 4 + 3] = fmaf(c, UB3(ww[q]), acc[s * 16 + q * 4 + 3]);
        }
      }
    }
    const float cs128 = 128.f * csum;
#pragma unroll
    for (int k = 0; k < 64; ++k) {
      acc[k] -= cs128;
      acc[k] += __shfl_xor(acc[k], 16);
      acc[k] += __shfl_xor(acc[k], 32);
    }
    float* hrow = p->out + (size_t)t * 1024;
    float hvv[16];
#pragma unroll
    for (int s = 0; s < 4; ++s) {
      if (s == g) {
        float* hp = hrow + s * 256 + l16 * 16;
#pragma unroll
        for (int q = 0; q < 4; ++q) {
          float4 h0 = *(float4*)(hp + q * 4);
          h0.x += acc[s * 16 + q * 4 + 0]; h0.y += acc[s * 16 + q * 4 + 1]; h0.z += acc[s * 16 + q * 4 + 2]; h0.w += acc[s * 16 + q * 4 + 3];
          *(float4*)(hp + q * 4) = h0;
          hvv[q * 4 + 0] = h0.x; hvv[q * 4 + 1] = h0.y; hvv[q * 4 + 2] = h0.z; hvv[q * 4 + 3] = h0.w;
        }
      }
    }
    float ss = 0.f;
#pragma unroll
    for (int k = 0; k < 16; ++k) ss += hvv[k] * hvv[k];
    ss = wave_sum(ss);
    const float scl = rsqrtf(ss * (1.f / 1024.f) + 1e-6f);
    {
      const int col = g * 256 + l16 * 16;
      unsigned o8[8];
#pragma unroll
      for (int q = 0; q < 4; ++q) {
        const float4 g0 = *(const float4*)(pn + col + q * 4);
        o8[q * 2] = pack2(hvv[q * 4 + 0] * scl * g0.x, hvv[q * 4 + 1] * scl * g0.y);
        o8[q * 2 + 1] = pack2(hvv[q * 4 + 2] * scl * g0.z, hvv[q * 4 + 3] * scl * g0.w);
      }
      *(uint4*)(act + col) = make_uint4(o8[0], o8[1], o8[2], o8[3]);
      *(uint4*)(act + col + 8) = make_uint4(o8[4], o8[5], o8[6], o8[7]);
    }
  }
}

DI void phase11(KP p, char* smem) {
  for (int tile = blockIdx.x; tile < 136 * 8; tile += gridDim.x) {
    const int mt = tile >> 3, nt = tile & 7;
    const int m0 = mt * 128, n0 = nt * 128;
    f32x16 acc[2][2];
    unsigned ppk[2][2][8];
    const float* pa = (m0 < TP) ? p->in[5] + (size_t)m0 * 256 : p->in[6] + (size_t)(m0 - TP) * 256;
    gemm128<true>(pa, 256, (const bf16_t*)(p->ws + OFF_PP) + (size_t)n0 * 256, 256, 256, acc, smem);
#pragma unroll
    for (int mi = 0; mi < 2; ++mi)
#pragma unroll
      for (int ni = 0; ni < 2; ++ni)
#pragma unroll
        for (int i = 0; i < 8; ++i) ppk[mi][ni][i] = pack2(acc[mi][ni][2 * i], acc[mi][ni][2 * i + 1]);
    gemm128<false>((const bf16_t*)(p->ws + OFF_ACT) + (size_t)m0 * 1024, 1024,
                   (const bf16_t*)(p->ws + OFF_PG) + (size_t)n0 * 1024, 1024, 1024, acc, smem);
    const int lane = tidx() & 63, w = tidx() >> 6;
    const int wm = w >> 1, wn = w & 1, r = lane & 31, h = lane >> 5;
#pragma unroll
    for (int mi = 0; mi < 2; ++mi)
#pragma unroll
      for (int ni = 0; ni < 2; ++ni)
#pragma unroll
        for (int i = 0; i < 16; ++i) {
          const float pp = (i & 1) ? hi2f(ppk[mi][ni][i >> 1]) : lo2f(ppk[mi][ni][i >> 1]);
          acc[mi][ni][i] = sigmoidf_(acc[mi][ni][i]) * pp;
        }
#pragma unroll
    for (int mi = 0; mi < 2; ++mi) {
#pragma unroll
      for (int ni = 0; ni < 2; ++ni)
#pragma unroll
        for (int i = 0; i < 16; ++i)
          acc[mi][ni][i] += p->out[(size_t)(m0 + wm * 64 + mi * 32 + crow(i, h)) * 1024 + n0 + wn * 64 + ni * 32 + r];
#pragma unroll
      for (int ni = 0; ni < 2; ++ni)
#pragma unroll
        for (int i = 0; i < 16; ++i)
          p->out[(size_t)(m0 + wm * 64 + mi * 32 + crow(i, h)) * 1024 + n0 + wn * 64 + ni * 32 + r] = acc[mi][ni][i];
    }
  }
}

DI void phase12(KP p) {
  const int lane = tidx() & 63, w = tidx() >> 6;
  const float* g = p->in[29];
  for (int t = blockIdx.x * 4 + w; t < T; t += gridDim.x * 4) {
    float* x = p->out + (size_t)t * 1024;
    float4 v[4];
    float ss = 0.f;
#pragma unroll
    for (int i = 0; i < 4; ++i) {
      v[i] = ((const float4*)x)[i * 64 + lane];
      ss += v[i].x * v[i].x + v[i].y * v[i].y + v[i].z * v[i].z + v[i].w * v[i].w;
    }
    ss = wave_sum(ss);
    const float sc = rsqrtf(ss * (1.f / 1024.f) + 1e-6f);
#pragma unroll
    for (int i = 0; i < 4; ++i) {
      const float4 gg = ((const float4*)g)[i * 64 + lane];
      ((float4*)x)[i * 64 + lane] = make_float4(v[i].x * sc * gg.x, v[i].y * sc * gg.y, v[i].z * sc * gg.z, v[i].w * sc * gg.w);
    }
  }
}

DI void run_phase(int ph, char* smem) {
  KP p = getp();
  switch (ph) {
    case 0: phase0(p, smem); break;
    case 1: phase1(p, smem); break;
    case 2: phase2(p); break;
    case 3: phase3(p, smem); break;
    case 4: phase4(p, smem); break;
    case 5: phase5(p); break;
    case 6: phase6(p, smem); break;
    case 7: phase7(p); break;
    case 8: phase8(p, smem); break;
    case 9: phase9(p, smem); break;
    case 10: phase10(p); break;
    case 11: phase11(p, smem); break;
    case 12: phase12(p); break;
    default: break;
  }
}

template <int LO, int HI>
__global__ void __launch_bounds__(256, 2) mega_kernel(Params p) {
  __shared__ __attribute__((aligned(16))) char smem[SMEM_BYTES];
  __shared__ uint4 xb_words;
  if (gridDim.x == 0x7fffffffu) cg::this_grid().sync();
  XcdBarrier xb;
  if (HI - LO > 1) {
    if (threadIdx.x == 0) xb_words = make_uint4(0u, 0u, 0u, 0u);
    __syncthreads();
    xb = xcd_barrier_post((unsigned*)(getp()->ws + OFF_CTR), (volatile LAS unsigned*)&xb_words);
  }
#pragma unroll
  for (int ph = LO; ph < HI; ++ph) {
    run_phase(ph, smem);
    if (ph + 1 < HI) xcd_barrier(xb);
  }
}

template <int PH>
static void launch_phases(const Params& p, int grid, hipStream_t stream) {
  hipLaunchKernelGGL((mega_kernel<PH, PH + 1>), dim3(grid), dim3(256), 0, stream, p);
  if constexpr (PH + 1 < 13) launch_phases<PH + 1>(p, grid, stream);
}

extern "C" void kernel_launch(void* const* d_in, const int* in_sizes, int n_in, void* d_out, int out_size,
                              void* d_ws, size_t ws_size, hipStream_t stream) {
  static int grid_blocks = 0;
  if (!grid_blocks) {
    int dev = 0, cus = 0, per_cu = 0;
    (void)hipGetDevice(&dev);
    (void)hipDeviceGetAttribute(&cus, hipDeviceAttributeMultiprocessorCount, dev);
#if MK_MULTI
    per_cu = 2;
#else
    (void)hipOccupancyMaxActiveBlocksPerMultiprocessor(&per_cu, mega_kernel<0, 13>, 256, 0);
#endif
    if (per_cu < 1) per_cu = 1;
    if (per_cu > 2) per_cu = 2;
    grid_blocks = cus * per_cu;
  }
  Params p{};
  for (int i = 0; i < 30; ++i) p.in[i] = (const float*)d_in[i];
  p.out = (float*)d_out;
  p.ws = (char*)d_ws;
  if (ws_size < WS_END) { fprintf(stderr, "workspace too small: %zu < %zu\n", ws_size, (size_t)WS_END); return; }
  (void)hipMemsetAsync((char*)d_ws + OFF_CTR, 0, 32768, stream);
#if MK_MULTI
  launch_phases<0>(p, grid_blocks, stream);
#else
  void* args[] = {&p};
  hipError_t e = hipLaunchCooperativeKernel((void*)mega_kernel<0, 13>, dim3(grid_blocks), dim3(256), args, 0, stream);
  if (e != hipSuccess) fprintf(stderr, "cooperative launch failed: %s (grid %d)\n", hipGetErrorString(e), grid_blocks);
#endif
}
```

```cpp
#include <hip/hip_runtime.h>
#include <hip/hip_cooperative_groups.h>
#include <cstdio>
namespace cg = cooperative_groups;

#ifndef MK_MULTI
#define MK_MULTI 0
#endif

typedef unsigned short bf16_t;
typedef __attribute__((ext_vector_type(8))) short bf16x8;
typedef __attribute__((ext_vector_type(16))) float f32x16;
typedef __attribute__((ext_vector_type(2))) __bf16 bf2_t;
typedef __attribute__((ext_vector_type(2))) float f2_t;
#define DI __device__ __forceinline__

constexpr int T = 17408, TP = 16384;
constexpr int NPH = 14;

constexpr size_t O_RETP = (size_t)T * 1024;
constexpr size_t O_WKVP = O_RETP + 262144;
constexpr size_t O_SHP = O_WKVP + 262144;
constexpr size_t O_RETS = O_SHP + 14336;
constexpr size_t O_WKVS = O_RETS + 4194304;
constexpr size_t O_SHS = O_WKVS + 4194304;

constexpr size_t OFF_WIN = 0;
constexpr size_t OFF_WOUT = OFF_WIN + (size_t)3840 * 1024 * 2;
constexpr size_t OFF_WQ = OFF_WOUT + (size_t)1024 * 1024 * 2;
constexpr size_t OFF_KEYS = OFF_WQ + (size_t)2048 * 1024 * 2;
constexpr size_t OFF_PG = OFF_KEYS + (size_t)16 * 128 * 128 * 2;
constexpr size_t OFF_PP = OFF_PG + (size_t)1024 * 1024 * 2;
constexpr size_t OFF_W2 = OFF_PP + (size_t)1024 * 256 * 2;
constexpr size_t OFF_A2 = OFF_W2 + (size_t)512 * 64 * 2;
constexpr size_t OFF_G2 = OFF_A2 + (size_t)512 * 64 * 2;
constexpr size_t OFF_ROPE = OFF_G2 + (size_t)512 * 128 * 2;
constexpr size_t OFF_CTR = OFF_ROPE + (size_t)2056 * 32 * 2 * 4;
constexpr size_t OFF_ACT = OFF_CTR + 32768;
constexpr size_t OFF_TAB = OFF_ACT + (size_t)T * 1024 * 2;
constexpr size_t OFF_PREP = OFF_TAB + (size_t)2 * 16384 * 1024 * 2;
constexpr size_t SZ512 = (size_t)T * 512 * 2;
constexpr size_t OFF_R = OFF_PREP;
constexpr size_t OFF_K = OFF_R + SZ512;
constexpr size_t OFF_V = OFF_K + SZ512;
constexpr size_t OFF_KK = OFF_V + SZ512;
constexpr size_t OFF_BB = OFF_KK + SZ512;
constexpr size_t OFF_GATE = OFF_BB + SZ512;
constexpr size_t OFF_EW = OFF_GATE + SZ512;
constexpr size_t OFF_LORA = OFF_EW + (size_t)T * 512 * 4;
constexpr size_t OFF_INVN = OFF_LORA + (size_t)T * 256 * 2;
constexpr size_t WS_END = OFF_INVN + (size_t)T * 8 * 4;
constexpr size_t OFF_QPEER = OFF_PREP;
constexpr size_t OFF_IDX = OFF_QPEER + (size_t)T * 2048 * 2;
constexpr size_t OFF_GSM = OFF_IDX + (size_t)T * 128 * 4;

constexpr int SMEM_BYTES = 79872;

struct Params {
  const float* in[30];
  float* out;
  char* ws;
};

typedef const __attribute__((address_space(4))) Params* KP;
__device__ __forceinline__ KP getp() {
  KP q = (KP)__builtin_amdgcn_kernarg_segment_ptr();
  asm volatile("" : "+s"(q));
  return q;
}
DI int tidx() { int t = threadIdx.x; asm volatile("" : "+v"(t)); return t; }
DI bf16_t f2bf(float x) { return __builtin_bit_cast(bf16_t, (__bf16)x); }
DI float bf2f(bf16_t b) { return __uint_as_float(((unsigned)b) << 16); }
DI unsigned pack2(float a, float b) { const f2_t v = {a, b}; return __builtin_bit_cast(unsigned, __builtin_convertvector(v, bf2_t)); }
DI float lo2f(unsigned u) { return __uint_as_float(u << 16); }
DI float hi2f(unsigned u) { return __uint_as_float(u & 0xffff0000u); }
DI int crow(int reg, int h) { return (reg & 3) + 8 * (reg >> 2) + 4 * h; }
DI float wave_sum(float v) {
#pragma unroll
  for (int o = 32; o >= 1; o >>= 1) v += __shfl_xor(v, o);
  return v;
}
DI float allreduce16(float v) {
  v += __int_as_float(__builtin_amdgcn_update_dpp(0, __float_as_int(v), 0x128, 0xf, 0xf, false));
  v += __int_as_float(__builtin_amdgcn_update_dpp(0, __float_as_int(v), 0x124, 0xf, 0xf, false));
  v += __int_as_float(__builtin_amdgcn_update_dpp(0, __float_as_int(v), 0x122, 0xf, 0xf, false));
  v += __int_as_float(__builtin_amdgcn_update_dpp(0, __float_as_int(v), 0x121, 0xf, 0xf, false));
  return v;
}
#define DPP_ADD(v, ctrl) v += __int_as_float(__builtin_amdgcn_update_dpp(0, __float_as_int(v), ctrl, 0xf, 0xf, false))
DI void allreduce16x2(float& a, float& b) {
  DPP_ADD(a, 0x128); DPP_ADD(b, 0x128);
  DPP_ADD(a, 0x124); DPP_ADD(b, 0x124);
  DPP_ADD(a, 0x122); DPP_ADD(b, 0x122);
  DPP_ADD(a, 0x121); DPP_ADD(b, 0x121);
}
DI float allreduce8(float v) {
  v += __int_as_float(__builtin_amdgcn_update_dpp(0, __float_as_int(v), 0xB1, 0xf, 0xf, false));
  v += __int_as_float(__builtin_amdgcn_update_dpp(0, __float_as_int(v), 0x4E, 0xf, 0xf, false));
  v += __int_as_float(__builtin_amdgcn_update_dpp(0, __float_as_int(v), 0x141, 0xf, 0xf, false));
  return v;
}
DI void unpack8f(const uint4& u, float (&f)[8]) {
  f[0] = lo2f(u.x); f[1] = hi2f(u.x); f[2] = lo2f(u.y); f[3] = hi2f(u.y);
  f[4] = lo2f(u.z); f[5] = hi2f(u.z); f[6] = lo2f(u.w); f[7] = hi2f(u.w);
}
DI uint4 pack8f(const float (&f)[8]) {
  return make_uint4(pack2(f[0], f[1]), pack2(f[2], f[3]), pack2(f[4], f[5]), pack2(f[6], f[7]));
}
DI float sigmoidf_(float x) { return __builtin_amdgcn_rcpf(1.f + __expf(-x)); }
DI const float* xrow(KP p, int t) {
  return t < TP ? p->in[0] + (size_t)t * 1024 : p->in[1] + (size_t)(t - TP) * 1024;
}
struct TokInfo { int sample, b, l; };
DI TokInfo tokinfo(int t) {
  TokInfo ti;
  if (t >= TP) { ti.sample = 1; ti.b = (t - TP) >> 3; ti.l = (t - TP) & 7; }
  else { ti.sample = 0; ti.b = t >> 11; ti.l = t & 2047; }
  return ti;
}

#define XB_TMO      128
#define XB_XCNT(j)  (256  + 64 * (j))
#define XB_XSUB(j)  (1280 + 64 * (j))
#define XB_XGEN(j)  (2304 + 64 * (j))
#define XB_TOP      3328
#define XB_TOPGEN   3392
#define XCD_BAR_WORDS 3456
#define XB_SPIN_CAP (1u << 20)
#define LAS __attribute__((address_space(3)))
DI unsigned xb_ld(unsigned* p) { return __hip_atomic_load(p, __ATOMIC_RELAXED, __HIP_MEMORY_SCOPE_AGENT); }
DI unsigned xb_add(unsigned* p, unsigned v) { return __hip_atomic_fetch_add(p, v, __ATOMIC_RELAXED, __HIP_MEMORY_SCOPE_AGENT); }
DI unsigned xb_xcc_id() { return (unsigned)__builtin_amdgcn_s_getreg((3 << 11) | 20) & 0xFu; }
#define XB_SPIN(cond, bar) do { unsigned _sp = 0; while (cond) { __builtin_amdgcn_s_sleep(1); \
    if ((++_sp & 255u) == 0u) { if (xb_ld(&(bar)[XB_TMO])) break; if (_sp > XB_SPIN_CAP) { atomicAdd(&(bar)[XB_TMO], 1u); break; } } } } while (0)
struct XcdBarrier { unsigned* bar; unsigned x; volatile LAS unsigned* st; };
DI XcdBarrier xcd_barrier_post(unsigned* bar, volatile LAS unsigned* st) {
  XcdBarrier b; b.bar = bar; b.x = xb_xcc_id(); b.st = st;
  if (threadIdx.x == 0) (void)xb_add(&bar[XB_XCNT(b.x)], 1u);
  return b;
}
DI void xcd_barrier_complete(unsigned* bar, unsigned x, unsigned& nloc, unsigned& nx) {
  const unsigned G = gridDim.x * gridDim.y * gridDim.z;
  unsigned sum, cnt, mine, sp = 0u;
  for (;;) {
    sum = 0u; cnt = 0u; mine = 0u;
#pragma unroll
    for (unsigned j = 0; j < 16; ++j) { const unsigned c = xb_ld(&bar[XB_XCNT(j)]); sum += c; cnt += (c > 0u) ? 1u : 0u; mine = (j == x) ? c : mine; }
    if (sum == G) break;
    __builtin_amdgcn_s_sleep(1);
    if ((++sp & 255u) == 0u) { if (xb_ld(&bar[XB_TMO])) break; if (sp > XB_SPIN_CAP) { atomicAdd(&bar[XB_TMO], 1u); break; } }
  }
  nloc = mine > 0u ? mine : 1u; nx = cnt > 0u ? cnt : 1u;
}
DI void xcd_barrier(const XcdBarrier& b) {
  asm volatile("s_waitcnt vmcnt(0)" ::: "memory");
  __syncthreads();
  if (threadIdx.x == 0) {
    unsigned* bar = b.bar;
    __builtin_amdgcn_s_waitcnt(0);
    unsigned nloc = b.st[0], nx = b.st[1];
    if (nloc == 0u) { xcd_barrier_complete(bar, b.x, nloc, nx); b.st[0] = nloc; b.st[1] = nx; }
    const unsigned old = xb_add(&bar[XB_XSUB(b.x)], 1u);
    const unsigned gen = old / nloc;
    if (old + 1u == (gen + 1u) * nloc) {
      __builtin_amdgcn_fence(__ATOMIC_RELEASE, "agent");
      asm volatile("s_waitcnt vmcnt(0)" ::: "memory");
      const unsigned og = xb_add(&bar[XB_TOP], 1u);
      const unsigned tg = og / nx;
      if (og + 1u == (tg + 1u) * nx) xb_add(&bar[XB_TOPGEN], 1u);
      else XB_SPIN(xb_ld(&bar[XB_TOPGEN]) == tg, bar);
      __builtin_amdgcn_fence(__ATOMIC_ACQUIRE, "agent");
      xb_add(&bar[XB_XGEN(b.x)], 1u);
      asm volatile("s_waitcnt vmcnt(0)" ::: "memory");
    } else {
      XB_SPIN(xb_ld(&bar[XB_XGEN(b.x)]) == gen, bar);
      __builtin_amdgcn_fence(__ATOMIC_ACQUIRE, "agent");
      asm volatile("s_waitcnt vmcnt(0)" ::: "memory");
    }
  }
  __syncthreads();
}

constexpr int LDT = 72;
constexpr int GBUF = 2 * 128 * LDT;
template <bool AF32>
DI void gemm128(const void* __restrict__ Ap, int lda, const bf16_t* __restrict__ Bt, int ldb, int K,
                f32x16 (&acc)[2][2], char* smem) {
  bf16_t* S0 = (bf16_t*)smem;
  const int tid = tidx(), lane = tid & 63, w = tid >> 6;
  const int wm = w >> 1, wn = w & 1, r = lane & 31, h = lane >> 5;
  const int lrow = tid >> 3, lch = tid & 7;
#pragma unroll
  for (int i = 0; i < 2; ++i)
#pragma unroll
    for (int j = 0; j < 2; ++j)
#pragma unroll
      for (int e = 0; e < 16; ++e) acc[i][j][e] = 0.f;
  uint4 ra0, ra1, ra2, ra3, rb0, rb1, rb2, rb3;
  const bf16_t* Ab = (const bf16_t*)Ap + (size_t)lrow * lda + lch * 8;
  const float* Af = (const float*)Ap + (size_t)lrow * lda + lch * 8;
  const bf16_t* Bb = Bt + (size_t)lrow * ldb + lch * 8;
  const size_t a32 = (size_t)32 * lda, b32 = (size_t)32 * ldb;
#define GEMM_LDA(dst, q, k0)                                                                          \
  if constexpr (AF32) {                                                                               \
    const float4 f0 = *(const float4*)(Af + (q) * a32 + (k0));                                        \
    const float4 f1 = *(const float4*)(Af + (q) * a32 + (k0) + 4);                                    \
    dst = make_uint4(pack2(f0.x, f0.y), pack2(f0.z, f0.w), pack2(f1.x, f1.y), pack2(f1.z, f1.w));     \
  } else {                                                                                            \
    dst = *(const uint4*)(Ab + (q) * a32 + (k0));                                                     \
  }
#define GEMM_LOADG(k0)                                                                                \
  {                                                                                                   \
    GEMM_LDA(ra0, 0, k0) GEMM_LDA(ra1, 1, k0) GEMM_LDA(ra2, 2, k0) GEMM_LDA(ra3, 3, k0)               \
    rb0 = *(const uint4*)(Bb + (k0));                                                                 \
    rb1 = *(const uint4*)(Bb + b32 + (k0));                                                           \
    rb2 = *(const uint4*)(Bb + 2 * b32 + (k0));                                                       \
    rb3 = *(const uint4*)(Bb + 3 * b32 + (k0));                                                       \
  }
#define GEMM_STORE(buf)                                                                               \
  {                                                                                                   \
    bf16_t* ad = S0 + (buf) * GBUF + lrow * LDT + lch * 8;                                            \
    bf16_t* bd = ad + 128 * LDT;                                                                      \
    *(uint4*)(ad) = ra0; *(uint4*)(ad + 32 * LDT) = ra1; *(uint4*)(ad + 64 * LDT) = ra2; *(uint4*)(ad + 96 * LDT) = ra3; \
    *(uint4*)(bd) = rb0; *(uint4*)(bd + 32 * LDT) = rb1; *(uint4*)(bd + 64 * LDT) = rb2; *(uint4*)(bd + 96 * LDT) = rb3; \
  }
  const int nk = K >> 6;
  GEMM_LOADG(0)
  GEMM_STORE(0)
  if (nk > 1) GEMM_LOADG(64)
  __syncthreads();
  for (int kt = 0; kt < nk; ++kt) {
    if (kt + 1 < nk) GEMM_STORE((kt + 1) & 1)
    if (kt + 2 < nk) GEMM_LOADG((kt + 2) << 6)
    __builtin_amdgcn_sched_barrier(0);
    const bf16_t* As = S0 + (kt & 1) * GBUF;
    const bf16_t* Bs = As + 128 * LDT;
#pragma unroll
    for (int ks = 0; ks < 4; ++ks) {
      bf16x8 a0 = *(const bf16x8*)(As + (wm * 64 + r) * LDT + ks * 16 + h * 8);
      bf16x8 a1 = *(const bf16x8*)(As + (wm * 64 + 32 + r) * LDT + ks * 16 + h * 8);
      bf16x8 b0 = *(const bf16x8*)(Bs + (wn * 64 + r) * LDT + ks * 16 + h * 8);
      bf16x8 b1 = *(const bf16x8*)(Bs + (wn * 64 + 32 + r) * LDT + ks * 16 + h * 8);
      acc[0][0] = __builtin_amdgcn_mfma_f32_32x32x16_bf16(a0, b0, acc[0][0], 0, 0, 0);
      acc[0][1] = __builtin_amdgcn_mfma_f32_32x32x16_bf16(a0, b1, acc[0][1], 0, 0, 0);
      acc[1][0] = __builtin_amdgcn_mfma_f32_32x32x16_bf16(a1, b0, acc[1][0], 0, 0, 0);
      acc[1][1] = __builtin_amdgcn_mfma_f32_32x32x16_bf16(a1, b1, acc[1][1], 0, 0, 0);
    }
    __syncthreads();
  }
}
template <class F>
DI void epi_each(f32x16 (&acc)[2][2], F f) {
  const int lane = tidx() & 63, w = tidx() >> 6;
  const int wm = w >> 1, wn = w & 1, r = lane & 31, h = lane >> 5;
#pragma unroll
  for (int mi = 0; mi < 2; ++mi)
#pragma unroll
    for (int ni = 0; ni < 2; ++ni)
#pragma unroll
      for (int i = 0; i < 16; ++i) f(wm * 64 + mi * 32 + crow(i, h), wn * 64 + ni * 32 + r, acc[mi][ni][i]);
}

DI void transpose_tile(const float* __restrict__ src, bf16_t* __restrict__ dst, int K, int N, int kt, int nt, float* sm) {
  const int tid = tidx();
  const int k0 = kt * 64, n0 = nt * 64;
#pragma unroll
  for (int i = 0; i < 16; ++i) {
    int k = i * 4 + (tid >> 6), n = tid & 63;
    sm[k * 65 + n] = src[(size_t)(k0 + k) * N + n0 + n];
  }
  __syncthreads();
  int n = tid >> 2, ks = (tid & 3) * 16;
  unsigned pk[8];
#pragma unroll
  for (int j = 0; j < 8; ++j) pk[j] = pack2(sm[(ks + 2 * j) * 65 + n], sm[(ks + 2 * j + 1) * 65 + n]);
  uint4* d = (uint4*)(dst + (size_t)(n0 + n) * K + k0 + ks);
  d[0] = make_uint4(pk[0], pk[1], pk[2], pk[3]);
  d[1] = make_uint4(pk[4], pk[5], pk[6], pk[7]);
  __syncthreads();
}
DI void rmsnorm_row_bf(const float* __restrict__ x, const float* __restrict__ g, bf16_t* __restrict__ o, int lane) {
  float4 v[4];
  float ss = 0.f;
#pragma unroll
  for (int i = 0; i < 4; ++i) {
    v[i] = ((const float4*)x)[i * 64 + lane];
    ss += v[i].x * v[i].x + v[i].y * v[i].y + v[i].z * v[i].z + v[i].w * v[i].w;
  }
  ss = wave_sum(ss);
  float sc = rsqrtf(ss * (1.f / 1024.f) + 1e-6f);
#pragma unroll
  for (int i = 0; i < 4; ++i) {
    float4 gg = ((const float4*)g)[i * 64 + lane];
    uint2 pk = make_uint2(pack2(v[i].x * sc * gg.x, v[i].y * sc * gg.y), pack2(v[i].z * sc * gg.z, v[i].w * sc * gg.w));
    ((uint2*)o)[i * 64 + lane] = pk;
  }
}

#define TJ(IDX, OFF, KK_, NN_)                                                                             \
  {                                                                                                        \
    const int ntl = ((KK_) / 64) * ((NN_) / 64);                                                           \
    if (it < ntl) {                                                                                        \
      transpose_tile(p->in[IDX], (bf16_t*)(p->ws + (OFF)), (KK_), (NN_), it / ((NN_) / 64), it % ((NN_) / 64), (float*)smem); \
      continue;                                                                                            \
    }                                                                                                      \
    it -= ntl;                                                                                             \
  }

DI void phase0(KP p, char* smem) {
  const int tid = tidx(), lane = tid & 63, w = tid >> 6;
  constexpr int N_TR = 960 + 8 + 8 + 16;
  constexpr int N_KEYS = 128, N_ROPE = 257, N_NORM = T / 4;
  for (int item = blockIdx.x; item < N_TR + N_KEYS + N_ROPE + N_NORM; item += gridDim.x) {
    int it = item;
    TJ(8, OFF_WIN, 1024, 3840)
    TJ(11, OFF_W2, 64, 512)
    TJ(13, OFF_A2, 64, 512)
    TJ(14, OFF_G2, 128, 512)
    if (it < N_KEYS) {
      const float* src = p->in[23] + (size_t)it * 2048 + tid * 8;
      float4 f0 = *(const float4*)src, f1 = *(const float4*)(src + 4);
      *(uint4*)((bf16_t*)(p->ws + OFF_KEYS) + (size_t)it * 2048 + tid * 8) =
          make_uint4(pack2(f0.x, f0.y), pack2(f0.z, f0.w), pack2(f1.x, f1.y), pack2(f1.z, f1.w));
      continue;
    }
    it -= N_KEYS;
    if (it < N_ROPE) {
      int e = it * 256 + tid;
      int pidx = e >> 5, f = e & 31;
      if (pidx < 2056) {
        const float pos = (pidx < 2048) ? (float)pidx : (float)(16384 + pidx - 2048);
        const float inv = exp2f(-(float)f * 0.41524101186092f);
        const float ang = pos * inv;
        const float kq = rintf(ang * 0.15915494309189535f);
        float rr = fmaf(-kq, 6.28125f, ang);
        rr = fmaf(-kq, 1.9353071795864769e-3f, rr);
        float* rt = (float*)(p->ws + OFF_ROPE);
        rt[e * 2] = cosf(rr);
        rt[e * 2 + 1] = sinf(rr);
      }
      continue;
    }
    it -= N_ROPE;
    {
      int t = it * 4 + w;
      rmsnorm_row_bf(xrow(p, t), p->in[7], (bf16_t*)(p->ws + OFF_ACT) + (size_t)t * 1024, lane);
    }
  }
}

DI void phase1(KP p, char* smem) {
  const int lane = tidx() & 63, w = tidx() >> 6;
  const int wm = w >> 1, wn = w & 1, r = lane & 31, h = lane >> 5;
  bf16_t* RET = (bf16_t*)p->out;
  bf16_t* RWP = (bf16_t*)(p->ws + OFF_TAB);
  const float2* rope = (const float2*)(p->ws + OFF_ROPE);
  for (int tile = blockIdx.x; tile < 136 * 30; tile += gridDim.x) {
    const int mt = tile / 30, nt = tile % 30;
    const int m0 = mt * 128, n0 = nt * 128;
    f32x16 acc[2][2];
    gemm128<false>((const bf16_t*)(p->ws + OFF_ACT) + (size_t)m0 * 1024, 1024,
                   (const bf16_t*)(p->ws + OFF_WIN) + (size_t)n0 * 1024, 1024, 1024, acc, smem);
    const int nb = n0 + wn * 64;
    if (nb < 1024) {
      float2 cs[2][16];
#pragma unroll
      for (int mi = 0; mi < 2; ++mi)
#pragma unroll
        for (int i = 0; i < 16; ++i) {
          const TokInfo ti = tokinfo(m0 + wm * 64 + mi * 32 + crow(i, h));
          cs[mi][i] = rope[(ti.sample ? 2048 + ti.l : ti.l) * 32 + r];
        }
      const float scl = (nb >= 512) ? 0.125f : 1.f;
#pragma unroll
      for (int mi = 0; mi < 2; ++mi)
#pragma unroll
        for (int i = 0; i < 16; ++i) {
          const float v0 = acc[mi][0][i], v1 = acc[mi][1][i];
          acc[mi][0][i] = (v0 * cs[mi][i].x - v1 * cs[mi][i].y) * scl;
          acc[mi][1][i] = (v1 * cs[mi][i].x + v0 * cs[mi][i].y) * scl;
        }
    }
#pragma unroll
    for (int mi = 0; mi < 2; ++mi)
#pragma unroll
      for (int i = 0; i < 16; ++i) {
        const int t = m0 + wm * 64 + mi * 32 + crow(i, h);
        const float v0 = acc[mi][0][i], v1 = acc[mi][1][i];
        if (nb < 2048) {
          RET[(size_t)t * 2048 + nb + r] = f2bf(v0);
          RET[(size_t)t * 2048 + nb + 32 + r] = f2bf(v1);
        } else {
          const TokInfo ti = tokinfo(t);
          const int c = nb - 2048 + r;
          RWP[(size_t)t * 1792 + c] = f2bf(v0);
          RWP[(size_t)t * 1792 + c + 32] = f2bf(v1);
          if (ti.sample) {
            if (ti.l == 7) { p->out[O_SHS + ti.b * 1792 + c] = v0; p->out[O_SHS + ti.b * 1792 + c + 32] = v1; }
          } else {
            if (ti.l == 2047) { p->out[O_SHP + ti.b * 1792 + c] = v0; p->out[O_SHP + ti.b * 1792 + c + 32] = v1; }
          }
        }
      }
  }
}

DI void phase2(KP p) {
  const int lane = tidx() & 63, w = tidx() >> 6;
  const bf16_t* RWP = (const bf16_t*)(p->ws + OFF_TAB);
  bf16_t* Rb = (bf16_t*)(p->ws + OFF_R);
  bf16_t* Kb = (bf16_t*)(p->ws + OFF_K);
  bf16_t* Vb = (bf16_t*)(p->ws + OFF_V);
  bf16_t* LA = (bf16_t*)(p->ws + OFF_LORA);
  float* INVN = (float*)(p->ws + OFF_INVN);
  const float* mu = p->in[9];
  const float* kkw = p->in[15];
  for (int t = blockIdx.x * 4 + w; t < T; t += gridDim.x * 4) {
    const TokInfo ti = tokinfo(t);
    const bf16_t* cur = RWP + (size_t)t * 1792;
    const bf16_t* prv = cur - 1792;
    const float* sh = p->in[4] + (size_t)ti.b * 1792;
    float f[4][8];
#pragma unroll
    for (int i = 0; i < 4; ++i) {
      const int c8 = (lane + 64 * i) * 8;
      if (i < 3 || lane < 32) {
        float cv[8], pv[8];
        unpack8f(*(const uint4*)(cur + c8), cv);
        if (ti.l > 0) unpack8f(*(const uint4*)(prv + c8), pv);
        else if (ti.sample) {
          const float4 s0 = *(const float4*)(sh + c8), s1 = *(const float4*)(sh + c8 + 4);
          pv[0] = s0.x; pv[1] = s0.y; pv[2] = s0.z; pv[3] = s0.w; pv[4] = s1.x; pv[5] = s1.y; pv[6] = s1.z; pv[7] = s1.w;
        } else {
#pragma unroll
          for (int k = 0; k < 8; ++k) pv[k] = 0.f;
        }
        const float4 m0 = *(const float4*)(mu + c8), m1 = *(const float4*)(mu + c8 + 4);
        const float mm[8] = {m0.x, m0.y, m0.z, m0.w, m1.x, m1.y, m1.z, m1.w};
#pragma unroll
        for (int k = 0; k < 8; ++k) f[i][k] = cv[k] + (pv[k] - cv[k]) * mm[k];
      } else {
#pragma unroll
        for (int k = 0; k < 8; ++k) f[i][k] = 0.f;
      }
    }
    *(uint4*)(Rb + (size_t)t * 512 + lane * 8) = pack8f(f[0]);
    {
      const uint4 kb = pack8f(f[1]);
      *(uint4*)(Kb + (size_t)t * 512 + lane * 8) = kb;
      float kr[8];
      unpack8f(kb, kr);
      const float4 q0 = *(const float4*)(kkw + lane * 8), q1 = *(const float4*)(kkw + lane * 8 + 4);
      const float qq[8] = {q0.x, q0.y, q0.z, q0.w, q1.x, q1.y, q1.z, q1.w};
      float ss = 0.f;
#pragma unroll
      for (int k = 0; k < 8; ++k) { const float kq = kr[k] * qq[k]; ss += kq * kq; }
      ss = allreduce8(ss);
      if ((lane & 7) == 0) INVN[t * 8 + (lane >> 3)] = 1.f / fmaxf(sqrtf(ss), 1e-12f);
    }
    *(uint4*)(Vb + (size_t)t * 512 + lane * 8) = pack8f(f[2]);
    if (lane < 32) {
      float o[8];
#pragma unroll
      for (int k = 0; k < 8; ++k) {
        const float x = f[3][k];
        o[k] = (lane < 8) ? (1.f - 2.f * __builtin_amdgcn_rcpf(1.f + __expf(2.f * x))) : ((lane < 16) ? x : sigmoidf_(x));
      }
      *(uint4*)(LA + (size_t)t * 256 + lane * 8) = pack8f(o);
    }
  }
}

DI void phase3(KP p, char* smem) {
  const bf16_t* LA = (const bf16_t*)(p->ws + OFF_LORA);
  bf16_t* Kb = (bf16_t*)(p->ws + OFF_K);
  bf16_t* KKb = (bf16_t*)(p->ws + OFF_KK);
  bf16_t* BBb = (bf16_t*)(p->ws + OFF_BB);
  bf16_t* GTb = (bf16_t*)(p->ws + OFF_GATE);
  float* EW = (float*)(p->ws + OFF_EW);
  const float* INVN = (const float*)(p->ws + OFF_INVN);
  const float* w0 = p->in[10];
  const float* a0 = p->in[12];
  const float* kkw = p->in[15];
  const float* kaw = p->in[16];
  for (int item = blockIdx.x; item < 136 * 12; item += gridDim.x) {
    const int mt = item / 12, rem = item % 12, kind = rem >> 2, nt = rem & 3;
    const int m0 = mt * 128, n0 = nt * 128;
    f32x16 acc[2][2];
    if (kind == 0) {
      gemm128<false>(LA + (size_t)m0 * 256, 256, (const bf16_t*)(p->ws + OFF_W2) + n0 * 64, 64, 64, acc, smem);
      epi_each(acc, [&](int rr, int cc, float v) {
        const int t = m0 + rr, c = n0 + cc;
        const float x = v + w0[c];
        const float z = -x;
        const float sp = fmaxf(z, 0.f) + __logf(1.f + __expf(-fabsf(z)));
        const float ww = -sp - 0.5f;
        EW[(size_t)t * 512 + c] = __expf(-__expf(ww));
      });
    } else if (kind == 1) {
      gemm128<false>(LA + (size_t)m0 * 256 + 64, 256, (const bf16_t*)(p->ws + OFF_A2) + n0 * 64, 64, 64, acc, smem);
      {
        const int lane = tidx() & 63, w = tidx() >> 6;
        const int wm = w >> 1, wn = w & 1, r = lane & 31, h = lane >> 5;
#pragma unroll 1
        for (int mi = 0; mi < 2; ++mi) {
          const int tb = m0 + wm * 64 + mi * 32;
          float inv[16];
#pragma unroll
          for (int i = 0; i < 16; ++i) inv[i] = INVN[(tb + crow(i, h)) * 8 + ((n0 + wn * 64) >> 6)];
#pragma unroll
          for (int ni = 0; ni < 2; ++ni) {
            const int c = n0 + wn * 64 + ni * 32 + r;
            const float a0c = a0[c], kkc = kkw[c], kac = kaw[c];
            float k7v[16];
#pragma unroll
            for (int i = 0; i < 16; ++i) k7v[i] = bf2f(Kb[(size_t)(tb + crow(i, h)) * 512 + c]);
#pragma unroll
            for (int i = 0; i < 16; ++i) {
              const float av = (mi == 0) ? acc[0][ni][i] : acc[1][ni][i];
              const float a = sigmoidf_(av + a0c);
              const size_t o = (size_t)(tb + crow(i, h)) * 512 + c;
              const float kkv = k7v[i] * kkc * inv[i];
              Kb[o] = f2bf(k7v[i] * (1.f + (a - 1.f) * kac));
              KKb[o] = f2bf(kkv);
              BBb[o] = f2bf(kkv * a);
            }
          }
        }
      }
    } else {
      gemm128<false>(LA + (size_t)m0 * 256 + 128, 256, (const bf16_t*)(p->ws + OFF_G2) + n0 * 128, 128, 128, acc, smem);
      epi_each(acc, [&](int rr, int cc, float v) { GTb[(size_t)(m0 + rr) * 512 + n0 + cc] = f2bf(v); });
    }
  }
}

DI void rwkv_scan(KP p, int tok0, int hd, int q, int nsteps, const float* __restrict__ S0, float* __restrict__ Sout, char* smem) {
  const int tid = tidx(), lane = tid & 63, w = tid >> 6, g = lane >> 4, l16 = lane & 15;
  const int rl = w * 4 + g;
  const int row = q * 16 + rl;
  const int j0 = l16 * 4;
  const bf16_t* Rb = (const bf16_t*)(p->ws + OFF_R);
  const bf16_t* Kb = (const bf16_t*)(p->ws + OFF_K);
  const bf16_t* Vb = (const bf16_t*)(p->ws + OFF_V);
  const bf16_t* KKb = (const bf16_t*)(p->ws + OFF_KK);
  const bf16_t* BBb = (const bf16_t*)(p->ws + OFF_BB);
  const float* EW = (const float*)(p->ws + OFF_EW);
  bf16_t* ACT = (bf16_t*)(p->ws + OFF_ACT);
  float* ew_s = (float*)smem;
  float* kk_s = ew_s + 2048;
  float* bb_s = kk_s + 2048;
  float* kp_s = bb_s + 2048;
  float* r_s = kp_s + 2048;
  float* v_s = r_s + 2048;
  float* y_s = v_s + 512;
  f2_t s01 = (f2_t){0.f, 0.f}, s23 = (f2_t){0.f, 0.f};
  if (S0) { const float4 t4 = *(const float4*)(S0 + row * 64 + j0); s01 = (f2_t){t4.x, t4.y}; s23 = (f2_t){t4.z, t4.w}; }
  uint4 rg_r = make_uint4(0, 0, 0, 0), rg_k = rg_r, rg_kk = rg_r, rg_bb = rg_r, rg_v = rg_r;
  float4 rg_e0 = make_float4(0, 0, 0, 0), rg_e1 = rg_e0;
  const int st_l = tid >> 3, c8 = (tid & 7) * 8;
  auto gload = [&](int sb) {
    if (sb + st_l < nsteps) {
      const size_t o = (size_t)(tok0 + sb + st_l) * 512 + hd * 64 + c8;
      rg_r = *(const uint4*)(Rb + o);
      rg_k = *(const uint4*)(Kb + o);
      rg_kk = *(const uint4*)(KKb + o);
      rg_bb = *(const uint4*)(BBb + o);
      rg_e0 = *(const float4*)(EW + o);
      rg_e1 = *(const float4*)(EW + o + 4);
    }
    if (tid < 64) {
      const int sv = tid >> 1;
      if (sb + sv < nsteps) rg_v = *(const uint4*)(Vb + (size_t)(tok0 + sb + sv) * 512 + hd * 64 + q * 16 + (tid & 1) * 8);
    }
  };
  auto unpack8 = [&](float* d, const uint4& u) {
    *(float4*)d = make_float4(lo2f(u.x), hi2f(u.x), lo2f(u.y), hi2f(u.y));
    *(float4*)(d + 4) = make_float4(lo2f(u.z), hi2f(u.z), lo2f(u.w), hi2f(u.w));
  };
  auto sstore = [&]() {
    const int o = st_l * 64 + c8;
    unpack8(r_s + o, rg_r);
    unpack8(kp_s + o, rg_k);
    unpack8(kk_s + o, rg_kk);
    unpack8(bb_s + o, rg_bb);
    *(float4*)(ew_s + o) = rg_e0;
    *(float4*)(ew_s + o + 4) = rg_e1;
    if (tid < 64) unpack8(v_s + (tid >> 1) * 16 + (tid & 1) * 8, rg_v);
  };
  gload(0);
  for (int sb = 0; sb < nsteps; sb += 32) {
    __syncthreads();
    sstore();
    __syncthreads();
    if (sb + 32 < nsteps) gload(sb + 32);
    const int tc = min(32, nsteps - sb);
#define SC_LD(X, st)                                              \
  {                                                               \
    const float* b_ = ew_s + (st) * 64 + j0;                      \
    X##e = *(const float4*)(b_);                                  \
    X##q = *(const float4*)(b_ + 2048);                           \
    X##b = *(const float4*)(b_ + 4096);                           \
    X##k = *(const float4*)(b_ + 6144);                           \
    X##r = *(const float4*)(b_ + 8192);                           \
    X##v = v_s[(st) * 16 + rl];                                   \
  }
#define SC_STEP(X, st)                                                                     \
  {                                                                                        \
    const f2_t p2 = s01 * (f2_t){X##q.x, X##q.y} + s23 * (f2_t){X##q.z, X##q.w};           \
    float pdp = p2.x + p2.y;                                                               \
      \
    const f2_t vk01 = (f2_t){X##k.x, X##k.y} * X##v, vk23 = (f2_t){X##k.z, X##k.w} * X##v; \
    const f2_t base01 = s01 * (f2_t){X##e.x, X##e.y} + vk01;                               \
    const f2_t base23 = s23 * (f2_t){X##e.z, X##e.w} + vk23;                               \
    allreduce16x2(pdp, ypart);     \
    if (l16 == 0 && (st) > 0) y_s[((st) - 1) * 16 + rl] = ypart;                           \
    s01 = base01 - (f2_t){X##b.x, X##b.y} * pdp;                              \
    s23 = base23 - (f2_t){X##b.z, X##b.w} * pdp;                                           \
    const f2_t y2 = s01 * (f2_t){X##r.x, X##r.y} + s23 * (f2_t){X##r.z, X##r.w};           \
    ypart = y2.x + y2.y;                                                                   \
  }
    {
      float4 Ae, Aq, Ab, Ak, Ar, Be, Bq, Bb, Bk, Br;
      float Av, Bv;
      float ypart = 0.f;
      SC_LD(A, 0)
      for (int st = 0; st < tc; st += 2) {
        SC_LD(B, st + 1)
        SC_STEP(A, st)
        SC_LD(A, min(st + 2, tc - 1))
        SC_STEP(B, st + 1)
      }
      ypart = allreduce16(ypart);
      if (l16 == 0) y_s[(tc - 1) * 16 + rl] = ypart;
    }
    __syncthreads();
    if (tid < tc * 8) {
      const int st = tid >> 3, pr = tid & 7;
      const unsigned pk = pack2(y_s[st * 16 + 2 * pr], y_s[st * 16 + 2 * pr + 1]);
      *(unsigned*)(ACT + (size_t)(tok0 + sb + st) * 1024 + 512 + hd * 64 + q * 16 + 2 * pr) = pk;
    }
  }
  *(float4*)(Sout + row * 64 + j0) = make_float4(s01.x, s01.y, s23.x, s23.y);
}

constexpr int RL = 136;
DI void ret_prompt(KP p, int b, int hd, char* smem) {
  const int tid = tidx(), lane = tid & 63, w = tid >> 6, r = lane & 31, h = lane >> 5;
  const bf16_t* RET = (const bf16_t*)p->out;
  bf16_t* ACT = (bf16_t*)(p->ws + OFF_ACT);
  bf16_t* Vt = (bf16_t*)smem;
  bf16_t* Kzt = (bf16_t*)(smem + 17408);
  bf16_t* St = (bf16_t*)(smem + 34816);
  bf16_t* Sc = (bf16_t*)(smem + 44032);
  float* Of = (float*)(smem + 44032);
  float* dec = (float*)(smem + 78848);
  const float lg = log1pf(-exp2f(-5.f - (float)hd));
  if (tid < 129) dec[tid] = expf((float)tid * lg);
  for (int e = tid; e < 64 * 72; e += 256) St[e] = 0;
  __syncthreads();
  const float g128 = dec[128];
  f32x16 Sacc;
#pragma unroll
  for (int e = 0; e < 16; ++e) Sacc[e] = 0.f;
  const int vt = w >> 1, dt = w & 1;
  for (int c = 0; c < 16; ++c) {
    const int tokc = b * 2048 + c * 128;
    {
      const int j = tid >> 1, hf = tid & 1;
      const bf16_t* vsrc = RET + (size_t)(tokc + j) * 2048 + 1024 + hd * 64 + hf * 32;
      const bf16_t* ksrc = RET + (size_t)(tokc + j) * 2048 + 512 + hd * 64 + hf * 32;
      const float zj = dec[127 - j];
#pragma unroll
      for (int qd = 0; qd < 4; ++qd) {
        const uint4 uv = *(const uint4*)(vsrc + qd * 8);
        const uint4 uk = *(const uint4*)(ksrc + qd * 8);
        const unsigned vv[4] = {uv.x, uv.y, uv.z, uv.w};
        const unsigned kk[4] = {uk.x, uk.y, uk.z, uk.w};
#pragma unroll
        for (int e = 0; e < 4; ++e) {
          const int col = hf * 32 + qd * 8 + e * 2;
          Vt[col * RL + j] = (bf16_t)(vv[e] & 0xffffu);
          Vt[(col + 1) * RL + j] = (bf16_t)(vv[e] >> 16);
          Kzt[col * RL + j] = f2bf(lo2f(kk[e]) * zj);
          Kzt[(col + 1) * RL + j] = f2bf(hi2f(kk[e]) * zj);
        }
      }
    }
    bf16x8 qf[4];
    {
      const bf16_t* qsrc = RET + (size_t)(tokc + 32 * w + r) * 2048 + hd * 64 + h * 8;
#pragma unroll
      for (int ks = 0; ks < 4; ++ks) qf[ks] = *(const bf16x8*)(qsrc + ks * 16);
    }
#pragma unroll
    for (int jb = 0; jb < 2; ++jb) {
      bf16x8 kf[2][4];
#pragma unroll
      for (int jj = 0; jj < 2; ++jj) {
        const int jt = jb * 2 + jj;
        if (jt <= w) {
          const bf16_t* ksrc = RET + (size_t)(tokc + 32 * jt + r) * 2048 + 512 + hd * 64 + h * 8;
#pragma unroll
          for (int ks = 0; ks < 4; ++ks) kf[jj][ks] = *(const bf16x8*)(ksrc + ks * 16);
        }
      }
#pragma unroll
      for (int jj = 0; jj < 2; ++jj) {
        const int jt = jb * 2 + jj;
        if (jt <= w) {
          f32x16 sc;
#pragma unroll
          for (int e = 0; e < 16; ++e) sc[e] = 0.f;
#pragma unroll
          for (int ks = 0; ks < 4; ++ks) sc = __builtin_amdgcn_mfma_f32_32x32x16_bf16(qf[ks], kf[jj][ks], sc, 0, 0, 0);
#pragma unroll
          for (int e = 0; e < 16; ++e) {
            const int i = 32 * w + crow(e, h), j = 32 * jt + r;
            const int d = i - j;
            const float val = (d >= 0) ? sc[e] * dec[d >= 0 ? d : 0] : 0.f;
            Sc[i * RL + j] = f2bf(val);
          }
        }
      }
    }
    __syncthreads();
    f32x16 oacc[2];
#pragma unroll
    for (int nt = 0; nt < 2; ++nt) {
#pragma unroll
      for (int e = 0; e < 16; ++e) oacc[nt][e] = 0.f;
#pragma unroll
      for (int ks = 0; ks < 4; ++ks) {
        const bf16x8 sf = *(const bf16x8*)(St + (nt * 32 + r) * 72 + ks * 16 + h * 8);
        oacc[nt] = __builtin_amdgcn_mfma_f32_32x32x16_bf16(qf[ks], sf, oacc[nt], 0, 0, 0);
      }
#pragma unroll
      for (int e = 0; e < 16; ++e) oacc[nt][e] *= dec[32 * w + crow(e, h) + 1];
    }
    for (int ks = 0; ks < 2 * (w + 1); ++ks) {
      const bf16x8 af = *(const bf16x8*)(Sc + (32 * w + r) * RL + ks * 16 + h * 8);
#pragma unroll
      for (int nt = 0; nt < 2; ++nt) {
        const bf16x8 vf = *(const bf16x8*)(Vt + (nt * 32 + r) * RL + ks * 16 + h * 8);
        oacc[nt] = __builtin_amdgcn_mfma_f32_32x32x16_bf16(af, vf, oacc[nt], 0, 0, 0);
      }
    }
#pragma unroll
    for (int e = 0; e < 16; ++e) Sacc[e] *= g128;
#pragma unroll
    for (int ks = 0; ks < 8; ++ks) {
      const bf16x8 af = *(const bf16x8*)(Vt + (vt * 32 + r) * RL + ks * 16 + h * 8);
      const bf16x8 bf = *(const bf16x8*)(Kzt + (dt * 32 + r) * RL + ks * 16 + h * 8);
      Sacc = __builtin_amdgcn_mfma_f32_32x32x16_bf16(af, bf, Sacc, 0, 0, 0);
    }
    __syncthreads();
#pragma unroll
    for (int nt = 0; nt < 2; ++nt)
#pragma unroll
      for (int e = 0; e < 16; ++e) Of[(32 * w + crow(e, h)) * 66 + nt * 32 + r] = oacc[nt][e];
#pragma unroll
    for (int e = 0; e < 16; ++e) St[(vt * 32 + crow(e, h)) * 72 + dt * 32 + r] = f2bf(Sacc[e]);
    __syncthreads();
    {
      const int i = tid >> 1, hf = tid & 1;
      const int t = tokc + i;
      float vals[32];
      float sm = 0.f;
#pragma unroll
      for (int k = 0; k < 32; ++k) { vals[k] = Of[i * 66 + hf * 32 + k]; sm += vals[k]; }
      sm += __shfl_xor(sm, 1);
      const float mean = sm * (1.f / 64.f);
      float vs = 0.f;
#pragma unroll
      for (int k = 0; k < 32; ++k) { vals[k] -= mean; vs += vals[k] * vals[k]; }
      vs += __shfl_xor(vs, 1);
      const float rs = rsqrtf(vs * (1.f / 64.f) + 1e-5f);
      const bf16_t* gsrc = RET + (size_t)t * 2048 + 1536 + hd * 64 + hf * 32;
      bf16_t* dst = ACT + (size_t)t * 1024 + hd * 64 + hf * 32;
#pragma unroll
      for (int qd = 0; qd < 4; ++qd) {
        const uint4 ug = *(const uint4*)(gsrc + qd * 8);
        const unsigned gg[4] = {ug.x, ug.y, ug.z, ug.w};
        unsigned o4[4];
#pragma unroll
        for (int e = 0; e < 4; ++e) {
          const float g0 = lo2f(gg[e]), g1 = hi2f(gg[e]);
          const float a0 = vals[qd * 8 + 2 * e] * rs * (g0 * sigmoidf_(g0));
          const float a1 = vals[qd * 8 + 2 * e + 1] * rs * (g1 * sigmoidf_(g1));
          o4[e] = pack2(a0, a1);
        }
        *(uint4*)(dst + qd * 8) = make_uint4(o4[0], o4[1], o4[2], o4[3]);
      }
    }
    __syncthreads();
  }
  float* so = p->out + O_RETP + (size_t)(b * 8 + hd) * 4096;
#pragma unroll
  for (int gq = 0; gq < 4; ++gq)
    *(float4*)(so + (dt * 32 + r) * 64 + vt * 32 + 8 * gq + 4 * h) =
        make_float4(Sacc[4 * gq], Sacc[4 * gq + 1], Sacc[4 * gq + 2], Sacc[4 * gq + 3]);
}

DI void ret_sample(KP p, int b, int hd, char* smem) {
  const int tid = tidx();
  const bf16_t* RET = (const bf16_t*)p->out;
  bf16_t* ACT = (bf16_t*)(p->ws + OFF_ACT);
  float* q_s = (float*)smem;
  float* k_s = q_s + 512;
  float* v_s = k_s + 512;
  float* A_s = v_s + 512;
  float* part = A_s + 64;
  const int tok0 = TP + b * 8;
  const float lg = log1pf(-exp2f(-5.f - (float)hd));
  __syncthreads();
  {
    const int e = tid * 2, rw = e >> 6, cl = e & 63;
    const bf16_t* base = RET + (size_t)(tok0 + rw) * 2048 + hd * 64 + cl;
    const unsigned uq = *(const unsigned*)(base), uk = *(const unsigned*)(base + 512), uv = *(const unsigned*)(base + 1024);
    q_s[e] = lo2f(uq); q_s[e + 1] = hi2f(uq);
    k_s[e] = lo2f(uk); k_s[e + 1] = hi2f(uk);
    v_s[e] = lo2f(uv); v_s[e + 1] = hi2f(uv);
  }
  __syncthreads();
  if (tid < 64) {
    const int i = tid >> 3, j = tid & 7;
    float a = 0.f;
    if (i >= j) {
#pragma unroll 4
      for (int d = 0; d < 64; ++d) a = fmaf(q_s[i * 64 + d], k_s[j * 64 + d], a);
      a *= expf((float)(i - j) * lg);
    }
    A_s[tid] = a;
  }
  {
    const int dg = tid >> 6, v = tid & 63;
    const float* S0 = p->in[2] + (size_t)(b * 8 + hd) * 4096;
    float* So = p->out + O_RETS + (size_t)(b * 8 + hd) * 4096;
    float oi[8];
#pragma unroll
    for (int i = 0; i < 8; ++i) oi[i] = 0.f;
    const float g8 = expf(8.f * lg);
    float kv[8];
#pragma unroll
    for (int j = 0; j < 8; ++j) kv[j] = v_s[j * 64 + v] * expf((float)(7 - j) * lg);
#pragma unroll 1
    for (int hb = 0; hb < 2; ++hb) {
      float sv[8];
#pragma unroll
      for (int dd = 0; dd < 8; ++dd) sv[dd] = S0[(dg * 16 + hb * 8 + dd) * 64 + v];
#pragma unroll
      for (int dd = 0; dd < 8; ++dd) {
        const int d = dg * 16 + hb * 8 + dd;
        const float s = sv[dd];
        float sn = s * g8;
#pragma unroll
        for (int j = 0; j < 8; ++j) sn = fmaf(k_s[j * 64 + d], kv[j], sn);
        So[d * 64 + v] = sn;
#pragma unroll
        for (int i = 0; i < 8; ++i) oi[i] = fmaf(q_s[i * 64 + d], s, oi[i]);
      }
    }
#pragma unroll
    for (int i = 0; i < 8; ++i) part[(dg * 8 + i) * 64 + v] = oi[i];
  }
  __syncthreads();
#pragma unroll
  for (int rep = 0; rep < 2; ++rep) {
    const int i = (tid >> 6) + 4 * rep, v = tid & 63;
    float o = part[(0 * 8 + i) * 64 + v] + part[(1 * 8 + i) * 64 + v] + part[(2 * 8 + i) * 64 + v] + part[(3 * 8 + i) * 64 + v];
    o *= expf((float)(i + 1) * lg);
    for (int j = 0; j <= i; ++j) o = fmaf(A_s[i * 8 + j], v_s[j * 64 + v], o);
    const float mean = wave_sum(o) * (1.f / 64.f);
    const float dv = o - mean;
    const float var = wave_sum(dv * dv) * (1.f / 64.f);
    const int t = tok0 + i;
    const float gt = bf2f(RET[(size_t)t * 2048 + 1536 + hd * 64 + v]);
    ACT[(size_t)t * 1024 + hd * 64 + v] = f2bf(dv * rsqrtf(var + 1e-5f) * (gt * sigmoidf_(gt)));
  }
}

constexpr size_t TAB_V8 = (size_t)16384 * 1024;
constexpr size_t TAB_SC = (size_t)2 * 16384 * 1024;
DI void convert_tab(KP p, int it) {
  const int tid = tidx(), lane = tid & 63, w = tid >> 6;
  const int row0 = it * 8 + w * 2;
  const float* src = (row0 < 16384) ? p->in[24] + (size_t)row0 * 1024 : p->in[25] + (size_t)(row0 - 16384) * 1024;
  float4 v[2][4];
#pragma unroll
  for (int rr = 0; rr < 2; ++rr)
#pragma unroll
    for (int i = 0; i < 4; ++i) v[rr][i] = *(const float4*)(src + rr * 1024 + i * 256 + lane * 4);
#pragma unroll
  for (int rr = 0; rr < 2; ++rr) {
    float am = 0.f;
#pragma unroll
    for (int i = 0; i < 4; ++i)
      am = fmaxf(am, fmaxf(fmaxf(fabsf(v[rr][i].x), fabsf(v[rr][i].y)), fmaxf(fabsf(v[rr][i].z), fabsf(v[rr][i].w))));
#pragma unroll
    for (int o = 32; o >= 1; o >>= 1) am = fmaxf(am, __shfl_xor(am, o));
    am = fmaxf(am, 1e-30f);
    const float inv = 127.f / am;
    unsigned char* dst = (unsigned char*)(p->ws + OFF_TAB) + (size_t)(row0 + rr) * 1024;
#pragma unroll
    for (int i = 0; i < 4; ++i) {
      const unsigned q0 = (unsigned)((int)rintf(v[rr][i].x * inv) + 128);
      const unsigned q1 = (unsigned)((int)rintf(v[rr][i].y * inv) + 128);
      const unsigned q2 = (unsigned)((int)rintf(v[rr][i].z * inv) + 128);
      const unsigned q3 = (unsigned)((int)rintf(v[rr][i].w * inv) + 128);
      *(unsigned*)(dst + i * 256 + lane * 4) = q0 | (q1 << 8) | (q2 << 16) | (q3 << 24);
    }
    if (lane == 0) ((float*)(p->ws + OFF_TAB + TAB_SC))[row0 + rr] = am * (1.f / 127.f);
  }
}

DI void phase4_other(KP p, int it, char* smem) {
  if (it < 64) { ret_prompt(p, it >> 3, it & 7, smem); return; }
  it -= 64;
  if (it < 4096) {
    const int bh = it >> 2, q = it & 3, b = bh >> 3, hd = bh & 7;
    rwkv_scan(p, TP + b * 8, hd, q, 8, p->in[3] + (size_t)bh * 4096, p->out + O_WKVS + (size_t)bh * 4096, smem);
    return;
  }
  it -= 4096;
  if (it < 1024) { ret_sample(p, it >> 3, it & 7, smem); return; }
  it -= 1024;
  if (it < 4096) { convert_tab(p, it); return; }
  it -= 4096;
#define TJ4(IDX, OFF, KK_, NN_)                                                                            \
  {                                                                                                        \
    const int ntl = ((KK_) / 64) * ((NN_) / 64);                                                           \
    if (it < ntl) {                                                                                        \
      transpose_tile(p->in[IDX], (bf16_t*)(p->ws + (OFF)), (KK_), (NN_), it / ((NN_) / 64), it % ((NN_) / 64), (float*)smem); \
      return;                                                                                              \
    }                                                                                                      \
    it -= ntl;                                                                                             \
  }
  TJ4(20, OFF_WOUT, 1024, 1024)
  TJ4(22, OFF_WQ, 1024, 2048)
  TJ4(27, OFF_PG, 1024, 1024)
  TJ4(28, OFF_PP, 256, 1024)
}
DI void phase4(KP p, char* smem) {
  constexpr int N_OTHER = 64 + 4096 + 1024 + 4096 + (256 + 512 + 256 + 64);
  int* s_item = (int*)(smem + SMEM_BYTES - 16);
  unsigned* ctr = (unsigned*)(p->ws + OFF_CTR);
  unsigned* cukey = (unsigned*)(p->ws + OFF_CTR + 16384);
  __syncthreads();
  if (tidx() == 0) {
    const unsigned hw = (unsigned)__builtin_amdgcn_s_getreg((7 << 11) | (8 << 6) | 4);
    const unsigned key = (xb_xcc_id() << 8) | (hw & 0xffu);
    const unsigned old = atomicAdd(&cukey[key], 1u);
    int it = -1;
    if (old == 0u) { const unsigned q = atomicAdd(&ctr[1], 1u); if (q < 256u) it = (int)q; }
    *s_item = it;
  }
  __syncthreads();
  {
    const int it = *s_item;
    if (it >= 0) {
      const int bh = it >> 2, q = it & 3, b = bh >> 3, hd = bh & 7;
      __builtin_amdgcn_s_setprio(3);
      rwkv_scan(p, b * 2048, hd, q, 2048, nullptr, p->out + O_WKVP + (size_t)bh * 4096, smem);
      __builtin_amdgcn_s_setprio(0);
    }
  }
  for (;;) {
    __syncthreads();
    if (tidx() == 0) *s_item = (int)atomicAdd(&ctr[0], 1u);
    __syncthreads();
    const int it = *s_item;
    if (it >= N_OTHER) break;
    phase4_other(p, it, smem);
  }
  for (;;) {
    __syncthreads();
    if (tidx() == 0) *s_item = (int)atomicAdd(&ctr[1], 1u);
    __syncthreads();
    const int it = *s_item;
    if (it >= 256) break;
    const int bh = it >> 2, q = it & 3, b = bh >> 3, hd = bh & 7;
    rwkv_scan(p, b * 2048, hd, q, 2048, nullptr, p->out + O_WKVP + (size_t)bh * 4096, smem);
  }
}

DI void phase5(KP p) {
  const int lane = tidx() & 63, w = tidx() >> 6;
  bf16_t* ACT = (bf16_t*)(p->ws + OFF_ACT);
  const bf16_t* Rb = (const bf16_t*)(p->ws + OFF_R);
  const bf16_t* Kb = (const bf16_t*)(p->ws + OFF_K);
  const bf16_t* Vb = (const bf16_t*)(p->ws + OFF_V);
  const bf16_t* GTb = (const bf16_t*)(p->ws + OFF_GATE);
  const int c8 = lane * 8;
  float rk8[8], lg8[8], lb8[8];
  {
    const float4 a0 = *(const float4*)(p->in[17] + c8), a1 = *(const float4*)(p->in[17] + c8 + 4);
    const float4 b0 = *(const float4*)(p->in[18] + c8), b1 = *(const float4*)(p->in[18] + c8 + 4);
    const float4 d0 = *(const float4*)(p->in[19] + c8), d1 = *(const float4*)(p->in[19] + c8 + 4);
    rk8[0] = a0.x; rk8[1] = a0.y; rk8[2] = a0.z; rk8[3] = a0.w; rk8[4] = a1.x; rk8[5] = a1.y; rk8[6] = a1.z; rk8[7] = a1.w;
    lg8[0] = b0.x; lg8[1] = b0.y; lg8[2] = b0.z; lg8[3] = b0.w; lg8[4] = b1.x; lg8[5] = b1.y; lg8[6] = b1.z; lg8[7] = b1.w;
    lb8[0] = d0.x; lb8[1] = d0.y; lb8[2] = d0.z; lb8[3] = d0.w; lb8[4] = d1.x; lb8[5] = d1.y; lb8[6] = d1.z; lb8[7] = d1.w;
  }
  for (int t = blockIdx.x * 4 + w; t < T; t += gridDim.x * 4) {
    const size_t o = (size_t)t * 512 + c8;
    bf16_t* yp = ACT + (size_t)t * 1024 + 512 + c8;
    const uint4 uy = *(const uint4*)yp, ur = *(const uint4*)(Rb + o), uk = *(const uint4*)(Kb + o),
                uv = *(const uint4*)(Vb + o), ug = *(const uint4*)(GTb + o);
    float y[8], r[8], k[8], v[8], g[8];
    unpack8f(uy, y); unpack8f(ur, r); unpack8f(uk, k); unpack8f(uv, v); unpack8f(ug, g);
    float sm = 0.f, rk = 0.f;
#pragma unroll
    for (int e = 0; e < 8; ++e) { sm += y[e]; rk = fmaf(r[e] * k[e], rk8[e], rk); }
    sm = allreduce8(sm);
    rk = allreduce8(rk);
    const float mean = sm * (1.f / 64.f);
    float vs = 0.f;
#pragma unroll
    for (int e = 0; e < 8; ++e) { y[e] -= mean; vs += y[e] * y[e]; }
    vs = allreduce8(vs);
    const float rs = rsqrtf(vs * (1.f / 64.f) + 64e-5f);
    float ov[8];
#pragma unroll
    for (int e = 0; e < 8; ++e) ov[e] = (y[e] * rs * lg8[e] + lb8[e] + rk * v[e]) * g[e];
    *(uint4*)yp = pack8f(ov);
  }
}

DI void phase6(KP p, char* smem) {
  for (int tile = blockIdx.x; tile < 136 * 8; tile += gridDim.x) {
    const int mt = tile >> 3, nt = tile & 7;
    const int m0 = mt * 128, n0 = nt * 128;
    f32x16 acc[2][2];
    gemm128<false>((const bf16_t*)(p->ws + OFF_ACT) + (size_t)m0 * 1024, 1024,
                   (const bf16_t*)(p->ws + OFF_WOUT) + (size_t)n0 * 1024, 1024, 1024, acc, smem);
    {
      const int lane = tidx() & 63, w = tidx() >> 6;
      const int wm = w >> 1, wn = w & 1, r = lane & 31, h = lane >> 5;
      const float* xb = (m0 < TP) ? p->in[0] + (size_t)m0 * 1024 : p->in[1] + (size_t)(m0 - TP) * 1024;
#pragma unroll
      for (int mi = 0; mi < 2; ++mi)
#pragma unroll
        for (int ni = 0; ni < 2; ++ni)
#pragma unroll
          for (int i = 0; i < 16; ++i)
            acc[mi][ni][i] += xb[(size_t)(wm * 64 + mi * 32 + crow(i, h)) * 1024 + n0 + wn * 64 + ni * 32 + r];
#pragma unroll
      for (int mi = 0; mi < 2; ++mi)
#pragma unroll
        for (int ni = 0; ni < 2; ++ni)
#pragma unroll
          for (int i = 0; i < 16; ++i)
            p->out[(size_t)(m0 + wm * 64 + mi * 32 + crow(i, h)) * 1024 + n0 + wn * 64 + ni * 32 + r] = acc[mi][ni][i];
    }
  }
}

DI void phase7(KP p) {
  const int lane = tidx() & 63, w = tidx() >> 6;
  for (int t = blockIdx.x * 4 + w; t < T; t += gridDim.x * 4)
    rmsnorm_row_bf(p->out + (size_t)t * 1024, p->in[21], (bf16_t*)(p->ws + OFF_ACT) + (size_t)t * 1024, lane);
}

DI void phase8(KP p, char* smem) {
  bf16_t* QP = (bf16_t*)(p->ws + OFF_QPEER);
  for (int tile = blockIdx.x; tile < 136 * 16; tile += gridDim.x) {
    const int mt = tile >> 4, nt = tile & 15;
    const int m0 = mt * 128, n0 = nt * 128;
    f32x16 acc[2][2];
    gemm128<false>((const bf16_t*)(p->ws + OFF_ACT) + (size_t)m0 * 1024, 1024,
                   (const bf16_t*)(p->ws + OFF_WQ) + (size_t)n0 * 1024, 1024, 1024, acc, smem);
    epi_each(acc, [&](int rr, int cc, float v) { QP[(size_t)(m0 + rr) * 2048 + n0 + cc] = f2bf(v); });
  }
}

DI unsigned sortkey(float f) { unsigned u = __float_as_uint(f); return (u & 0x80000000u) ? ~u : (u | 0x80000000u); }
DI float unsortkey(unsigned k) { unsigned u = (k & 0x80000000u) ? (k ^ 0x80000000u) : ~k; return __uint_as_float(u); }
DI void ins16(unsigned (&l)[16], unsigned x) {
#pragma unroll
  for (int i = 0; i < 16; ++i) { const unsigned hi = max(l[i], x); x = min(l[i], x); l[i] = hi; }
}
DI void cswap_desc(unsigned& a, unsigned& b) { const unsigned hi = max(a, b), lo = min(a, b); a = hi; b = lo; }
DI void bsort16(unsigned (&v)[16]) {
#pragma unroll
  for (int ke = 1; ke <= 4; ++ke)
#pragma unroll
    for (int je = ke - 1; je >= 0; --je)
#pragma unroll
      for (int i = 0; i < 16; ++i) {
        const int k = 1 << ke, j = 1 << je, l = i ^ j;
        if (l > i) { if ((i & k) == 0) cswap_desc(v[i], v[l]); else cswap_desc(v[l], v[i]); }
      }
}
DI void bmerge16(unsigned (&a)[16], const unsigned (&b)[16]) {
#pragma unroll
  for (int i = 0; i < 16; ++i) a[i] = max(a[i], b[15 - i]);
#pragma unroll
  for (int je = 3; je >= 0; --je)
#pragma unroll
    for (int i = 0; i < 16; ++i) {
      const int j = 1 << je, l = i ^ j;
      if (l > i) cswap_desc(a[i], a[l]);
    }
}
DI void phase9(KP p, char* smem) {
  const int tid = tidx();
  const bf16_t* QP = (const bf16_t*)(p->ws + OFF_QPEER);
  const bf16_t* KEYS = (const bf16_t*)(p->ws + OFF_KEYS);
  int* IDX = (int*)(p->ws + OFF_IDX);
  float* GSM = (float*)(p->ws + OFF_GSM);
  float* sc = (float*)smem;
  unsigned* mrg = (unsigned*)smem;
  const int row = tid >> 1, half = tid & 1;
  for (int item = blockIdx.x; item < 136 * 8; item += gridDim.x) {
    const int mt = item >> 3, hd = item & 7;
    const int m0 = mt * 128;
    unsigned kc[2][16];
#pragma unroll
    for (int c = 0; c < 2; ++c) {
      f32x16 acc[2][2];
      gemm128<false>(QP + (size_t)m0 * 2048 + (hd * 2 + c) * 128, 2048, KEYS + (size_t)(hd * 2 + c) * 16384, 128, 128, acc, smem);
      __syncthreads();
      epi_each(acc, [&](int rr, int cc, float v) { sc[rr * 129 + cc] = v; });
      __syncthreads();
      unsigned lst[16];
#pragma unroll
      for (int gi = 0; gi < 4; ++gi) {
        unsigned grp[16];
#pragma unroll
        for (int i = 0; i < 16; ++i) {
          const int col = half * 64 + gi * 16 + i;
          grp[i] = (sortkey(sc[row * 129 + col]) & ~127u) | (unsigned)(127 - col);
        }
        bsort16(grp);
        if (gi == 0) {
#pragma unroll
          for (int i = 0; i < 16; ++i) lst[i] = grp[i];
        } else {
          bmerge16(lst, grp);
        }
      }
      __syncthreads();
      if (half) {
#pragma unroll
        for (int i = 0; i < 16; ++i) mrg[row * 16 + i] = lst[i];
      }
      __syncthreads();
      if (!half) {
        unsigned grp[16];
#pragma unroll
        for (int i = 0; i < 16; ++i) grp[i] = mrg[row * 16 + i];
        bmerge16(lst, grp);
      }
#pragma unroll
      for (int i = 0; i < 16; ++i) kc[c][i] = lst[i];
    }
    if (!half) {
      float sv0[16], sv1[16];
#pragma unroll
      for (int i = 0; i < 16; ++i) { sv0[i] = unsortkey(kc[0][i] & ~127u); sv1[i] = unsortkey(kc[1][i] & ~127u); }
      unsigned cl[16];
#pragma unroll
      for (int i = 0; i < 16; ++i) cl[i] = 0u;
#pragma unroll
      for (int a = 0; a < 16; ++a)
#pragma unroll
        for (int b = 0; b < 16 / (a + 1); ++b)
          ins16(cl, (sortkey(sv0[a] + sv1[b]) & ~255u) | (unsigned)(255 - (a * 16 + b)));
      float ex[16];
      float sum = 0.f;
      const float mx = unsortkey(cl[0] & ~255u);
#pragma unroll
      for (int i = 0; i < 16; ++i) { ex[i] = __expf(unsortkey(cl[i] & ~255u) - mx); sum += ex[i]; }
      const float inv = 1.f / sum;
      int eo[16];
#pragma unroll
      for (int i = 0; i < 16; ++i) {
        const int ci = 255 - (int)(cl[i] & 255u);
        const int a = ci >> 4, b = ci & 15;
        int i0 = 0, i1 = 0;
#pragma unroll
        for (int k = 0; k < 16; ++k) {
          i0 = (a == k) ? (127 - (int)(kc[0][k] & 127u)) : i0;
          i1 = (b == k) ? (127 - (int)(kc[1][k] & 127u)) : i1;
        }
        eo[i] = i0 * 128 + i1;
        ex[i] *= inv;
      }
      const size_t o = ((size_t)(m0 + row) * 8 + hd) * 16;
#pragma unroll
      for (int qd = 0; qd < 4; ++qd) {
        *(int4*)(IDX + o + qd * 4) = make_int4(eo[qd * 4], eo[qd * 4 + 1], eo[qd * 4 + 2], eo[qd * 4 + 3]);
        *(float4*)(GSM + o + qd * 4) = make_float4(ex[qd * 4], ex[qd * 4 + 1], ex[qd * 4 + 2], ex[qd * 4 + 3]);
      }
    }
  }
}

#define UB0(u) ((float)((u) & 0xffu))
#define UB1(u) ((float)(((u) >> 8) & 0xffu))
#define UB2(u) ((float)(((u) >> 16) & 0xffu))
#define UB3(u) ((float)((u) >> 24))
DI void phase10(KP p) {
  const int lane = tidx() & 63, w = tidx() >> 6;
  const int g = lane >> 4, l16 = lane & 15;
  bf16_t* ACT = (bf16_t*)(p->ws + OFF_ACT);
  const unsigned char* UB = (const unsigned char*)(p->ws + OFF_TAB);
  const unsigned char* VB = UB + TAB_V8;
  const float* USC = (const float*)(p->ws + OFF_TAB + TAB_SC);
  const float* VSC = USC + 16384;
  const int* IDX = (const int*)(p->ws + OFF_IDX);
  const float* GSM = (const float*)(p->ws + OFF_GSM);
  const float* pn = p->in[26];
  for (int t = blockIdx.x * 4 + w; t < T; t += gridDim.x * 4) {
    bf16_t* act = ACT + (size_t)t * 1024;
    float xf[64];
    float xsum = 0.f;
#pragma unroll
    for (int s = 0; s < 4; ++s) {
      const uint4 x0 = *(const uint4*)(act + s * 256 + l16 * 16);
      const uint4 x1 = *(const uint4*)(act + s * 256 + l16 * 16 + 8);
      const unsigned xx[8] = {x0.x, x0.y, x0.z, x0.w, x1.x, x1.y, x1.z, x1.w};
#pragma unroll
      for (int q = 0; q < 8; ++q) { xf[s * 16 + 2 * q] = lo2f(xx[q]); xf[s * 16 + 2 * q + 1] = hi2f(xx[q]); }
    }
#pragma unroll
    for (int k = 0; k < 64; ++k) xsum += xf[k];
    const int id0 = IDX[(size_t)t * 128 + lane], id1 = IDX[(size_t)t * 128 + 64 + lane];
    const float gs0 = GSM[(size_t)t * 128 + lane], gs1 = GSM[(size_t)t * 128 + 64 + lane];
    float acc[64];
#pragma unroll
    for (int k = 0; k < 64; ++k) acc[k] = 0.f;
    float csum = 0.f;
    for (int it = 0; it < 32; ++it) {
      const int n = (it * 4 + g) & 63;
      const int e = __shfl((it < 16) ? id0 : id1, n);
      const float gw = __shfl((it < 16) ? gs0 : gs1, n);
      const unsigned char* ur = UB + (size_t)e * 1024 + l16 * 16;
      const unsigned char* vr = VB + (size_t)e * 1024 + l16 * 16;
      uint4 uu[4], vv[4];
#pragma unroll
      for (int s = 0; s < 4; ++s) uu[s] = *(const uint4*)(ur + s * 256);
#pragma unroll
      for (int s = 0; s < 4; ++s) vv[s] = *(const uint4*)(vr + s * 256);
      const float su = USC[e], sv = VSC[e];
      float hv = 0.f;
#pragma unroll
      for (int s = 0; s < 4; ++s) {
        const unsigned ww[4] = {uu[s].x, uu[s].y, uu[s].z, uu[s].w};
#pragma unroll
        for (int q = 0; q < 4; ++q) {
          hv = fmaf(xf[s * 16 + q * 4 + 0], UB0(ww[q]), hv);
          hv = fmaf(xf[s * 16 + q * 4 + 1], UB1(ww[q]), hv);
          hv = fmaf(xf[s * 16 + q * 4 + 2], UB2(ww[q]), hv);
          hv = fmaf(xf[s * 16 + q * 4 + 3], UB3(ww[q]), hv);
        }
      }
      hv = fmaf(-128.f, xsum, hv);
      hv = allreduce16(hv) * su;
      const float c = 0.5f * hv * (1.f + erff(hv * 0.70710678118f)) * gw * sv;
      csum += c;
#pragma unroll
      for (int s = 0; s < 4; ++s) {
        const unsigned ww[4] = {vv[s].x, vv[s].y, vv[s].z, vv[s].w};
#pragma unroll
        for (int q = 0; q < 4; ++q) {
          acc[s * 16 + q * 4 + 0] = fmaf(c, UB0(ww[q]), acc[s * 16 + q * 4 + 0]);
          acc[s * 16 + q * 4 + 1] = fmaf(c, UB1(ww[q]), acc[s * 16 + q * 4 + 1]);
          acc[s * 16 + q * 4 + 2] = fmaf(c, UB2(ww[q]), acc[s * 16 + q * 4 + 2]);
          acc[s * 16 + q * 4 + 3] = fmaf(c, UB3(ww[q]), acc[s * 16 + q * 4 + 3]);
        }
      }
    }
    const float cs128 = 128.f * csum;
#pragma unroll
    for (int k = 0; k < 64; ++k) {
      acc[k] -= cs128;
      acc[k] += __shfl_xor(acc[k], 16);
      acc[k] += __shfl_xor(acc[k], 32);
    }
    float* hrow = p->out + (size_t)t * 1024;
    float hvv[16];
#pragma unroll
    for (int s = 0; s < 4; ++s) {
      if (s == g) {
        float* hp = hrow + s * 256 + l16 * 16;
#pragma unroll
        for (int q = 0; q < 4; ++q) {
          float4 h0 = *(float4*)(hp + q * 4);
          h0.x += acc[s * 16 + q * 4 + 0]; h0.y += acc[s * 16 + q * 4 + 1]; h0.z += acc[s * 16 + q * 4 + 2]; h0.w += acc[s * 16 + q * 4 + 3];
          *(float4*)(hp + q * 4) = h0;
          hvv[q * 4 + 0] = h0.x; hvv[q * 4 + 1] = h0.y; hvv[q * 4 + 2] = h0.z; hvv[q * 4 + 3] = h0.w;
        }
      }
    }
    float ss = 0.f;
#pragma unroll
    for (int k = 0; k < 16; ++k) ss += hvv[k] * hvv[k];
    ss = wave_sum(ss);
    const float scl = rsqrtf(ss * (1.f / 1024.f) + 1e-6f);
    {
      const int col = g * 256 + l16 * 16;
      unsigned o8[8];
#pragma unroll
      for (int q = 0; q < 4; ++q) {
        const float4 g0 = *(const float4*)(pn + col + q * 4);
        o8[q * 2] = pack2(hvv[q * 4 + 0] * scl * g0.x, hvv[q * 4 + 1] * scl * g0.y);
        o8[q * 2 + 1] = pack2(hvv[q * 4 + 2] * scl * g0.z, hvv[q * 4 + 3] * scl * g0.w);
      }
      *(uint4*)(act + col) = make_uint4(o8[0], o8[1], o8[2], o8[3]);
      *(uint4*)(act + col + 8) = make_uint4(o8[4], o8[5], o8[6], o8[7]);
    }
  }
}

DI void phase11(KP p, char* smem) {
  for (int tile = blockIdx.x; tile < 136 * 8; tile += gridDim.x) {
    const int mt = tile >> 3, nt = tile & 7;
    const int m0 = mt * 128, n0 = nt * 128;
    f32x16 acc[2][2];
    unsigned ppk[2][2][8];
    const float* pa = (m0 < TP) ? p->in[5] + (size_t)m0 * 256 : p->in[6] + (size_t)(m0 - TP) * 256;
    gemm128<true>(pa, 256, (const bf16_t*)(p->ws + OFF_PP) + (size_t)n0 * 256, 256, 256, acc, smem);
#pragma unroll
    for (int mi = 0; mi < 2; ++mi)
#pragma unroll
      for (int ni = 0; ni < 2; ++ni)
#pragma unroll
        for (int i = 0; i < 8; ++i) ppk[mi][ni][i] = pack2(acc[mi][ni][2 * i], acc[mi][ni][2 * i + 1]);
    gemm128<false>((const bf16_t*)(p->ws + OFF_ACT) + (size_t)m0 * 1024, 1024,
                   (const bf16_t*)(p->ws + OFF_PG) + (size_t)n0 * 1024, 1024, 1024, acc, smem);
    const int lane = tidx() & 63, w = tidx() >> 6;
    const int wm = w >> 1, wn = w & 1, r = lane & 31, h = lane >> 5;
#pragma unroll
    for (int mi = 0; mi < 2; ++mi)
#pragma unroll
      for (int ni = 0; ni < 2; ++ni)
#pragma unroll
        for (int i = 0; i < 16; ++i) {
          const float pp = (i & 1) ? hi2f(ppk[mi][ni][i >> 1]) : lo2f(ppk[mi][ni][i >> 1]);
          acc[mi][ni][i] = sigmoidf_(acc[mi][ni][i]) * pp;
        }
#pragma unroll
    for (int mi = 0; mi < 2; ++mi) {
#pragma unroll
      for (int ni = 0; ni < 2; ++ni)
#pragma unroll
        for (int i = 0; i < 16; ++i)
          acc[mi][ni][i] += p->out[(size_t)(m0 + wm * 64 + mi * 32 + crow(i, h)) * 1024 + n0 + wn * 64 + ni * 32 + r];
#pragma unroll
      for (int ni = 0; ni < 2; ++ni)
#pragma unroll
        for (int i = 0; i < 16; ++i)
          p->out[(size_t)(m0 + wm * 64 + mi * 32 + crow(i, h)) * 1024 + n0 + wn * 64 + ni * 32 + r] = acc[mi][ni][i];
    }
  }
}

DI void phase12(KP p) {
  const int lane = tidx() & 63, w = tidx() >> 6;
  const float* g = p->in[29];
  for (int t = blockIdx.x * 4 + w; t < T; t += gridDim.x * 4) {
    float* x = p->out + (size_t)t * 1024;
    float4 v[4];
    float ss = 0.f;
#pragma unroll
    for (int i = 0; i < 4; ++i) {
      v[i] = ((const float4*)x)[i * 64 + lane];
      ss += v[i].x * v[i].x + v[i].y * v[i].y + v[i].z * v[i].z + v[i].w * v[i].w;
    }
    ss = wave_sum(ss);
    const float sc = rsqrtf(ss * (1.f / 1024.f) + 1e-6f);
#pragma unroll
    for (int i = 0; i < 4; ++i) {
      const float4 gg = ((const float4*)g)[i * 64 + lane];
      ((float4*)x)[i * 64 + lane] = make_float4(v[i].x * sc * gg.x, v[i].y * sc * gg.y, v[i].z * sc * gg.z, v[i].w * sc * gg.w);
    }
  }
}

DI void run_phase(int ph, char* smem) {
  KP p = getp();
  switch (ph) {
    case 0: phase0(p, smem); break;
    case 1: phase1(p, smem); break;
    case 2: phase2(p); break;
    case 3: phase3(p, smem); break;
    case 4: phase4(p, smem); break;
    case 5: phase5(p); break;
    case 6: phase6(p, smem); break;
    case 7: phase7(p); break;
    case 8: phase8(p, smem); break;
    case 9: phase9(p, smem); break;
    case 10: phase10(p); break;
    case 11: phase11(p, smem); break;
    case 12: phase12(p); break;
    default: break;
  }
}

template <int LO, int HI>
__global__ void __launch_bounds__(256, 2) mega_kernel(Params p) {
  __shared__ __attribute__((aligned(16))) char smem[SMEM_BYTES];
  __shared__ uint4 xb_words;
  if (gridDim.x == 0x7fffffffu) cg::this_grid().sync();
  XcdBarrier xb;
  if (HI - LO > 1) {
    if (threadIdx.x == 0) xb_words = make_uint4(0u, 0u, 0u, 0u);
    __syncthreads();
    xb = xcd_barrier_post((unsigned*)(getp()->ws + OFF_CTR), (volatile LAS unsigned*)&xb_words);
  }
#pragma unroll
  for (int ph = LO; ph < HI; ++ph) {
    run_phase(ph, smem);
    if (ph + 1 < HI) xcd_barrier(xb);
  }
}

template <int PH>
static void launch_phases(const Params& p, int grid, hipStream_t stream) {
  hipLaunchKernelGGL((mega_kernel<PH, PH + 1>), dim3(grid), dim3(256), 0, stream, p);
  if constexpr (PH + 1 < 13) launch_phases<PH + 1>(p, grid, stream);
}

extern "C" void kernel_launch(void* const* d_in, const int* in_sizes, int n_in, void* d_out, int out_size,
                              void* d_ws, size_t ws_size, hipStream_t stream) {
  static int grid_blocks = 0;
  if (!grid_blocks) {
    int dev = 0, cus = 0, per_cu = 0;
    (void)hipGetDevice(&dev);
    (void)hipDeviceGetAttribute(&cus, hipDeviceAttributeMultiprocessorCount, dev);
#if MK_MULTI
    per_cu = 2;
#else
    (void)hipOccupancyMaxActiveBlocksPerMultiprocessor(&per_cu, mega_kernel<0, 13>, 256, 0);
#endif
    if (per_cu < 1) per_cu = 1;
    if (per_cu > 2) per_cu = 2;
    grid_blocks = cus * per_cu;
  }
  Params p{};
  for (int i = 0; i < 30; ++i) p.in[i] = (const float*)d_in[i];
  p.out = (float*)d_out;
  p.ws = (char*)d_ws;
  if (ws_size < WS_END) { fprintf(stderr, "workspace too small: %zu < %zu\n", ws_size, (size_t)WS_END); return; }
  (void)hipMemsetAsync((char*)d_ws + OFF_CTR, 0, 32768, stream);
#if MK_MULTI
  launch_phases<0>(p, grid_blocks, stream);
#else
  void* args[] = {&p};
  hipError_t e = hipLaunchCooperativeKernel((void*)mega_kernel<0, 13>, dim3(grid_blocks), dim3(256), args, 0, stream);
  if (e != hipSuccess) fprintf(stderr, "cooperative launch failed: %s (grid %d)\n", hipGetErrorString(e), grid_blocks);
#endif
}
```

```cpp
#include <hip/hip_runtime.h>
#include <hip/hip_cooperative_groups.h>
#include <cstdio>
namespace cg = cooperative_groups;

#ifndef MK_MULTI
#define MK_MULTI 0
#endif

typedef unsigned short bf16_t;
typedef __attribute__((ext_vector_type(8))) short bf16x8;
typedef __attribute__((ext_vector_type(16))) float f32x16;
typedef __attribute__((ext_vector_type(2))) __bf16 bf2_t;
typedef __attribute__((ext_vector_type(2))) float f2_t;
#define DI __device__ __forceinline__

constexpr int T = 17408, TP = 16384;
constexpr int NPH = 14;

constexpr size_t O_RETP = (size_t)T * 1024;
constexpr size_t O_WKVP = O_RETP + 262144;
constexpr size_t O_SHP = O_WKVP + 262144;
constexpr size_t O_RETS = O_SHP + 14336;
constexpr size_t O_WKVS = O_RETS + 4194304;
constexpr size_t O_SHS = O_WKVS + 4194304;

constexpr size_t OFF_WIN = 0;
constexpr size_t OFF_WOUT = OFF_WIN + (size_t)3840 * 1024 * 2;
constexpr size_t OFF_WQ = OFF_WOUT + (size_t)1024 * 1024 * 2;
constexpr size_t OFF_KEYS = OFF_WQ + (size_t)2048 * 1024 * 2;
constexpr size_t OFF_PG = OFF_KEYS + (size_t)16 * 128 * 128 * 2;
constexpr size_t OFF_PP = OFF_PG + (size_t)1024 * 1024 * 2;
constexpr size_t OFF_W2 = OFF_PP + (size_t)1024 * 256 * 2;
constexpr size_t OFF_A2 = OFF_W2 + (size_t)512 * 64 * 2;
constexpr size_t OFF_G2 = OFF_A2 + (size_t)512 * 64 * 2;
constexpr size_t OFF_ROPE = OFF_G2 + (size_t)512 * 128 * 2;
constexpr size_t OFF_CTR = OFF_ROPE + (size_t)2056 * 32 * 2 * 4;
constexpr size_t OFF_ACT = OFF_CTR + 32768;
constexpr size_t OFF_TAB = OFF_ACT + (size_t)T * 1024 * 2;
constexpr size_t OFF_PREP = OFF_TAB + (size_t)2 * 16384 * 1024 * 2;
constexpr size_t SZ512 = (size_t)T * 512 * 2;
constexpr size_t OFF_R = OFF_PREP;
constexpr size_t OFF_K = OFF_R + SZ512;
constexpr size_t OFF_V = OFF_K + SZ512;
constexpr size_t OFF_KK = OFF_V + SZ512;
constexpr size_t OFF_BB = OFF_KK + SZ512;
constexpr size_t OFF_GATE = OFF_BB + SZ512;
constexpr size_t OFF_EW = OFF_GATE + SZ512;
constexpr size_t OFF_LORA = OFF_EW + (size_t)T * 512 * 4;
constexpr size_t OFF_INVN = OFF_LORA + (size_t)T * 256 * 2;
constexpr size_t WS_END = OFF_INVN + (size_t)T * 8 * 4;
constexpr size_t OFF_QPEER = OFF_PREP;
constexpr size_t OFF_IDX = OFF_QPEER + (size_t)T * 2048 * 2;
constexpr size_t OFF_GSM = OFF_IDX + (size_t)T * 128 * 4;

constexpr int SMEM_BYTES = 79872;

struct Params {
  const float* in[30];
  float* out;
  char* ws;
};

typedef const __attribute__((address_space(4))) Params* KP;
__device__ __forceinline__ KP getp() {
  KP q = (KP)__builtin_amdgcn_kernarg_segment_ptr();
  asm volatile("" : "+s"(q));
  return q;
}
DI int tidx() { int t = threadIdx.x; asm volatile("" : "+v"(t)); return t; }
DI bf16_t f2bf(float x) { return __builtin_bit_cast(bf16_t, (__bf16)x); }
DI float bf2f(bf16_t b) { return __uint_as_float(((unsigned)b) << 16); }
DI unsigned pack2(float a, float b) { const f2_t v = {a, b}; return __builtin_bit_cast(unsigned, __builtin_convertvector(v, bf2_t)); }
DI float lo2f(unsigned u) { return __uint_as_float(u << 16); }
DI float hi2f(unsigned u) { return __uint_as_float(u & 0xffff0000u); }
DI int crow(int reg, int h) { return (reg & 3) + 8 * (reg >> 2) + 4 * h; }
DI float wave_sum(float v) {
#pragma unroll
  for (int o = 32; o >= 1; o >>= 1) v += __shfl_xor(v, o);
  return v;
}
DI float allreduce16(float v) {
  v += __int_as_float(__builtin_amdgcn_update_dpp(0, __float_as_int(v), 0x128, 0xf, 0xf, false));
  v += __int_as_float(__builtin_amdgcn_update_dpp(0, __float_as_int(v), 0x124, 0xf, 0xf, false));
  v += __int_as_float(__builtin_amdgcn_update_dpp(0, __float_as_int(v), 0x122, 0xf, 0xf, false));
  v += __int_as_float(__builtin_amdgcn_update_dpp(0, __float_as_int(v), 0x121, 0xf, 0xf, false));
  return v;
}
#define DPP_ADD(v, ctrl) v += __int_as_float(__builtin_amdgcn_update_dpp(0, __float_as_int(v), ctrl, 0xf, 0xf, false))
DI void allreduce16x2(float& a, float& b) {
  DPP_ADD(a, 0x128); DPP_ADD(b, 0x128);
  DPP_ADD(a, 0x124); DPP_ADD(b, 0x124);
  DPP_ADD(a, 0x122); DPP_ADD(b, 0x122);
  DPP_ADD(a, 0x121); DPP_ADD(b, 0x121);
}
DI float allreduce8(float v) {
  v += __int_as_float(__builtin_amdgcn_update_dpp(0, __float_as_int(v), 0xB1, 0xf, 0xf, false));
  v += __int_as_float(__builtin_amdgcn_update_dpp(0, __float_as_int(v), 0x4E, 0xf, 0xf, false));
  v += __int_as_float(__builtin_amdgcn_update_dpp(0, __float_as_int(v), 0x141, 0xf, 0xf, false));
  return v;
}
DI void unpack8f(const uint4& u, float (&f)[8]) {
  f[0] = lo2f(u.x); f[1] = hi2f(u.x); f[2] = lo2f(u.y); f[3] = hi2f(u.y);
  f[4] = lo2f(u.z); f[5] = hi2f(u.z); f[6] = lo2f(u.w); f[7] = hi2f(u.w);
}
DI uint4 pack8f(const float (&f)[8]) {
  return make_uint4(pack2(f[0], f[1]), pack2(f[2], f[3]), pack2(f[4], f[5]), pack2(f[6], f[7]));
}
DI float sigmoidf_(float x) { return __builtin_amdgcn_rcpf(1.f + __expf(-x)); }
DI const float* xrow(KP p, int t) {
  return t < TP ? p->in[0] + (size_t)t * 1024 : p->in[1] + (size_t)(t - TP) * 1024;
}
struct TokInfo { int sample, b, l; };
DI TokInfo tokinfo(int t) {
  TokInfo ti;
  if (t >= TP) { ti.sample = 1; ti.b = (t - TP) >> 3; ti.l = (t - TP) & 7; }
  else { ti.sample = 0; ti.b = t >> 11; ti.l = t & 2047; }
  return ti;
}

#define XB_TMO      128
#define XB_XCNT(j)  (256  + 64 * (j))
#define XB_XSUB(j)  (1280 + 64 * (j))
#define XB_XGEN(j)  (2304 + 64 * (j))
#define XB_TOP      3328
#define XB_TOPGEN   3392
#define XCD_BAR_WORDS 3456
#define XB_SPIN_CAP (1u << 20)
#define LAS __attribute__((address_space(3)))
DI unsigned xb_ld(unsigned* p) { return __hip_atomic_load(p, __ATOMIC_RELAXED, __HIP_MEMORY_SCOPE_AGENT); }
DI unsigned xb_add(unsigned* p, unsigned v) { return __hip_atomic_fetch_add(p, v, __ATOMIC_RELAXED, __HIP_MEMORY_SCOPE_AGENT); }
DI unsigned xb_xcc_id() { return (unsigned)__builtin_amdgcn_s_getreg((3 << 11) | 20) & 0xFu; }
#define XB_SPIN(cond, bar) do { unsigned _sp = 0; while (cond) { __builtin_amdgcn_s_sleep(1); \
    if ((++_sp & 255u) == 0u) { if (xb_ld(&(bar)[XB_TMO])) break; if (_sp > XB_SPIN_CAP) { atomicAdd(&(bar)[XB_TMO], 1u); break; } } } } while (0)
struct XcdBarrier { unsigned* bar; unsigned x; volatile LAS unsigned* st; };
DI XcdBarrier xcd_barrier_post(unsigned* bar, volatile LAS unsigned* st) {
  XcdBarrier b; b.bar = bar; b.x = xb_xcc_id(); b.st = st;
  if (threadIdx.x == 0) (void)xb_add(&bar[XB_XCNT(b.x)], 1u);
  return b;
}
DI void xcd_barrier_complete(unsigned* bar, unsigned x, unsigned& nloc, unsigned& nx) {
  const unsigned G = gridDim.x * gridDim.y * gridDim.z;
  unsigned sum, cnt, mine, sp = 0u;
  for (;;) {
    sum = 0u; cnt = 0u; mine = 0u;
#pragma unroll
    for (unsigned j = 0; j < 16; ++j) { const unsigned c = xb_ld(&bar[XB_XCNT(j)]); sum += c; cnt += (c > 0u) ? 1u : 0u; mine = (j == x) ? c : mine; }
    if (sum == G) break;
    __builtin_amdgcn_s_sleep(1);
    if ((++sp & 255u) == 0u) { if (xb_ld(&bar[XB_TMO])) break; if (sp > XB_SPIN_CAP) { atomicAdd(&bar[XB_TMO], 1u); break; } }
  }
  nloc = mine > 0u ? mine : 1u; nx = cnt > 0u ? cnt : 1u;
}
DI void xcd_barrier(const XcdBarrier& b) {
  asm volatile("s_waitcnt vmcnt(0)" ::: "memory");
  __syncthreads();
  if (threadIdx.x == 0) {
    unsigned* bar = b.bar;
    __builtin_amdgcn_s_waitcnt(0);
    unsigned nloc = b.st[0], nx = b.st[1];
    if (nloc == 0u) { xcd_barrier_complete(bar, b.x, nloc, nx); b.st[0] = nloc; b.st[1] = nx; }
    const unsigned old = xb_add(&bar[XB_XSUB(b.x)], 1u);
    const unsigned gen = old / nloc;
    if (old + 1u == (gen + 1u) * nloc) {
      __builtin_amdgcn_fence(__ATOMIC_RELEASE, "agent");
      asm volatile("s_waitcnt vmcnt(0)" ::: "memory");
      const unsigned og = xb_add(&bar[XB_TOP], 1u);
      const unsigned tg = og / nx;
      if (og + 1u == (tg + 1u) * nx) xb_add(&bar[XB_TOPGEN], 1u);
      else XB_SPIN(xb_ld(&bar[XB_TOPGEN]) == tg, bar);
      __builtin_amdgcn_fence(__ATOMIC_ACQUIRE, "agent");
      xb_add(&bar[XB_XGEN(b.x)], 1u);
      asm volatile("s_waitcnt vmcnt(0)" ::: "memory");
    } else {
      XB_SPIN(xb_ld(&bar[XB_XGEN(b.x)]) == gen, bar);
      __builtin_amdgcn_fence(__ATOMIC_ACQUIRE, "agent");
      asm volatile("s_waitcnt vmcnt(0)" ::: "memory");
    }
  }
  __syncthreads();
}

constexpr int LDT = 72;
constexpr int GBUF = 2 * 128 * LDT;
template <bool AF32>
DI void gemm128(const void* __restrict__ Ap, int lda, const bf16_t* __restrict__ Bt, int ldb, int K,
                f32x16 (&acc)[2][2], char* smem) {
  bf16_t* S0 = (bf16_t*)smem;
  const int tid = tidx(), lane = tid & 63, w = tid >> 6;
  const int wm = w >> 1, wn = w & 1, r = lane & 31, h = lane >> 5;
  const int lrow = tid >> 3, lch = tid & 7;
#pragma unroll
  for (int i = 0; i < 2; ++i)
#pragma unroll
    for (int j = 0; j < 2; ++j)
#pragma unroll
      for (int e = 0; e < 16; ++e) acc[i][j][e] = 0.f;
  uint4 ra0, ra1, ra2, ra3, rb0, rb1, rb2, rb3;
  const bf16_t* Ab = (const bf16_t*)Ap + (size_t)lrow * lda + lch * 8;
  const float* Af = (const float*)Ap + (size_t)lrow * lda + lch * 8;
  const bf16_t* Bb = Bt + (size_t)lrow * ldb + lch * 8;
  const size_t a32 = (size_t)32 * lda, b32 = (size_t)32 * ldb;
#define GEMM_LDA(dst, q, k0)                                                                          \
  if constexpr (AF32) {                                                                               \
    const float4 f0 = *(const float4*)(Af + (q) * a32 + (k0));                                        \
    const float4 f1 = *(const float4*)(Af + (q) * a32 + (k0) + 4);                                    \
    dst = make_uint4(pack2(f0.x, f0.y), pack2(f0.z, f0.w), pack2(f1.x, f1.y), pack2(f1.z, f1.w));     \
  } else {                                                                                            \
    dst = *(const uint4*)(Ab + (q) * a32 + (k0));                                                     \
  }
#define GEMM_LOADG(k0)                                                                                \
  {                                                                                                   \
    GEMM_LDA(ra0, 0, k0) GEMM_LDA(ra1, 1, k0) GEMM_LDA(ra2, 2, k0) GEMM_LDA(ra3, 3, k0)               \
    rb0 = *(const uint4*)(Bb + (k0));                                                                 \
    rb1 = *(const uint4*)(Bb + b32 + (k0));                                                           \
    rb2 = *(const uint4*)(Bb + 2 * b32 + (k0));                                                       \
    rb3 = *(const uint4*)(Bb + 3 * b32 + (k0));                                                       \
  }
#define GEMM_STORE(buf)                                                                               \
  {                                                                                                   \
    bf16_t* ad = S0 + (buf) * GBUF + lrow * LDT + lch * 8;                                            \
    bf16_t* bd = ad + 128 * LDT;                                                                      \
    *(uint4*)(ad) = ra0; *(uint4*)(ad + 32 * LDT) = ra1; *(uint4*)(ad + 64 * LDT) = ra2; *(uint4*)(ad + 96 * LDT) = ra3; \
    *(uint4*)(bd) = rb0; *(uint4*)(bd + 32 * LDT) = rb1; *(uint4*)(bd + 64 * LDT) = rb2; *(uint4*)(bd + 96 * LDT) = rb3; \
  }
  const int nk = K >> 6;
  GEMM_LOADG(0)
  GEMM_STORE(0)
  if (nk > 1) GEMM_LOADG(64)
  __syncthreads();
  for (int kt = 0; kt < nk; ++kt) {
    if (kt + 1 < nk) GEMM_STORE((kt + 1) & 1)
    if (kt + 2 < nk) GEMM_LOADG((kt + 2) << 6)
    __builtin_amdgcn_sched_barrier(0);
    const bf16_t* As = S0 + (kt & 1) * GBUF;
    const bf16_t* Bs = As + 128 * LDT;
#pragma unroll
    for (int ks = 0; ks < 4; ++ks) {
      bf16x8 a0 = *(const bf16x8*)(As + (wm * 64 + r) * LDT + ks * 16 + h * 8);
      bf16x8 a1 = *(const bf16x8*)(As + (wm * 64 + 32 + r) * LDT + ks * 16 + h * 8);
      bf16x8 b0 = *(const bf16x8*)(Bs + (wn * 64 + r) * LDT + ks * 16 + h * 8);
      bf16x8 b1 = *(const bf16x8*)(Bs + (wn * 64 + 32 + r) * LDT + ks * 16 + h * 8);
      acc[0][0] = __builtin_amdgcn_mfma_f32_32x32x16_bf16(a0, b0, acc[0][0], 0, 0, 0);
      acc[0][1] = __builtin_amdgcn_mfma_f32_32x32x16_bf16(a0, b1, acc[0][1], 0, 0, 0);
      acc[1][0] = __builtin_amdgcn_mfma_f32_32x32x16_bf16(a1, b0, acc[1][0], 0, 0, 0);
      acc[1][1] = __builtin_amdgcn_mfma_f32_32x32x16_bf16(a1, b1, acc[1][1], 0, 0, 0);
    }
    __syncthreads();
  }
}
template <class F>
DI void epi_each(f32x16 (&acc)[2][2], F f) {
  const int lane = tidx() & 63, w = tidx() >> 6;
  const int wm = w >> 1, wn = w & 1, r = lane & 31, h = lane >> 5;
#pragma unroll
  for (int mi = 0; mi < 2; ++mi)
#pragma unroll
    for (int ni = 0; ni < 2; ++ni)
#pragma unroll
      for (int i = 0; i < 16; ++i) f(wm * 64 + mi * 32 + crow(i, h), wn * 64 + ni * 32 + r, acc[mi][ni][i]);
}

DI void transpose_tile(const float* __restrict__ src, bf16_t* __restrict__ dst, int K, int N, int kt, int nt, float* sm) {
  const int tid = tidx();
  const int k0 = kt * 64, n0 = nt * 64;
#pragma unroll
  for (int i = 0; i < 16; ++i) {
    int k = i * 4 + (tid >> 6), n = tid & 63;
    sm[k * 65 + n] = src[(size_t)(k0 + k) * N + n0 + n];
  }
  __syncthreads();
  int n = tid >> 2, ks = (tid & 3) * 16;
  unsigned pk[8];
#pragma unroll
  for (int j = 0; j < 8; ++j) pk[j] = pack2(sm[(ks + 2 * j) * 65 + n], sm[(ks + 2 * j + 1) * 65 + n]);
  uint4* d = (uint4*)(dst + (size_t)(n0 + n) * K + k0 + ks);
  d[0] = make_uint4(pk[0], pk[1], pk[2], pk[3]);
  d[1] = make_uint4(pk[4], pk[5], pk[6], pk[7]);
  __syncthreads();
}
DI void rmsnorm_row_bf(const float* __restrict__ x, const float* __restrict__ g, bf16_t* __restrict__ o, int lane) {
  float4 v[4];
  float ss = 0.f;
#pragma unroll
  for (int i = 0; i < 4; ++i) {
    v[i] = ((const float4*)x)[i * 64 + lane];
    ss += v[i].x * v[i].x + v[i].y * v[i].y + v[i].z * v[i].z + v[i].w * v[i].w;
  }
  ss = wave_sum(ss);
  float sc = rsqrtf(ss * (1.f / 1024.f) + 1e-6f);
#pragma unroll
  for (int i = 0; i < 4; ++i) {
    float4 gg = ((const float4*)g)[i * 64 + lane];
    uint2 pk = make_uint2(pack2(v[i].x * sc * gg.x, v[i].y * sc * gg.y), pack2(v[i].z * sc * gg.z, v[i].w * sc * gg.w));
    ((uint2*)o)[i * 64 + lane] = pk;
  }
}

#define TJ(IDX, OFF, KK_, NN_)                                                                             \
  {                                                                                                        \
    const int ntl = ((KK_) / 64) * ((NN_) / 64);                                                           \
    if (it < ntl) {                                                                                        \
      transpose_tile(p->in[IDX], (bf16_t*)(p->ws + (OFF)), (KK_), (NN_), it / ((NN_) / 64), it % ((NN_) / 64), (float*)smem); \
      continue;                                                                                            \
    }                                                                                                      \
    it -= ntl;                                                                                             \
  }

DI void phase0(KP p, char* smem) {
  const int tid = tidx(), lane = tid & 63, w = tid >> 6;
  constexpr int N_TR = 960 + 8 + 8 + 16;
  constexpr int N_KEYS = 128, N_ROPE = 257, N_NORM = T / 4;
  for (int item = blockIdx.x; item < N_TR + N_KEYS + N_ROPE + N_NORM; item += gridDim.x) {
    int it = item;
    TJ(8, OFF_WIN, 1024, 3840)
    TJ(11, OFF_W2, 64, 512)
    TJ(13, OFF_A2, 64, 512)
    TJ(14, OFF_G2, 128, 512)
    if (it < N_KEYS) {
      const float* src = p->in[23] + (size_t)it * 2048 + tid * 8;
      float4 f0 = *(const float4*)src, f1 = *(const float4*)(src + 4);
      *(uint4*)((bf16_t*)(p->ws + OFF_KEYS) + (size_t)it * 2048 + tid * 8) =
          make_uint4(pack2(f0.x, f0.y), pack2(f0.z, f0.w), pack2(f1.x, f1.y), pack2(f1.z, f1.w));
      continue;
    }
    it -= N_KEYS;
    if (it < N_ROPE) {
      int e = it * 256 + tid;
      int pidx = e >> 5, f = e & 31;
      if (pidx < 2056) {
        const float pos = (pidx < 2048) ? (float)pidx : (float)(16384 + pidx - 2048);
        const float inv = exp2f(-(float)f * 0.41524101186092f);
        const float ang = pos * inv;
        const float kq = rintf(ang * 0.15915494309189535f);
        float rr = fmaf(-kq, 6.28125f, ang);
        rr = fmaf(-kq, 1.9353071795864769e-3f, rr);
        float* rt = (float*)(p->ws + OFF_ROPE);
        rt[e * 2] = cosf(rr);
        rt[e * 2 + 1] = sinf(rr);
      }
      continue;
    }
    it -= N_ROPE;
    {
      int t = it * 4 + w;
      rmsnorm_row_bf(xrow(p, t), p->in[7], (bf16_t*)(p->ws + OFF_ACT) + (size_t)t * 1024, lane);
    }
  }
}

DI void phase1(KP p, char* smem) {
  const int lane = tidx() & 63, w = tidx() >> 6;
  const int wm = w >> 1, wn = w & 1, r = lane & 31, h = lane >> 5;
  bf16_t* RET = (bf16_t*)p->out;
  bf16_t* RWP = (bf16_t*)(p->ws + OFF_TAB);
  const float2* rope = (const float2*)(p->ws + OFF_ROPE);
  for (int tile = blockIdx.x; tile < 136 * 30; tile += gridDim.x) {
    const int mt = tile / 30, nt = tile % 30;
    const int m0 = mt * 128, n0 = nt * 128;
    f32x16 acc[2][2];
    gemm128<false>((const bf16_t*)(p->ws + OFF_ACT) + (size_t)m0 * 1024, 1024,
                   (const bf16_t*)(p->ws + OFF_WIN) + (size_t)n0 * 1024, 1024, 1024, acc, smem);
    const int nb = n0 + wn * 64;
    if (nb < 1024) {
      float2 cs[2][16];
#pragma unroll
      for (int mi = 0; mi < 2; ++mi)
#pragma unroll
        for (int i = 0; i < 16; ++i) {
          const TokInfo ti = tokinfo(m0 + wm * 64 + mi * 32 + crow(i, h));
          cs[mi][i] = rope[(ti.sample ? 2048 + ti.l : ti.l) * 32 + r];
        }
      const float scl = (nb >= 512) ? 0.125f : 1.f;
#pragma unroll
      for (int mi = 0; mi < 2; ++mi)
#pragma unroll
        for (int i = 0; i < 16; ++i) {
          const float v0 = acc[mi][0][i], v1 = acc[mi][1][i];
          acc[mi][0][i] = (v0 * cs[mi][i].x - v1 * cs[mi][i].y) * scl;
          acc[mi][1][i] = (v1 * cs[mi][i].x + v0 * cs[mi][i].y) * scl;
        }
    }
#pragma unroll
    for (int mi = 0; mi < 2; ++mi)
#pragma unroll
      for (int i = 0; i < 16; ++i) {
        const int t = m0 + wm * 64 + mi * 32 + crow(i, h);
        const float v0 = acc[mi][0][i], v1 = acc[mi][1][i];
        if (nb < 2048) {
          RET[(size_t)t * 2048 + nb + r] = f2bf(v0);
          RET[(size_t)t * 2048 + nb + 32 + r] = f2bf(v1);
        } else {
          const TokInfo ti = tokinfo(t);
          const int c = nb - 2048 + r;
          RWP[(size_t)t * 1792 + c] = f2bf(v0);
          RWP[(size_t)t * 1792 + c + 32] = f2bf(v1);
          if (ti.sample) {
            if (ti.l == 7) { p->out[O_SHS + ti.b * 1792 + c] = v0; p->out[O_SHS + ti.b * 1792 + c + 32] = v1; }
          } else {
            if (ti.l == 2047) { p->out[O_SHP + ti.b * 1792 + c] = v0; p->out[O_SHP + ti.b * 1792 + c + 32] = v1; }
          }
        }
      }
  }
}

DI void phase2(KP p) {
  const int lane = tidx() & 63, w = tidx() >> 6;
  const bf16_t* RWP = (const bf16_t*)(p->ws + OFF_TAB);
  bf16_t* Rb = (bf16_t*)(p->ws + OFF_R);
  bf16_t* Kb = (bf16_t*)(p->ws + OFF_K);
  bf16_t* Vb = (bf16_t*)(p->ws + OFF_V);
  bf16_t* LA = (bf16_t*)(p->ws + OFF_LORA);
  float* INVN = (float*)(p->ws + OFF_INVN);
  const float* mu = p->in[9];
  const float* kkw = p->in[15];
  for (int t = blockIdx.x * 4 + w; t < T; t += gridDim.x * 4) {
    const TokInfo ti = tokinfo(t);
    const bf16_t* cur = RWP + (size_t)t * 1792;
    const bf16_t* prv = cur - 1792;
    const float* sh = p->in[4] + (size_t)ti.b * 1792;
    float f[4][8];
#pragma unroll
    for (int i = 0; i < 4; ++i) {
      const int c8 = (lane + 64 * i) * 8;
      if (i < 3 || lane < 32) {
        float cv[8], pv[8];
        unpack8f(*(const uint4*)(cur + c8), cv);
        if (ti.l > 0) unpack8f(*(const uint4*)(prv + c8), pv);
        else if (ti.sample) {
          const float4 s0 = *(const float4*)(sh + c8), s1 = *(const float4*)(sh + c8 + 4);
          pv[0] = s0.x; pv[1] = s0.y; pv[2] = s0.z; pv[3] = s0.w; pv[4] = s1.x; pv[5] = s1.y; pv[6] = s1.z; pv[7] = s1.w;
        } else {
#pragma unroll
          for (int k = 0; k < 8; ++k) pv[k] = 0.f;
        }
        const float4 m0 = *(const float4*)(mu + c8), m1 = *(const float4*)(mu + c8 + 4);
        const float mm[8] = {m0.x, m0.y, m0.z, m0.w, m1.x, m1.y, m1.z, m1.w};
#pragma unroll
        for (int k = 0; k < 8; ++k) f[i][k] = cv[k] + (pv[k] - cv[k]) * mm[k];
      } else {
#pragma unroll
        for (int k = 0; k < 8; ++k) f[i][k] = 0.f;
      }
    }
    *(uint4*)(Rb + (size_t)t * 512 + lane * 8) = pack8f(f[0]);
    {
      const uint4 kb = pack8f(f[1]);
      *(uint4*)(Kb + (size_t)t * 512 + lane * 8) = kb;
      float kr[8];
      unpack8f(kb, kr);
      const float4 q0 = *(const float4*)(kkw + lane * 8), q1 = *(const float4*)(kkw + lane * 8 + 4);
      const float qq[8] = {q0.x, q0.y, q0.z, q0.w, q1.x, q1.y, q1.z, q1.w};
      float ss = 0.f;
#pragma unroll
      for (int k = 0; k < 8; ++k) { const float kq = kr[k] * qq[k]; ss += kq * kq; }
      ss = allreduce8(ss);
      if ((lane & 7) == 0) INVN[t * 8 + (lane >> 3)] = 1.f / fmaxf(sqrtf(ss), 1e-12f);
    }
    *(uint4*)(Vb + (size_t)t * 512 + lane * 8) = pack8f(f[2]);
    if (lane < 32) {
      float o[8];
#pragma unroll
      for (int k = 0; k < 8; ++k) {
        const float x = f[3][k];
        o[k] = (lane < 8) ? (1.f - 2.f * __builtin_amdgcn_rcpf(1.f + __expf(2.f * x))) : ((lane < 16) ? x : sigmoidf_(x));
      }
      *(uint4*)(LA + (size_t)t * 256 + lane * 8) = pack8f(o);
    }
  }
}

DI void phase3(KP p, char* smem) {
  const bf16_t* LA = (const bf16_t*)(p->ws + OFF_LORA);
  bf16_t* Kb = (bf16_t*)(p->ws + OFF_K);
  bf16_t* KKb = (bf16_t*)(p->ws + OFF_KK);
  bf16_t* BBb = (bf16_t*)(p->ws + OFF_BB);
  bf16_t* GTb = (bf16_t*)(p->ws + OFF_GATE);
  float* EW = (float*)(p->ws + OFF_EW);
  const float* INVN = (const float*)(p->ws + OFF_INVN);
  const float* w0 = p->in[10];
  const float* a0 = p->in[12];
  const float* kkw = p->in[15];
  const float* kaw = p->in[16];
  for (int item = blockIdx.x; item < 136 * 12; item += gridDim.x) {
    const int mt = item / 12, rem = item % 12, kind = rem >> 2, nt = rem & 3;
    const int m0 = mt * 128, n0 = nt * 128;
    f32x16 acc[2][2];
    if (kind == 0) {
      gemm128<false>(LA + (size_t)m0 * 256, 256, (const bf16_t*)(p->ws + OFF_W2) + n0 * 64, 64, 64, acc, smem);
      epi_each(acc, [&](int rr, int cc, float v) {
        const int t = m0 + rr, c = n0 + cc;
        const float x = v + w0[c];
        const float z = -x;
        const float sp = fmaxf(z, 0.f) + __logf(1.f + __expf(-fabsf(z)));
        const float ww = -sp - 0.5f;
        EW[(size_t)t * 512 + c] = __expf(-__expf(ww));
      });
    } else if (kind == 1) {
      gemm128<false>(LA + (size_t)m0 * 256 + 64, 256, (const bf16_t*)(p->ws + OFF_A2) + n0 * 64, 64, 64, acc, smem);
      {
        const int lane = tidx() & 63, w = tidx() >> 6;
        const int wm = w >> 1, wn = w & 1, r = lane & 31, h = lane >> 5;
#pragma unroll 1
        for (int mi = 0; mi < 2; ++mi) {
          const int tb = m0 + wm * 64 + mi * 32;
          float inv[16];
#pragma unroll
          for (int i = 0; i < 16; ++i) inv[i] = INVN[(tb + crow(i, h)) * 8 + ((n0 + wn * 64) >> 6)];
#pragma unroll
          for (int ni = 0; ni < 2; ++ni) {
            const int c = n0 + wn * 64 + ni * 32 + r;
            const float a0c = a0[c], kkc = kkw[c], kac = kaw[c];
            float k7v[16];
#pragma unroll
            for (int i = 0; i < 16; ++i) k7v[i] = bf2f(Kb[(size_t)(tb + crow(i, h)) * 512 + c]);
#pragma unroll
            for (int i = 0; i < 16; ++i) {
              const float av = (mi == 0) ? acc[0][ni][i] : acc[1][ni][i];
              const float a = sigmoidf_(av + a0c);
              const size_t o = (size_t)(tb + crow(i, h)) * 512 + c;
              const float kkv = k7v[i] * kkc * inv[i];
              Kb[o] = f2bf(k7v[i] * (1.f + (a - 1.f) * kac));
              KKb[o] = f2bf(kkv);
              BBb[o] = f2bf(kkv * a);
            }
          }
        }
      }
    } else {
      gemm128<false>(LA + (size_t)m0 * 256 + 128, 256, (const bf16_t*)(p->ws + OFF_G2) + n0 * 128, 128, 128, acc, smem);
      epi_each(acc, [&](int rr, int cc, float v) { GTb[(size_t)(m0 + rr) * 512 + n0 + cc] = f2bf(v); });
    }
  }
}

DI void rwkv_scan(KP p, int tok0, int hd, int q, int nsteps, const float* __restrict__ S0, float* __restrict__ Sout, char* smem) {
  const int tid = tidx(), lane = tid & 63, w = tid >> 6, g = lane >> 4, l16 = lane & 15;
  const int rl = w * 4 + g;
  const int row = q * 16 + rl;
  const int j0 = l16 * 4;
  const bf16_t* Rb = (const bf16_t*)(p->ws + OFF_R);
  const bf16_t* Kb = (const bf16_t*)(p->ws + OFF_K);
  const bf16_t* Vb = (const bf16_t*)(p->ws + OFF_V);
  const bf16_t* KKb = (const bf16_t*)(p->ws + OFF_KK);
  const bf16_t* BBb = (const bf16_t*)(p->ws + OFF_BB);
  const float* EW = (const float*)(p->ws + OFF_EW);
  bf16_t* ACT = (bf16_t*)(p->ws + OFF_ACT);
  float* ew_s = (float*)smem;
  float* kk_s = ew_s + 2048;
  float* bb_s = kk_s + 2048;
  float* kp_s = bb_s + 2048;
  float* r_s = kp_s + 2048;
  float* v_s = r_s + 2048;
  float* y_s = v_s + 512;
  f2_t s01 = (f2_t){0.f, 0.f}, s23 = (f2_t){0.f, 0.f};
  if (S0) { const float4 t4 = *(const float4*)(S0 + row * 64 + j0); s01 = (f2_t){t4.x, t4.y}; s23 = (f2_t){t4.z, t4.w}; }
  uint4 rg_r = make_uint4(0, 0, 0, 0), rg_k = rg_r, rg_kk = rg_r, rg_bb = rg_r, rg_v = rg_r;
  float4 rg_e0 = make_float4(0, 0, 0, 0), rg_e1 = rg_e0;
  const int st_l = tid >> 3, c8 = (tid & 7) * 8;
  auto gload = [&](int sb) {
    if (sb + st_l < nsteps) {
      const size_t o = (size_t)(tok0 + sb + st_l) * 512 + hd * 64 + c8;
      rg_r = *(const uint4*)(Rb + o);
      rg_k = *(const uint4*)(Kb + o);
      rg_kk = *(const uint4*)(KKb + o);
      rg_bb = *(const uint4*)(BBb + o);
      rg_e0 = *(const float4*)(EW + o);
      rg_e1 = *(const float4*)(EW + o + 4);
    }
    if (tid < 64) {
      const int sv = tid >> 1;
      if (sb + sv < nsteps) rg_v = *(const uint4*)(Vb + (size_t)(tok0 + sb + sv) * 512 + hd * 64 + q * 16 + (tid & 1) * 8);
    }
  };
  auto unpack8 = [&](float* d, const uint4& u) {
    *(float4*)d = make_float4(lo2f(u.x), hi2f(u.x), lo2f(u.y), hi2f(u.y));
    *(float4*)(d + 4) = make_float4(lo2f(u.z), hi2f(u.z), lo2f(u.w), hi2f(u.w));
  };
  auto sstore = [&]() {
    const int o = st_l * 64 + c8;
    unpack8(r_s + o, rg_r);
    unpack8(kp_s + o, rg_k);
    unpack8(kk_s + o, rg_kk);
    unpack8(bb_s + o, rg_bb);
    *(float4*)(ew_s + o) = rg_e0;
    *(float4*)(ew_s + o + 4) = rg_e1;
    if (tid < 64) unpack8(v_s + (tid >> 1) * 16 + (tid & 1) * 8, rg_v);
  };
  gload(0);
  for (int sb = 0; sb < nsteps; sb += 32) {
    __syncthreads();
    sstore();
    __syncthreads();
    if (sb + 32 < nsteps) gload(sb + 32);
    const int tc = min(32, nsteps - sb);
#define SC_LD(X, st)                                              \
  {                                                               \
    const float* b_ = ew_s + (st) * 64 + j0;                      \
    X##e = *(const float4*)(b_);                                  \
    X##q = *(const float4*)(b_ + 2048);                           \
    X##b = *(const float4*)(b_ + 4096);                           \
    X##k = *(const float4*)(b_ + 6144);                           \
    X##r = *(const float4*)(b_ + 8192);                           \
    X##v = v_s[(st) * 16 + rl];                                   \
  }
#define SC_STEP(X, st)                                                                     \
  {                                                                                        \
    const f2_t p2 = s01 * (f2_t){X##q.x, X##q.y} + s23 * (f2_t){X##q.z, X##q.w};           \
    float pdp = p2.x + p2.y;                                                               \
      \
    const f2_t vk01 = (f2_t){X##k.x, X##k.y} * X##v, vk23 = (f2_t){X##k.z, X##k.w} * X##v; \
    const f2_t base01 = s01 * (f2_t){X##e.x, X##e.y} + vk01;                               \
    const f2_t base23 = s23 * (f2_t){X##e.z, X##e.w} + vk23;                               \
    allreduce16x2(pdp, ypart);     \
    if (l16 == 0 && (st) > 0) y_s[((st) - 1) * 16 + rl] = ypart;                           \
    s01 = base01 - (f2_t){X##b.x, X##b.y} * pdp;                              \
    s23 = base23 - (f2_t){X##b.z, X##b.w} * pdp;                                           \
    const f2_t y2 = s01 * (f2_t){X##r.x, X##r.y} + s23 * (f2_t){X##r.z, X##r.w};           \
    ypart = y2.x + y2.y;                                                                   \
  }
    {
      float4 Ae, Aq, Ab, Ak, Ar, Be, Bq, Bb, Bk, Br;
      float Av, Bv;
      float ypart = 0.f;
      SC_LD(A, 0)
      for (int st = 0; st < tc; st += 2) {
        SC_LD(B, st + 1)
        SC_STEP(A, st)
        SC_LD(A, min(st + 2, tc - 1))
        SC_STEP(B, st + 1)
      }
      ypart = allreduce16(ypart);
      if (l16 == 0) y_s[(tc - 1) * 16 + rl] = ypart;
    }
    __syncthreads();
    if (tid < tc * 8) {
      const int st = tid >> 3, pr = tid & 7;
      const unsigned pk = pack2(y_s[st * 16 + 2 * pr], y_s[st * 16 + 2 * pr + 1]);
      *(unsigned*)(ACT + (size_t)(tok0 + sb + st) * 1024 + 512 + hd * 64 + q * 16 + 2 * pr) = pk;
    }
  }
  *(float4*)(Sout + row * 64 + j0) = make_float4(s01.x, s01.y, s23.x, s23.y);
}

constexpr int RL = 136;
DI void ret_prompt(KP p, int b, int hd, char* smem) {
  const int tid = tidx(), lane = tid & 63, w = tid >> 6, r = lane & 31, h = lane >> 5;
  const bf16_t* RET = (const bf16_t*)p->out;
  bf16_t* ACT = (bf16_t*)(p->ws + OFF_ACT);
  bf16_t* Vt = (bf16_t*)smem;
  bf16_t* Kzt = (bf16_t*)(smem + 17408);
  bf16_t* St = (bf16_t*)(smem + 34816);
  bf16_t* Sc = (bf16_t*)(smem + 44032);
  float* Of = (float*)(smem + 44032);
  float* dec = (float*)(smem + 78848);
  const float lg = log1pf(-exp2f(-5.f - (float)hd));
  if (tid < 129) dec[tid] = expf((float)tid * lg);
  for (int e = tid; e < 64 * 72; e += 256) St[e] = 0;
  __syncthreads();
  const float g128 = dec[128];
  f32x16 Sacc;
#pragma unroll
  for (int e = 0; e < 16; ++e) Sacc[e] = 0.f;
  const int vt = w >> 1, dt = w & 1;
  for (int c = 0; c < 16; ++c) {
    const int tokc = b * 2048 + c * 128;
    {
      const int j = tid >> 1, hf = tid & 1;
      const bf16_t* vsrc = RET + (size_t)(tokc + j) * 2048 + 1024 + hd * 64 + hf * 32;
      const bf16_t* ksrc = RET + (size_t)(tokc + j) * 2048 + 512 + hd * 64 + hf * 32;
      const float zj = dec[127 - j];
#pragma unroll
      for (int qd = 0; qd < 4; ++qd) {
        const uint4 uv = *(const uint4*)(vsrc + qd * 8);
        const uint4 uk = *(const uint4*)(ksrc + qd * 8);
        const unsigned vv[4] = {uv.x, uv.y, uv.z, uv.w};
        const unsigned kk[4] = {uk.x, uk.y, uk.z, uk.w};
#pragma unroll
        for (int e = 0; e < 4; ++e) {
          const int col = hf * 32 + qd * 8 + e * 2;
          Vt[col * RL + j] = (bf16_t)(vv[e] & 0xffffu);
          Vt[(col + 1) * RL + j] = (bf16_t)(vv[e] >> 16);
          Kzt[col * RL + j] = f2bf(lo2f(kk[e]) * zj);
          Kzt[(col + 1) * RL + j] = f2bf(hi2f(kk[e]) * zj);
        }
      }
    }
    bf16x8 qf[4];
    {
      const bf16_t* qsrc = RET + (size_t)(tokc + 32 * w + r) * 2048 + hd * 64 + h * 8;
#pragma unroll
      for (int ks = 0; ks < 4; ++ks) qf[ks] = *(const bf16x8*)(qsrc + ks * 16);
    }
#pragma unroll
    for (int jb = 0; jb < 2; ++jb) {
      bf16x8 kf[2][4];
#pragma unroll
      for (int jj = 0; jj < 2; ++jj) {
        const int jt = jb * 2 + jj;
        if (jt <= w) {
          const bf16_t* ksrc = RET + (size_t)(tokc + 32 * jt + r) * 2048 + 512 + hd * 64 + h * 8;
#pragma unroll
          for (int ks = 0; ks < 4; ++ks) kf[jj][ks] = *(const bf16x8*)(ksrc + ks * 16);
        }
      }
#pragma unroll
      for (int jj = 0; jj < 2; ++jj) {
        const int jt = jb * 2 + jj;
        if (jt <= w) {
          f32x16 sc;
#pragma unroll
          for (int e = 0; e < 16; ++e) sc[e] = 0.f;
#pragma unroll
          for (int ks = 0; ks < 4; ++ks) sc = __builtin_amdgcn_mfma_f32_32x32x16_bf16(qf[ks], kf[jj][ks], sc, 0, 0, 0);
#pragma unroll
          for (int e = 0; e < 16; ++e) {
            const int i = 32 * w + crow(e, h), j = 32 * jt + r;
            const int d = i - j;
            const float val = (d >= 0) ? sc[e] * dec[d >= 0 ? d : 0] : 0.f;
            Sc[i * RL + j] = f2bf(val);
          }
        }
      }
    }
    __syncthreads();
    f32x16 oacc[2];
#pragma unroll
    for (int nt = 0; nt < 2; ++nt) {
#pragma unroll
      for (int e = 0; e < 16; ++e) oacc[nt][e] = 0.f;
#pragma unroll
      for (int ks = 0; ks < 4; ++ks) {
        const bf16x8 sf = *(const bf16x8*)(St + (nt * 32 + r) * 72 + ks * 16 + h * 8);
        oacc[nt] = __builtin_amdgcn_mfma_f32_32x32x16_bf16(qf[ks], sf, oacc[nt], 0, 0, 0);
      }
#pragma unroll
      for (int e = 0; e < 16; ++e) oacc[nt][e] *= dec[32 * w + crow(e, h) + 1];
    }
    for (int ks = 0; ks < 2 * (w + 1); ++ks) {
      const bf16x8 af = *(const bf16x8*)(Sc + (32 * w + r) * RL + ks * 16 + h * 8);
#pragma unroll
      for (int nt = 0; nt < 2; ++nt) {
        const bf16x8 vf = *(const bf16x8*)(Vt + (nt * 32 + r) * RL + ks * 16 + h * 8);
        oacc[nt] = __builtin_amdgcn_mfma_f32_32x32x16_bf16(af, vf, oacc[nt], 0, 0, 0);
      }
    }
#pragma unroll
    for (int e = 0; e < 16; ++e) Sacc[e] *= g128;
#pragma unroll
    for (int ks = 0; ks < 8; ++ks) {
      const bf16x8 af = *(const bf16x8*)(Vt + (vt * 32 + r) * RL + ks * 16 + h * 8);
      const bf16x8 bf = *(const bf16x8*)(Kzt + (dt * 32 + r) * RL + ks * 16 + h * 8);
      Sacc = __builtin_amdgcn_mfma_f32_32x32x16_bf16(af, bf, Sacc, 0, 0, 0);
    }
    __syncthreads();
#pragma unroll
    for (int nt = 0; nt < 2; ++nt)
#pragma unroll
      for (int e = 0; e < 16; ++e) Of[(32 * w + crow(e, h)) * 66 + nt * 32 + r] = oacc[nt][e];
#pragma unroll
    for (int e = 0; e < 16; ++e) St[(vt * 32 + crow(e, h)) * 72 + dt * 32 + r] = f2bf(Sacc[e]);
    __syncthreads();
    {
      const int i = tid >> 1, hf = tid & 1;
      const int t = tokc + i;
      float vals[32];
      float sm = 0.f;
#pragma unroll
      for (int k = 0; k < 32; ++k) { vals[k] = Of[i * 66 + hf * 32 + k]; sm += vals[k]; }
      sm += __shfl_xor(sm, 1);
      const float mean = sm * (1.f / 64.f);
      float vs = 0.f;
#pragma unroll
      for (int k = 0; k < 32; ++k) { vals[k] -= mean; vs += vals[k] * vals[k]; }
      vs += __shfl_xor(vs, 1);
      const float rs = rsqrtf(vs * (1.f / 64.f) + 1e-5f);
      const bf16_t* gsrc = RET + (size_t)t * 2048 + 1536 + hd * 64 + hf * 32;
      bf16_t* dst = ACT + (size_t)t * 1024 + hd * 64 + hf * 32;
#pragma unroll
      for (int qd = 0; qd < 4; ++qd) {
        const uint4 ug = *(const uint4*)(gsrc + qd * 8);
        const unsigned gg[4] = {ug.x, ug.y, ug.z, ug.w};
        unsigned o4[4];
#pragma unroll
        for (int e = 0; e < 4; ++e) {
          const float g0 = lo2f(gg[e]), g1 = hi2f(gg[e]);
          const float a0 = vals[qd * 8 + 2 * e] * rs * (g0 * sigmoidf_(g0));
          const float a1 = vals[qd * 8 + 2 * e + 1] * rs * (g1 * sigmoidf_(g1));
          o4[e] = pack2(a0, a1);
        }
        *(uint4*)(dst + qd * 8) = make_uint4(o4[0], o4[1], o4[2], o4[3]);
      }
    }
    __syncthreads();
  }
  float* so = p->out + O_RETP + (size_t)(b * 8 + hd) * 4096;
#pragma unroll
  for (int gq = 0; gq < 4; ++gq)
    *(float4*)(so + (dt * 32 + r) * 64 + vt * 32 + 8 * gq + 4 * h) =
        make_float4(Sacc[4 * gq], Sacc[4 * gq + 1], Sacc[4 * gq + 2], Sacc[4 * gq + 3]);
}

DI void ret_sample(KP p, int b, int hd, char* smem) {
  const int tid = tidx();
  const bf16_t* RET = (const bf16_t*)p->out;
  bf16_t* ACT = (bf16_t*)(p->ws + OFF_ACT);
  float* q_s = (float*)smem;
  float* k_s = q_s + 512;
  float* v_s = k_s + 512;
  float* A_s = v_s + 512;
  float* part = A_s + 64;
  const int tok0 = TP + b * 8;
  const float lg = log1pf(-exp2f(-5.f - (float)hd));
  __syncthreads();
  {
    const int e = tid * 2, rw = e >> 6, cl = e & 63;
    const bf16_t* base = RET + (size_t)(tok0 + rw) * 2048 + hd * 64 + cl;
    const unsigned uq = *(const unsigned*)(base), uk = *(const unsigned*)(base + 512), uv = *(const unsigned*)(base + 1024);
    q_s[e] = lo2f(uq); q_s[e + 1] = hi2f(uq);
    k_s[e] = lo2f(uk); k_s[e + 1] = hi2f(uk);
    v_s[e] = lo2f(uv); v_s[e + 1] = hi2f(uv);
  }
  __syncthreads();
  if (tid < 64) {
    const int i = tid >> 3, j = tid & 7;
    float a = 0.f;
    if (i >= j) {
#pragma unroll 4
      for (int d = 0; d < 64; ++d) a = fmaf(q_s[i * 64 + d], k_s[j * 64 + d], a);
      a *= expf((float)(i - j) * lg);
    }
    A_s[tid] = a;
  }
  {
    const int dg = tid >> 6, v = tid & 63;
    const float* S0 = p->in[2] + (size_t)(b * 8 + hd) * 4096;
    float* So = p->out + O_RETS + (size_t)(b * 8 + hd) * 4096;
    float oi[8];
#pragma unroll
    for (int i = 0; i < 8; ++i) oi[i] = 0.f;
    const float g8 = expf(8.f * lg);
    float kv[8];
#pragma unroll
    for (int j = 0; j < 8; ++j) kv[j] = v_s[j * 64 + v] * expf((float)(7 - j) * lg);
#pragma unroll 1
    for (int hb = 0; hb < 2; ++hb) {
      float sv[8];
#pragma unroll
      for (int dd = 0; dd < 8; ++dd) sv[dd] = S0[(dg * 16 + hb * 8 + dd) * 64 + v];
#pragma unroll
      for (int dd = 0; dd < 8; ++dd) {
        const int d = dg * 16 + hb * 8 + dd;
        const float s = sv[dd];
        float sn = s * g8;
#pragma unroll
        for (int j = 0; j < 8; ++j) sn = fmaf(k_s[j * 64 + d], kv[j], sn);
        So[d * 64 + v] = sn;
#pragma unroll
        for (int i = 0; i < 8; ++i) oi[i] = fmaf(q_s[i * 64 + d], s, oi[i]);
      }
    }
#pragma unroll
    for (int i = 0; i < 8; ++i) part[(dg * 8 + i) * 64 + v] = oi[i];
  }
  __syncthreads();
#pragma unroll
  for (int rep = 0; rep < 2; ++rep) {
    const int i = (tid >> 6) + 4 * rep, v = tid & 63;
    float o = part[(0 * 8 + i) * 64 + v] + part[(1 * 8 + i) * 64 + v] + part[(2 * 8 + i) * 64 + v] + part[(3 * 8 + i) * 64 + v];
    o *= expf((float)(i + 1) * lg);
    for (int j = 0; j <= i; ++j) o = fmaf(A_s[i * 8 + j], v_s[j * 64 + v], o);
    const float mean = wave_sum(o) * (1.f / 64.f);
    const float dv = o - mean;
    const float var = wave_sum(dv * dv) * (1.f / 64.f);
    const int t = tok0 + i;
    const float gt = bf2f(RET[(size_t)t * 2048 + 1536 + hd * 64 + v]);
    ACT[(size_t)t * 1024 + hd * 64 + v] = f2bf(dv * rsqrtf(var + 1e-5f) * (gt * sigmoidf_(gt)));
  }
}

constexpr size_t TAB_V8 = (size_t)16384 * 1024;
constexpr size_t TAB_SC = (size_t)2 * 16384 * 1024;
DI void convert_tab(KP p, int it) {
  const int tid = tidx(), lane = tid & 63, w = tid >> 6;
  const int row0 = it * 8 + w * 2;
  const float* src = (row0 < 16384) ? p->in[24] + (size_t)row0 * 1024 : p->in[25] + (size_t)(row0 - 16384) * 1024;
  float4 v[2][4];
#pragma unroll
  for (int rr = 0; rr < 2; ++rr)
#pragma unroll
    for (int i = 0; i < 4; ++i) v[rr][i] = *(const float4*)(src + rr * 1024 + i * 256 + lane * 4);
#pragma unroll
  for (int rr = 0; rr < 2; ++rr) {
    float am = 0.f;
#pragma unroll
    for (int i = 0; i < 4; ++i)
      am = fmaxf(am, fmaxf(fmaxf(fabsf(v[rr][i].x), fabsf(v[rr][i].y)), fmaxf(fabsf(v[rr][i].z), fabsf(v[rr][i].w))));
#pragma unroll
    for (int o = 32; o >= 1; o >>= 1) am = fmaxf(am, __shfl_xor(am, o));
    am = fmaxf(am, 1e-30f);
    const float inv = 127.f / am;
    unsigned char* dst = (unsigned char*)(p->ws + OFF_TAB) + (size_t)(row0 + rr) * 1024;
#pragma unroll
    for (int i = 0; i < 4; ++i) {
      const unsigned q0 = (unsigned)((int)rintf(v[rr][i].x * inv) + 128);
      const unsigned q1 = (unsigned)((int)rintf(v[rr][i].y * inv) + 128);
      const unsigned q2 = (unsigned)((int)rintf(v[rr][i].z * inv) + 128);
      const unsigned q3 = (unsigned)((int)rintf(v[rr][i].w * inv) + 128);
      *(unsigned*)(dst + i * 256 + lane * 4) = q0 | (q1 << 8) | (q2 << 16) | (q3 << 24);
    }
    if (lane == 0) ((float*)(p->ws + OFF_TAB + TAB_SC))[row0 + rr] = am * (1.f / 127.f);
  }
}

DI void phase4_other(KP p, int it, char* smem) {
  if (it < 64) { ret_prompt(p, it >> 3, it & 7, smem); return; }
  it -= 64;
  if (it < 4096) {
    const int bh = it >> 2, q = it & 3, b = bh >> 3, hd = bh & 7;
    rwkv_scan(p, TP + b * 8, hd, q, 8, p->in[3] + (size_t)bh * 4096, p->out + O_WKVS + (size_t)bh * 4096, smem);
    return;
  }
  it -= 4096;
  if (it < 1024) { ret_sample(p, it >> 3, it & 7, smem); return; }
  it -= 1024;
  if (it < 4096) { convert_tab(p, it); return; }
  it -= 4096;
#define TJ4(IDX, OFF, KK_, NN_)                                                                            \
  {                                                                                                        \
    const int ntl = ((KK_) / 64) * ((NN_) / 64);                                                           \
    if (it < ntl) {                                                                                        \
      transpose_tile(p->in[IDX], (bf16_t*)(p->ws + (OFF)), (KK_), (NN_), it / ((NN_) / 64), it % ((NN_) / 64), (float*)smem); \
      return;                                                                                              \
    }                                                                                                      \
    it -= ntl;                                                                                             \
  }
  TJ4(20, OFF_WOUT, 1024, 1024)
  TJ4(22, OFF_WQ, 1024, 2048)
  TJ4(27, OFF_PG, 1024, 1024)
  TJ4(28, OFF_PP, 256, 1024)
}
DI void phase4(KP p, char* smem) {
  constexpr int N_OTHER = 64 + 4096 + 1024 + 4096 + (256 + 512 + 256 + 64);
  int* s_item = (int*)(smem + SMEM_BYTES - 16);
  unsigned* ctr = (unsigned*)(p->ws + OFF_CTR);
  unsigned* cukey = (unsigned*)(p->ws + OFF_CTR + 16384);
  __syncthreads();
  if (tidx() == 0) {
    const unsigned hw = (unsigned)__builtin_amdgcn_s_getreg((7 << 11) | (8 << 6) | 4);
    const unsigned key = (xb_xcc_id() << 8) | (hw & 0xffu);
    const unsigned old = atomicAdd(&cukey[key], 1u);
    int it = -1;
    if (old == 0u) { const unsigned q = atomicAdd(&ctr[1], 1u); if (q < 256u) it = (int)q; }
    *s_item = it;
  }
  __syncthreads();
  {
    const int it = *s_item;
    if (it >= 0) {
      const int bh = it >> 2, q = it & 3, b = bh >> 3, hd = bh & 7;
      __builtin_amdgcn_s_setprio(3);
      rwkv_scan(p, b * 2048, hd, q, 2048, nullptr, p->out + O_WKVP + (size_t)bh * 4096, smem);
      __builtin_amdgcn_s_setprio(0);
    }
  }
  for (;;) {
    __syncthreads();
    if (tidx() == 0) *s_item = (int)atomicAdd(&ctr[0], 1u);
    __syncthreads();
    const int it = *s_item;
    if (it >= N_OTHER) break;
    phase4_other(p, it, smem);
  }
  for (;;) {
    __syncthreads();
    if (tidx() == 0) *s_item = (int)atomicAdd(&ctr[1], 1u);
    __syncthreads();
    const int it = *s_item;
    if (it >= 256) break;
    const int bh = it >> 2, q = it & 3, b = bh >> 3, hd = bh & 7;
    rwkv_scan(p, b * 2048, hd, q, 2048, nullptr, p->out + O_WKVP + (size_t)bh * 4096, smem);
  }
}

DI void phase5(KP p) {
  const int lane = tidx() & 63, w = tidx() >> 6;
  bf16_t* ACT = (bf16_t*)(p->ws + OFF_ACT);
  const bf16_t* Rb = (const bf16_t*)(p->ws + OFF_R);
  const bf16_t* Kb = (const bf16_t*)(p->ws + OFF_K);
  const bf16_t* Vb = (const bf16_t*)(p->ws + OFF_V);
  const bf16_t* GTb = (const bf16_t*)(p->ws + OFF_GATE);
  const int c8 = lane * 8;
  float rk8[8], lg8[8], lb8[8];
  {
    const float4 a0 = *(const float4*)(p->in[17] + c8), a1 = *(const float4*)(p->in[17] + c8 + 4);
    const float4 b0 = *(const float4*)(p->in[18] + c8), b1 = *(const float4*)(p->in[18] + c8 + 4);
    const float4 d0 = *(const float4*)(p->in[19] + c8), d1 = *(const float4*)(p->in[19] + c8 + 4);
    rk8[0] = a0.x; rk8[1] = a0.y; rk8[2] = a0.z; rk8[3] = a0.w; rk8[4] = a1.x; rk8[5] = a1.y; rk8[6] = a1.z; rk8[7] = a1.w;
    lg8[0] = b0.x; lg8[1] = b0.y; lg8[2] = b0.z; lg8[3] = b0.w; lg8[4] = b1.x; lg8[5] = b1.y; lg8[6] = b1.z; lg8[7] = b1.w;
    lb8[0] = d0.x; lb8[1] = d0.y; lb8[2] = d0.z; lb8[3] = d0.w; lb8[4] = d1.x; lb8[5] = d1.y; lb8[6] = d1.z; lb8[7] = d1.w;
  }
  for (int t = blockIdx.x * 4 + w; t < T; t += gridDim.x * 4) {
    const size_t o = (size_t)t * 512 + c8;
    bf16_t* yp = ACT + (size_t)t * 1024 + 512 + c8;
    const uint4 uy = *(const uint4*)yp, ur = *(const uint4*)(Rb + o), uk = *(const uint4*)(Kb + o),
                uv = *(const uint4*)(Vb + o), ug = *(const uint4*)(GTb + o);
    float y[8], r[8], k[8], v[8], g[8];
    unpack8f(uy, y); unpack8f(ur, r); unpack8f(uk, k); unpack8f(uv, v); unpack8f(ug, g);
    float sm = 0.f, rk = 0.f;
#pragma unroll
    for (int e = 0; e < 8; ++e) { sm += y[e]; rk = fmaf(r[e] * k[e], rk8[e], rk); }
    sm = allreduce8(sm);
    rk = allreduce8(rk);
    const float mean = sm * (1.f / 64.f);
    float vs = 0.f;
#pragma unroll
    for (int e = 0; e < 8; ++e) { y[e] -= mean; vs += y[e] * y[e]; }
    vs = allreduce8(vs);
    const float rs = rsqrtf(vs * (1.f / 64.f) + 64e-5f);
    float ov[8];
#pragma unroll
    for (int e = 0; e < 8; ++e) ov[e] = (y[e] * rs * lg8[e] + lb8[e] + rk * v[e]) * g[e];
    *(uint4*)yp = pack8f(ov);
  }
}

DI void phase6(KP p, char* smem) {
  for (int tile = blockIdx.x; tile < 136 * 8; tile += gridDim.x) {
    const int mt = tile >> 3, nt = tile & 7;
    const int m0 = mt * 128, n0 = nt * 128;
    f32x16 acc[2][2];
    gemm128<false>((const bf16_t*)(p->ws + OFF_ACT) + (size_t)m0 * 1024, 1024,
                   (const bf16_t*)(p->ws + OFF_WOUT) + (size_t)n0 * 1024, 1024, 1024, acc, smem);
    {
      const int lane = tidx() & 63, w = tidx() >> 6;
      const int wm = w >> 1, wn = w & 1, r = lane & 31, h = lane >> 5;
      const float* xb = (m0 < TP) ? p->in[0] + (size_t)m0 * 1024 : p->in[1] + (size_t)(m0 - TP) * 1024;
#pragma unroll
      for (int mi = 0; mi < 2; ++mi)
#pragma unroll
        for (int ni = 0; ni < 2; ++ni)
#pragma unroll
          for (int i = 0; i < 16; ++i)
            acc[mi][ni][i] += xb[(size_t)(wm * 64 + mi * 32 + crow(i, h)) * 1024 + n0 + wn * 64 + ni * 32 + r];
#pragma unroll
      for (int mi = 0; mi < 2; ++mi)
#pragma unroll
        for (int ni = 0; ni < 2; ++ni)
#pragma unroll
          for (int i = 0; i < 16; ++i)
            p->out[(size_t)(m0 + wm * 64 + mi * 32 + crow(i, h)) * 1024 + n0 + wn * 64 + ni * 32 + r] = acc[mi][ni][i];
    }
  }
}

DI void phase7(KP p) {
  const int lane = tidx() & 63, w = tidx() >> 6;
  for (int t = blockIdx.x * 4 + w; t < T; t += gridDim.x * 4)
    rmsnorm_row_bf(p->out + (size_t)t * 1024, p->in[21], (bf16_t*)(p->ws + OFF_ACT) + (size_t)t * 1024, lane);
}

DI void phase8(KP p, char* smem) {
  bf16_t* QP = (bf16_t*)(p->ws + OFF_QPEER);
  for (int tile = blockIdx.x; tile < 136 * 16; tile += gridDim.x) {
    const int mt = tile >> 4, nt = tile & 15;
    const int m0 = mt * 128, n0 = nt * 128;
    f32x16 acc[2][2];
    gemm128<false>((const bf16_t*)(p->ws + OFF_ACT) + (size_t)m0 * 1024, 1024,
                   (const bf16_t*)(p->ws + OFF_WQ) + (size_t)n0 * 1024, 1024, 1024, acc, smem);
    epi_each(acc, [&](int rr, int cc, float v) { QP[(size_t)(m0 + rr) * 2048 + n0 + cc] = f2bf(v); });
  }
}

DI unsigned sortkey(float f) { unsigned u = __float_as_uint(f); return (u & 0x80000000u) ? ~u : (u | 0x80000000u); }
DI float unsortkey(unsigned k) { unsigned u = (k & 0x80000000u) ? (k ^ 0x80000000u) : ~k; return __uint_as_float(u); }
DI void ins16(unsigned (&l)[16], unsigned x) {
#pragma unroll
  for (int i = 0; i < 16; ++i) { const unsigned hi = max(l[i], x); x = min(l[i], x); l[i] = hi; }
}
DI void cswap_desc(unsigned& a, unsigned& b) { const unsigned hi = max(a, b), lo = min(a, b); a = hi; b = lo; }
DI void bsort16(unsigned (&v)[16]) {
#pragma unroll
  for (int ke = 1; ke <= 4; ++ke)
#pragma unroll
    for (int je = ke - 1; je >= 0; --je)
#pragma unroll
      for (int i = 0; i < 16; ++i) {
        const int k = 1 << ke, j = 1 << je, l = i ^ j;
        if (l > i) { if ((i & k) == 0) cswap_desc(v[i], v[l]); else cswap_desc(v[l], v[i]); }
      }
}
DI void bmerge16(unsigned (&a)[16], const unsigned (&b)[16]) {
#pragma unroll
  for (int i = 0; i < 16; ++i) a[i] = max(a[i], b[15 - i]);
#pragma unroll
  for (int je = 3; je >= 0; --je)
#pragma unroll
    for (int i = 0; i < 16; ++i) {
      const int j = 1 << je, l = i ^ j;
      if (l > i) cswap_desc(a[i], a[l]);
    }
}
DI void phase9(KP p, char* smem) {
  const int tid = tidx();
  const bf16_t* QP = (const bf16_t*)(p->ws + OFF_QPEER);
  const bf16_t* KEYS = (const bf16_t*)(p->ws + OFF_KEYS);
  int* IDX = (int*)(p->ws + OFF_IDX);
  float* GSM = (float*)(p->ws + OFF_GSM);
  float* sc = (float*)smem;
  unsigned* mrg = (unsigned*)smem;
  const int row = tid >> 1, half = tid & 1;
  for (int item = blockIdx.x; item < 136 * 8; item += gridDim.x) {
    const int mt = item >> 3, hd = item & 7;
    const int m0 = mt * 128;
    unsigned kc[2][16];
#pragma unroll
    for (int c = 0; c < 2; ++c) {
      f32x16 acc[2][2];
      gemm128<false>(QP + (size_t)m0 * 2048 + (hd * 2 + c) * 128, 2048, KEYS + (size_t)(hd * 2 + c) * 16384, 128, 128, acc, smem);
      __syncthreads();
      epi_each(acc, [&](int rr, int cc, float v) { sc[rr * 129 + cc] = v; });
      __syncthreads();
      unsigned lst[16];
#pragma unroll
      for (int gi = 0; gi < 4; ++gi) {
        unsigned grp[16];
#pragma unroll
        for (int i = 0; i < 16; ++i) {
          const int col = half * 64 + gi * 16 + i;
          grp[i] = (sortkey(sc[row * 129 + col]) & ~127u) | (unsigned)(127 - col);
        }
        bsort16(grp);
        if (gi == 0) {
#pragma unroll
          for (int i = 0; i < 16; ++i) lst[i] = grp[i];
        } else {
          bmerge16(lst, grp);
        }
      }
      __syncthreads();
      if (half) {
#pragma unroll
        for (int i = 0; i < 16; ++i) mrg[row * 16 + i] = lst[i];
      }
      __syncthreads();
      if (!half) {
        unsigned grp[16];
#pragma unroll
        for (int i = 0; i < 16; ++i) grp[i] = mrg[row * 16 + i];
        bmerge16(lst, grp);
      }
#pragma unroll
      for (int i = 0; i < 16; ++i) kc[c][i] = lst[i];
    }
    if (!half) {
      float sv0[16], sv1[16];
#pragma unroll
      for (int i = 0; i < 16; ++i) { sv0[i] = unsortkey(kc[0][i] & ~127u); sv1[i] = unsortkey(kc[1][i] & ~127u); }
      unsigned cl[16];
#pragma unroll
      for (int i = 0; i < 16; ++i) cl[i] = 0u;
#pragma unroll
      for (int a = 0; a < 16; ++a)
#pragma unroll
        for (int b = 0; b < 16 / (a + 1); ++b)
          ins16(cl, (sortkey(sv0[a] + sv1[b]) & ~255u) | (unsigned)(255 - (a * 16 + b)));
      float ex[16];
      float sum = 0.f;
      const float mx = unsortkey(cl[0] & ~255u);
#pragma unroll
      for (int i = 0; i < 16; ++i) { ex[i] = __expf(unsortkey(cl[i] & ~255u) - mx); sum += ex[i]; }
      const float inv = 1.f / sum;
      int eo[16];
#pragma unroll
      for (int i = 0; i < 16; ++i) {
        const int ci = 255 - (int)(cl[i] & 255u);
        const int a = ci >> 4, b = ci & 15;
        int i0 = 0, i1 = 0;
#pragma unroll
        for (int k = 0; k < 16; ++k) {
          i0 = (a == k) ? (127 - (int)(kc[0][k] & 127u)) : i0;
          i1 = (b == k) ? (127 - (int)(kc[1][k] & 127u)) : i1;
        }
        eo[i] = i0 * 128 + i1;
        ex[i] *= inv;
      }
      const size_t o = ((size_t)(m0 + row) * 8 + hd) * 16;
#pragma unroll
      for (int qd = 0; qd < 4; ++qd) {
        *(int4*)(IDX + o + qd * 4) = make_int4(eo[qd * 4], eo[qd * 4 + 1], eo[qd * 4 + 2], eo[qd * 4 + 3]);
        *(float4*)(GSM + o + qd * 4) = make_float4(ex[qd * 4], ex[qd * 4 + 1], ex[qd * 4 + 2], ex[qd * 4 + 3]);
      }
    }
  }
}

#define UB0(u) ((float)((u) & 0xffu))
#define UB1(u) ((float)(((u) >> 8) & 0xffu))
#define UB2(u) ((float)(((u) >> 16) & 0xffu))
#define UB3(u) ((float)((u) >> 24))
template <int MODE>
DI void peer_token(KP p, const int t, const int it0, const int it1, char* smem) {
  const int lane = tidx() & 63, w = tidx() >> 6;
  const int g = lane >> 4, l16 = lane & 15;
  bf16_t* ACT = (bf16_t*)(p->ws + OFF_ACT);
  const unsigned char* UB = (const unsigned char*)(p->ws + OFF_TAB);
  const unsigned char* VB = UB + TAB_V8;
  const float* USC = (const float*)(p->ws + OFF_TAB + TAB_SC);
  const float* VSC = USC + 16384;
  const int* IDX = (const int*)(p->ws + OFF_IDX);
  const float* GSM = (const float*)(p->ws + OFF_GSM);
  const float* pn = p->in[26];
  {
    bf16_t* act = ACT + (size_t)t * 1024;
    float xf[64];
    float xsum = 0.f;
#pragma unroll
    for (int s = 0; s < 4; ++s) {
      const uint4 x0 = *(const uint4*)(act + s * 256 + l16 * 16);
      const uint4 x1 = *(const uint4*)(act + s * 256 + l16 * 16 + 8);
      const unsigned xx[8] = {x0.x, x0.y, x0.z, x0.w, x1.x, x1.y, x1.z, x1.w};
#pragma unroll
      for (int q = 0; q < 8; ++q) { xf[s * 16 + 2 * q] = lo2f(xx[q]); xf[s * 16 + 2 * q + 1] = hi2f(xx[q]); }
    }
#pragma unroll
    for (int k = 0; k < 64; ++k) xsum += xf[k];
    const int id0 = IDX[(size_t)t * 128 + lane], id1 = IDX[(size_t)t * 128 + 64 + lane];
    const float gs0 = GSM[(size_t)t * 128 + lane], gs1 = GSM[(size_t)t * 128 + 64 + lane];
    float acc[64];
#pragma unroll
    for (int k = 0; k < 64; ++k) acc[k] = 0.f;
    float csum = 0.f;
    for (int it = it0; it < it1; ++it) {
      const int n = (it * 4 + g) & 63;
      const int e = __shfl((it < 16) ? id0 : id1, n);
      const float gw = __shfl((it < 16) ? gs0 : gs1, n);
      const unsigned char* ur = UB + (size_t)e * 1024 + l16 * 16;
      const unsigned char* vr = VB + (size_t)e * 1024 + l16 * 16;
      uint4 uu[4], vv[4];
#pragma unroll
      for (int s = 0; s < 4; ++s) uu[s] = *(const uint4*)(ur + s * 256);
#pragma unroll
      for (int s = 0; s < 4; ++s) vv[s] = *(const uint4*)(vr + s * 256);
      const float su = USC[e], sv = VSC[e];
      float hv = 0.f;
#pragma unroll
      for (int s = 0; s < 4; ++s) {
        const unsigned ww[4] = {uu[s].x, uu[s].y, uu[s].z, uu[s].w};
#pragma unroll
        for (int q = 0; q < 4; ++q) {
          hv = fmaf(xf[s * 16 + q * 4 + 0], UB0(ww[q]), hv);
          hv = fmaf(xf[s * 16 + q * 4 + 1], UB1(ww[q]), hv);
          hv = fmaf(xf[s * 16 + q * 4 + 2], UB2(ww[q]), hv);
          hv = fmaf(xf[s * 16 + q * 4 + 3], UB3(ww[q]), hv);
        }
      }
      hv = fmaf(-128.f, xsum, hv);
      hv = allreduce16(hv) * su;
      const float c = 0.5f * hv * (1.f + erff(hv * 0.70710678118f)) * gw * sv;
      csum += c;
#pragma unroll
      for (int s = 0; s < 4; ++s) {
        const unsigned ww[4] = {vv[s].x, vv[s].y, vv[s].z, vv[s].w};
#pragma unroll
        for (int q = 0; q < 4; ++q) {
          acc[s * 16 + q * 4 + 0] = fmaf(c, UB0(ww[q]), acc[s * 16 + q * 4 + 0]);
          acc[s * 16 + q * 4 + 1] = fmaf(c, UB1(ww[q]), acc[s * 16 + q * 4 + 1]);
          acc[s * 16 + q * 4 + 2] = fmaf(c, UB2(ww[q]), acc[s * 16 + q * 4 + 2]);
          acc[s * 16 + q * 4 + 3] = fmaf(c, UB3(ww[q]), acc[s * 16 + q * 4 + 3]);
        }
      }
    }
    const float cs128 = 128.f * csum;
#pragma unroll
    for (int k = 0; k < 64; ++k) {
      acc[k] -= cs128;
      acc[k] += __shfl_xor(acc[k], 16);
      acc[k] += __shfl_xor(acc[k], 32);
    }
    float* hrow = p->out + (size_t)t * 1024;
    float hvv[16];
#pragma unroll
    for (int s = 0; s < 4; ++s) {
      if (s == g) {
#pragma unroll
        for (int k = 0; k < 16; ++k) hvv[k] = acc[s * 16 + k];
      }
    }
    if (MODE == 1) {
      float* ex = (float*)smem + ((w >> 1) * 64 + lane) * 16;
      if (w & 1) {
#pragma unroll
        for (int q = 0; q < 4; ++q) *(float4*)(ex + q * 4) = make_float4(hvv[q * 4], hvv[q * 4 + 1], hvv[q * 4 + 2], hvv[q * 4 + 3]);
      }
      __syncthreads();
      if (w & 1) return;
#pragma unroll
      for (int q = 0; q < 4; ++q) {
        const float4 e4 = *(const float4*)(ex + q * 4);
        hvv[q * 4] += e4.x; hvv[q * 4 + 1] += e4.y; hvv[q * 4 + 2] += e4.z; hvv[q * 4 + 3] += e4.w;
      }
    }
    {
      float* hp = hrow + g * 256 + l16 * 16;
      const float4 r0 = *(const float4*)(hp), r1 = *(const float4*)(hp + 4), r2 = *(const float4*)(hp + 8), r3 = *(const float4*)(hp + 12);
      hvv[0] += r0.x; hvv[1] += r0.y; hvv[2] += r0.z; hvv[3] += r0.w; hvv[4] += r1.x; hvv[5] += r1.y; hvv[6] += r1.z; hvv[7] += r1.w;
      hvv[8] += r2.x; hvv[9] += r2.y; hvv[10] += r2.z; hvv[11] += r2.w; hvv[12] += r3.x; hvv[13] += r3.y; hvv[14] += r3.z; hvv[15] += r3.w;
      *(float4*)(hp) = make_float4(hvv[0], hvv[1], hvv[2], hvv[3]);
      *(float4*)(hp + 4) = make_float4(hvv[4], hvv[5], hvv[6], hvv[7]);
      *(float4*)(hp + 8) = make_float4(hvv[8], hvv[9], hvv[10], hvv[11]);
      *(float4*)(hp + 12) = make_float4(hvv[12], hvv[13], hvv[14], hvv[15]);
    }
    float ss = 0.f;
#pragma unroll
    for (int k = 0; k < 16; ++k) ss += hvv[k] * hvv[k];
    ss = wave_sum(ss);
    const float scl = rsqrtf(ss * (1.f / 1024.f) + 1e-6f);
    {
      const int col = g * 256 + l16 * 16;
      unsigned o8[8];
#pragma unroll
      for (int q = 0; q < 4; ++q) {
        const float4 g0 = *(const float4*)(pn + col + q * 4);
        o8[q * 2] = pack2(hvv[q * 4 + 0] * scl * g0.x, hvv[q * 4 + 1] * scl * g0.y);
        o8[q * 2 + 1] = pack2(hvv[q * 4 + 2] * scl * g0.z, hvv[q * 4 + 3] * scl * g0.w);
      }
      *(uint4*)(act + col) = make_uint4(o8[0], o8[1], o8[2], o8[3]);
      *(uint4*)(act + col + 8) = make_uint4(o8[4], o8[5], o8[6], o8[7]);
    }
  }
}

DI void phase10(KP p, char* smem) {
  const int w = tidx() >> 6;
  if (gridDim.x == 512) {
#pragma unroll 1
    for (int k = 0; k < 8; ++k) peer_token<0>(p, (int)blockIdx.x * 4 + w + k * 2048, 0, 32, smem);
    __syncthreads();
    peer_token<1>(p, 16384 + 2 * (int)blockIdx.x + (w >> 1), (w & 1) * 16, (w & 1) * 16 + 16, smem);
  } else {
    for (int t = blockIdx.x * 4 + w; t < T; t += gridDim.x * 4) peer_token<0>(p, t, 0, 32, smem);
  }
}

DI void phase11(KP p, char* smem) {
  for (int tile = blockIdx.x; tile < 136 * 8; tile += gridDim.x) {
    const int mt = tile >> 3, nt = tile & 7;
    const int m0 = mt * 128, n0 = nt * 128;
    f32x16 acc[2][2];
    unsigned ppk[2][2][8];
    const float* pa = (m0 < TP) ? p->in[5] + (size_t)m0 * 256 : p->in[6] + (size_t)(m0 - TP) * 256;
    gemm128<true>(pa, 256, (const bf16_t*)(p->ws + OFF_PP) + (size_t)n0 * 256, 256, 256, acc, smem);
#pragma unroll
    for (int mi = 0; mi < 2; ++mi)
#pragma unroll
      for (int ni = 0; ni < 2; ++ni)
#pragma unroll
        for (int i = 0; i < 8; ++i) ppk[mi][ni][i] = pack2(acc[mi][ni][2 * i], acc[mi][ni][2 * i + 1]);
    gemm128<false>((const bf16_t*)(p->ws + OFF_ACT) + (size_t)m0 * 1024, 1024,
                   (const bf16_t*)(p->ws + OFF_PG) + (size_t)n0 * 1024, 1024, 1024, acc, smem);
    const int lane = tidx() & 63, w = tidx() >> 6;
    const int wm = w >> 1, wn = w & 1, r = lane & 31, h = lane >> 5;
#pragma unroll
    for (int mi = 0; mi < 2; ++mi)
#pragma unroll
      for (int ni = 0; ni < 2; ++ni)
#pragma unroll
        for (int i = 0; i < 16; ++i) {
          const float pp = (i & 1) ? hi2f(ppk[mi][ni][i >> 1]) : lo2f(ppk[mi][ni][i >> 1]);
          acc[mi][ni][i] = sigmoidf_(acc[mi][ni][i]) * pp;
        }
#pragma unroll
    for (int mi = 0; mi < 2; ++mi) {
#pragma unroll
      for (int ni = 0; ni < 2; ++ni)
#pragma unroll
        for (int i = 0; i < 16; ++i)
          acc[mi][ni][i] += p->out[(size_t)(m0 + wm * 64 + mi * 32 + crow(i, h)) * 1024 + n0 + wn * 64 + ni * 32 + r];
#pragma unroll
      for (int ni = 0; ni < 2; ++ni)
#pragma unroll
        for (int i = 0; i < 16; ++i)
          p->out[(size_t)(m0 + wm * 64 + mi * 32 + crow(i, h)) * 1024 + n0 + wn * 64 + ni * 32 + r] = acc[mi][ni][i];
    }
  }
}

DI void phase12(KP p) {
  const int lane = tidx() & 63, w = tidx() >> 6;
  const float* g = p->in[29];
  for (int t = blockIdx.x * 4 + w; t < T; t += gridDim.x * 4) {
    float* x = p->out + (size_t)t * 1024;
    float4 v[4];
    float ss = 0.f;
#pragma unroll
    for (int i = 0; i < 4; ++i) {
      v[i] = ((const float4*)x)[i * 64 + lane];
      ss += v[i].x * v[i].x + v[i].y * v[i].y + v[i].z * v[i].z + v[i].w * v[i].w;
    }
    ss = wave_sum(ss);
    const float sc = rsqrtf(ss * (1.f / 1024.f) + 1e-6f);
#pragma unroll
    for (int i = 0; i < 4; ++i) {
      const float4 gg = ((const float4*)g)[i * 64 + lane];
      ((float4*)x)[i * 64 + lane] = make_float4(v[i].x * sc * gg.x, v[i].y * sc * gg.y, v[i].z * sc * gg.z, v[i].w * sc * gg.w);
    }
  }
}

DI void run_phase(int ph, char* smem) {
  KP p = getp();
  switch (ph) {
    case 0: phase0(p, smem); break;
    case 1: phase1(p, smem); break;
    case 2: phase2(p); break;
    case 3: phase3(p, smem); break;
    case 4: phase4(p, smem); break;
    case 5: phase5(p); break;
    case 6: phase6(p, smem); break;
    case 7: phase7(p); break;
    case 8: phase8(p, smem); break;
    case 9: phase9(p, smem); break;
    case 10: phase10(p, smem); break;
    case 11: phase11(p, smem); break;
    case 12: phase12(p); break;
    default: break;
  }
}

template <int LO, int HI>
__global__ void __launch_bounds__(256, 2) mega_kernel(Params p) {
  __shared__ __attribute__((aligned(16))) char smem[SMEM_BYTES];
  __shared__ uint4 xb_words;
  if (gridDim.x == 0x7fffffffu) cg::this_grid().sync();
  XcdBarrier xb;
  if (HI - LO > 1) {
    if (threadIdx.x == 0) xb_words = make_uint4(0u, 0u, 0u, 0u);
    __syncthreads();
    xb = xcd_barrier_post((unsigned*)(getp()->ws + OFF_CTR), (volatile LAS unsigned*)&xb_words);
  }
#pragma unroll
  for (int ph = LO; ph < HI; ++ph) {
    run_phase(ph, smem);
    if (ph + 1 < HI) xcd_barrier(xb);
  }
}

template <int PH>
static void launch_phases(const Params& p, int grid, hipStream_t stream) {
  hipLaunchKernelGGL((mega_kernel<PH, PH + 1>), dim3(grid), dim3(256), 0, stream, p);
  if constexpr (PH + 1 < 13) launch_phases<PH + 1>(p, grid, stream);
}

extern "C" void kernel_launch(void* const* d_in, const int* in_sizes, int n_in, void* d_out, int out_size,
                              void* d_ws, size_t ws_size, hipStream_t stream) {
  static int grid_blocks = 0;
  if (!grid_blocks) {
    int dev = 0, cus = 0, per_cu = 0;
    (void)hipGetDevice(&dev);
    (void)hipDeviceGetAttribute(&cus, hipDeviceAttributeMultiprocessorCount, dev);
#if MK_MULTI
    per_cu = 2;
#else
    (void)hipOccupancyMaxActiveBlocksPerMultiprocessor(&per_cu, mega_kernel<0, 13>, 256, 0);
#endif
    if (per_cu < 1) per_cu = 1;
    if (per_cu > 2) per_cu = 2;
    grid_blocks = cus * per_cu;
  }
  Params p{};
  for (int i = 0; i < 30; ++i) p.in[i] = (const float*)d_in[i];
  p.out = (float*)d_out;
  p.ws = (char*)d_ws;
  if (ws_size < WS_END) { fprintf(stderr, "workspace too small: %zu < %zu\n", ws_size, (size_t)WS_END); return; }
  (void)hipMemsetAsync((char*)d_ws + OFF_CTR, 0, 32768, stream);
#if MK_MULTI
  launch_phases<0>(p, grid_blocks, stream);
#else
  void* args[] = {&p};
  hipError_t e = hipLaunchCooperativeKernel((void*)mega_kernel<0, 13>, dim3(grid_blocks), dim3(256), args, 0, stream);
  if (e != hipSuccess) fprintf(stderr, "cooperative launch failed: %s (grid %d)\n", hipGetErrorString(e), grid_blocks);
#endif
}
```

```cpp
#include <hip/hip_runtime.h>
#include <hip/hip_cooperative_groups.h>
#include <cstdio>
namespace cg = cooperative_groups;

#ifndef MK_MULTI
#define MK_MULTI 0
#endif

typedef unsigned short bf16_t;
typedef __attribute__((ext_vector_type(8))) short bf16x8;
typedef __attribute__((ext_vector_type(16))) float f32x16;
typedef __attribute__((ext_vector_type(2))) __bf16 bf2_t;
typedef __attribute__((ext_vector_type(2))) float f2_t;
#define DI __device__ __forceinline__

constexpr int T = 17408, TP = 16384;
constexpr int NPH = 14;

constexpr size_t O_RETP = (size_t)T * 1024;
constexpr size_t O_WKVP = O_RETP + 262144;
constexpr size_t O_SHP = O_WKVP + 262144;
constexpr size_t O_RETS = O_SHP + 14336;
constexpr size_t O_WKVS = O_RETS + 4194304;
constexpr size_t O_SHS = O_WKVS + 4194304;

constexpr size_t OFF_WIN = 0;
constexpr size_t OFF_WOUT = OFF_WIN + (size_t)3840 * 1024 * 2;
constexpr size_t OFF_WQ = OFF_WOUT + (size_t)1024 * 1024 * 2;
constexpr size_t OFF_KEYS = OFF_WQ + (size_t)2048 * 1024 * 2;
constexpr size_t OFF_PG = OFF_KEYS + (size_t)16 * 128 * 128 * 2;
constexpr size_t OFF_PP = OFF_PG + (size_t)1024 * 1024 * 2;
constexpr size_t OFF_W2 = OFF_PP + (size_t)1024 * 256 * 2;
constexpr size_t OFF_A2 = OFF_W2 + (size_t)512 * 64 * 2;
constexpr size_t OFF_G2 = OFF_A2 + (size_t)512 * 64 * 2;
constexpr size_t OFF_ROPE = OFF_G2 + (size_t)512 * 128 * 2;
constexpr size_t OFF_CTR = OFF_ROPE + (size_t)2056 * 32 * 2 * 4;
constexpr size_t OFF_ACT = OFF_CTR + 32768;
constexpr size_t OFF_TAB = OFF_ACT + (size_t)T * 1024 * 2;
constexpr size_t OFF_PREP = OFF_TAB + (size_t)2 * 16384 * 1024 * 2;
constexpr size_t SZ512 = (size_t)T * 512 * 2;
constexpr size_t OFF_R = OFF_PREP;
constexpr size_t OFF_K = OFF_R + SZ512;
constexpr size_t OFF_V = OFF_K + SZ512;
constexpr size_t OFF_KK = OFF_V + SZ512;
constexpr size_t OFF_BB = OFF_KK + SZ512;
constexpr size_t OFF_GATE = OFF_BB + SZ512;
constexpr size_t OFF_EW = OFF_GATE + SZ512;
constexpr size_t OFF_LORA = OFF_EW + (size_t)T * 512 * 4;
constexpr size_t OFF_INVN = OFF_LORA + (size_t)T * 256 * 2;
constexpr size_t WS_END = OFF_INVN + (size_t)T * 8 * 4;
constexpr size_t OFF_QPEER = OFF_PREP;
constexpr size_t OFF_IDX = OFF_QPEER + (size_t)T * 2048 * 2;
constexpr size_t OFF_GSM = OFF_IDX + (size_t)T * 128 * 4;

constexpr int SMEM_BYTES = 79872;

struct Params {
  const float* in[30];
  float* out;
  char* ws;
};

typedef const __attribute__((address_space(4))) Params* KP;
__device__ __forceinline__ KP getp() {
  KP q = (KP)__builtin_amdgcn_kernarg_segment_ptr();
  asm volatile("" : "+s"(q));
  return q;
}
DI int tidx() { int t = threadIdx.x; asm volatile("" : "+v"(t)); return t; }
DI bf16_t f2bf(float x) { return __builtin_bit_cast(bf16_t, (__bf16)x); }
DI float bf2f(bf16_t b) { return __uint_as_float(((unsigned)b) << 16); }
DI unsigned pack2(float a, float b) { const f2_t v = {a, b}; return __builtin_bit_cast(unsigned, __builtin_convertvector(v, bf2_t)); }
DI float lo2f(unsigned u) { return __uint_as_float(u << 16); }
DI float hi2f(unsigned u) { return __uint_as_float(u & 0xffff0000u); }
DI int crow(int reg, int h) { return (reg & 3) + 8 * (reg >> 2) + 4 * h; }
DI float wave_sum(float v) {
#pragma unroll
  for (int o = 32; o >= 1; o >>= 1) v += __shfl_xor(v, o);
  return v;
}
DI float allreduce16(float v) {
  v += __int_as_float(__builtin_amdgcn_update_dpp(0, __float_as_int(v), 0x128, 0xf, 0xf, false));
  v += __int_as_float(__builtin_amdgcn_update_dpp(0, __float_as_int(v), 0x124, 0xf, 0xf, false));
  v += __int_as_float(__builtin_amdgcn_update_dpp(0, __float_as_int(v), 0x122, 0xf, 0xf, false));
  v += __int_as_float(__builtin_amdgcn_update_dpp(0, __float_as_int(v), 0x121, 0xf, 0xf, false));
  return v;
}
#define DPP_ADD(v, ctrl) v += __int_as_float(__builtin_amdgcn_update_dpp(0, __float_as_int(v), ctrl, 0xf, 0xf, false))
DI void allreduce16x2(float& a, float& b) {
  DPP_ADD(a, 0x128); DPP_ADD(b, 0x128);
  DPP_ADD(a, 0x124); DPP_ADD(b, 0x124);
  DPP_ADD(a, 0x122); DPP_ADD(b, 0x122);
  DPP_ADD(a, 0x121); DPP_ADD(b, 0x121);
}
DI float allreduce8(float v) {
  v += __int_as_float(__builtin_amdgcn_update_dpp(0, __float_as_int(v), 0xB1, 0xf, 0xf, false));
  v += __int_as_float(__builtin_amdgcn_update_dpp(0, __float_as_int(v), 0x4E, 0xf, 0xf, false));
  v += __int_as_float(__builtin_amdgcn_update_dpp(0, __float_as_int(v), 0x141, 0xf, 0xf, false));
  return v;
}
DI void unpack8f(const uint4& u, float (&f)[8]) {
  f[0] = lo2f(u.x); f[1] = hi2f(u.x); f[2] = lo2f(u.y); f[3] = hi2f(u.y);
  f[4] = lo2f(u.z); f[5] = hi2f(u.z); f[6] = lo2f(u.w); f[7] = hi2f(u.w);
}
DI uint4 pack8f(const float (&f)[8]) {
  return make_uint4(pack2(f[0], f[1]), pack2(f[2], f[3]), pack2(f[4], f[5]), pack2(f[6], f[7]));
}
DI float log_gamma(int hd) {
  const float e = __uint_as_float((unsigned)(127 - 5 - hd) << 23);
  return -e * (1.f + e * (0.5f + e * (0.33333334f + e * (0.25f + e * 0.2f))));
}
DI float sigmoidf_(float x) { return __builtin_amdgcn_rcpf(1.f + __expf(-x)); }
DI const float* xrow(KP p, int t) {
  return t < TP ? p->in[0] + (size_t)t * 1024 : p->in[1] + (size_t)(t - TP) * 1024;
}
struct TokInfo { int sample, b, l; };
DI TokInfo tokinfo(int t) {
  TokInfo ti;
  if (t >= TP) { ti.sample = 1; ti.b = (t - TP) >> 3; ti.l = (t - TP) & 7; }
  else { ti.sample = 0; ti.b = t >> 11; ti.l = t & 2047; }
  return ti;
}

#define XB_TMO      128
#define XB_XCNT(j)  (256  + 64 * (j))
#define XB_XSUB(j)  (1280 + 64 * (j))
#define XB_XGEN(j)  (2304 + 64 * (j))
#define XB_TOP      3328
#define XB_TOPGEN   3392
#define XCD_BAR_WORDS 3456
#define XB_SPIN_CAP (1u << 20)
#define LAS __attribute__((address_space(3)))
DI unsigned xb_ld(unsigned* p) { return __hip_atomic_load(p, __ATOMIC_RELAXED, __HIP_MEMORY_SCOPE_AGENT); }
DI unsigned xb_add(unsigned* p, unsigned v) { return __hip_atomic_fetch_add(p, v, __ATOMIC_RELAXED, __HIP_MEMORY_SCOPE_AGENT); }
DI unsigned xb_xcc_id() { return (unsigned)__builtin_amdgcn_s_getreg((3 << 11) | 20) & 0xFu; }
#define XB_SPIN(cond, bar) do { unsigned _sp = 0; while (cond) { __builtin_amdgcn_s_sleep(1); \
    if ((++_sp & 255u) == 0u) { if (xb_ld(&(bar)[XB_TMO])) break; if (_sp > XB_SPIN_CAP) { atomicAdd(&(bar)[XB_TMO], 1u); break; } } } } while (0)
struct XcdBarrier { unsigned* bar; unsigned x; volatile LAS unsigned* st; };
DI XcdBarrier xcd_barrier_post(unsigned* bar, volatile LAS unsigned* st) {
  XcdBarrier b; b.bar = bar; b.x = xb_xcc_id(); b.st = st;
  if (threadIdx.x == 0) (void)xb_add(&bar[XB_XCNT(b.x)], 1u);
  return b;
}
DI void xcd_barrier_complete(unsigned* bar, unsigned x, unsigned& nloc, unsigned& nx) {
  const unsigned G = gridDim.x * gridDim.y * gridDim.z;
  unsigned sum, cnt, mine, sp = 0u;
  for (;;) {
    sum = 0u; cnt = 0u; mine = 0u;
#pragma unroll
    for (unsigned j = 0; j < 16; ++j) { const unsigned c = xb_ld(&bar[XB_XCNT(j)]); sum += c; cnt += (c > 0u) ? 1u : 0u; mine = (j == x) ? c : mine; }
    if (sum == G) break;
    __builtin_amdgcn_s_sleep(1);
    if ((++sp & 255u) == 0u) { if (xb_ld(&bar[XB_TMO])) break; if (sp > XB_SPIN_CAP) { atomicAdd(&bar[XB_TMO], 1u); break; } }
  }
  nloc = mine > 0u ? mine : 1u; nx = cnt > 0u ? cnt : 1u;
}
DI void xcd_barrier(const XcdBarrier& b) {
  asm volatile("s_waitcnt vmcnt(0)" ::: "memory");
  __syncthreads();
  if (threadIdx.x == 0) {
    unsigned* bar = b.bar;
    __builtin_amdgcn_s_waitcnt(0);
    unsigned nloc = b.st[0], nx = b.st[1];
    if (nloc == 0u) { xcd_barrier_complete(bar, b.x, nloc, nx); b.st[0] = nloc; b.st[1] = nx; }
    const unsigned old = xb_add(&bar[XB_XSUB(b.x)], 1u);
    const unsigned gen = old / nloc;
    if (old + 1u == (gen + 1u) * nloc) {
      __builtin_amdgcn_fence(__ATOMIC_RELEASE, "agent");
      asm volatile("s_waitcnt vmcnt(0)" ::: "memory");
      const unsigned og = xb_add(&bar[XB_TOP], 1u);
      const unsigned tg = og / nx;
      if (og + 1u == (tg + 1u) * nx) xb_add(&bar[XB_TOPGEN], 1u);
      else XB_SPIN(xb_ld(&bar[XB_TOPGEN]) == tg, bar);
      __builtin_amdgcn_fence(__ATOMIC_ACQUIRE, "agent");
      xb_add(&bar[XB_XGEN(b.x)], 1u);
      asm volatile("s_waitcnt vmcnt(0)" ::: "memory");
    } else {
      XB_SPIN(xb_ld(&bar[XB_XGEN(b.x)]) == gen, bar);
      __builtin_amdgcn_fence(__ATOMIC_ACQUIRE, "agent");
      asm volatile("s_waitcnt vmcnt(0)" ::: "memory");
    }
  }
  __syncthreads();
}

constexpr int LDT = 72;
constexpr int GBUF = 2 * 128 * LDT;
template <bool AF32>
DI void gemm128(const void* __restrict__ Ap, int lda, const bf16_t* __restrict__ Bt, int ldb, int K,
                f32x16 (&acc)[2][2], char* smem) {
  bf16_t* S0 = (bf16_t*)smem;
  const int tid = tidx(), lane = tid & 63, w = tid >> 6;
  const int wm = w >> 1, wn = w & 1, r = lane & 31, h = lane >> 5;
  const int lrow = tid >> 3, lch = tid & 7;
#pragma unroll
  for (int i = 0; i < 2; ++i)
#pragma unroll
    for (int j = 0; j < 2; ++j)
#pragma unroll
      for (int e = 0; e < 16; ++e) acc[i][j][e] = 0.f;
  uint4 ra0, ra1, ra2, ra3, rb0, rb1, rb2, rb3;
  const bf16_t* Ab = (const bf16_t*)Ap + (size_t)lrow * lda + lch * 8;
  const float* Af = (const float*)Ap + (size_t)lrow * lda + lch * 8;
  const bf16_t* Bb = Bt + (size_t)lrow * ldb + lch * 8;
  const size_t a32 = (size_t)32 * lda, b32 = (size_t)32 * ldb;
#define GEMM_LDA(dst, q, k0)                                                                          \
  if constexpr (AF32) {                                                                               \
    const float4 f0 = *(const float4*)(Af + (q) * a32 + (k0));                                        \
    const float4 f1 = *(const float4*)(Af + (q) * a32 + (k0) + 4);                                    \
    dst = make_uint4(pack2(f0.x, f0.y), pack2(f0.z, f0.w), pack2(f1.x, f1.y), pack2(f1.z, f1.w));     \
  } else {                                                                                            \
    dst = *(const uint4*)(Ab + (q) * a32 + (k0));                                                     \
  }
#define GEMM_LOADG(k0)                                                                                \
  {                                                                                                   \
    GEMM_LDA(ra0, 0, k0) GEMM_LDA(ra1, 1, k0) GEMM_LDA(ra2, 2, k0) GEMM_LDA(ra3, 3, k0)               \
    rb0 = *(const uint4*)(Bb + (k0));                                                                 \
    rb1 = *(const uint4*)(Bb + b32 + (k0));                                                           \
    rb2 = *(const uint4*)(Bb + 2 * b32 + (k0));                                                       \
    rb3 = *(const uint4*)(Bb + 3 * b32 + (k0));                                                       \
  }
#define GEMM_STORE(buf)                                                                               \
  {                                                                                                   \
    bf16_t* ad = S0 + (buf) * GBUF + lrow * LDT + lch * 8;                                            \
    bf16_t* bd = ad + 128 * LDT;                                                                      \
    *(uint4*)(ad) = ra0; *(uint4*)(ad + 32 * LDT) = ra1; *(uint4*)(ad + 64 * LDT) = ra2; *(uint4*)(ad + 96 * LDT) = ra3; \
    *(uint4*)(bd) = rb0; *(uint4*)(bd + 32 * LDT) = rb1; *(uint4*)(bd + 64 * LDT) = rb2; *(uint4*)(bd + 96 * LDT) = rb3; \
  }
  const int nk = K >> 6;
  GEMM_LOADG(0)
  GEMM_STORE(0)
  if (nk > 1) GEMM_LOADG(64)
  __syncthreads();
  for (int kt = 0; kt < nk; ++kt) {
    if (kt + 1 < nk) GEMM_STORE((kt + 1) & 1)
    if (kt + 2 < nk) GEMM_LOADG((kt + 2) << 6)
    __builtin_amdgcn_sched_barrier(0);
    const bf16_t* As = S0 + (kt & 1) * GBUF;
    const bf16_t* Bs = As + 128 * LDT;
#pragma unroll
    for (int ks = 0; ks < 4; ++ks) {
      bf16x8 a0 = *(const bf16x8*)(As + (wm * 64 + r) * LDT + ks * 16 + h * 8);
      bf16x8 a1 = *(const bf16x8*)(As + (wm * 64 + 32 + r) * LDT + ks * 16 + h * 8);
      bf16x8 b0 = *(const bf16x8*)(Bs + (wn * 64 + r) * LDT + ks * 16 + h * 8);
      bf16x8 b1 = *(const bf16x8*)(Bs + (wn * 64 + 32 + r) * LDT + ks * 16 + h * 8);
      acc[0][0] = __builtin_amdgcn_mfma_f32_32x32x16_bf16(a0, b0, acc[0][0], 0, 0, 0);
      acc[0][1] = __builtin_amdgcn_mfma_f32_32x32x16_bf16(a0, b1, acc[0][1], 0, 0, 0);
      acc[1][0] = __builtin_amdgcn_mfma_f32_32x32x16_bf16(a1, b0, acc[1][0], 0, 0, 0);
      acc[1][1] = __builtin_amdgcn_mfma_f32_32x32x16_bf16(a1, b1, acc[1][1], 0, 0, 0);
    }
    __syncthreads();
  }
}
template <class F>
DI void epi_each(f32x16 (&acc)[2][2], F f) {
  const int lane = tidx() & 63, w = tidx() >> 6;
  const int wm = w >> 1, wn = w & 1, r = lane & 31, h = lane >> 5;
#pragma unroll
  for (int mi = 0; mi < 2; ++mi)
#pragma unroll
    for (int ni = 0; ni < 2; ++ni)
#pragma unroll
      for (int i = 0; i < 16; ++i) f(wm * 64 + mi * 32 + crow(i, h), wn * 64 + ni * 32 + r, acc[mi][ni][i]);
}

DI void transpose_tile(const float* __restrict__ src, bf16_t* __restrict__ dst, int K, int N, int kt, int nt, float* sm) {
  const int tid = tidx();
  const int k0 = kt * 64, n0 = nt * 64;
#pragma unroll
  for (int i = 0; i < 16; ++i) {
    int k = i * 4 + (tid >> 6), n = tid & 63;
    sm[k * 65 + n] = src[(size_t)(k0 + k) * N + n0 + n];
  }
  __syncthreads();
  int n = tid >> 2, ks = (tid & 3) * 16;
  unsigned pk[8];
#pragma unroll
  for (int j = 0; j < 8; ++j) pk[j] = pack2(sm[(ks + 2 * j) * 65 + n], sm[(ks + 2 * j + 1) * 65 + n]);
  uint4* d = (uint4*)(dst + (size_t)(n0 + n) * K + k0 + ks);
  d[0] = make_uint4(pk[0], pk[1], pk[2], pk[3]);
  d[1] = make_uint4(pk[4], pk[5], pk[6], pk[7]);
  __syncthreads();
}
DI void rmsnorm_row_bf(const float* __restrict__ x, const float* __restrict__ g, bf16_t* __restrict__ o, int lane) {
  float4 v[4];
  float ss = 0.f;
#pragma unroll
  for (int i = 0; i < 4; ++i) {
    v[i] = ((const float4*)x)[i * 64 + lane];
    ss += v[i].x * v[i].x + v[i].y * v[i].y + v[i].z * v[i].z + v[i].w * v[i].w;
  }
  ss = wave_sum(ss);
  float sc = rsqrtf(ss * (1.f / 1024.f) + 1e-6f);
#pragma unroll
  for (int i = 0; i < 4; ++i) {
    float4 gg = ((const float4*)g)[i * 64 + lane];
    uint2 pk = make_uint2(pack2(v[i].x * sc * gg.x, v[i].y * sc * gg.y), pack2(v[i].z * sc * gg.z, v[i].w * sc * gg.w));
    ((uint2*)o)[i * 64 + lane] = pk;
  }
}

#define TJ(IDX, OFF, KK_, NN_)                                                                             \
  {                                                                                                        \
    const int ntl = ((KK_) / 64) * ((NN_) / 64);                                                           \
    if (it < ntl) {                                                                                        \
      transpose_tile(p->in[IDX], (bf16_t*)(p->ws + (OFF)), (KK_), (NN_), it / ((NN_) / 64), it % ((NN_) / 64), (float*)smem); \
      continue;                                                                                            \
    }                                                                                                      \
    it -= ntl;                                                                                             \
  }

DI void phase0(KP p, char* smem) {
  const int tid = tidx(), lane = tid & 63, w = tid >> 6;
  constexpr int N_TR = 960 + 8 + 8 + 16;
  constexpr int N_KEYS = 128, N_ROPE = 257, N_NORM = T / 4;
  for (int item = blockIdx.x; item < N_TR + N_KEYS + N_ROPE + N_NORM; item += gridDim.x) {
    int it = item;
    TJ(8, OFF_WIN, 1024, 3840)
    TJ(11, OFF_W2, 64, 512)
    TJ(13, OFF_A2, 64, 512)
    TJ(14, OFF_G2, 128, 512)
    if (it < N_KEYS) {
      const float* src = p->in[23] + (size_t)it * 2048 + tid * 8;
      float4 f0 = *(const float4*)src, f1 = *(const float4*)(src + 4);
      *(uint4*)((bf16_t*)(p->ws + OFF_KEYS) + (size_t)it * 2048 + tid * 8) =
          make_uint4(pack2(f0.x, f0.y), pack2(f0.z, f0.w), pack2(f1.x, f1.y), pack2(f1.z, f1.w));
      continue;
    }
    it -= N_KEYS;
    if (it < N_ROPE) {
      int e = it * 256 + tid;
      int pidx = e >> 5, f = e & 31;
      if (pidx < 2056) {
        const float pos = (pidx < 2048) ? (float)pidx : (float)(16384 + pidx - 2048);
        const float inv = exp2f(-(float)f * 0.41524101186092f);
        const float ang = pos * inv;
        const float kq = rintf(ang * 0.15915494309189535f);
        float rr = fmaf(-kq, 6.28125f, ang);
        rr = fmaf(-kq, 1.9353071795864769e-3f, rr);
        float* rt = (float*)(p->ws + OFF_ROPE);
        rt[e * 2] = cosf(rr);
        rt[e * 2 + 1] = sinf(rr);
      }
      continue;
    }
    it -= N_ROPE;
    {
      int t = it * 4 + w;
      rmsnorm_row_bf(xrow(p, t), p->in[7], (bf16_t*)(p->ws + OFF_ACT) + (size_t)t * 1024, lane);
    }
  }
}

DI void phase1(KP p, char* smem) {
  const int lane = tidx() & 63, w = tidx() >> 6;
  const int wm = w >> 1, wn = w & 1, r = lane & 31, h = lane >> 5;
  bf16_t* RET = (bf16_t*)p->out;
  bf16_t* RWP = (bf16_t*)(p->ws + OFF_TAB);
  const float2* rope = (const float2*)(p->ws + OFF_ROPE);
  for (int tile = blockIdx.x; tile < 136 * 30; tile += gridDim.x) {
    const int mt = tile / 30, nt = tile % 30;
    const int m0 = mt * 128, n0 = nt * 128;
    f32x16 acc[2][2];
    gemm128<false>((const bf16_t*)(p->ws + OFF_ACT) + (size_t)m0 * 1024, 1024,
                   (const bf16_t*)(p->ws + OFF_WIN) + (size_t)n0 * 1024, 1024, 1024, acc, smem);
    const int nb = n0 + wn * 64;
    if (nb < 1024) {
      float2 cs[2][16];
#pragma unroll
      for (int mi = 0; mi < 2; ++mi)
#pragma unroll
        for (int i = 0; i < 16; ++i) {
          const TokInfo ti = tokinfo(m0 + wm * 64 + mi * 32 + crow(i, h));
          cs[mi][i] = rope[(ti.sample ? 2048 + ti.l : ti.l) * 32 + r];
        }
      const float scl = (nb >= 512) ? 0.125f : 1.f;
#pragma unroll
      for (int mi = 0; mi < 2; ++mi)
#pragma unroll
        for (int i = 0; i < 16; ++i) {
          const float v0 = acc[mi][0][i], v1 = acc[mi][1][i];
          acc[mi][0][i] = (v0 * cs[mi][i].x - v1 * cs[mi][i].y) * scl;
          acc[mi][1][i] = (v1 * cs[mi][i].x + v0 * cs[mi][i].y) * scl;
        }
    }
#pragma unroll
    for (int mi = 0; mi < 2; ++mi)
#pragma unroll
      for (int i = 0; i < 16; ++i) {
        const int t = m0 + wm * 64 + mi * 32 + crow(i, h);
        const float v0 = acc[mi][0][i], v1 = acc[mi][1][i];
        if (nb < 2048) {
          RET[(size_t)t * 2048 + nb + r] = f2bf(v0);
          RET[(size_t)t * 2048 + nb + 32 + r] = f2bf(v1);
        } else {
          const TokInfo ti = tokinfo(t);
          const int c = nb - 2048 + r;
          RWP[(size_t)t * 1792 + c] = f2bf(v0);
          RWP[(size_t)t * 1792 + c + 32] = f2bf(v1);
          if (ti.sample) {
            if (ti.l == 7) { p->out[O_SHS + ti.b * 1792 + c] = v0; p->out[O_SHS + ti.b * 1792 + c + 32] = v1; }
          } else {
            if (ti.l == 2047) { p->out[O_SHP + ti.b * 1792 + c] = v0; p->out[O_SHP + ti.b * 1792 + c + 32] = v1; }
          }
        }
      }
  }
}

DI void phase2(KP p) {
  const int lane = tidx() & 63, w = tidx() >> 6;
  const bf16_t* RWP = (const bf16_t*)(p->ws + OFF_TAB);
  bf16_t* Rb = (bf16_t*)(p->ws + OFF_R);
  bf16_t* Kb = (bf16_t*)(p->ws + OFF_K);
  bf16_t* Vb = (bf16_t*)(p->ws + OFF_V);
  bf16_t* LA = (bf16_t*)(p->ws + OFF_LORA);
  float* INVN = (float*)(p->ws + OFF_INVN);
  const float* mu = p->in[9];
  const float* kkw = p->in[15];
  for (int t = blockIdx.x * 4 + w; t < T; t += gridDim.x * 4) {
    const TokInfo ti = tokinfo(t);
    const bf16_t* cur = RWP + (size_t)t * 1792;
    const bf16_t* prv = cur - 1792;
    const float* sh = p->in[4] + (size_t)ti.b * 1792;
    float f[4][8];
#pragma unroll
    for (int i = 0; i < 4; ++i) {
      const int c8 = (lane + 64 * i) * 8;
      if (i < 3 || lane < 32) {
        float cv[8], pv[8];
        unpack8f(*(const uint4*)(cur + c8), cv);
        if (ti.l > 0) unpack8f(*(const uint4*)(prv + c8), pv);
        else if (ti.sample) {
          const float4 s0 = *(const float4*)(sh + c8), s1 = *(const float4*)(sh + c8 + 4);
          pv[0] = s0.x; pv[1] = s0.y; pv[2] = s0.z; pv[3] = s0.w; pv[4] = s1.x; pv[5] = s1.y; pv[6] = s1.z; pv[7] = s1.w;
        } else {
#pragma unroll
          for (int k = 0; k < 8; ++k) pv[k] = 0.f;
        }
        const float4 m0 = *(const float4*)(mu + c8), m1 = *(const float4*)(mu + c8 + 4);
        const float mm[8] = {m0.x, m0.y, m0.z, m0.w, m1.x, m1.y, m1.z, m1.w};
#pragma unroll
        for (int k = 0; k < 8; ++k) f[i][k] = cv[k] + (pv[k] - cv[k]) * mm[k];
      } else {
#pragma unroll
        for (int k = 0; k < 8; ++k) f[i][k] = 0.f;
      }
    }
    *(uint4*)(Rb + (size_t)t * 512 + lane * 8) = pack8f(f[0]);
    {
      const uint4 kb = pack8f(f[1]);
      *(uint4*)(Kb + (size_t)t * 512 + lane * 8) = kb;
      float kr[8];
      unpack8f(kb, kr);
      const float4 q0 = *(const float4*)(kkw + lane * 8), q1 = *(const float4*)(kkw + lane * 8 + 4);
      const float qq[8] = {q0.x, q0.y, q0.z, q0.w, q1.x, q1.y, q1.z, q1.w};
      float ss = 0.f;
#pragma unroll
      for (int k = 0; k < 8; ++k) { const float kq = kr[k] * qq[k]; ss += kq * kq; }
      ss = allreduce8(ss);
      if ((lane & 7) == 0) INVN[t * 8 + (lane >> 3)] = 1.f / fmaxf(sqrtf(ss), 1e-12f);
    }
    *(uint4*)(Vb + (size_t)t * 512 + lane * 8) = pack8f(f[2]);
    if (lane < 32) {
      float o[8];
#pragma unroll
      for (int k = 0; k < 8; ++k) {
        const float x = f[3][k];
        o[k] = (lane < 8) ? (1.f - 2.f * __builtin_amdgcn_rcpf(1.f + __expf(2.f * x))) : ((lane < 16) ? x : sigmoidf_(x));
      }
      *(uint4*)(LA + (size_t)t * 256 + lane * 8) = pack8f(o);
    }
  }
}

DI void phase3(KP p, char* smem) {
  const bf16_t* LA = (const bf16_t*)(p->ws + OFF_LORA);
  bf16_t* Kb = (bf16_t*)(p->ws + OFF_K);
  bf16_t* KKb = (bf16_t*)(p->ws + OFF_KK);
  bf16_t* BBb = (bf16_t*)(p->ws + OFF_BB);
  bf16_t* GTb = (bf16_t*)(p->ws + OFF_GATE);
  float* EW = (float*)(p->ws + OFF_EW);
  const float* INVN = (const float*)(p->ws + OFF_INVN);
  const float* w0 = p->in[10];
  const float* a0 = p->in[12];
  const float* kkw = p->in[15];
  const float* kaw = p->in[16];
  for (int item = blockIdx.x; item < 136 * 12; item += gridDim.x) {
    const int mt = item / 12, rem = item % 12, kind = rem >> 2, nt = rem & 3;
    const int m0 = mt * 128, n0 = nt * 128;
    f32x16 acc[2][2];
    if (kind == 0) {
      gemm128<false>(LA + (size_t)m0 * 256, 256, (const bf16_t*)(p->ws + OFF_W2) + n0 * 64, 64, 64, acc, smem);
      epi_each(acc, [&](int rr, int cc, float v) {
        const int t = m0 + rr, c = n0 + cc;
        const float x = v + w0[c];
        const float z = -x;
        const float sp = fmaxf(z, 0.f) + __logf(1.f + __expf(-fabsf(z)));
        const float ww = -sp - 0.5f;
        EW[(size_t)t * 512 + c] = __expf(-__expf(ww));
      });
    } else if (kind == 1) {
      gemm128<false>(LA + (size_t)m0 * 256 + 64, 256, (const bf16_t*)(p->ws + OFF_A2) + n0 * 64, 64, 64, acc, smem);
      {
        const int lane = tidx() & 63, w = tidx() >> 6;
        const int wm = w >> 1, wn = w & 1, r = lane & 31, h = lane >> 5;
#pragma unroll 1
        for (int mi = 0; mi < 2; ++mi) {
          const int tb = m0 + wm * 64 + mi * 32;
          float inv[16];
#pragma unroll
          for (int i = 0; i < 16; ++i) inv[i] = INVN[(tb + crow(i, h)) * 8 + ((n0 + wn * 64) >> 6)];
#pragma unroll
          for (int ni = 0; ni < 2; ++ni) {
            const int c = n0 + wn * 64 + ni * 32 + r;
            const float a0c = a0[c], kkc = kkw[c], kac = kaw[c];
            float k7v[16];
#pragma unroll
            for (int i = 0; i < 16; ++i) k7v[i] = bf2f(Kb[(size_t)(tb + crow(i, h)) * 512 + c]);
#pragma unroll
            for (int i = 0; i < 16; ++i) {
              const float av = (mi == 0) ? acc[0][ni][i] : acc[1][ni][i];
              const float a = sigmoidf_(av + a0c);
              const size_t o = (size_t)(tb + crow(i, h)) * 512 + c;
              const float kkv = k7v[i] * kkc * inv[i];
              Kb[o] = f2bf(k7v[i] * (1.f + (a - 1.f) * kac));
              KKb[o] = f2bf(kkv);
              BBb[o] = f2bf(kkv * a);
            }
          }
        }
      }
    } else {
      gemm128<false>(LA + (size_t)m0 * 256 + 128, 256, (const bf16_t*)(p->ws + OFF_G2) + n0 * 128, 128, 128, acc, smem);
      epi_each(acc, [&](int rr, int cc, float v) { GTb[(size_t)(m0 + rr) * 512 + n0 + cc] = f2bf(v); });
    }
  }
}

DI void rwkv_scan(KP p, int tok0, int hd, int q, int nsteps, const float* __restrict__ S0, float* __restrict__ Sout, char* smem) {
  const int tid = tidx(), lane = tid & 63, w = tid >> 6, g = lane >> 4, l16 = lane & 15;
  const int rl = w * 4 + g;
  const int row = q * 16 + rl;
  const int j0 = l16 * 4;
  const bf16_t* Rb = (const bf16_t*)(p->ws + OFF_R);
  const bf16_t* Kb = (const bf16_t*)(p->ws + OFF_K);
  const bf16_t* Vb = (const bf16_t*)(p->ws + OFF_V);
  const bf16_t* KKb = (const bf16_t*)(p->ws + OFF_KK);
  const bf16_t* BBb = (const bf16_t*)(p->ws + OFF_BB);
  const float* EW = (const float*)(p->ws + OFF_EW);
  bf16_t* ACT = (bf16_t*)(p->ws + OFF_ACT);
  float* ew_s = (float*)smem;
  float* kk_s = ew_s + 2048;
  float* bb_s = kk_s + 2048;
  float* kp_s = bb_s + 2048;
  float* r_s = kp_s + 2048;
  float* v_s = r_s + 2048;
  float* y_s = v_s + 512;
  f2_t s01 = (f2_t){0.f, 0.f}, s23 = (f2_t){0.f, 0.f};
  if (S0) { const float4 t4 = *(const float4*)(S0 + row * 64 + j0); s01 = (f2_t){t4.x, t4.y}; s23 = (f2_t){t4.z, t4.w}; }
  uint4 rg_r = make_uint4(0, 0, 0, 0), rg_k = rg_r, rg_kk = rg_r, rg_bb = rg_r, rg_v = rg_r;
  float4 rg_e0 = make_float4(0, 0, 0, 0), rg_e1 = rg_e0;
  const int st_l = tid >> 3, c8 = (tid & 7) * 8;
  auto gload = [&](int sb) {
    if (sb + st_l < nsteps) {
      const size_t o = (size_t)(tok0 + sb + st_l) * 512 + hd * 64 + c8;
      rg_r = *(const uint4*)(Rb + o);
      rg_k = *(const uint4*)(Kb + o);
      rg_kk = *(const uint4*)(KKb + o);
      rg_bb = *(const uint4*)(BBb + o);
      rg_e0 = *(const float4*)(EW + o);
      rg_e1 = *(const float4*)(EW + o + 4);
    }
    if (tid < 64) {
      const int sv = tid >> 1;
      if (sb + sv < nsteps) rg_v = *(const uint4*)(Vb + (size_t)(tok0 + sb + sv) * 512 + hd * 64 + q * 16 + (tid & 1) * 8);
    }
  };
  auto unpack8 = [&](float* d, const uint4& u) {
    *(float4*)d = make_float4(lo2f(u.x), hi2f(u.x), lo2f(u.y), hi2f(u.y));
    *(float4*)(d + 4) = make_float4(lo2f(u.z), hi2f(u.z), lo2f(u.w), hi2f(u.w));
  };
  auto sstore = [&]() {
    const int o = st_l * 64 + c8;
    unpack8(r_s + o, rg_r);
    unpack8(kp_s + o, rg_k);
    unpack8(kk_s + o, rg_kk);
    unpack8(bb_s + o, rg_bb);
    *(float4*)(ew_s + o) = rg_e0;
    *(float4*)(ew_s + o + 4) = rg_e1;
    if (tid < 64) unpack8(v_s + (tid >> 1) * 16 + (tid & 1) * 8, rg_v);
  };
  gload(0);
  for (int sb = 0; sb < nsteps; sb += 32) {
    __syncthreads();
    sstore();
    __syncthreads();
    if (sb + 32 < nsteps) gload(sb + 32);
    const int tc = min(32, nsteps - sb);
#define SC_LD(X, st)                                              \
  {                                                               \
    const float* b_ = ew_s + (st) * 64 + j0;                      \
    X##e = *(const float4*)(b_);                                  \
    X##q = *(const float4*)(b_ + 2048);                           \
    X##b = *(const float4*)(b_ + 4096);                           \
    X##k = *(const float4*)(b_ + 6144);                           \
    X##r = *(const float4*)(b_ + 8192);                           \
    X##v = v_s[(st) * 16 + rl];                                   \
  }
#define SC_STEP(X, st)                                                                     \
  {                                                                                        \
    const f2_t p2 = s01 * (f2_t){X##q.x, X##q.y} + s23 * (f2_t){X##q.z, X##q.w};           \
    float pdp = p2.x + p2.y;                                                               \
      \
    const f2_t vk01 = (f2_t){X##k.x, X##k.y} * X##v, vk23 = (f2_t){X##k.z, X##k.w} * X##v; \
    const f2_t base01 = s01 * (f2_t){X##e.x, X##e.y} + vk01;                               \
    const f2_t base23 = s23 * (f2_t){X##e.z, X##e.w} + vk23;                               \
    allreduce16x2(pdp, ypart);     \
    if (l16 == 0 && (st) > 0) y_s[((st) - 1) * 16 + rl] = ypart;                           \
    s01 = base01 - (f2_t){X##b.x, X##b.y} * pdp;                              \
    s23 = base23 - (f2_t){X##b.z, X##b.w} * pdp;                                           \
    const f2_t y2 = s01 * (f2_t){X##r.x, X##r.y} + s23 * (f2_t){X##r.z, X##r.w};           \
    ypart = y2.x + y2.y;                                                                   \
  }
    {
      float4 Ae, Aq, Ab, Ak, Ar, Be, Bq, Bb, Bk, Br;
      float Av, Bv;
      float ypart = 0.f;
      SC_LD(A, 0)
      for (int st = 0; st < tc; st += 2) {
        SC_LD(B, st + 1)
        SC_STEP(A, st)
        SC_LD(A, min(st + 2, tc - 1))
        SC_STEP(B, st + 1)
      }
      ypart = allreduce16(ypart);
      if (l16 == 0) y_s[(tc - 1) * 16 + rl] = ypart;
    }
    __syncthreads();
    if (tid < tc * 8) {
      const int st = tid >> 3, pr = tid & 7;
      const unsigned pk = pack2(y_s[st * 16 + 2 * pr], y_s[st * 16 + 2 * pr + 1]);
      *(unsigned*)(ACT + (size_t)(tok0 + sb + st) * 1024 + 512 + hd * 64 + q * 16 + 2 * pr) = pk;
    }
  }
  *(float4*)(Sout + row * 64 + j0) = make_float4(s01.x, s01.y, s23.x, s23.y);
}

constexpr int RL = 136;
DI void ret_prompt(KP p, int b, int hd, char* smem) {
  const int tid = tidx(), lane = tid & 63, w = tid >> 6, r = lane & 31, h = lane >> 5;
  const bf16_t* RET = (const bf16_t*)p->out;
  bf16_t* ACT = (bf16_t*)(p->ws + OFF_ACT);
  bf16_t* Vt = (bf16_t*)smem;
  bf16_t* Kzt = (bf16_t*)(smem + 17408);
  bf16_t* St = (bf16_t*)(smem + 34816);
  bf16_t* Sc = (bf16_t*)(smem + 44032);
  float* Of = (float*)(smem + 44032);
  float* dec = (float*)(smem + 78848);
  const float lg = log_gamma(hd);
  if (tid < 129) dec[tid] = __expf((float)tid * lg);
  for (int e = tid; e < 64 * 72; e += 256) St[e] = 0;
  __syncthreads();
  const float g128 = dec[128];
  f32x16 Sacc;
#pragma unroll
  for (int e = 0; e < 16; ++e) Sacc[e] = 0.f;
  const int vt = w >> 1, dt = w & 1;
  for (int c = 0; c < 16; ++c) {
    const int tokc = b * 2048 + c * 128;
    {
      const int j = tid >> 1, hf = tid & 1;
      const bf16_t* vsrc = RET + (size_t)(tokc + j) * 2048 + 1024 + hd * 64 + hf * 32;
      const bf16_t* ksrc = RET + (size_t)(tokc + j) * 2048 + 512 + hd * 64 + hf * 32;
      const float zj = dec[127 - j];
#pragma unroll
      for (int qd = 0; qd < 4; ++qd) {
        const uint4 uv = *(const uint4*)(vsrc + qd * 8);
        const uint4 uk = *(const uint4*)(ksrc + qd * 8);
        const unsigned vv[4] = {uv.x, uv.y, uv.z, uv.w};
        const unsigned kk[4] = {uk.x, uk.y, uk.z, uk.w};
#pragma unroll
        for (int e = 0; e < 4; ++e) {
          const int col = hf * 32 + qd * 8 + e * 2;
          Vt[col * RL + j] = (bf16_t)(vv[e] & 0xffffu);
          Vt[(col + 1) * RL + j] = (bf16_t)(vv[e] >> 16);
          Kzt[col * RL + j] = f2bf(lo2f(kk[e]) * zj);
          Kzt[(col + 1) * RL + j] = f2bf(hi2f(kk[e]) * zj);
        }
      }
    }
    bf16x8 qf[4];
    {
      const bf16_t* qsrc = RET + (size_t)(tokc + 32 * w + r) * 2048 + hd * 64 + h * 8;
#pragma unroll
      for (int ks = 0; ks < 4; ++ks) qf[ks] = *(const bf16x8*)(qsrc + ks * 16);
    }
#pragma unroll
    for (int jb = 0; jb < 2; ++jb) {
      bf16x8 kf[2][4];
#pragma unroll
      for (int jj = 0; jj < 2; ++jj) {
        const int jt = jb * 2 + jj;
        if (jt <= w) {
          const bf16_t* ksrc = RET + (size_t)(tokc + 32 * jt + r) * 2048 + 512 + hd * 64 + h * 8;
#pragma unroll
          for (int ks = 0; ks < 4; ++ks) kf[jj][ks] = *(const bf16x8*)(ksrc + ks * 16);
        }
      }
#pragma unroll
      for (int jj = 0; jj < 2; ++jj) {
        const int jt = jb * 2 + jj;
        if (jt <= w) {
          f32x16 sc;
#pragma unroll
          for (int e = 0; e < 16; ++e) sc[e] = 0.f;
#pragma unroll
          for (int ks = 0; ks < 4; ++ks) sc = __builtin_amdgcn_mfma_f32_32x32x16_bf16(qf[ks], kf[jj][ks], sc, 0, 0, 0);
#pragma unroll
          for (int e = 0; e < 16; ++e) {
            const int i = 32 * w + crow(e, h), j = 32 * jt + r;
            const int d = i - j;
            const float val = (d >= 0) ? sc[e] * dec[d >= 0 ? d : 0] : 0.f;
            Sc[i * RL + j] = f2bf(val);
          }
        }
      }
    }
    __syncthreads();
    f32x16 oacc[2];
#pragma unroll
    for (int nt = 0; nt < 2; ++nt) {
#pragma unroll
      for (int e = 0; e < 16; ++e) oacc[nt][e] = 0.f;
#pragma unroll
      for (int ks = 0; ks < 4; ++ks) {
        const bf16x8 sf = *(const bf16x8*)(St + (nt * 32 + r) * 72 + ks * 16 + h * 8);
        oacc[nt] = __builtin_amdgcn_mfma_f32_32x32x16_bf16(qf[ks], sf, oacc[nt], 0, 0, 0);
      }
#pragma unroll
      for (int e = 0; e < 16; ++e) oacc[nt][e] *= dec[32 * w + crow(e, h) + 1];
    }
    for (int ks = 0; ks < 2 * (w + 1); ++ks) {
      const bf16x8 af = *(const bf16x8*)(Sc + (32 * w + r) * RL + ks * 16 + h * 8);
#pragma unroll
      for (int nt = 0; nt < 2; ++nt) {
        const bf16x8 vf = *(const bf16x8*)(Vt + (nt * 32 + r) * RL + ks * 16 + h * 8);
        oacc[nt] = __builtin_amdgcn_mfma_f32_32x32x16_bf16(af, vf, oacc[nt], 0, 0, 0);
      }
    }
#pragma unroll
    for (int e = 0; e < 16; ++e) Sacc[e] *= g128;
#pragma unroll
    for (int ks = 0; ks < 8; ++ks) {
      const bf16x8 af = *(const bf16x8*)(Vt + (vt * 32 + r) * RL + ks * 16 + h * 8);
      const bf16x8 bf = *(const bf16x8*)(Kzt + (dt * 32 + r) * RL + ks * 16 + h * 8);
      Sacc = __builtin_amdgcn_mfma_f32_32x32x16_bf16(af, bf, Sacc, 0, 0, 0);
    }
    __syncthreads();
#pragma unroll
    for (int nt = 0; nt < 2; ++nt)
#pragma unroll
      for (int e = 0; e < 16; ++e) Of[(32 * w + crow(e, h)) * 66 + nt * 32 + r] = oacc[nt][e];
#pragma unroll
    for (int e = 0; e < 16; ++e) St[(vt * 32 + crow(e, h)) * 72 + dt * 32 + r] = f2bf(Sacc[e]);
    __syncthreads();
    {
      const int i = tid >> 1, hf = tid & 1;
      const int t = tokc + i;
      float vals[32];
      float sm = 0.f;
#pragma unroll
      for (int k = 0; k < 32; ++k) { vals[k] = Of[i * 66 + hf * 32 + k]; sm += vals[k]; }
      sm += __shfl_xor(sm, 1);
      const float mean = sm * (1.f / 64.f);
      float vs = 0.f;
#pragma unroll
      for (int k = 0; k < 32; ++k) { vals[k] -= mean; vs += vals[k] * vals[k]; }
      vs += __shfl_xor(vs, 1);
      const float rs = rsqrtf(vs * (1.f / 64.f) + 1e-5f);
      const bf16_t* gsrc = RET + (size_t)t * 2048 + 1536 + hd * 64 + hf * 32;
      bf16_t* dst = ACT + (size_t)t * 1024 + hd * 64 + hf * 32;
#pragma unroll
      for (int qd = 0; qd < 4; ++qd) {
        const uint4 ug = *(const uint4*)(gsrc + qd * 8);
        const unsigned gg[4] = {ug.x, ug.y, ug.z, ug.w};
        unsigned o4[4];
#pragma unroll
        for (int e = 0; e < 4; ++e) {
          const float g0 = lo2f(gg[e]), g1 = hi2f(gg[e]);
          const float a0 = vals[qd * 8 + 2 * e] * rs * (g0 * sigmoidf_(g0));
          const float a1 = vals[qd * 8 + 2 * e + 1] * rs * (g1 * sigmoidf_(g1));
          o4[e] = pack2(a0, a1);
        }
        *(uint4*)(dst + qd * 8) = make_uint4(o4[0], o4[1], o4[2], o4[3]);
      }
    }
    __syncthreads();
  }
  float* so = p->out + O_RETP + (size_t)(b * 8 + hd) * 4096;
#pragma unroll
  for (int gq = 0; gq < 4; ++gq)
    *(float4*)(so + (dt * 32 + r) * 64 + vt * 32 + 8 * gq + 4 * h) =
        make_float4(Sacc[4 * gq], Sacc[4 * gq + 1], Sacc[4 * gq + 2], Sacc[4 * gq + 3]);
}

DI void ret_sample(KP p, int b, int hd, char* smem) {
  const int tid = tidx();
  const bf16_t* RET = (const bf16_t*)p->out;
  bf16_t* ACT = (bf16_t*)(p->ws + OFF_ACT);
  float* q_s = (float*)smem;
  float* k_s = q_s + 512;
  float* v_s = k_s + 512;
  float* A_s = v_s + 512;
  float* part = A_s + 64;
  const int tok0 = TP + b * 8;
  const float lg = log_gamma(hd);
  __syncthreads();
  {
    const int e = tid * 2, rw = e >> 6, cl = e & 63;
    const bf16_t* base = RET + (size_t)(tok0 + rw) * 2048 + hd * 64 + cl;
    const unsigned uq = *(const unsigned*)(base), uk = *(const unsigned*)(base + 512), uv = *(const unsigned*)(base + 1024);
    q_s[e] = lo2f(uq); q_s[e + 1] = hi2f(uq);
    k_s[e] = lo2f(uk); k_s[e + 1] = hi2f(uk);
    v_s[e] = lo2f(uv); v_s[e + 1] = hi2f(uv);
  }
  __syncthreads();
  if (tid < 64) {
    const int i = tid >> 3, j = tid & 7;
    float a = 0.f;
    if (i >= j) {
#pragma unroll 4
      for (int d = 0; d < 64; ++d) a = fmaf(q_s[i * 64 + d], k_s[j * 64 + d], a);
      a *= __expf((float)(i - j) * lg);
    }
    A_s[tid] = a;
  }
  {
    const int dg = tid >> 6, v = tid & 63;
    const float* S0 = p->in[2] + (size_t)(b * 8 + hd) * 4096;
    float* So = p->out + O_RETS + (size_t)(b * 8 + hd) * 4096;
    float oi[8];
#pragma unroll
    for (int i = 0; i < 8; ++i) oi[i] = 0.f;
    const float g8 = __expf(8.f * lg);
    float kv[8];
#pragma unroll
    for (int j = 0; j < 8; ++j) kv[j] = v_s[j * 64 + v] * __expf((float)(7 - j) * lg);
#pragma unroll 1
    for (int hb = 0; hb < 2; ++hb) {
      float sv[8];
#pragma unroll
      for (int dd = 0; dd < 8; ++dd) sv[dd] = S0[(dg * 16 + hb * 8 + dd) * 64 + v];
#pragma unroll
      for (int dd = 0; dd < 8; ++dd) {
        const int d = dg * 16 + hb * 8 + dd;
        const float s = sv[dd];
        float sn = s * g8;
#pragma unroll
        for (int j = 0; j < 8; ++j) sn = fmaf(k_s[j * 64 + d], kv[j], sn);
        So[d * 64 + v] = sn;
#pragma unroll
        for (int i = 0; i < 8; ++i) oi[i] = fmaf(q_s[i * 64 + d], s, oi[i]);
      }
    }
#pragma unroll
    for (int i = 0; i < 8; ++i) part[(dg * 8 + i) * 64 + v] = oi[i];
  }
  __syncthreads();
#pragma unroll
  for (int rep = 0; rep < 2; ++rep) {
    const int i = (tid >> 6) + 4 * rep, v = tid & 63;
    float o = part[(0 * 8 + i) * 64 + v] + part[(1 * 8 + i) * 64 + v] + part[(2 * 8 + i) * 64 + v] + part[(3 * 8 + i) * 64 + v];
    o *= __expf((float)(i + 1) * lg);
    for (int j = 0; j <= i; ++j) o = fmaf(A_s[i * 8 + j], v_s[j * 64 + v], o);
    const float mean = wave_sum(o) * (1.f / 64.f);
    const float dv = o - mean;
    const float var = wave_sum(dv * dv) * (1.f / 64.f);
    const int t = tok0 + i;
    const float gt = bf2f(RET[(size_t)t * 2048 + 1536 + hd * 64 + v]);
    ACT[(size_t)t * 1024 + hd * 64 + v] = f2bf(dv * rsqrtf(var + 1e-5f) * (gt * sigmoidf_(gt)));
  }
}

constexpr size_t TAB_V8 = (size_t)16384 * 1024;
constexpr size_t TAB_SC = (size_t)2 * 16384 * 1024;
DI void convert_tab(KP p, int it) {
  const int tid = tidx(), lane = tid & 63, w = tid >> 6;
  const int row0 = it * 8 + w * 2;
  const float* src = (row0 < 16384) ? p->in[24] + (size_t)row0 * 1024 : p->in[25] + (size_t)(row0 - 16384) * 1024;
  float4 v[2][4];
#pragma unroll
  for (int rr = 0; rr < 2; ++rr)
#pragma unroll
    for (int i = 0; i < 4; ++i) v[rr][i] = *(const float4*)(src + rr * 1024 + i * 256 + lane * 4);
#pragma unroll
  for (int rr = 0; rr < 2; ++rr) {
    float am = 0.f;
#pragma unroll
    for (int i = 0; i < 4; ++i)
      am = fmaxf(am, fmaxf(fmaxf(fabsf(v[rr][i].x), fabsf(v[rr][i].y)), fmaxf(fabsf(v[rr][i].z), fabsf(v[rr][i].w))));
#pragma unroll
    for (int o = 32; o >= 1; o >>= 1) am = fmaxf(am, __shfl_xor(am, o));
    am = fmaxf(am, 1e-30f);
    const float inv = 127.f / am;
    unsigned char* dst = (unsigned char*)(p->ws + OFF_TAB) + (size_t)(row0 + rr) * 1024;
#pragma unroll
    for (int i = 0; i < 4; ++i) {
      const unsigned q0 = (unsigned)((int)rintf(v[rr][i].x * inv) + 128);
      const unsigned q1 = (unsigned)((int)rintf(v[rr][i].y * inv) + 128);
      const unsigned q2 = (unsigned)((int)rintf(v[rr][i].z * inv) + 128);
      const unsigned q3 = (unsigned)((int)rintf(v[rr][i].w * inv) + 128);
      *(unsigned*)(dst + i * 256 + lane * 4) = q0 | (q1 << 8) | (q2 << 16) | (q3 << 24);
    }
    if (lane == 0) ((float*)(p->ws + OFF_TAB + TAB_SC))[row0 + rr] = am * (1.f / 127.f);
  }
}

DI void phase4_other(KP p, int it, char* smem) {
  if (it < 64) { ret_prompt(p, it >> 3, it & 7, smem); return; }
  it -= 64;
  if (it < 4096) {
    const int bh = it >> 2, q = it & 3, b = bh >> 3, hd = bh & 7;
    rwkv_scan(p, TP + b * 8, hd, q, 8, p->in[3] + (size_t)bh * 4096, p->out + O_WKVS + (size_t)bh * 4096, smem);
    return;
  }
  it -= 4096;
  if (it < 1024) { ret_sample(p, it >> 3, it & 7, smem); return; }
  it -= 1024;
  if (it < 4096) { convert_tab(p, it); return; }
  it -= 4096;
#define TJ4(IDX, OFF, KK_, NN_)                                                                            \
  {                                                                                                        \
    const int ntl = ((KK_) / 64) * ((NN_) / 64);                                                           \
    if (it < ntl) {                                                                                        \
      transpose_tile(p->in[IDX], (bf16_t*)(p->ws + (OFF)), (KK_), (NN_), it / ((NN_) / 64), it % ((NN_) / 64), (float*)smem); \
      return;                                                                                              \
    }                                                                                                      \
    it -= ntl;                                                                                             \
  }
  TJ4(20, OFF_WOUT, 1024, 1024)
  TJ4(22, OFF_WQ, 1024, 2048)
  TJ4(27, OFF_PG, 1024, 1024)
  TJ4(28, OFF_PP, 256, 1024)
}
DI void phase4(KP p, char* smem) {
  constexpr int N_OTHER = 64 + 4096 + 1024 + 4096 + (256 + 512 + 256 + 64);
  int* s_item = (int*)(smem + SMEM_BYTES - 16);
  unsigned* ctr = (unsigned*)(p->ws + OFF_CTR);
  unsigned* cukey = (unsigned*)(p->ws + OFF_CTR + 16384);
  __syncthreads();
  if (tidx() == 0) {
    const unsigned hw = (unsigned)__builtin_amdgcn_s_getreg((7 << 11) | (8 << 6) | 4);
    const unsigned key = (xb_xcc_id() << 8) | (hw & 0xffu);
    const unsigned old = atomicAdd(&cukey[key], 1u);
    int it = -1;
    if (old == 0u) { const unsigned q = atomicAdd(&ctr[1], 1u); if (q < 256u) it = (int)q; }
    *s_item = it;
  }
  __syncthreads();
  {
    const int it = *s_item;
    if (it >= 0) {
      const int bh = it >> 2, q = it & 3, b = bh >> 3, hd = bh & 7;
      __builtin_amdgcn_s_setprio(3);
      rwkv_scan(p, b * 2048, hd, q, 2048, nullptr, p->out + O_WKVP + (size_t)bh * 4096, smem);
      __builtin_amdgcn_s_setprio(0);
    }
  }
  for (;;) {
    __syncthreads();
    if (tidx() == 0) *s_item = (int)atomicAdd(&ctr[0], 1u);
    __syncthreads();
    const int it = *s_item;
    if (it >= N_OTHER) break;
    phase4_other(p, it, smem);
  }
  for (;;) {
    __syncthreads();
    if (tidx() == 0) *s_item = (int)atomicAdd(&ctr[1], 1u);
    __syncthreads();
    const int it = *s_item;
    if (it >= 256) break;
    const int bh = it >> 2, q = it & 3, b = bh >> 3, hd = bh & 7;
    rwkv_scan(p, b * 2048, hd, q, 2048, nullptr, p->out + O_WKVP + (size_t)bh * 4096, smem);
  }
}

DI void phase5(KP p) {
  const int lane = tidx() & 63, w = tidx() >> 6;
  bf16_t* ACT = (bf16_t*)(p->ws + OFF_ACT);
  const bf16_t* Rb = (const bf16_t*)(p->ws + OFF_R);
  const bf16_t* Kb = (const bf16_t*)(p->ws + OFF_K);
  const bf16_t* Vb = (const bf16_t*)(p->ws + OFF_V);
  const bf16_t* GTb = (const bf16_t*)(p->ws + OFF_GATE);
  const int c8 = lane * 8;
  float rk8[8], lg8[8], lb8[8];
  {
    const float4 a0 = *(const float4*)(p->in[17] + c8), a1 = *(const float4*)(p->in[17] + c8 + 4);
    const float4 b0 = *(const float4*)(p->in[18] + c8), b1 = *(const float4*)(p->in[18] + c8 + 4);
    const float4 d0 = *(const float4*)(p->in[19] + c8), d1 = *(const float4*)(p->in[19] + c8 + 4);
    rk8[0] = a0.x; rk8[1] = a0.y; rk8[2] = a0.z; rk8[3] = a0.w; rk8[4] = a1.x; rk8[5] = a1.y; rk8[6] = a1.z; rk8[7] = a1.w;
    lg8[0] = b0.x; lg8[1] = b0.y; lg8[2] = b0.z; lg8[3] = b0.w; lg8[4] = b1.x; lg8[5] = b1.y; lg8[6] = b1.z; lg8[7] = b1.w;
    lb8[0] = d0.x; lb8[1] = d0.y; lb8[2] = d0.z; lb8[3] = d0.w; lb8[4] = d1.x; lb8[5] = d1.y; lb8[6] = d1.z; lb8[7] = d1.w;
  }
  for (int t = blockIdx.x * 4 + w; t < T; t += gridDim.x * 4) {
    const size_t o = (size_t)t * 512 + c8;
    bf16_t* yp = ACT + (size_t)t * 1024 + 512 + c8;
    const uint4 uy = *(const uint4*)yp, ur = *(const uint4*)(Rb + o), uk = *(const uint4*)(Kb + o),
                uv = *(const uint4*)(Vb + o), ug = *(const uint4*)(GTb + o);
    float y[8], r[8], k[8], v[8], g[8];
    unpack8f(uy, y); unpack8f(ur, r); unpack8f(uk, k); unpack8f(uv, v); unpack8f(ug, g);
    float sm = 0.f, rk = 0.f;
#pragma unroll
    for (int e = 0; e < 8; ++e) { sm += y[e]; rk = fmaf(r[e] * k[e], rk8[e], rk); }
    sm = allreduce8(sm);
    rk = allreduce8(rk);
    const float mean = sm * (1.f / 64.f);
    float vs = 0.f;
#pragma unroll
    for (int e = 0; e < 8; ++e) { y[e] -= mean; vs += y[e] * y[e]; }
    vs = allreduce8(vs);
    const float rs = rsqrtf(vs * (1.f / 64.f) + 64e-5f);
    float ov[8];
#pragma unroll
    for (int e = 0; e < 8; ++e) ov[e] = (y[e] * rs * lg8[e] + lb8[e] + rk * v[e]) * g[e];
    *(uint4*)yp = pack8f(ov);
  }
}

DI void phase6(KP p, char* smem) {
  for (int tile = blockIdx.x; tile < 136 * 8; tile += gridDim.x) {
    const int mt = tile >> 3, nt = tile & 7;
    const int m0 = mt * 128, n0 = nt * 128;
    f32x16 acc[2][2];
    gemm128<false>((const bf16_t*)(p->ws + OFF_ACT) + (size_t)m0 * 1024, 1024,
                   (const bf16_t*)(p->ws + OFF_WOUT) + (size_t)n0 * 1024, 1024, 1024, acc, smem);
    {
      const int lane = tidx() & 63, w = tidx() >> 6;
      const int wm = w >> 1, wn = w & 1, r = lane & 31, h = lane >> 5;
      const float* xb = (m0 < TP) ? p->in[0] + (size_t)m0 * 1024 : p->in[1] + (size_t)(m0 - TP) * 1024;
#pragma unroll
      for (int mi = 0; mi < 2; ++mi)
#pragma unroll
        for (int ni = 0; ni < 2; ++ni)
#pragma unroll
          for (int i = 0; i < 16; ++i)
            acc[mi][ni][i] += xb[(size_t)(wm * 64 + mi * 32 + crow(i, h)) * 1024 + n0 + wn * 64 + ni * 32 + r];
#pragma unroll
      for (int mi = 0; mi < 2; ++mi)
#pragma unroll
        for (int ni = 0; ni < 2; ++ni)
#pragma unroll
          for (int i = 0; i < 16; ++i)
            p->out[(size_t)(m0 + wm * 64 + mi * 32 + crow(i, h)) * 1024 + n0 + wn * 64 + ni * 32 + r] = acc[mi][ni][i];
    }
  }
}

DI void phase7(KP p) {
  const int lane = tidx() & 63, w = tidx() >> 6;
  for (int t = blockIdx.x * 4 + w; t < T; t += gridDim.x * 4)
    rmsnorm_row_bf(p->out + (size_t)t * 1024, p->in[21], (bf16_t*)(p->ws + OFF_ACT) + (size_t)t * 1024, lane);
}

DI void phase8(KP p, char* smem) {
  bf16_t* QP = (bf16_t*)(p->ws + OFF_QPEER);
  for (int tile = blockIdx.x; tile < 136 * 16; tile += gridDim.x) {
    const int mt = tile >> 4, nt = tile & 15;
    const int m0 = mt * 128, n0 = nt * 128;
    f32x16 acc[2][2];
    gemm128<false>((const bf16_t*)(p->ws + OFF_ACT) + (size_t)m0 * 1024, 1024,
                   (const bf16_t*)(p->ws + OFF_WQ) + (size_t)n0 * 1024, 1024, 1024, acc, smem);
    epi_each(acc, [&](int rr, int cc, float v) { QP[(size_t)(m0 + rr) * 2048 + n0 + cc] = f2bf(v); });
  }
}

DI unsigned sortkey(float f) { unsigned u = __float_as_uint(f); return (u & 0x80000000u) ? ~u : (u | 0x80000000u); }
DI float unsortkey(unsigned k) { unsigned u = (k & 0x80000000u) ? (k ^ 0x80000000u) : ~k; return __uint_as_float(u); }
DI void ins16(unsigned (&l)[16], unsigned x) {
#pragma unroll
  for (int i = 0; i < 16; ++i) { const unsigned hi = max(l[i], x); x = min(l[i], x); l[i] = hi; }
}
DI void cswap_desc(unsigned& a, unsigned& b) { const unsigned hi = max(a, b), lo = min(a, b); a = hi; b = lo; }
DI void bsort16(unsigned (&v)[16]) {
#pragma unroll
  for (int ke = 1; ke <= 4; ++ke)
#pragma unroll
    for (int je = ke - 1; je >= 0; --je)
#pragma unroll
      for (int i = 0; i < 16; ++i) {
        const int k = 1 << ke, j = 1 << je, l = i ^ j;
        if (l > i) { if ((i & k) == 0) cswap_desc(v[i], v[l]); else cswap_desc(v[l], v[i]); }
      }
}
DI void bmerge16(unsigned (&a)[16], const unsigned (&b)[16]) {
#pragma unroll
  for (int i = 0; i < 16; ++i) a[i] = max(a[i], b[15 - i]);
#pragma unroll
  for (int je = 3; je >= 0; --je)
#pragma unroll
    for (int i = 0; i < 16; ++i) {
      const int j = 1 << je, l = i ^ j;
      if (l > i) cswap_desc(a[i], a[l]);
    }
}
DI void phase9(KP p, char* smem) {
  const int tid = tidx();
  const bf16_t* QP = (const bf16_t*)(p->ws + OFF_QPEER);
  const bf16_t* KEYS = (const bf16_t*)(p->ws + OFF_KEYS);
  int* IDX = (int*)(p->ws + OFF_IDX);
  float* GSM = (float*)(p->ws + OFF_GSM);
  float* sc = (float*)smem;
  unsigned* mrg = (unsigned*)smem;
  const int row = tid >> 1, half = tid & 1;
  for (int item = blockIdx.x; item < 136 * 8; item += gridDim.x) {
    const int mt = item >> 3, hd = item & 7;
    const int m0 = mt * 128;
    unsigned kc[2][16];
#pragma unroll
    for (int c = 0; c < 2; ++c) {
      f32x16 acc[2][2];
      gemm128<false>(QP + (size_t)m0 * 2048 + (hd * 2 + c) * 128, 2048, KEYS + (size_t)(hd * 2 + c) * 16384, 128, 128, acc, smem);
      __syncthreads();
      epi_each(acc, [&](int rr, int cc, float v) { sc[rr * 129 + cc] = v; });
      __syncthreads();
      unsigned lst[16];
#pragma unroll
      for (int gi = 0; gi < 4; ++gi) {
        unsigned grp[16];
#pragma unroll
        for (int i = 0; i < 16; ++i) {
          const int col = half * 64 + gi * 16 + i;
          grp[i] = (sortkey(sc[row * 129 + col]) & ~127u) | (unsigned)(127 - col);
        }
        bsort16(grp);
        if (gi == 0) {
#pragma unroll
          for (int i = 0; i < 16; ++i) lst[i] = grp[i];
        } else {
          bmerge16(lst, grp);
        }
      }
      __syncthreads();
      if (half) {
#pragma unroll
        for (int i = 0; i < 16; ++i) mrg[row * 16 + i] = lst[i];
      }
      __syncthreads();
      if (!half) {
        unsigned grp[16];
#pragma unroll
        for (int i = 0; i < 16; ++i) grp[i] = mrg[row * 16 + i];
        bmerge16(lst, grp);
      }
#pragma unroll
      for (int i = 0; i < 16; ++i) kc[c][i] = lst[i];
    }
    if (!half) {
      float sv0[16], sv1[16];
#pragma unroll
      for (int i = 0; i < 16; ++i) { sv0[i] = unsortkey(kc[0][i] & ~127u); sv1[i] = unsortkey(kc[1][i] & ~127u); }
      unsigned cl[16];
#pragma unroll
      for (int i = 0; i < 16; ++i) cl[i] = 0u;
#pragma unroll
      for (int a = 0; a < 16; ++a)
#pragma unroll
        for (int b = 0; b < 16 / (a + 1); ++b)
          ins16(cl, (sortkey(sv0[a] + sv1[b]) & ~255u) | (unsigned)(255 - (a * 16 + b)));
      float ex[16];
      float sum = 0.f;
      const float mx = unsortkey(cl[0] & ~255u);
#pragma unroll
      for (int i = 0; i < 16; ++i) { ex[i] = __expf(unsortkey(cl[i] & ~255u) - mx); sum += ex[i]; }
      const float inv = 1.f / sum;
      int eo[16];
#pragma unroll
      for (int i = 0; i < 16; ++i) {
        const int ci = 255 - (int)(cl[i] & 255u);
        const int a = ci >> 4, b = ci & 15;
        int i0 = 0, i1 = 0;
#pragma unroll
        for (int k = 0; k < 16; ++k) {
          i0 = (a == k) ? (127 - (int)(kc[0][k] & 127u)) : i0;
          i1 = (b == k) ? (127 - (int)(kc[1][k] & 127u)) : i1;
        }
        eo[i] = i0 * 128 + i1;
        ex[i] *= inv;
      }
      const size_t o = ((size_t)(m0 + row) * 8 + hd) * 16;
#pragma unroll
      for (int qd = 0; qd < 4; ++qd) {
        *(int4*)(IDX + o + qd * 4) = make_int4(eo[qd * 4], eo[qd * 4 + 1], eo[qd * 4 + 2], eo[qd * 4 + 3]);
        *(float4*)(GSM + o + qd * 4) = make_float4(ex[qd * 4], ex[qd * 4 + 1], ex[qd * 4 + 2], ex[qd * 4 + 3]);
      }
    }
  }
}

#define UB0(u) ((float)((u) & 0xffu))
#define UB1(u) ((float)(((u) >> 8) & 0xffu))
#define UB2(u) ((float)(((u) >> 16) & 0xffu))
#define UB3(u) ((float)((u) >> 24))
template <int MODE, bool HALF>
DI void peer_token(KP p, const int t, const int it0, const int it1, char* smem) {
  const int lane = tidx() & 63, w = tidx() >> 6;
  const int g = lane >> 4, l16 = lane & 15;
  bf16_t* ACT = (bf16_t*)(p->ws + OFF_ACT);
  const unsigned char* UB = (const unsigned char*)(p->ws + OFF_TAB);
  const unsigned char* VB = UB + TAB_V8;
  const float* USC = (const float*)(p->ws + OFF_TAB + TAB_SC);
  const float* VSC = USC + 16384;
  const int* IDX = (const int*)(p->ws + OFF_IDX);
  const float* GSM = (const float*)(p->ws + OFF_GSM);
  const float* pn = p->in[26];
  {
    bf16_t* act = ACT + (size_t)t * 1024;
    float xf[64];
    float xsum = 0.f;
    float* CV = (float*)(p->ws + OFF_QPEER) + (size_t)t * 128;
    float c0 = 0.f, c1 = 0.f;
    if (MODE == 3) { c0 = CV[lane]; c1 = CV[64 + lane]; }
#pragma unroll
    for (int s = 0; s < 4; ++s) {
      if (MODE == 3) break;
      const uint4 x0 = *(const uint4*)(act + s * 256 + l16 * 16);
      const uint4 x1 = *(const uint4*)(act + s * 256 + l16 * 16 + 8);
      const unsigned xx[8] = {x0.x, x0.y, x0.z, x0.w, x1.x, x1.y, x1.z, x1.w};
#pragma unroll
      for (int q = 0; q < 8; ++q) { xf[s * 16 + 2 * q] = lo2f(xx[q]); xf[s * 16 + 2 * q + 1] = hi2f(xx[q]); }
    }
#pragma unroll
    for (int k = 0; k < 64; ++k) xsum += (MODE == 3) ? 0.f : xf[k];
    const int id0 = IDX[(size_t)t * 128 + lane], id1 = IDX[(size_t)t * 128 + 64 + lane];
    const float gs0 = GSM[(size_t)t * 128 + lane], gs1 = GSM[(size_t)t * 128 + 64 + lane];
    float acc[64];
#pragma unroll
    for (int k = 0; k < 64; ++k) acc[k] = 0.f;
    float csum = 0.f;
    for (int it = it0; it < it1; ++it) {
      const int n = (it * 4 + g) & 63;
      const int e = __shfl((it < 16) ? id0 : id1, n);
      const float gw = __shfl((it < 16) ? gs0 : gs1, n);
      const unsigned char* ur = UB + (size_t)e * 1024 + l16 * 16;
      const unsigned char* vr = VB + (size_t)e * 1024 + l16 * 16;
      uint4 uu[4], vv[4];
      if (MODE != 3) {
#pragma unroll
        for (int s = 0; s < 4; ++s) uu[s] = *(const uint4*)(ur + s * 256);
      }
      if (MODE != 2) {
#pragma unroll
        for (int s = 0; s < 4; ++s) vv[s] = *(const uint4*)(vr + s * 256);
      }
      float c;
      if (MODE == 3) {
        c = __shfl((it < 16) ? c0 : c1, n);
      } else {
      const float su = USC[e], sv = VSC[e];
      float hv = 0.f;
#pragma unroll
      for (int s = 0; s < 4; ++s) {
        const unsigned ww[4] = {uu[s].x, uu[s].y, uu[s].z, uu[s].w};
#pragma unroll
        for (int q = 0; q < 4; ++q) {
          hv = fmaf(xf[s * 16 + q * 4 + 0], UB0(ww[q]), hv);
          hv = fmaf(xf[s * 16 + q * 4 + 1], UB1(ww[q]), hv);
          hv = fmaf(xf[s * 16 + q * 4 + 2], UB2(ww[q]), hv);
          hv = fmaf(xf[s * 16 + q * 4 + 3], UB3(ww[q]), hv);
        }
      }
      hv = fmaf(-128.f, xsum, hv);
      hv = allreduce16(hv) * su;
      c = 0.5f * hv * (1.f + erff(hv * 0.70710678118f)) * gw * sv;
      }
      if (MODE == 2) {
        const float cc = __shfl(c, ((lane - it * 4) & 3) * 16);
        if ((lane >> 2) == (it & 15)) { if (it < 16) c0 = cc; else c1 = cc; }
        continue;
      }
      csum += c;
#pragma unroll
      for (int s = 0; s < 4; ++s) {
        const unsigned ww[4] = {vv[s].x, vv[s].y, vv[s].z, vv[s].w};
#pragma unroll
        for (int q = 0; q < 4; ++q) {
          acc[s * 16 + q * 4 + 0] = fmaf(c, UB0(ww[q]), acc[s * 16 + q * 4 + 0]);
          acc[s * 16 + q * 4 + 1] = fmaf(c, UB1(ww[q]), acc[s * 16 + q * 4 + 1]);
          acc[s * 16 + q * 4 + 2] = fmaf(c, UB2(ww[q]), acc[s * 16 + q * 4 + 2]);
          acc[s * 16 + q * 4 + 3] = fmaf(c, UB3(ww[q]), acc[s * 16 + q * 4 + 3]);
        }
      }
    }
    if (MODE == 2) {
      if (!HALF || it0 == 0) CV[lane] = c0;
      if (!HALF || it0 != 0) CV[64 + lane] = c1;
      return;
    }
    const float cs128 = 128.f * csum;
#pragma unroll
    for (int k = 0; k < 64; ++k) {
      acc[k] -= cs128;
      acc[k] += __shfl_xor(acc[k], 16);
      acc[k] += __shfl_xor(acc[k], 32);
    }
    float* hrow = p->out + (size_t)t * 1024;
    float hvv[16];
#pragma unroll
    for (int s = 0; s < 4; ++s) {
      if (s == g) {
#pragma unroll
        for (int k = 0; k < 16; ++k) hvv[k] = acc[s * 16 + k];
      }
    }
    if (HALF) {
      float* ex = (float*)smem + ((w >> 1) * 64 + lane) * 16;
      if (w & 1) {
#pragma unroll
        for (int q = 0; q < 4; ++q) *(float4*)(ex + q * 4) = make_float4(hvv[q * 4], hvv[q * 4 + 1], hvv[q * 4 + 2], hvv[q * 4 + 3]);
      }
      __syncthreads();
      if (w & 1) return;
#pragma unroll
      for (int q = 0; q < 4; ++q) {
        const float4 e4 = *(const float4*)(ex + q * 4);
        hvv[q * 4] += e4.x; hvv[q * 4 + 1] += e4.y; hvv[q * 4 + 2] += e4.z; hvv[q * 4 + 3] += e4.w;
      }
    }
    {
      float* hp = hrow + g * 256 + l16 * 16;
      const float4 r0 = *(const float4*)(hp), r1 = *(const float4*)(hp + 4), r2 = *(const float4*)(hp + 8), r3 = *(const float4*)(hp + 12);
      hvv[0] += r0.x; hvv[1] += r0.y; hvv[2] += r0.z; hvv[3] += r0.w; hvv[4] += r1.x; hvv[5] += r1.y; hvv[6] += r1.z; hvv[7] += r1.w;
      hvv[8] += r2.x; hvv[9] += r2.y; hvv[10] += r2.z; hvv[11] += r2.w; hvv[12] += r3.x; hvv[13] += r3.y; hvv[14] += r3.z; hvv[15] += r3.w;
      *(float4*)(hp) = make_float4(hvv[0], hvv[1], hvv[2], hvv[3]);
      *(float4*)(hp + 4) = make_float4(hvv[4], hvv[5], hvv[6], hvv[7]);
      *(float4*)(hp + 8) = make_float4(hvv[8], hvv[9], hvv[10], hvv[11]);
      *(float4*)(hp + 12) = make_float4(hvv[12], hvv[13], hvv[14], hvv[15]);
    }
    float ss = 0.f;
#pragma unroll
    for (int k = 0; k < 16; ++k) ss += hvv[k] * hvv[k];
    ss = wave_sum(ss);
    const float scl = rsqrtf(ss * (1.f / 1024.f) + 1e-6f);
    {
      const int col = g * 256 + l16 * 16;
      unsigned o8[8];
#pragma unroll
      for (int q = 0; q < 4; ++q) {
        const float4 g0 = *(const float4*)(pn + col + q * 4);
        o8[q * 2] = pack2(hvv[q * 4 + 0] * scl * g0.x, hvv[q * 4 + 1] * scl * g0.y);
        o8[q * 2 + 1] = pack2(hvv[q * 4 + 2] * scl * g0.z, hvv[q * 4 + 3] * scl * g0.w);
      }
      *(uint4*)(act + col) = make_uint4(o8[0], o8[1], o8[2], o8[3]);
      *(uint4*)(act + col + 8) = make_uint4(o8[4], o8[5], o8[6], o8[7]);
    }
  }
}

DI void phase10(KP p, char* smem) {
  const int w = tidx() >> 6;
  if (gridDim.x == 512) {
#pragma unroll 1
    for (int k = 0; k < 8; ++k) peer_token<2, false>(p, (int)blockIdx.x * 4 + w + k * 2048, 0, 32, smem);
#pragma unroll 1
    for (int k = 0; k < 8; ++k) peer_token<3, false>(p, (int)blockIdx.x * 4 + w + k * 2048, 0, 32, smem);
    __syncthreads();
    peer_token<2, true>(p, 16384 + 2 * (int)blockIdx.x + (w >> 1), (w & 1) * 16, (w & 1) * 16 + 16, smem);
    peer_token<3, true>(p, 16384 + 2 * (int)blockIdx.x + (w >> 1), (w & 1) * 16, (w & 1) * 16 + 16, smem);
  } else {
    for (int t = blockIdx.x * 4 + w; t < T; t += gridDim.x * 4) { peer_token<2, false>(p, t, 0, 32, smem); peer_token<3, false>(p, t, 0, 32, smem); }
  }
}

DI void phase11(KP p, char* smem) {
  for (int tile = blockIdx.x; tile < 136 * 8; tile += gridDim.x) {
    const int mt = tile >> 3, nt = tile & 7;
    const int m0 = mt * 128, n0 = nt * 128;
    f32x16 acc[2][2];
    unsigned ppk[2][2][8];
    const float* pa = (m0 < TP) ? p->in[5] + (size_t)m0 * 256 : p->in[6] + (size_t)(m0 - TP) * 256;
    gemm128<true>(pa, 256, (const bf16_t*)(p->ws + OFF_PP) + (size_t)n0 * 256, 256, 256, acc, smem);
#pragma unroll
    for (int mi = 0; mi < 2; ++mi)
#pragma unroll
      for (int ni = 0; ni < 2; ++ni)
#pragma unroll
        for (int i = 0; i < 8; ++i) ppk[mi][ni][i] = pack2(acc[mi][ni][2 * i], acc[mi][ni][2 * i + 1]);
    gemm128<false>((const bf16_t*)(p->ws + OFF_ACT) + (size_t)m0 * 1024, 1024,
                   (const bf16_t*)(p->ws + OFF_PG) + (size_t)n0 * 1024, 1024, 1024, acc, smem);
    const int lane = tidx() & 63, w = tidx() >> 6;
    const int wm = w >> 1, wn = w & 1, r = lane & 31, h = lane >> 5;
#pragma unroll
    for (int mi = 0; mi < 2; ++mi)
#pragma unroll
      for (int ni = 0; ni < 2; ++ni)
#pragma unroll
        for (int i = 0; i < 16; ++i) {
          const float pp = (i & 1) ? hi2f(ppk[mi][ni][i >> 1]) : lo2f(ppk[mi][ni][i >> 1]);
          acc[mi][ni][i] = sigmoidf_(acc[mi][ni][i]) * pp;
        }
#pragma unroll
    for (int mi = 0; mi < 2; ++mi) {
#pragma unroll
      for (int ni = 0; ni < 2; ++ni)
#pragma unroll
        for (int i = 0; i < 16; ++i)
          acc[mi][ni][i] += p->out[(size_t)(m0 + wm * 64 + mi * 32 + crow(i, h)) * 1024 + n0 + wn * 64 + ni * 32 + r];
#pragma unroll
      for (int ni = 0; ni < 2; ++ni)
#pragma unroll
        for (int i = 0; i < 16; ++i)
          p->out[(size_t)(m0 + wm * 64 + mi * 32 + crow(i, h)) * 1024 + n0 + wn * 64 + ni * 32 + r] = acc[mi][ni][i];
    }
  }
}

DI void phase12(KP p) {
  const int lane = tidx() & 63, w = tidx() >> 6;
  const float* g = p->in[29];
  for (int t = blockIdx.x * 4 + w; t < T; t += gridDim.x * 4) {
    float* x = p->out + (size_t)t * 1024;
    float4 v[4];
    float ss = 0.f;
#pragma unroll
    for (int i = 0; i < 4; ++i) {
      v[i] = ((const float4*)x)[i * 64 + lane];
      ss += v[i].x * v[i].x + v[i].y * v[i].y + v[i].z * v[i].z + v[i].w * v[i].w;
    }
    ss = wave_sum(ss);
    const float sc = rsqrtf(ss * (1.f / 1024.f) + 1e-6f);
#pragma unroll
    for (int i = 0; i < 4; ++i) {
      const float4 gg = ((const float4*)g)[i * 64 + lane];
      ((float4*)x)[i * 64 + lane] = make_float4(v[i].x * sc * gg.x, v[i].y * sc * gg.y, v[i].z * sc * gg.z, v[i].w * sc * gg.w);
    }
  }
}

DI void run_phase(int ph, char* smem) {
  KP p = getp();
  switch (ph) {
    case 0: phase0(p, smem); break;
    case 1: phase1(p, smem); break;
    case 2: phase2(p); break;
    case 3: phase3(p, smem); break;
    case 4: phase4(p, smem); break;
    case 5: phase5(p); break;
    case 6: phase6(p, smem); break;
    case 7: phase7(p); break;
    case 8: phase8(p, smem); break;
    case 9: phase9(p, smem); break;
    case 10: phase10(p, smem); break;
    case 11: phase11(p, smem); break;
    case 12: phase12(p); break;
    default: break;
  }
}

template <int LO, int HI>
__global__ void __launch_bounds__(256, 2) mega_kernel(Params p) {
  __shared__ __attribute__((aligned(16))) char smem[SMEM_BYTES];
  __shared__ uint4 xb_words;
  if (gridDim.x == 0x7fffffffu) cg::this_grid().sync();
  XcdBarrier xb;
  if (HI - LO > 1) {
    if (threadIdx.x == 0) xb_words = make_uint4(0u, 0u, 0u, 0u);
    __syncthreads();
    xb = xcd_barrier_post((unsigned*)(getp()->ws + OFF_CTR), (volatile LAS unsigned*)&xb_words);
  }
#pragma unroll
  for (int ph = LO; ph < HI; ++ph) {
    run_phase(ph, smem);
    if (ph + 1 < HI) xcd_barrier(xb);
  }
}

template <int PH>
static void launch_phases(const Params& p, int grid, hipStream_t stream) {
  hipLaunchKernelGGL((mega_kernel<PH, PH + 1>), dim3(grid), dim3(256), 0, stream, p);
  if constexpr (PH + 1 < 13) launch_phases<PH + 1>(p, grid, stream);
}

extern "C" void kernel_launch(void* const* d_in, const int* in_sizes, int n_in, void* d_out, int out_size,
                              void* d_ws, size_t ws_size, hipStream_t stream) {
  static int grid_blocks = 0;
  if (!grid_blocks) {
    int dev = 0, cus = 0, per_cu = 0;
    (void)hipGetDevice(&dev);
    (void)hipDeviceGetAttribute(&cus, hipDeviceAttributeMultiprocessorCount, dev);
#if MK_MULTI
    per_cu = 2;
#else
    (void)hipOccupancyMaxActiveBlocksPerMultiprocessor(&per_cu, mega_kernel<0, 13>, 256, 0);
#endif
    if (per_cu < 1) per_cu = 1;
    if (per_cu > 2) per_cu = 2;
    grid_blocks = cus * per_cu;
  }
  Params p{};
  for (int i = 0; i < 30; ++i) p.in[i] = (const float*)d_in[i];
  p.out = (float*)d_out;
  p.ws = (char*)d_ws;
  if (ws_size < WS_END) { fprintf(stderr, "workspace too small: %zu < %zu\n", ws_size, (size_t)WS_END); return; }
  (void)hipMemsetAsync((char*)d_ws + OFF_CTR, 0, 32768, stream);
#if MK_MULTI
  launch_phases<0>(p, grid_blocks, stream);
#else
  void* args[] = {&p};
  hipError_t e = hipLaunchCooperativeKernel((void*)mega_kernel<0, 13>, dim3(grid_blocks), dim3(256), args, 0, stream);
  if (e != hipSuccess) fprintf(stderr, "cooperative launch failed: %s (grid %d)\n", hipGetErrorString(e), grid_blocks);
#endif
}
```

```cpp
#include <hip/hip_runtime.h>
#include <hip/hip_cooperative_groups.h>
#include <cstdio>
namespace cg = cooperative_groups;

#ifndef MK_MULTI
#define MK_MULTI 0
#endif

typedef unsigned short bf16_t;
typedef __attribute__((ext_vector_type(8))) short bf16x8;
typedef __attribute__((ext_vector_type(16))) float f32x16;
typedef __attribute__((ext_vector_type(2))) __bf16 bf2_t;
typedef __attribute__((ext_vector_type(2))) float f2_t;
#define DI __device__ __forceinline__

constexpr int T = 17408, TP = 16384;
constexpr int NPH = 14;

constexpr size_t O_RETP = (size_t)T * 1024;
constexpr size_t O_WKVP = O_RETP + 262144;
constexpr size_t O_SHP = O_WKVP + 262144;
constexpr size_t O_RETS = O_SHP + 14336;
constexpr size_t O_WKVS = O_RETS + 4194304;
constexpr size_t O_SHS = O_WKVS + 4194304;

constexpr size_t OFF_WIN = 0;
constexpr size_t OFF_WOUT = OFF_WIN + (size_t)3840 * 1024 * 2;
constexpr size_t OFF_WQ = OFF_WOUT + (size_t)1024 * 1024 * 2;
constexpr size_t OFF_KEYS = OFF_WQ + (size_t)2048 * 1024 * 2;
constexpr size_t OFF_PG = OFF_KEYS + (size_t)16 * 128 * 128 * 2;
constexpr size_t OFF_PP = OFF_PG + (size_t)1024 * 1024 * 2;
constexpr size_t OFF_W2 = OFF_PP + (size_t)1024 * 256 * 2;
constexpr size_t OFF_A2 = OFF_W2 + (size_t)512 * 64 * 2;
constexpr size_t OFF_G2 = OFF_A2 + (size_t)512 * 64 * 2;
constexpr size_t OFF_ROPE = OFF_G2 + (size_t)512 * 128 * 2;
constexpr size_t OFF_CTR = OFF_ROPE + (size_t)2056 * 32 * 2 * 4;
constexpr size_t OFF_ACT = OFF_CTR + 32768;
constexpr size_t OFF_TAB = OFF_ACT + (size_t)T * 1024 * 2;
constexpr size_t OFF_PREP = OFF_TAB + (size_t)2 * 16384 * 1024 * 2;
constexpr size_t SZ512 = (size_t)T * 512 * 2;
constexpr size_t OFF_R = OFF_PREP;
constexpr size_t OFF_K = OFF_R + SZ512;
constexpr size_t OFF_V = OFF_K + SZ512;
constexpr size_t OFF_KK = OFF_V + SZ512;
constexpr size_t OFF_BB = OFF_KK + SZ512;
constexpr size_t OFF_GATE = OFF_BB + SZ512;
constexpr size_t OFF_EW = OFF_GATE + SZ512;
constexpr size_t OFF_LORA = OFF_EW + (size_t)T * 512 * 4;
constexpr size_t OFF_INVN = OFF_LORA + (size_t)T * 256 * 2;
constexpr size_t WS_END = OFF_INVN + (size_t)T * 8 * 4;
constexpr size_t OFF_QPEER = OFF_PREP;
constexpr size_t OFF_IDX = OFF_QPEER + (size_t)T * 2048 * 2;
constexpr size_t OFF_GSM = OFF_IDX + (size_t)T * 128 * 4;

constexpr int SMEM_BYTES = 79872;

struct Params {
  const float* in[30];
  float* out;
  char* ws;
};

typedef const __attribute__((address_space(4))) Params* KP;
__device__ __forceinline__ KP getp() {
  KP q = (KP)__builtin_amdgcn_kernarg_segment_ptr();
  asm volatile("" : "+s"(q));
  return q;
}
DI int tidx() { int t = threadIdx.x; asm volatile("" : "+v"(t)); return t; }
DI bf16_t f2bf(float x) { return __builtin_bit_cast(bf16_t, (__bf16)x); }
DI float bf2f(bf16_t b) { return __uint_as_float(((unsigned)b) << 16); }
DI unsigned pack2(float a, float b) { const f2_t v = {a, b}; return __builtin_bit_cast(unsigned, __builtin_convertvector(v, bf2_t)); }
DI float lo2f(unsigned u) { return __uint_as_float(u << 16); }
DI float hi2f(unsigned u) { return __uint_as_float(u & 0xffff0000u); }
DI int crow(int reg, int h) { return (reg & 3) + 8 * (reg >> 2) + 4 * h; }
DI float wave_sum(float v) {
#pragma unroll
  for (int o = 32; o >= 1; o >>= 1) v += __shfl_xor(v, o);
  return v;
}
DI float allreduce16(float v) {
  v += __int_as_float(__builtin_amdgcn_update_dpp(0, __float_as_int(v), 0x128, 0xf, 0xf, false));
  v += __int_as_float(__builtin_amdgcn_update_dpp(0, __float_as_int(v), 0x124, 0xf, 0xf, false));
  v += __int_as_float(__builtin_amdgcn_update_dpp(0, __float_as_int(v), 0x122, 0xf, 0xf, false));
  v += __int_as_float(__builtin_amdgcn_update_dpp(0, __float_as_int(v), 0x121, 0xf, 0xf, false));
  return v;
}
#define DPP_ADD(v, ctrl) v += __int_as_float(__builtin_amdgcn_update_dpp(0, __float_as_int(v), ctrl, 0xf, 0xf, false))
DI void allreduce16x2(float& a, float& b) {
  DPP_ADD(a, 0x128); DPP_ADD(b, 0x128);
  DPP_ADD(a, 0x124); DPP_ADD(b, 0x124);
  DPP_ADD(a, 0x122); DPP_ADD(b, 0x122);
  DPP_ADD(a, 0x121); DPP_ADD(b, 0x121);
}
DI float allreduce8(float v) {
  v += __int_as_float(__builtin_amdgcn_update_dpp(0, __float_as_int(v), 0xB1, 0xf, 0xf, false));
  v += __int_as_float(__builtin_amdgcn_update_dpp(0, __float_as_int(v), 0x4E, 0xf, 0xf, false));
  v += __int_as_float(__builtin_amdgcn_update_dpp(0, __float_as_int(v), 0x141, 0xf, 0xf, false));
  return v;
}
DI void unpack8f(const uint4& u, float (&f)[8]) {
  f[0] = lo2f(u.x); f[1] = hi2f(u.x); f[2] = lo2f(u.y); f[3] = hi2f(u.y);
  f[4] = lo2f(u.z); f[5] = hi2f(u.z); f[6] = lo2f(u.w); f[7] = hi2f(u.w);
}
DI uint4 pack8f(const float (&f)[8]) {
  return make_uint4(pack2(f[0], f[1]), pack2(f[2], f[3]), pack2(f[4], f[5]), pack2(f[6], f[7]));
}
DI float log_gamma(int hd) {
  const float e = __uint_as_float((unsigned)(127 - 5 - hd) << 23);
  return -e * (1.f + e * (0.5f + e * (0.33333334f + e * (0.25f + e * 0.2f))));
}
DI float sigmoidf_(float x) { return __builtin_amdgcn_rcpf(1.f + __expf(-x)); }
DI const float* xrow(KP p, int t) {
  return t < TP ? p->in[0] + (size_t)t * 1024 : p->in[1] + (size_t)(t - TP) * 1024;
}
struct TokInfo { int sample, b, l; };
DI TokInfo tokinfo(int t) {
  TokInfo ti;
  if (t >= TP) { ti.sample = 1; ti.b = (t - TP) >> 3; ti.l = (t - TP) & 7; }
  else { ti.sample = 0; ti.b = t >> 11; ti.l = t & 2047; }
  return ti;
}

#define XB_TMO      128
#define XB_XCNT(j)  (256  + 64 * (j))
#define XB_XSUB(j)  (1280 + 64 * (j))
#define XB_XGEN(j)  (2304 + 64 * (j))
#define XB_TOP      3328
#define XB_TOPGEN   3392
#define XCD_BAR_WORDS 3456
#define XB_SPIN_CAP (1u << 20)
#define LAS __attribute__((address_space(3)))
DI unsigned xb_ld(unsigned* p) { return __hip_atomic_load(p, __ATOMIC_RELAXED, __HIP_MEMORY_SCOPE_AGENT); }
DI unsigned xb_add(unsigned* p, unsigned v) { return __hip_atomic_fetch_add(p, v, __ATOMIC_RELAXED, __HIP_MEMORY_SCOPE_AGENT); }
DI unsigned xb_xcc_id() { return (unsigned)__builtin_amdgcn_s_getreg((3 << 11) | 20) & 0xFu; }
#define XB_SPIN(cond, bar) do { unsigned _sp = 0; while (cond) { __builtin_amdgcn_s_sleep(1); \
    if ((++_sp & 255u) == 0u) { if (xb_ld(&(bar)[XB_TMO])) break; if (_sp > XB_SPIN_CAP) { atomicAdd(&(bar)[XB_TMO], 1u); break; } } } } while (0)
struct XcdBarrier { unsigned* bar; unsigned x; volatile LAS unsigned* st; };
DI XcdBarrier xcd_barrier_post(unsigned* bar, volatile LAS unsigned* st) {
  XcdBarrier b; b.bar = bar; b.x = xb_xcc_id(); b.st = st;
  if (threadIdx.x == 0) (void)xb_add(&bar[XB_XCNT(b.x)], 1u);
  return b;
}
DI void xcd_barrier_complete(unsigned* bar, unsigned x, unsigned& nloc, unsigned& nx) {
  const unsigned G = gridDim.x * gridDim.y * gridDim.z;
  unsigned sum, cnt, mine, sp = 0u;
  for (;;) {
    sum = 0u; cnt = 0u; mine = 0u;
#pragma unroll
    for (unsigned j = 0; j < 16; ++j) { const unsigned c = xb_ld(&bar[XB_XCNT(j)]); sum += c; cnt += (c > 0u) ? 1u : 0u; mine = (j == x) ? c : mine; }
    if (sum == G) break;
    __builtin_amdgcn_s_sleep(1);
    if ((++sp & 255u) == 0u) { if (xb_ld(&bar[XB_TMO])) break; if (sp > XB_SPIN_CAP) { atomicAdd(&bar[XB_TMO], 1u); break; } }
  }
  nloc = mine > 0u ? mine : 1u; nx = cnt > 0u ? cnt : 1u;
}
DI void xcd_barrier(const XcdBarrier& b) {
  asm volatile("s_waitcnt vmcnt(0)" ::: "memory");
  __syncthreads();
  if (threadIdx.x == 0) {
    unsigned* bar = b.bar;
    __builtin_amdgcn_s_waitcnt(0);
    unsigned nloc = b.st[0], nx = b.st[1];
    if (nloc == 0u) { xcd_barrier_complete(bar, b.x, nloc, nx); b.st[0] = nloc; b.st[1] = nx; }
    const unsigned old = xb_add(&bar[XB_XSUB(b.x)], 1u);
    const unsigned gen = old / nloc;
    if (old + 1u == (gen + 1u) * nloc) {
      __builtin_amdgcn_fence(__ATOMIC_RELEASE, "agent");
      asm volatile("s_waitcnt vmcnt(0)" ::: "memory");
      const unsigned og = xb_add(&bar[XB_TOP], 1u);
      const unsigned tg = og / nx;
      if (og + 1u == (tg + 1u) * nx) xb_add(&bar[XB_TOPGEN], 1u);
      else XB_SPIN(xb_ld(&bar[XB_TOPGEN]) == tg, bar);
      __builtin_amdgcn_fence(__ATOMIC_ACQUIRE, "agent");
      xb_add(&bar[XB_XGEN(b.x)], 1u);
      asm volatile("s_waitcnt vmcnt(0)" ::: "memory");
    } else {
      XB_SPIN(xb_ld(&bar[XB_XGEN(b.x)]) == gen, bar);
      __builtin_amdgcn_fence(__ATOMIC_ACQUIRE, "agent");
      asm volatile("s_waitcnt vmcnt(0)" ::: "memory");
    }
  }
  __syncthreads();
}

constexpr int LDT = 72;
constexpr int GBUF = 2 * 128 * LDT;
template <bool AF32>
DI void gemm128(const void* __restrict__ Ap, int lda, const bf16_t* __restrict__ Bt, int ldb, int K,
                f32x16 (&acc)[2][2], char* smem) {
  bf16_t* S0 = (bf16_t*)smem;
  const int tid = tidx(), lane = tid & 63, w = tid >> 6;
  const int wm = w >> 1, wn = w & 1, r = lane & 31, h = lane >> 5;
  const int lrow = tid >> 3, lch = tid & 7;
#pragma unroll
  for (int i = 0; i < 2; ++i)
#pragma unroll
    for (int j = 0; j < 2; ++j)
#pragma unroll
      for (int e = 0; e < 16; ++e) acc[i][j][e] = 0.f;
  uint4 ra0, ra1, ra2, ra3, rb0, rb1, rb2, rb3;
  const bf16_t* Ab = (const bf16_t*)Ap + (size_t)lrow * lda + lch * 8;
  const float* Af = (const float*)Ap + (size_t)lrow * lda + lch * 8;
  const bf16_t* Bb = Bt + (size_t)lrow * ldb + lch * 8;
  const size_t a32 = (size_t)32 * lda, b32 = (size_t)32 * ldb;
#define GEMM_LDA(dst, q, k0)                                                                          \
  if constexpr (AF32) {                                                                               \
    const float4 f0 = *(const float4*)(Af + (q) * a32 + (k0));                                        \
    const float4 f1 = *(const float4*)(Af + (q) * a32 + (k0) + 4);                                    \
    dst = make_uint4(pack2(f0.x, f0.y), pack2(f0.z, f0.w), pack2(f1.x, f1.y), pack2(f1.z, f1.w));     \
  } else {                                                                                            \
    dst = *(const uint4*)(Ab + (q) * a32 + (k0));                                                     \
  }
#define GEMM_LOADG(k0)                                                                                \
  {                                                                                                   \
    GEMM_LDA(ra0, 0, k0) GEMM_LDA(ra1, 1, k0) GEMM_LDA(ra2, 2, k0) GEMM_LDA(ra3, 3, k0)               \
    rb0 = *(const uint4*)(Bb + (k0));                                                                 \
    rb1 = *(const uint4*)(Bb + b32 + (k0));                                                           \
    rb2 = *(const uint4*)(Bb + 2 * b32 + (k0));                                                       \
    rb3 = *(const uint4*)(Bb + 3 * b32 + (k0));                                                       \
  }
#define GEMM_STORE(buf)                                                                               \
  {                                                                                                   \
    bf16_t* ad = S0 + (buf) * GBUF + lrow * LDT + lch * 8;                                            \
    bf16_t* bd = ad + 128 * LDT;                                                                      \
    *(uint4*)(ad) = ra0; *(uint4*)(ad + 32 * LDT) = ra1; *(uint4*)(ad + 64 * LDT) = ra2; *(uint4*)(ad + 96 * LDT) = ra3; \
    *(uint4*)(bd) = rb0; *(uint4*)(bd + 32 * LDT) = rb1; *(uint4*)(bd + 64 * LDT) = rb2; *(uint4*)(bd + 96 * LDT) = rb3; \
  }
  const int nk = K >> 6;
  GEMM_LOADG(0)
  GEMM_STORE(0)
  if (nk > 1) GEMM_LOADG(64)
  __syncthreads();
  for (int kt = 0; kt < nk; ++kt) {
    if (kt + 1 < nk) GEMM_STORE((kt + 1) & 1)
    if (kt + 2 < nk) GEMM_LOADG((kt + 2) << 6)
    __builtin_amdgcn_sched_barrier(0);
    const bf16_t* As = S0 + (kt & 1) * GBUF;
    const bf16_t* Bs = As + 128 * LDT;
#pragma unroll
    for (int ks = 0; ks < 4; ++ks) {
      bf16x8 a0 = *(const bf16x8*)(As + (wm * 64 + r) * LDT + ks * 16 + h * 8);
      bf16x8 a1 = *(const bf16x8*)(As + (wm * 64 + 32 + r) * LDT + ks * 16 + h * 8);
      bf16x8 b0 = *(const bf16x8*)(Bs + (wn * 64 + r) * LDT + ks * 16 + h * 8);
      bf16x8 b1 = *(const bf16x8*)(Bs + (wn * 64 + 32 + r) * LDT + ks * 16 + h * 8);
      acc[0][0] = __builtin_amdgcn_mfma_f32_32x32x16_bf16(a0, b0, acc[0][0], 0, 0, 0);
      acc[0][1] = __builtin_amdgcn_mfma_f32_32x32x16_bf16(a0, b1, acc[0][1], 0, 0, 0);
      acc[1][0] = __builtin_amdgcn_mfma_f32_32x32x16_bf16(a1, b0, acc[1][0], 0, 0, 0);
      acc[1][1] = __builtin_amdgcn_mfma_f32_32x32x16_bf16(a1, b1, acc[1][1], 0, 0, 0);
    }
    __syncthreads();
  }
}
template <class F>
DI void epi_each(f32x16 (&acc)[2][2], F f) {
  const int lane = tidx() & 63, w = tidx() >> 6;
  const int wm = w >> 1, wn = w & 1, r = lane & 31, h = lane >> 5;
#pragma unroll
  for (int mi = 0; mi < 2; ++mi)
#pragma unroll
    for (int ni = 0; ni < 2; ++ni)
#pragma unroll
      for (int i = 0; i < 16; ++i) f(wm * 64 + mi * 32 + crow(i, h), wn * 64 + ni * 32 + r, acc[mi][ni][i]);
}

DI void transpose_tile(const float* __restrict__ src, bf16_t* __restrict__ dst, int K, int N, int kt, int nt, float* sm) {
  const int tid = tidx();
  const int k0 = kt * 64, n0 = nt * 64;
#pragma unroll
  for (int i = 0; i < 16; ++i) {
    int k = i * 4 + (tid >> 6), n = tid & 63;
    sm[k * 65 + n] = src[(size_t)(k0 + k) * N + n0 + n];
  }
  __syncthreads();
  int n = tid >> 2, ks = (tid & 3) * 16;
  unsigned pk[8];
#pragma unroll
  for (int j = 0; j < 8; ++j) pk[j] = pack2(sm[(ks + 2 * j) * 65 + n], sm[(ks + 2 * j + 1) * 65 + n]);
  uint4* d = (uint4*)(dst + (size_t)(n0 + n) * K + k0 + ks);
  d[0] = make_uint4(pk[0], pk[1], pk[2], pk[3]);
  d[1] = make_uint4(pk[4], pk[5], pk[6], pk[7]);
  __syncthreads();
}
DI void rmsnorm_row_bf(const float* __restrict__ x, const float* __restrict__ g, bf16_t* __restrict__ o, int lane) {
  float4 v[4];
  float ss = 0.f;
#pragma unroll
  for (int i = 0; i < 4; ++i) {
    v[i] = ((const float4*)x)[i * 64 + lane];
    ss += v[i].x * v[i].x + v[i].y * v[i].y + v[i].z * v[i].z + v[i].w * v[i].w;
  }
  ss = wave_sum(ss);
  float sc = rsqrtf(ss * (1.f / 1024.f) + 1e-6f);
#pragma unroll
  for (int i = 0; i < 4; ++i) {
    float4 gg = ((const float4*)g)[i * 64 + lane];
    uint2 pk = make_uint2(pack2(v[i].x * sc * gg.x, v[i].y * sc * gg.y), pack2(v[i].z * sc * gg.z, v[i].w * sc * gg.w));
    ((uint2*)o)[i * 64 + lane] = pk;
  }
}

#define TJ(IDX, OFF, KK_, NN_)                                                                             \
  {                                                                                                        \
    const int ntl = ((KK_) / 64) * ((NN_) / 64);                                                           \
    if (it < ntl) {                                                                                        \
      transpose_tile(p->in[IDX], (bf16_t*)(p->ws + (OFF)), (KK_), (NN_), it / ((NN_) / 64), it % ((NN_) / 64), (float*)smem); \
      continue;                                                                                            \
    }                                                                                                      \
    it -= ntl;                                                                                             \
  }

DI void phase0(KP p, char* smem) {
  const int tid = tidx(), lane = tid & 63, w = tid >> 6;
  constexpr int N_TR = 960 + 8 + 8 + 16;
  constexpr int N_KEYS = 128, N_ROPE = 257, N_NORM = T / 4;
  for (int item = blockIdx.x; item < N_TR + N_KEYS + N_ROPE + N_NORM; item += gridDim.x) {
    int it = item;
    TJ(8, OFF_WIN, 1024, 3840)
    TJ(11, OFF_W2, 64, 512)
    TJ(13, OFF_A2, 64, 512)
    TJ(14, OFF_G2, 128, 512)
    if (it < N_KEYS) {
      const float* src = p->in[23] + (size_t)it * 2048 + tid * 8;
      float4 f0 = *(const float4*)src, f1 = *(const float4*)(src + 4);
      *(uint4*)((bf16_t*)(p->ws + OFF_KEYS) + (size_t)it * 2048 + tid * 8) =
          make_uint4(pack2(f0.x, f0.y), pack2(f0.z, f0.w), pack2(f1.x, f1.y), pack2(f1.z, f1.w));
      continue;
    }
    it -= N_KEYS;
    if (it < N_ROPE) {
      int e = it * 256 + tid;
      int pidx = e >> 5, f = e & 31;
      if (pidx < 2056) {
        const float pos = (pidx < 2048) ? (float)pidx : (float)(16384 + pidx - 2048);
        const float inv = exp2f(-(float)f * 0.41524101186092f);
        const float ang = pos * inv;
        const float kq = rintf(ang * 0.15915494309189535f);
        float rr = fmaf(-kq, 6.28125f, ang);
        rr = fmaf(-kq, 1.9353071795864769e-3f, rr);
        float* rt = (float*)(p->ws + OFF_ROPE);
        rt[e * 2] = cosf(rr);
        rt[e * 2 + 1] = sinf(rr);
      }
      continue;
    }
    it -= N_ROPE;
    {
      int t = it * 4 + w;
      rmsnorm_row_bf(xrow(p, t), p->in[7], (bf16_t*)(p->ws + OFF_ACT) + (size_t)t * 1024, lane);
    }
  }
}

DI void phase1(KP p, char* smem) {
  const int lane = tidx() & 63, w = tidx() >> 6;
  const int wm = w >> 1, wn = w & 1, r = lane & 31, h = lane >> 5;
  bf16_t* RET = (bf16_t*)p->out;
  bf16_t* RWP = (bf16_t*)(p->ws + OFF_TAB);
  const float2* rope = (const float2*)(p->ws + OFF_ROPE);
  for (int tile = blockIdx.x; tile < 136 * 30; tile += gridDim.x) {
    const int mt = tile / 30, nt = tile % 30;
    const int m0 = mt * 128, n0 = nt * 128;
    f32x16 acc[2][2];
    gemm128<false>((const bf16_t*)(p->ws + OFF_ACT) + (size_t)m0 * 1024, 1024,
                   (const bf16_t*)(p->ws + OFF_WIN) + (size_t)n0 * 1024, 1024, 1024, acc, smem);
    const int nb = n0 + wn * 64;
    if (nb < 1024) {
      float2 cs[2][16];
#pragma unroll
      for (int mi = 0; mi < 2; ++mi)
#pragma unroll
        for (int i = 0; i < 16; ++i) {
          const TokInfo ti = tokinfo(m0 + wm * 64 + mi * 32 + crow(i, h));
          cs[mi][i] = rope[(ti.sample ? 2048 + ti.l : ti.l) * 32 + r];
        }
      const float scl = (nb >= 512) ? 0.125f : 1.f;
#pragma unroll
      for (int mi = 0; mi < 2; ++mi)
#pragma unroll
        for (int i = 0; i < 16; ++i) {
          const float v0 = acc[mi][0][i], v1 = acc[mi][1][i];
          acc[mi][0][i] = (v0 * cs[mi][i].x - v1 * cs[mi][i].y) * scl;
          acc[mi][1][i] = (v1 * cs[mi][i].x + v0 * cs[mi][i].y) * scl;
        }
    }
#pragma unroll
    for (int mi = 0; mi < 2; ++mi)
#pragma unroll
      for (int i = 0; i < 16; ++i) {
        const int t = m0 + wm * 64 + mi * 32 + crow(i, h);
        const float v0 = acc[mi][0][i], v1 = acc[mi][1][i];
        if (nb < 2048) {
          RET[(size_t)t * 2048 + nb + r] = f2bf(v0);
          RET[(size_t)t * 2048 + nb + 32 + r] = f2bf(v1);
        } else {
          const TokInfo ti = tokinfo(t);
          const int c = nb - 2048 + r;
          RWP[(size_t)t * 1792 + c] = f2bf(v0);
          RWP[(size_t)t * 1792 + c + 32] = f2bf(v1);
          if (ti.sample) {
            if (ti.l == 7) { p->out[O_SHS + ti.b * 1792 + c] = v0; p->out[O_SHS + ti.b * 1792 + c + 32] = v1; }
          } else {
            if (ti.l == 2047) { p->out[O_SHP + ti.b * 1792 + c] = v0; p->out[O_SHP + ti.b * 1792 + c + 32] = v1; }
          }
        }
      }
  }
}

DI void phase2(KP p) {
  const int lane = tidx() & 63, w = tidx() >> 6;
  const bf16_t* RWP = (const bf16_t*)(p->ws + OFF_TAB);
  bf16_t* Rb = (bf16_t*)(p->ws + OFF_R);
  bf16_t* Kb = (bf16_t*)(p->ws + OFF_K);
  bf16_t* Vb = (bf16_t*)(p->ws + OFF_V);
  bf16_t* LA = (bf16_t*)(p->ws + OFF_LORA);
  float* INVN = (float*)(p->ws + OFF_INVN);
  const float* mu = p->in[9];
  const float* kkw = p->in[15];
  for (int t = blockIdx.x * 4 + w; t < T; t += gridDim.x * 4) {
    const TokInfo ti = tokinfo(t);
    const bf16_t* cur = RWP + (size_t)t * 1792;
    const bf16_t* prv = cur - 1792;
    const float* sh = p->in[4] + (size_t)ti.b * 1792;
    float f[4][8];
#pragma unroll
    for (int i = 0; i < 4; ++i) {
      const int c8 = (lane + 64 * i) * 8;
      if (i < 3 || lane < 32) {
        float cv[8], pv[8];
        unpack8f(*(const uint4*)(cur + c8), cv);
        if (ti.l > 0) unpack8f(*(const uint4*)(prv + c8), pv);
        else if (ti.sample) {
          const float4 s0 = *(const float4*)(sh + c8), s1 = *(const float4*)(sh + c8 + 4);
          pv[0] = s0.x; pv[1] = s0.y; pv[2] = s0.z; pv[3] = s0.w; pv[4] = s1.x; pv[5] = s1.y; pv[6] = s1.z; pv[7] = s1.w;
        } else {
#pragma unroll
          for (int k = 0; k < 8; ++k) pv[k] = 0.f;
        }
        const float4 m0 = *(const float4*)(mu + c8), m1 = *(const float4*)(mu + c8 + 4);
        const float mm[8] = {m0.x, m0.y, m0.z, m0.w, m1.x, m1.y, m1.z, m1.w};
#pragma unroll
        for (int k = 0; k < 8; ++k) f[i][k] = cv[k] + (pv[k] - cv[k]) * mm[k];
      } else {
#pragma unroll
        for (int k = 0; k < 8; ++k) f[i][k] = 0.f;
      }
    }
    *(uint4*)(Rb + (size_t)t * 512 + lane * 8) = pack8f(f[0]);
    {
      const uint4 kb = pack8f(f[1]);
      *(uint4*)(Kb + (size_t)t * 512 + lane * 8) = kb;
      float kr[8];
      unpack8f(kb, kr);
      const float4 q0 = *(const float4*)(kkw + lane * 8), q1 = *(const float4*)(kkw + lane * 8 + 4);
      const float qq[8] = {q0.x, q0.y, q0.z, q0.w, q1.x, q1.y, q1.z, q1.w};
      float ss = 0.f;
#pragma unroll
      for (int k = 0; k < 8; ++k) { const float kq = kr[k] * qq[k]; ss += kq * kq; }
      ss = allreduce8(ss);
      if ((lane & 7) == 0) INVN[t * 8 + (lane >> 3)] = 1.f / fmaxf(sqrtf(ss), 1e-12f);
    }
    *(uint4*)(Vb + (size_t)t * 512 + lane * 8) = pack8f(f[2]);
    if (lane < 32) {
      float o[8];
#pragma unroll
      for (int k = 0; k < 8; ++k) {
        const float x = f[3][k];
        o[k] = (lane < 8) ? (1.f - 2.f * __builtin_amdgcn_rcpf(1.f + __expf(2.f * x))) : ((lane < 16) ? x : sigmoidf_(x));
      }
      *(uint4*)(LA + (size_t)t * 256 + lane * 8) = pack8f(o);
    }
  }
}

DI void phase3(KP p, char* smem) {
  const bf16_t* LA = (const bf16_t*)(p->ws + OFF_LORA);
  bf16_t* Kb = (bf16_t*)(p->ws + OFF_K);
  bf16_t* KKb = (bf16_t*)(p->ws + OFF_KK);
  bf16_t* BBb = (bf16_t*)(p->ws + OFF_BB);
  bf16_t* GTb = (bf16_t*)(p->ws + OFF_GATE);
  float* EW = (float*)(p->ws + OFF_EW);
  const float* INVN = (const float*)(p->ws + OFF_INVN);
  const float* w0 = p->in[10];
  const float* a0 = p->in[12];
  const float* kkw = p->in[15];
  const float* kaw = p->in[16];
  for (int item = blockIdx.x; item < 136 * 12; item += gridDim.x) {
    const int mt = item / 12, rem = item % 12, kind = rem >> 2, nt = rem & 3;
    const int m0 = mt * 128, n0 = nt * 128;
    f32x16 acc[2][2];
    if (kind == 0) {
      gemm128<false>(LA + (size_t)m0 * 256, 256, (const bf16_t*)(p->ws + OFF_W2) + n0 * 64, 64, 64, acc, smem);
      epi_each(acc, [&](int rr, int cc, float v) {
        const int t = m0 + rr, c = n0 + cc;
        const float x = v + w0[c];
        const float z = -x;
        const float sp = fmaxf(z, 0.f) + __logf(1.f + __expf(-fabsf(z)));
        const float ww = -sp - 0.5f;
        EW[(size_t)t * 512 + c] = __expf(-__expf(ww));
      });
    } else if (kind == 1) {
      gemm128<false>(LA + (size_t)m0 * 256 + 64, 256, (const bf16_t*)(p->ws + OFF_A2) + n0 * 64, 64, 64, acc, smem);
      {
        const int lane = tidx() & 63, w = tidx() >> 6;
        const int wm = w >> 1, wn = w & 1, r = lane & 31, h = lane >> 5;
#pragma unroll 1
        for (int mi = 0; mi < 2; ++mi) {
          const int tb = m0 + wm * 64 + mi * 32;
          float inv[16];
#pragma unroll
          for (int i = 0; i < 16; ++i) inv[i] = INVN[(tb + crow(i, h)) * 8 + ((n0 + wn * 64) >> 6)];
#pragma unroll
          for (int ni = 0; ni < 2; ++ni) {
            const int c = n0 + wn * 64 + ni * 32 + r;
            const float a0c = a0[c], kkc = kkw[c], kac = kaw[c];
            float k7v[16];
#pragma unroll
            for (int i = 0; i < 16; ++i) k7v[i] = bf2f(Kb[(size_t)(tb + crow(i, h)) * 512 + c]);
#pragma unroll
            for (int i = 0; i < 16; ++i) {
              const float av = (mi == 0) ? acc[0][ni][i] : acc[1][ni][i];
              const float a = sigmoidf_(av + a0c);
              const size_t o = (size_t)(tb + crow(i, h)) * 512 + c;
              const float kkv = k7v[i] * kkc * inv[i];
              Kb[o] = f2bf(k7v[i] * (1.f + (a - 1.f) * kac));
              KKb[o] = f2bf(kkv);
              BBb[o] = f2bf(kkv * a);
            }
          }
        }
      }
    } else {
      gemm128<false>(LA + (size_t)m0 * 256 + 128, 256, (const bf16_t*)(p->ws + OFF_G2) + n0 * 128, 128, 128, acc, smem);
      epi_each(acc, [&](int rr, int cc, float v) { GTb[(size_t)(m0 + rr) * 512 + n0 + cc] = f2bf(v); });
    }
  }
}

DI void rwkv_scan(KP p, int tok0, int hd, int q, int nsteps, const float* __restrict__ S0, float* __restrict__ Sout, char* smem) {
  const int tid = tidx(), lane = tid & 63, w = tid >> 6, g = lane >> 4, l16 = lane & 15;
  const int rl = w * 4 + g;
  const int row = q * 16 + rl;
  const int j0 = l16 * 4;
  const bf16_t* Rb = (const bf16_t*)(p->ws + OFF_R);
  const bf16_t* Kb = (const bf16_t*)(p->ws + OFF_K);
  const bf16_t* Vb = (const bf16_t*)(p->ws + OFF_V);
  const bf16_t* KKb = (const bf16_t*)(p->ws + OFF_KK);
  const bf16_t* BBb = (const bf16_t*)(p->ws + OFF_BB);
  const float* EW = (const float*)(p->ws + OFF_EW);
  bf16_t* ACT = (bf16_t*)(p->ws + OFF_ACT);
  float* ew_s = (float*)smem;
  float* kk_s = ew_s + 2048;
  float* bb_s = kk_s + 2048;
  float* kp_s = bb_s + 2048;
  float* r_s = kp_s + 2048;
  float* v_s = r_s + 2048;
  float* y_s = v_s + 512;
  f2_t s01 = (f2_t){0.f, 0.f}, s23 = (f2_t){0.f, 0.f};
  if (S0) { const float4 t4 = *(const float4*)(S0 + row * 64 + j0); s01 = (f2_t){t4.x, t4.y}; s23 = (f2_t){t4.z, t4.w}; }
  uint4 rg_r = make_uint4(0, 0, 0, 0), rg_k = rg_r, rg_kk = rg_r, rg_bb = rg_r, rg_v = rg_r;
  float4 rg_e0 = make_float4(0, 0, 0, 0), rg_e1 = rg_e0;
  const int st_l = tid >> 3, c8 = (tid & 7) * 8;
  auto gload = [&](int sb) {
    if (sb + st_l < nsteps) {
      const size_t o = (size_t)(tok0 + sb + st_l) * 512 + hd * 64 + c8;
      rg_r = *(const uint4*)(Rb + o);
      rg_k = *(const uint4*)(Kb + o);
      rg_kk = *(const uint4*)(KKb + o);
      rg_bb = *(const uint4*)(BBb + o);
      rg_e0 = *(const float4*)(EW + o);
      rg_e1 = *(const float4*)(EW + o + 4);
    }
    if (tid < 64) {
      const int sv = tid >> 1;
      if (sb + sv < nsteps) rg_v = *(const uint4*)(Vb + (size_t)(tok0 + sb + sv) * 512 + hd * 64 + q * 16 + (tid & 1) * 8);
    }
  };
  auto unpack8 = [&](float* d, const uint4& u) {
    *(float4*)d = make_float4(lo2f(u.x), hi2f(u.x), lo2f(u.y), hi2f(u.y));
    *(float4*)(d + 4) = make_float4(lo2f(u.z), hi2f(u.z), lo2f(u.w), hi2f(u.w));
  };
  auto sstore = [&]() {
    const int o = st_l * 64 + c8;
    unpack8(r_s + o, rg_r);
    unpack8(kp_s + o, rg_k);
    unpack8(kk_s + o, rg_kk);
    unpack8(bb_s + o, rg_bb);
    *(float4*)(ew_s + o) = rg_e0;
    *(float4*)(ew_s + o + 4) = rg_e1;
    if (tid < 64) unpack8(v_s + (tid >> 1) * 16 + (tid & 1) * 8, rg_v);
  };
  gload(0);
  for (int sb = 0; sb < nsteps; sb += 32) {
    __syncthreads();
    sstore();
    __syncthreads();
    if (sb + 32 < nsteps) gload(sb + 32);
    const int tc = min(32, nsteps - sb);
#define SC_LD(X, st)                                              \
  {                                                               \
    const float* b_ = ew_s + (st) * 64 + j0;                      \
    X##e = *(const float4*)(b_);                                  \
    X##q = *(const float4*)(b_ + 2048);                           \
    X##b = *(const float4*)(b_ + 4096);                           \
    X##k = *(const float4*)(b_ + 6144);                           \
    X##r = *(const float4*)(b_ + 8192);                           \
    X##v = v_s[(st) * 16 + rl];                                   \
  }
#define SC_STEP(X, st)                                                                     \
  {                                                                                        \
    const f2_t p2 = s01 * (f2_t){X##q.x, X##q.y} + s23 * (f2_t){X##q.z, X##q.w};           \
    float pdp = p2.x + p2.y;                                                               \
      \
    const f2_t vk01 = (f2_t){X##k.x, X##k.y} * X##v, vk23 = (f2_t){X##k.z, X##k.w} * X##v; \
    const f2_t base01 = s01 * (f2_t){X##e.x, X##e.y} + vk01;                               \
    const f2_t base23 = s23 * (f2_t){X##e.z, X##e.w} + vk23;                               \
    allreduce16x2(pdp, ypart);     \
    if (l16 == 0 && (st) > 0) y_s[((st) - 1) * 16 + rl] = ypart;                           \
    s01 = base01 - (f2_t){X##b.x, X##b.y} * pdp;                              \
    s23 = base23 - (f2_t){X##b.z, X##b.w} * pdp;                                           \
    const f2_t y2 = s01 * (f2_t){X##r.x, X##r.y} + s23 * (f2_t){X##r.z, X##r.w};           \
    ypart = y2.x + y2.y;                                                                   \
  }
    {
      float4 Ae, Aq, Ab, Ak, Ar, Be, Bq, Bb, Bk, Br;
      float Av, Bv;
      float ypart = 0.f;
      SC_LD(A, 0)
      for (int st = 0; st < tc; st += 2) {
        SC_LD(B, st + 1)
        SC_STEP(A, st)
        SC_LD(A, min(st + 2, tc - 1))
        SC_STEP(B, st + 1)
      }
      ypart = allreduce16(ypart);
      if (l16 == 0) y_s[(tc - 1) * 16 + rl] = ypart;
    }
    __syncthreads();
    if (tid < tc * 8) {
      const int st = tid >> 3, pr = tid & 7;
      const unsigned pk = pack2(y_s[st * 16 + 2 * pr], y_s[st * 16 + 2 * pr + 1]);
      *(unsigned*)(ACT + (size_t)(tok0 + sb + st) * 1024 + 512 + hd * 64 + q * 16 + 2 * pr) = pk;
    }
  }
  *(float4*)(Sout + row * 64 + j0) = make_float4(s01.x, s01.y, s23.x, s23.y);
}

constexpr int RL = 136;
DI void ret_prompt(KP p, int b, int hd, char* smem) {
  const int tid = tidx(), lane = tid & 63, w = tid >> 6, r = lane & 31, h = lane >> 5;
  const bf16_t* RET = (const bf16_t*)p->out;
  bf16_t* ACT = (bf16_t*)(p->ws + OFF_ACT);
  bf16_t* Vt = (bf16_t*)smem;
  bf16_t* Kzt = (bf16_t*)(smem + 17408);
  bf16_t* St = (bf16_t*)(smem + 34816);
  bf16_t* Sc = (bf16_t*)(smem + 44032);
  float* Of = (float*)(smem + 44032);
  float* dec = (float*)(smem + 78848);
  const float lg = log_gamma(hd);
  if (tid < 129) dec[tid] = __expf((float)tid * lg);
  for (int e = tid; e < 64 * 72; e += 256) St[e] = 0;
  __syncthreads();
  const float g128 = dec[128];
  f32x16 Sacc;
#pragma unroll
  for (int e = 0; e < 16; ++e) Sacc[e] = 0.f;
  const int vt = w >> 1, dt = w & 1;
  for (int c = 0; c < 16; ++c) {
    const int tokc = b * 2048 + c * 128;
    {
      const int j = tid >> 1, hf = tid & 1;
      const bf16_t* vsrc = RET + (size_t)(tokc + j) * 2048 + 1024 + hd * 64 + hf * 32;
      const bf16_t* ksrc = RET + (size_t)(tokc + j) * 2048 + 512 + hd * 64 + hf * 32;
      const float zj = dec[127 - j];
#pragma unroll
      for (int qd = 0; qd < 4; ++qd) {
        const uint4 uv = *(const uint4*)(vsrc + qd * 8);
        const uint4 uk = *(const uint4*)(ksrc + qd * 8);
        const unsigned vv[4] = {uv.x, uv.y, uv.z, uv.w};
        const unsigned kk[4] = {uk.x, uk.y, uk.z, uk.w};
#pragma unroll
        for (int e = 0; e < 4; ++e) {
          const int col = hf * 32 + qd * 8 + e * 2;
          Vt[col * RL + j] = (bf16_t)(vv[e] & 0xffffu);
          Vt[(col + 1) * RL + j] = (bf16_t)(vv[e] >> 16);
          Kzt[col * RL + j] = f2bf(lo2f(kk[e]) * zj);
          Kzt[(col + 1) * RL + j] = f2bf(hi2f(kk[e]) * zj);
        }
      }
    }
    bf16x8 qf[4];
    {
      const bf16_t* qsrc = RET + (size_t)(tokc + 32 * w + r) * 2048 + hd * 64 + h * 8;
#pragma unroll
      for (int ks = 0; ks < 4; ++ks) qf[ks] = *(const bf16x8*)(qsrc + ks * 16);
    }
#pragma unroll
    for (int jb = 0; jb < 2; ++jb) {
      bf16x8 kf[2][4];
#pragma unroll
      for (int jj = 0; jj < 2; ++jj) {
        const int jt = jb * 2 + jj;
        if (jt <= w) {
          const bf16_t* ksrc = RET + (size_t)(tokc + 32 * jt + r) * 2048 + 512 + hd * 64 + h * 8;
#pragma unroll
          for (int ks = 0; ks < 4; ++ks) kf[jj][ks] = *(const bf16x8*)(ksrc + ks * 16);
        }
      }
#pragma unroll
      for (int jj = 0; jj < 2; ++jj) {
        const int jt = jb * 2 + jj;
        if (jt <= w) {
          f32x16 sc;
#pragma unroll
          for (int e = 0; e < 16; ++e) sc[e] = 0.f;
#pragma unroll
          for (int ks = 0; ks < 4; ++ks) sc = __builtin_amdgcn_mfma_f32_32x32x16_bf16(qf[ks], kf[jj][ks], sc, 0, 0, 0);
#pragma unroll
          for (int e = 0; e < 16; ++e) {
            const int i = 32 * w + crow(e, h), j = 32 * jt + r;
            const int d = i - j;
            const float val = (d >= 0) ? sc[e] * dec[d >= 0 ? d : 0] : 0.f;
            Sc[i * RL + j] = f2bf(val);
          }
        }
      }
    }
    __syncthreads();
    f32x16 oacc[2];
#pragma unroll
    for (int nt = 0; nt < 2; ++nt) {
#pragma unroll
      for (int e = 0; e < 16; ++e) oacc[nt][e] = 0.f;
#pragma unroll
      for (int ks = 0; ks < 4; ++ks) {
        const bf16x8 sf = *(const bf16x8*)(St + (nt * 32 + r) * 72 + ks * 16 + h * 8);
        oacc[nt] = __builtin_amdgcn_mfma_f32_32x32x16_bf16(qf[ks], sf, oacc[nt], 0, 0, 0);
      }
#pragma unroll
      for (int e = 0; e < 16; ++e) oacc[nt][e] *= dec[32 * w + crow(e, h) + 1];
    }
    for (int ks = 0; ks < 2 * (w + 1); ++ks) {
      const bf16x8 af = *(const bf16x8*)(Sc + (32 * w + r) * RL + ks * 16 + h * 8);
#pragma unroll
      for (int nt = 0; nt < 2; ++nt) {
        const bf16x8 vf = *(const bf16x8*)(Vt + (nt * 32 + r) * RL + ks * 16 + h * 8);
        oacc[nt] = __builtin_amdgcn_mfma_f32_32x32x16_bf16(af, vf, oacc[nt], 0, 0, 0);
      }
    }
#pragma unroll
    for (int e = 0; e < 16; ++e) Sacc[e] *= g128;
#pragma unroll
    for (int ks = 0; ks < 8; ++ks) {
      const bf16x8 af = *(const bf16x8*)(Vt + (vt * 32 + r) * RL + ks * 16 + h * 8);
      const bf16x8 bf = *(const bf16x8*)(Kzt + (dt * 32 + r) * RL + ks * 16 + h * 8);
      Sacc = __builtin_amdgcn_mfma_f32_32x32x16_bf16(af, bf, Sacc, 0, 0, 0);
    }
    __syncthreads();
#pragma unroll
    for (int nt = 0; nt < 2; ++nt)
#pragma unroll
      for (int e = 0; e < 16; ++e) Of[(32 * w + crow(e, h)) * 66 + nt * 32 + r] = oacc[nt][e];
#pragma unroll
    for (int e = 0; e < 16; ++e) St[(vt * 32 + crow(e, h)) * 72 + dt * 32 + r] = f2bf(Sacc[e]);
    __syncthreads();
    {
      const int i = tid >> 1, hf = tid & 1;
      const int t = tokc + i;
      float vals[32];
      float sm = 0.f;
#pragma unroll
      for (int k = 0; k < 32; ++k) { vals[k] = Of[i * 66 + hf * 32 + k]; sm += vals[k]; }
      sm += __shfl_xor(sm, 1);
      const float mean = sm * (1.f / 64.f);
      float vs = 0.f;
#pragma unroll
      for (int k = 0; k < 32; ++k) { vals[k] -= mean; vs += vals[k] * vals[k]; }
      vs += __shfl_xor(vs, 1);
      const float rs = rsqrtf(vs * (1.f / 64.f) + 1e-5f);
      const bf16_t* gsrc = RET + (size_t)t * 2048 + 1536 + hd * 64 + hf * 32;
      bf16_t* dst = ACT + (size_t)t * 1024 + hd * 64 + hf * 32;
#pragma unroll
      for (int qd = 0; qd < 4; ++qd) {
        const uint4 ug = *(const uint4*)(gsrc + qd * 8);
        const unsigned gg[4] = {ug.x, ug.y, ug.z, ug.w};
        unsigned o4[4];
#pragma unroll
        for (int e = 0; e < 4; ++e) {
          const float g0 = lo2f(gg[e]), g1 = hi2f(gg[e]);
          const float a0 = vals[qd * 8 + 2 * e] * rs * (g0 * sigmoidf_(g0));
          const float a1 = vals[qd * 8 + 2 * e + 1] * rs * (g1 * sigmoidf_(g1));
          o4[e] = pack2(a0, a1);
        }
        *(uint4*)(dst + qd * 8) = make_uint4(o4[0], o4[1], o4[2], o4[3]);
      }
    }
    __syncthreads();
  }
  float* so = p->out + O_RETP + (size_t)(b * 8 + hd) * 4096;
#pragma unroll
  for (int gq = 0; gq < 4; ++gq)
    *(float4*)(so + (dt * 32 + r) * 64 + vt * 32 + 8 * gq + 4 * h) =
        make_float4(Sacc[4 * gq], Sacc[4 * gq + 1], Sacc[4 * gq + 2], Sacc[4 * gq + 3]);
}

DI void ret_sample(KP p, int b, int hd, char* smem) {
  const int tid = tidx();
  const bf16_t* RET = (const bf16_t*)p->out;
  bf16_t* ACT = (bf16_t*)(p->ws + OFF_ACT);
  float* q_s = (float*)smem;
  float* k_s = q_s + 512;
  float* v_s = k_s + 512;
  float* A_s = v_s + 512;
  float* part = A_s + 64;
  const int tok0 = TP + b * 8;
  const float lg = log_gamma(hd);
  __syncthreads();
  {
    const int e = tid * 2, rw = e >> 6, cl = e & 63;
    const bf16_t* base = RET + (size_t)(tok0 + rw) * 2048 + hd * 64 + cl;
    const unsigned uq = *(const unsigned*)(base), uk = *(const unsigned*)(base + 512), uv = *(const unsigned*)(base + 1024);
    q_s[e] = lo2f(uq); q_s[e + 1] = hi2f(uq);
    k_s[e] = lo2f(uk); k_s[e + 1] = hi2f(uk);
    v_s[e] = lo2f(uv); v_s[e + 1] = hi2f(uv);
  }
  __syncthreads();
  if (tid < 64) {
    const int i = tid >> 3, j = tid & 7;
    float a = 0.f;
    if (i >= j) {
#pragma unroll 4
      for (int d = 0; d < 64; ++d) a = fmaf(q_s[i * 64 + d], k_s[j * 64 + d], a);
      a *= __expf((float)(i - j) * lg);
    }
    A_s[tid] = a;
  }
  {
    const int dg = tid >> 6, v = tid & 63;
    const float* S0 = p->in[2] + (size_t)(b * 8 + hd) * 4096;
    float* So = p->out + O_RETS + (size_t)(b * 8 + hd) * 4096;
    float oi[8];
#pragma unroll
    for (int i = 0; i < 8; ++i) oi[i] = 0.f;
    const float g8 = __expf(8.f * lg);
    float kv[8];
#pragma unroll
    for (int j = 0; j < 8; ++j) kv[j] = v_s[j * 64 + v] * __expf((float)(7 - j) * lg);
#pragma unroll 1
    for (int hb = 0; hb < 2; ++hb) {
      float sv[8];
#pragma unroll
      for (int dd = 0; dd < 8; ++dd) sv[dd] = S0[(dg * 16 + hb * 8 + dd) * 64 + v];
#pragma unroll
      for (int dd = 0; dd < 8; ++dd) {
        const int d = dg * 16 + hb * 8 + dd;
        const float s = sv[dd];
        float sn = s * g8;
#pragma unroll
        for (int j = 0; j < 8; ++j) sn = fmaf(k_s[j * 64 + d], kv[j], sn);
        So[d * 64 + v] = sn;
#pragma unroll
        for (int i = 0; i < 8; ++i) oi[i] = fmaf(q_s[i * 64 + d], s, oi[i]);
      }
    }
#pragma unroll
    for (int i = 0; i < 8; ++i) part[(dg * 8 + i) * 64 + v] = oi[i];
  }
  __syncthreads();
#pragma unroll
  for (int rep = 0; rep < 2; ++rep) {
    const int i = (tid >> 6) + 4 * rep, v = tid & 63;
    float o = part[(0 * 8 + i) * 64 + v] + part[(1 * 8 + i) * 64 + v] + part[(2 * 8 + i) * 64 + v] + part[(3 * 8 + i) * 64 + v];
    o *= __expf((float)(i + 1) * lg);
    for (int j = 0; j <= i; ++j) o = fmaf(A_s[i * 8 + j], v_s[j * 64 + v], o);
    const float mean = wave_sum(o) * (1.f / 64.f);
    const float dv = o - mean;
    const float var = wave_sum(dv * dv) * (1.f / 64.f);
    const int t = tok0 + i;
    const float gt = bf2f(RET[(size_t)t * 2048 + 1536 + hd * 64 + v]);
    ACT[(size_t)t * 1024 + hd * 64 + v] = f2bf(dv * rsqrtf(var + 1e-5f) * (gt * sigmoidf_(gt)));
  }
}

constexpr size_t TAB_V8 = (size_t)16384 * 1024;
constexpr size_t TAB_SC = (size_t)2 * 16384 * 1024;
DI void convert_tab(KP p, int it) {
  const int tid = tidx(), lane = tid & 63, w = tid >> 6;
  const int row0 = it * 8 + w * 2;
  const float* src = (row0 < 16384) ? p->in[24] + (size_t)row0 * 1024 : p->in[25] + (size_t)(row0 - 16384) * 1024;
  float4 v[2][4];
#pragma unroll
  for (int rr = 0; rr < 2; ++rr)
#pragma unroll
    for (int i = 0; i < 4; ++i) v[rr][i] = *(const float4*)(src + rr * 1024 + i * 256 + lane * 4);
#pragma unroll
  for (int rr = 0; rr < 2; ++rr) {
    float am = 0.f;
#pragma unroll
    for (int i = 0; i < 4; ++i)
      am = fmaxf(am, fmaxf(fmaxf(fabsf(v[rr][i].x), fabsf(v[rr][i].y)), fmaxf(fabsf(v[rr][i].z), fabsf(v[rr][i].w))));
#pragma unroll
    for (int o = 32; o >= 1; o >>= 1) am = fmaxf(am, __shfl_xor(am, o));
    am = fmaxf(am, 1e-30f);
    const float inv = 127.f / am;
    unsigned char* dst = (unsigned char*)(p->ws + OFF_TAB) + (size_t)(row0 + rr) * 1024;
#pragma unroll
    for (int i = 0; i < 4; ++i) {
      const unsigned q0 = (unsigned)((int)rintf(v[rr][i].x * inv) + 128);
      const unsigned q1 = (unsigned)((int)rintf(v[rr][i].y * inv) + 128);
      const unsigned q2 = (unsigned)((int)rintf(v[rr][i].z * inv) + 128);
      const unsigned q3 = (unsigned)((int)rintf(v[rr][i].w * inv) + 128);
      *(unsigned*)(dst + i * 256 + lane * 4) = q0 | (q1 << 8) | (q2 << 16) | (q3 << 24);
    }
    if (lane == 0) ((float*)(p->ws + OFF_TAB + TAB_SC))[row0 + rr] = am * (1.f / 127.f);
  }
}

DI void phase4_other(KP p, int it, char* smem) {
  if (it < 64) { ret_prompt(p, it >> 3, it & 7, smem); return; }
  it -= 64;
  if (it < 4096) {
    const int bh = it >> 2, q = it & 3, b = bh >> 3, hd = bh & 7;
    rwkv_scan(p, TP + b * 8, hd, q, 8, p->in[3] + (size_t)bh * 4096, p->out + O_WKVS + (size_t)bh * 4096, smem);
    return;
  }
  it -= 4096;
  if (it < 1024) { ret_sample(p, it >> 3, it & 7, smem); return; }
  it -= 1024;
  if (it < 4096) { convert_tab(p, it); return; }
  it -= 4096;
#define TJ4(IDX, OFF, KK_, NN_)                                                                            \
  {                                                                                                        \
    const int ntl = ((KK_) / 64) * ((NN_) / 64);                                                           \
    if (it < ntl) {                                                                                        \
      transpose_tile(p->in[IDX], (bf16_t*)(p->ws + (OFF)), (KK_), (NN_), it / ((NN_) / 64), it % ((NN_) / 64), (float*)smem); \
      return;                                                                                              \
    }                                                                                                      \
    it -= ntl;                                                                                             \
  }
  TJ4(20, OFF_WOUT, 1024, 1024)
  TJ4(22, OFF_WQ, 1024, 2048)
  TJ4(27, OFF_PG, 1024, 1024)
  TJ4(28, OFF_PP, 256, 1024)
}
DI void phase4(KP p, char* smem) {
  constexpr int N_OTHER = 64 + 4096 + 1024 + 4096 + (256 + 512 + 256 + 64);
  int* s_item = (int*)(smem + SMEM_BYTES - 16);
  unsigned* ctr = (unsigned*)(p->ws + OFF_CTR);
  unsigned* cukey = (unsigned*)(p->ws + OFF_CTR + 16384);
  __syncthreads();
  if (tidx() == 0) {
    const unsigned hw = (unsigned)__builtin_amdgcn_s_getreg((7 << 11) | (8 << 6) | 4);
    const unsigned key = (xb_xcc_id() << 8) | (hw & 0xffu);
    const unsigned old = atomicAdd(&cukey[key], 1u);
    int it = -1;
    if (old == 0u) { const unsigned q = atomicAdd(&ctr[1], 1u); if (q < 256u) it = (int)q; }
    *s_item = it;
  }
  __syncthreads();
  {
    const int it = *s_item;
    if (it >= 0) {
      const int bh = it >> 2, q = it & 3, b = bh >> 3, hd = bh & 7;
      __builtin_amdgcn_s_setprio(3);
      rwkv_scan(p, b * 2048, hd, q, 2048, nullptr, p->out + O_WKVP + (size_t)bh * 4096, smem);
      __builtin_amdgcn_s_setprio(0);
    }
  }
  for (;;) {
    __syncthreads();
    if (tidx() == 0) *s_item = (int)atomicAdd(&ctr[0], 1u);
    __syncthreads();
    const int it = *s_item;
    if (it >= N_OTHER) break;
    phase4_other(p, it, smem);
  }
  for (;;) {
    __syncthreads();
    if (tidx() == 0) *s_item = (int)atomicAdd(&ctr[1], 1u);
    __syncthreads();
    const int it = *s_item;
    if (it >= 256) break;
    const int bh = it >> 2, q = it & 3, b = bh >> 3, hd = bh & 7;
    rwkv_scan(p, b * 2048, hd, q, 2048, nullptr, p->out + O_WKVP + (size_t)bh * 4096, smem);
  }
}

DI void phase5(KP p) {
  const int lane = tidx() & 63, w = tidx() >> 6;
  bf16_t* ACT = (bf16_t*)(p->ws + OFF_ACT);
  const bf16_t* Rb = (const bf16_t*)(p->ws + OFF_R);
  const bf16_t* Kb = (const bf16_t*)(p->ws + OFF_K);
  const bf16_t* Vb = (const bf16_t*)(p->ws + OFF_V);
  const bf16_t* GTb = (const bf16_t*)(p->ws + OFF_GATE);
  const int c8 = lane * 8;
  float rk8[8], lg8[8], lb8[8];
  {
    const float4 a0 = *(const float4*)(p->in[17] + c8), a1 = *(const float4*)(p->in[17] + c8 + 4);
    const float4 b0 = *(const float4*)(p->in[18] + c8), b1 = *(const float4*)(p->in[18] + c8 + 4);
    const float4 d0 = *(const float4*)(p->in[19] + c8), d1 = *(const float4*)(p->in[19] + c8 + 4);
    rk8[0] = a0.x; rk8[1] = a0.y; rk8[2] = a0.z; rk8[3] = a0.w; rk8[4] = a1.x; rk8[5] = a1.y; rk8[6] = a1.z; rk8[7] = a1.w;
    lg8[0] = b0.x; lg8[1] = b0.y; lg8[2] = b0.z; lg8[3] = b0.w; lg8[4] = b1.x; lg8[5] = b1.y; lg8[6] = b1.z; lg8[7] = b1.w;
    lb8[0] = d0.x; lb8[1] = d0.y; lb8[2] = d0.z; lb8[3] = d0.w; lb8[4] = d1.x; lb8[5] = d1.y; lb8[6] = d1.z; lb8[7] = d1.w;
  }
  for (int t = blockIdx.x * 4 + w; t < T; t += gridDim.x * 4) {
    const size_t o = (size_t)t * 512 + c8;
    bf16_t* yp = ACT + (size_t)t * 1024 + 512 + c8;
    const uint4 uy = *(const uint4*)yp, ur = *(const uint4*)(Rb + o), uk = *(const uint4*)(Kb + o),
                uv = *(const uint4*)(Vb + o), ug = *(const uint4*)(GTb + o);
    float y[8], r[8], k[8], v[8], g[8];
    unpack8f(uy, y); unpack8f(ur, r); unpack8f(uk, k); unpack8f(uv, v); unpack8f(ug, g);
    float sm = 0.f, rk = 0.f;
#pragma unroll
    for (int e = 0; e < 8; ++e) { sm += y[e]; rk = fmaf(r[e] * k[e], rk8[e], rk); }
    sm = allreduce8(sm);
    rk = allreduce8(rk);
    const float mean = sm * (1.f / 64.f);
    float vs = 0.f;
#pragma unroll
    for (int e = 0; e < 8; ++e) { y[e] -= mean; vs += y[e] * y[e]; }
    vs = allreduce8(vs);
    const float rs = rsqrtf(vs * (1.f / 64.f) + 64e-5f);
    float ov[8];
#pragma unroll
    for (int e = 0; e < 8; ++e) ov[e] = (y[e] * rs * lg8[e] + lb8[e] + rk * v[e]) * g[e];
    *(uint4*)yp = pack8f(ov);
  }
}

DI void phase6(KP p, char* smem) {
  for (int tile = blockIdx.x; tile < 136 * 8; tile += gridDim.x) {
    const int mt = tile >> 3, nt = tile & 7;
    const int m0 = mt * 128, n0 = nt * 128;
    f32x16 acc[2][2];
    gemm128<false>((const bf16_t*)(p->ws + OFF_ACT) + (size_t)m0 * 1024, 1024,
                   (const bf16_t*)(p->ws + OFF_WOUT) + (size_t)n0 * 1024, 1024, 1024, acc, smem);
    {
      const int lane = tidx() & 63, w = tidx() >> 6;
      const int wm = w >> 1, wn = w & 1, r = lane & 31, h = lane >> 5;
      const float* xb = (m0 < TP) ? p->in[0] + (size_t)m0 * 1024 : p->in[1] + (size_t)(m0 - TP) * 1024;
#pragma unroll
      for (int mi = 0; mi < 2; ++mi)
#pragma unroll
        for (int ni = 0; ni < 2; ++ni)
#pragma unroll
          for (int i = 0; i < 16; ++i)
            acc[mi][ni][i] += xb[(size_t)(wm * 64 + mi * 32 + crow(i, h)) * 1024 + n0 + wn * 64 + ni * 32 + r];
#pragma unroll
      for (int mi = 0; mi < 2; ++mi)
#pragma unroll
        for (int ni = 0; ni < 2; ++ni)
#pragma unroll
          for (int i = 0; i < 16; ++i)
            p->out[(size_t)(m0 + wm * 64 + mi * 32 + crow(i, h)) * 1024 + n0 + wn * 64 + ni * 32 + r] = acc[mi][ni][i];
    }
  }
}

DI void phase7(KP p) {
  const int lane = tidx() & 63, w = tidx() >> 6;
  for (int t = blockIdx.x * 4 + w; t < T; t += gridDim.x * 4)
    rmsnorm_row_bf(p->out + (size_t)t * 1024, p->in[21], (bf16_t*)(p->ws + OFF_ACT) + (size_t)t * 1024, lane);
}

DI void phase8(KP p, char* smem) {
  bf16_t* QP = (bf16_t*)(p->ws + OFF_QPEER);
  for (int tile = blockIdx.x; tile < 136 * 16; tile += gridDim.x) {
    const int mt = tile >> 4, nt = tile & 15;
    const int m0 = mt * 128, n0 = nt * 128;
    f32x16 acc[2][2];
    gemm128<false>((const bf16_t*)(p->ws + OFF_ACT) + (size_t)m0 * 1024, 1024,
                   (const bf16_t*)(p->ws + OFF_WQ) + (size_t)n0 * 1024, 1024, 1024, acc, smem);
    epi_each(acc, [&](int rr, int cc, float v) { QP[(size_t)(m0 + rr) * 2048 + n0 + cc] = f2bf(v); });
  }
}

DI unsigned sortkey(float f) { unsigned u = __float_as_uint(f); return (u & 0x80000000u) ? ~u : (u | 0x80000000u); }
DI float unsortkey(unsigned k) { unsigned u = (k & 0x80000000u) ? (k ^ 0x80000000u) : ~k; return __uint_as_float(u); }
DI void ins16(unsigned (&l)[16], unsigned x) {
#pragma unroll
  for (int i = 0; i < 16; ++i) { const unsigned hi = max(l[i], x); x = min(l[i], x); l[i] = hi; }
}
DI void cswap_desc(unsigned& a, unsigned& b) { const unsigned hi = max(a, b), lo = min(a, b); a = hi; b = lo; }
DI void bsort16(unsigned (&v)[16]) {
#pragma unroll
  for (int ke = 1; ke <= 4; ++ke)
#pragma unroll
    for (int je = ke - 1; je >= 0; --je)
#pragma unroll
      for (int i = 0; i < 16; ++i) {
        const int k = 1 << ke, j = 1 << je, l = i ^ j;
        if (l > i) { if ((i & k) == 0) cswap_desc(v[i], v[l]); else cswap_desc(v[l], v[i]); }
      }
}
DI void bmerge16(unsigned (&a)[16], const unsigned (&b)[16]) {
#pragma unroll
  for (int i = 0; i < 16; ++i) a[i] = max(a[i], b[15 - i]);
#pragma unroll
  for (int je = 3; je >= 0; --je)
#pragma unroll
    for (int i = 0; i < 16; ++i) {
      const int j = 1 << je, l = i ^ j;
      if (l > i) cswap_desc(a[i], a[l]);
    }
}
DI void phase9(KP p, char* smem) {
  const int tid = tidx();
  const bf16_t* QP = (const bf16_t*)(p->ws + OFF_QPEER);
  const bf16_t* KEYS = (const bf16_t*)(p->ws + OFF_KEYS);
  int* IDX = (int*)(p->ws + OFF_IDX);
  float* GSM = (float*)(p->ws + OFF_GSM);
  float* sc = (float*)smem;
  unsigned* mrg = (unsigned*)smem;
  const int row = tid >> 1, half = tid & 1;
  for (int item = blockIdx.x; item < 136 * 8; item += gridDim.x) {
    const int mt = item >> 3, hd = item & 7;
    const int m0 = mt * 128;
    unsigned kc[2][16];
#pragma unroll
    for (int c = 0; c < 2; ++c) {
      f32x16 acc[2][2];
      gemm128<false>(QP + (size_t)m0 * 2048 + (hd * 2 + c) * 128, 2048, KEYS + (size_t)(hd * 2 + c) * 16384, 128, 128, acc, smem);
      __syncthreads();
      epi_each(acc, [&](int rr, int cc, float v) { sc[rr * 129 + cc] = v; });
      __syncthreads();
      unsigned lst[16];
#pragma unroll
      for (int gi = 0; gi < 4; ++gi) {
        unsigned grp[16];
#pragma unroll
        for (int i = 0; i < 16; ++i) {
          const int col = half * 64 + gi * 16 + i;
          grp[i] = (sortkey(sc[row * 129 + col]) & ~127u) | (unsigned)(127 - col);
        }
        bsort16(grp);
        if (gi == 0) {
#pragma unroll
          for (int i = 0; i < 16; ++i) lst[i] = grp[i];
        } else {
          bmerge16(lst, grp);
        }
      }
      __syncthreads();
      if (half) {
#pragma unroll
        for (int i = 0; i < 16; ++i) mrg[row * 16 + i] = lst[i];
      }
      __syncthreads();
      if (!half) {
        unsigned grp[16];
#pragma unroll
        for (int i = 0; i < 16; ++i) grp[i] = mrg[row * 16 + i];
        bmerge16(lst, grp);
      }
#pragma unroll
      for (int i = 0; i < 16; ++i) kc[c][i] = lst[i];
    }
    if (!half) {
      float sv0[16], sv1[16];
#pragma unroll
      for (int i = 0; i < 16; ++i) { sv0[i] = unsortkey(kc[0][i] & ~127u); sv1[i] = unsortkey(kc[1][i] & ~127u); }
      unsigned cl[16];
#pragma unroll
      for (int i = 0; i < 16; ++i) cl[i] = 0u;
#pragma unroll
      for (int a = 0; a < 16; ++a)
#pragma unroll
        for (int b = 0; b < 16 / (a + 1); ++b)
          ins16(cl, (sortkey(sv0[a] + sv1[b]) & ~255u) | (unsigned)(255 - (a * 16 + b)));
      float ex[16];
      float sum = 0.f;
      const float mx = unsortkey(cl[0] & ~255u);
#pragma unroll
      for (int i = 0; i < 16; ++i) { ex[i] = __expf(unsortkey(cl[i] & ~255u) - mx); sum += ex[i]; }
      const float inv = 1.f / sum;
      int eo[16];
#pragma unroll
      for (int i = 0; i < 16; ++i) {
        const int ci = 255 - (int)(cl[i] & 255u);
        const int a = ci >> 4, b = ci & 15;
        int i0 = 0, i1 = 0;
#pragma unroll
        for (int k = 0; k < 16; ++k) {
          i0 = (a == k) ? (127 - (int)(kc[0][k] & 127u)) : i0;
          i1 = (b == k) ? (127 - (int)(kc[1][k] & 127u)) : i1;
        }
        eo[i] = i0 * 128 + i1;
        ex[i] *= inv;
      }
      const size_t o = ((size_t)(m0 + row) * 8 + hd) * 16;
#pragma unroll
      for (int qd = 0; qd < 4; ++qd) {
        *(int4*)(IDX + o + qd * 4) = make_int4(eo[qd * 4], eo[qd * 4 + 1], eo[qd * 4 + 2], eo[qd * 4 + 3]);
        *(float4*)(GSM + o + qd * 4) = make_float4(ex[qd * 4], ex[qd * 4 + 1], ex[qd * 4 + 2], ex[qd * 4 + 3]);
      }
    }
  }
}

#define UB0(u) ((float)((u) & 0xffu))
#define UB1(u) ((float)(((u) >> 8) & 0xffu))
#define UB2(u) ((float)(((u) >> 16) & 0xffu))
#define UB3(u) ((float)((u) >> 24))
template <int MODE, bool HALF>
DI void peer_token(KP p, const int t, int it0, int it1, char* smem, const int uh = -1) {
  const int lane = tidx() & 63, w = tidx() >> 6;
  const int g = lane >> 4, l16 = lane & 15;
  bf16_t* ACT = (bf16_t*)(p->ws + OFF_ACT);
  const unsigned char* UB = (const unsigned char*)(p->ws + OFF_TAB);
  const unsigned char* VB = UB + TAB_V8;
  const float* USC = (const float*)(p->ws + OFF_TAB + TAB_SC);
  const float* VSC = USC + 16384;
  const int* IDX = (const int*)(p->ws + OFF_IDX);
  const float* GSM = (const float*)(p->ws + OFF_GSM);
  const float* pn = p->in[26];
  {
    bf16_t* act = ACT + (size_t)t * 1024;
    float xf[64];
    float xsum = 0.f;
    float* CV = (float*)(p->ws + OFF_QPEER) + (size_t)t * 128;
    float c0 = 0.f, c1 = 0.f;
    if (MODE == 3) { c0 = CV[lane]; c1 = CV[64 + lane]; }
#pragma unroll
    for (int s = 0; s < 4; ++s) {
      if (MODE == 3) break;
      const uint4 x0 = *(const uint4*)(act + s * 256 + l16 * 16);
      const uint4 x1 = *(const uint4*)(act + s * 256 + l16 * 16 + 8);
      const unsigned xx[8] = {x0.x, x0.y, x0.z, x0.w, x1.x, x1.y, x1.z, x1.w};
#pragma unroll
      for (int q = 0; q < 8; ++q) { xf[s * 16 + 2 * q] = lo2f(xx[q]); xf[s * 16 + 2 * q + 1] = hi2f(xx[q]); }
    }
#pragma unroll
    for (int k = 0; k < 64; ++k) xsum += (MODE == 3) ? 0.f : xf[k];
    int id0 = IDX[(size_t)t * 128 + lane], id1 = IDX[(size_t)t * 128 + 64 + lane];
    float gs0 = GSM[(size_t)t * 128 + lane], gs1 = GSM[(size_t)t * 128 + 64 + lane];
    int cnt0;
    {
      const bool ina = id0 < 8192, inb = id1 < 8192;
      const unsigned long long ba = __ballot(ina), bb = __ballot(inb);
      const unsigned long long lt = (1ull << lane) - 1ull;
      const int cnt_a = __popcll(ba), cnt_b = __popcll(bb);
      cnt0 = cnt_a + cnt_b;
      const int ra = ina ? __popcll(ba & lt) : cnt0 + __popcll(~ba & lt);
      const int rb = inb ? cnt_a + __popcll(bb & lt) : cnt0 + (64 - cnt_a) + __popcll(~bb & lt);
      int* pl = (int*)(smem + 16384) + w * 256;
      __builtin_amdgcn_wave_barrier();
      pl[ra] = id0; pl[rb] = id1;
      pl[128 + ra] = __float_as_int(gs0); pl[128 + rb] = __float_as_int(gs1);
      __builtin_amdgcn_fence(__ATOMIC_RELEASE, "wavefront");
      __builtin_amdgcn_wave_barrier();
      id0 = pl[lane]; id1 = pl[64 + lane];
      gs0 = __int_as_float(pl[128 + lane]); gs1 = __int_as_float(pl[192 + lane]);
      __builtin_amdgcn_wave_barrier();
    }
    if (uh == 0) { it0 = 0; it1 = (cnt0 + 3) >> 2; }
    if (uh == 1) { it0 = cnt0 >> 2; it1 = 32; }
    float acc[64];
#pragma unroll
    for (int k = 0; k < 64; ++k) acc[k] = 0.f;
    float csum = 0.f;
    for (int it = it0; it < it1; ++it) {
      const int n = (it * 4 + g) & 63;
      const int e = __shfl((it < 16) ? id0 : id1, n);
      const float gw = __shfl((it < 16) ? gs0 : gs1, n);
      const unsigned char* ur = UB + (size_t)e * 1024 + l16 * 16;
      const unsigned char* vr = VB + (size_t)e * 1024 + l16 * 16;
      uint4 uu[4], vv[4];
      if (MODE != 3) {
#pragma unroll
        for (int s = 0; s < 4; ++s) uu[s] = *(const uint4*)(ur + s * 256);
      }
      if (MODE != 2) {
#pragma unroll
        for (int s = 0; s < 4; ++s) vv[s] = *(const uint4*)(vr + s * 256);
      }
      float c;
      if (MODE == 3) {
        c = __shfl((it < 16) ? c0 : c1, n);
      } else {
      const float su = USC[e], sv = VSC[e];
      float hv = 0.f;
#pragma unroll
      for (int s = 0; s < 4; ++s) {
        const unsigned ww[4] = {uu[s].x, uu[s].y, uu[s].z, uu[s].w};
#pragma unroll
        for (int q = 0; q < 4; ++q) {
          hv = fmaf(xf[s * 16 + q * 4 + 0], UB0(ww[q]), hv);
          hv = fmaf(xf[s * 16 + q * 4 + 1], UB1(ww[q]), hv);
          hv = fmaf(xf[s * 16 + q * 4 + 2], UB2(ww[q]), hv);
          hv = fmaf(xf[s * 16 + q * 4 + 3], UB3(ww[q]), hv);
        }
      }
      hv = fmaf(-128.f, xsum, hv);
      hv = allreduce16(hv) * su;
      c = 0.5f * hv * (1.f + erff(hv * 0.70710678118f)) * gw * sv;
      }
      if (MODE == 2) {
        const float cc = __shfl(c, ((lane - it * 4) & 3) * 16);
        if ((lane >> 2) == (it & 15)) { if (it < 16) c0 = cc; else c1 = cc; }
        continue;
      }
      csum += c;
#pragma unroll
      for (int s = 0; s < 4; ++s) {
        const unsigned ww[4] = {vv[s].x, vv[s].y, vv[s].z, vv[s].w};
#pragma unroll
        for (int q = 0; q < 4; ++q) {
          acc[s * 16 + q * 4 + 0] = fmaf(c, UB0(ww[q]), acc[s * 16 + q * 4 + 0]);
          acc[s * 16 + q * 4 + 1] = fmaf(c, UB1(ww[q]), acc[s * 16 + q * 4 + 1]);
          acc[s * 16 + q * 4 + 2] = fmaf(c, UB2(ww[q]), acc[s * 16 + q * 4 + 2]);
          acc[s * 16 + q * 4 + 3] = fmaf(c, UB3(ww[q]), acc[s * 16 + q * 4 + 3]);
        }
      }
    }
    if (MODE == 2) {
      if ((lane >> 2) >= it0 && (lane >> 2) < it1) CV[lane] = c0;
      if (16 + (lane >> 2) >= it0 && 16 + (lane >> 2) < it1) CV[64 + lane] = c1;
      return;
    }
    const float cs128 = 128.f * csum;
#pragma unroll
    for (int k = 0; k < 64; ++k) {
      acc[k] -= cs128;
      acc[k] += __shfl_xor(acc[k], 16);
      acc[k] += __shfl_xor(acc[k], 32);
    }
    float* hrow = p->out + (size_t)t * 1024;
    float hvv[16];
#pragma unroll
    for (int s = 0; s < 4; ++s) {
      if (s == g) {
#pragma unroll
        for (int k = 0; k < 16; ++k) hvv[k] = acc[s * 16 + k];
      }
    }
    if (HALF) {
      float* ex = (float*)smem + ((w >> 1) * 64 + lane) * 16;
      if (w & 1) {
#pragma unroll
        for (int q = 0; q < 4; ++q) *(float4*)(ex + q * 4) = make_float4(hvv[q * 4], hvv[q * 4 + 1], hvv[q * 4 + 2], hvv[q * 4 + 3]);
      }
      __syncthreads();
      if (w & 1) return;
#pragma unroll
      for (int q = 0; q < 4; ++q) {
        const float4 e4 = *(const float4*)(ex + q * 4);
        hvv[q * 4] += e4.x; hvv[q * 4 + 1] += e4.y; hvv[q * 4 + 2] += e4.z; hvv[q * 4 + 3] += e4.w;
      }
    }
    {
      float* hp = hrow + g * 256 + l16 * 16;
      const float4 r0 = *(const float4*)(hp), r1 = *(const float4*)(hp + 4), r2 = *(const float4*)(hp + 8), r3 = *(const float4*)(hp + 12);
      hvv[0] += r0.x; hvv[1] += r0.y; hvv[2] += r0.z; hvv[3] += r0.w; hvv[4] += r1.x; hvv[5] += r1.y; hvv[6] += r1.z; hvv[7] += r1.w;
      hvv[8] += r2.x; hvv[9] += r2.y; hvv[10] += r2.z; hvv[11] += r2.w; hvv[12] += r3.x; hvv[13] += r3.y; hvv[14] += r3.z; hvv[15] += r3.w;
      *(float4*)(hp) = make_float4(hvv[0], hvv[1], hvv[2], hvv[3]);
      *(float4*)(hp + 4) = make_float4(hvv[4], hvv[5], hvv[6], hvv[7]);
      *(float4*)(hp + 8) = make_float4(hvv[8], hvv[9], hvv[10], hvv[11]);
      *(float4*)(hp + 12) = make_float4(hvv[12], hvv[13], hvv[14], hvv[15]);
    }
    float ss = 0.f;
#pragma unroll
    for (int k = 0; k < 16; ++k) ss += hvv[k] * hvv[k];
    ss = wave_sum(ss);
    const float scl = rsqrtf(ss * (1.f / 1024.f) + 1e-6f);
    {
      const int col = g * 256 + l16 * 16;
      unsigned o8[8];
#pragma unroll
      for (int q = 0; q < 4; ++q) {
        const float4 g0 = *(const float4*)(pn + col + q * 4);
        o8[q * 2] = pack2(hvv[q * 4 + 0] * scl * g0.x, hvv[q * 4 + 1] * scl * g0.y);
        o8[q * 2 + 1] = pack2(hvv[q * 4 + 2] * scl * g0.z, hvv[q * 4 + 3] * scl * g0.w);
      }
      *(uint4*)(act + col) = make_uint4(o8[0], o8[1], o8[2], o8[3]);
      *(uint4*)(act + col + 8) = make_uint4(o8[4], o8[5], o8[6], o8[7]);
    }
  }
}

DI void phase10(KP p, char* smem) {
  const int w = tidx() >> 6;
  if (gridDim.x == 512) {
#pragma unroll 1
    for (int k = 0; k < 16; ++k) peer_token<2, false>(p, (int)blockIdx.x * 4 + w + (k & 7) * 2048, 0, 32, smem, k >> 3);
#pragma unroll 1
    for (int k = 0; k < 8; ++k) peer_token<3, false>(p, (int)blockIdx.x * 4 + w + k * 2048, 0, 32, smem);
    __syncthreads();
    peer_token<2, true>(p, 16384 + 2 * (int)blockIdx.x + (w >> 1), (w & 1) * 16, (w & 1) * 16 + 16, smem);
    peer_token<3, true>(p, 16384 + 2 * (int)blockIdx.x + (w >> 1), (w & 1) * 16, (w & 1) * 16 + 16, smem);
  } else {
    for (int t = blockIdx.x * 4 + w; t < T; t += gridDim.x * 4) { peer_token<2, false>(p, t, 0, 32, smem); peer_token<3, false>(p, t, 0, 32, smem); }
  }
}

DI void phase11(KP p, char* smem) {
  for (int tile = blockIdx.x; tile < 136 * 8; tile += gridDim.x) {
    const int mt = tile >> 3, nt = tile & 7;
    const int m0 = mt * 128, n0 = nt * 128;
    f32x16 acc[2][2];
    unsigned ppk[2][2][8];
    const float* pa = (m0 < TP) ? p->in[5] + (size_t)m0 * 256 : p->in[6] + (size_t)(m0 - TP) * 256;
    gemm128<true>(pa, 256, (const bf16_t*)(p->ws + OFF_PP) + (size_t)n0 * 256, 256, 256, acc, smem);
#pragma unroll
    for (int mi = 0; mi < 2; ++mi)
#pragma unroll
      for (int ni = 0; ni < 2; ++ni)
#pragma unroll
        for (int i = 0; i < 8; ++i) ppk[mi][ni][i] = pack2(acc[mi][ni][2 * i], acc[mi][ni][2 * i + 1]);
    gemm128<false>((const bf16_t*)(p->ws + OFF_ACT) + (size_t)m0 * 1024, 1024,
                   (const bf16_t*)(p->ws + OFF_PG) + (size_t)n0 * 1024, 1024, 1024, acc, smem);
    const int lane = tidx() & 63, w = tidx() >> 6;
    const int wm = w >> 1, wn = w & 1, r = lane & 31, h = lane >> 5;
#pragma unroll
    for (int mi = 0; mi < 2; ++mi)
#pragma unroll
      for (int ni = 0; ni < 2; ++ni)
#pragma unroll
        for (int i = 0; i < 16; ++i) {
          const float pp = (i & 1) ? hi2f(ppk[mi][ni][i >> 1]) : lo2f(ppk[mi][ni][i >> 1]);
          acc[mi][ni][i] = sigmoidf_(acc[mi][ni][i]) * pp;
        }
#pragma unroll
    for (int mi = 0; mi < 2; ++mi) {
#pragma unroll
      for (int ni = 0; ni < 2; ++ni)
#pragma unroll
        for (int i = 0; i < 16; ++i)
          acc[mi][ni][i] += p->out[(size_t)(m0 + wm * 64 + mi * 32 + crow(i, h)) * 1024 + n0 + wn * 64 + ni * 32 + r];
#pragma unroll
      for (int ni = 0; ni < 2; ++ni)
#pragma unroll
        for (int i = 0; i < 16; ++i)
          p->out[(size_t)(m0 + wm * 64 + mi * 32 + crow(i, h)) * 1024 + n0 + wn * 64 + ni * 32 + r] = acc[mi][ni][i];
    }
  }
}

DI void phase12(KP p) {
  const int lane = tidx() & 63, w = tidx() >> 6;
  const float* g = p->in[29];
  for (int t = blockIdx.x * 4 + w; t < T; t += gridDim.x * 4) {
    float* x = p->out + (size_t)t * 1024;
    float4 v[4];
    float ss = 0.f;
#pragma unroll
    for (int i = 0; i < 4; ++i) {
      v[i] = ((const float4*)x)[i * 64 + lane];
      ss += v[i].x * v[i].x + v[i].y * v[i].y + v[i].z * v[i].z + v[i].w * v[i].w;
    }
    ss = wave_sum(ss);
    const float sc = rsqrtf(ss * (1.f / 1024.f) + 1e-6f);
#pragma unroll
    for (int i = 0; i < 4; ++i) {
      const float4 gg = ((const float4*)g)[i * 64 + lane];
      ((float4*)x)[i * 64 + lane] = make_float4(v[i].x * sc * gg.x, v[i].y * sc * gg.y, v[i].z * sc * gg.z, v[i].w * sc * gg.w);
    }
  }
}

DI void run_phase(int ph, char* smem) {
  KP p = getp();
  switch (ph) {
    case 0: phase0(p, smem); break;
    case 1: phase1(p, smem); break;
    case 2: phase2(p); break;
    case 3: phase3(p, smem); break;
    case 4: phase4(p, smem); break;
    case 5: phase5(p); break;
    case 6: phase6(p, smem); break;
    case 7: phase7(p); break;
    case 8: phase8(p, smem); break;
    case 9: phase9(p, smem); break;
    case 10: phase10(p, smem); break;
    case 11: phase11(p, smem); break;
    case 12: phase12(p); break;
    default: break;
  }
}

template <int LO, int HI>
__global__ void __launch_bounds__(256, 2) mega_kernel(Params p) {
  __shared__ __attribute__((aligned(16))) char smem[SMEM_BYTES];
  __shared__ uint4 xb_words;
  if (gridDim.x == 0x7fffffffu) cg::this_grid().sync();
  XcdBarrier xb;
  if (HI - LO > 1) {
    if (threadIdx.x == 0) xb_words = make_uint4(0u, 0u, 0u, 0u);
    __syncthreads();
    xb = xcd_barrier_post((unsigned*)(getp()->ws + OFF_CTR), (volatile LAS unsigned*)&xb_words);
  }
#pragma unroll
  for (int ph = LO; ph < HI; ++ph) {
    run_phase(ph, smem);
    if (ph + 1 < HI) xcd_barrier(xb);
  }
}

template <int PH>
static void launch_phases(const Params& p, int grid, hipStream_t stream) {
  hipLaunchKernelGGL((mega_kernel<PH, PH + 1>), dim3(grid), dim3(256), 0, stream, p);
  if constexpr (PH + 1 < 13) launch_phases<PH + 1>(p, grid, stream);
}

extern "C" void kernel_launch(void* const* d_in, const int* in_sizes, int n_in, void* d_out, int out_size,
                              void* d_ws, size_t ws_size, hipStream_t stream) {
  static int grid_blocks = 0;
  if (!grid_blocks) {
    int dev = 0, cus = 0, per_cu = 0;
    (void)hipGetDevice(&dev);
    (void)hipDeviceGetAttribute(&cus, hipDeviceAttributeMultiprocessorCount, dev);
#if MK_MULTI
    per_cu = 2;
#else
    (void)hipOccupancyMaxActiveBlocksPerMultiprocessor(&per_cu, mega_kernel<0, 13>, 256, 0);
#endif
    if (per_cu < 1) per_cu = 1;
    if (per_cu > 2) per_cu = 2;
    grid_blocks = cus * per_cu;
  }
  Params p{};
  for (int i = 0; i < 30; ++i) p.in[i] = (const float*)d_in[i];
  p.out = (float*)d_out;
  p.ws = (char*)d_ws;
  if (ws_size < WS_END) { fprintf(stderr, "workspace too small: %zu < %zu\n", ws_size, (size_t)WS_END); return; }
  (void)hipMemsetAsync((char*)d_ws + OFF_CTR, 0, 32768, stream);
#if MK_MULTI
  launch_phases<0>(p, grid_blocks, stream);
#else
  void* args[] = {&p};
  hipError_t e = hipLaunchCooperativeKernel((void*)mega_kernel<0, 13>, dim3(grid_blocks), dim3(256), args, 0, stream);
  if (e != hipSuccess) fprintf(stderr, "cooperative launch failed: %s (grid %d)\n", hipGetErrorString(e), grid_blocks);
#endif
}
```

```cpp
#include <hip/hip_runtime.h>
#include <hip/hip_cooperative_groups.h>
#include <cstdio>
namespace cg = cooperative_groups;

#ifndef MK_MULTI
#define MK_MULTI 0
#endif

typedef unsigned short bf16_t;
typedef __attribute__((ext_vector_type(8))) short bf16x8;
typedef __attribute__((ext_vector_type(16))) float f32x16;
typedef __attribute__((ext_vector_type(2))) __bf16 bf2_t;
typedef __attribute__((ext_vector_type(2))) float f2_t;
#define DI __device__ __forceinline__

constexpr int T = 17408, TP = 16384;
constexpr int NPH = 14;

constexpr size_t O_RETP = (size_t)T * 1024;
constexpr size_t O_WKVP = O_RETP + 262144;
constexpr size_t O_SHP = O_WKVP + 262144;
constexpr size_t O_RETS = O_SHP + 14336;
constexpr size_t O_WKVS = O_RETS + 4194304;
constexpr size_t O_SHS = O_WKVS + 4194304;

constexpr size_t OFF_WIN = 0;
constexpr size_t OFF_WOUT = OFF_WIN + (size_t)3840 * 1024 * 2;
constexpr size_t OFF_WQ = OFF_WOUT + (size_t)1024 * 1024 * 2;
constexpr size_t OFF_KEYS = OFF_WQ + (size_t)2048 * 1024 * 2;
constexpr size_t OFF_PG = OFF_KEYS + (size_t)16 * 128 * 128 * 2;
constexpr size_t OFF_PP = OFF_PG + (size_t)1024 * 1024 * 2;
constexpr size_t OFF_W2 = OFF_PP + (size_t)1024 * 256 * 2;
constexpr size_t OFF_A2 = OFF_W2 + (size_t)512 * 64 * 2;
constexpr size_t OFF_G2 = OFF_A2 + (size_t)512 * 64 * 2;
constexpr size_t OFF_ROPE = OFF_G2 + (size_t)512 * 128 * 2;
constexpr size_t OFF_CTR = OFF_ROPE + (size_t)2056 * 32 * 2 * 4;
constexpr size_t OFF_ACT = OFF_CTR + 32768;
constexpr size_t OFF_TAB = OFF_ACT + (size_t)T * 1024 * 2;
constexpr size_t OFF_PREP = OFF_TAB + (size_t)2 * 16384 * 1024 * 2;
constexpr size_t SZ512 = (size_t)T * 512 * 2;
constexpr size_t OFF_R = OFF_PREP;
constexpr size_t OFF_K = OFF_R + SZ512;
constexpr size_t OFF_V = OFF_K + SZ512;
constexpr size_t OFF_KK = OFF_V + SZ512;
constexpr size_t OFF_BB = OFF_KK + SZ512;
constexpr size_t OFF_GATE = OFF_BB + SZ512;
constexpr size_t OFF_EW = OFF_GATE + SZ512;
constexpr size_t OFF_LORA = OFF_EW + (size_t)T * 512 * 4;
constexpr size_t OFF_INVN = OFF_LORA + (size_t)T * 256 * 2;
constexpr size_t WS_END = OFF_INVN + (size_t)T * 8 * 4;
constexpr size_t OFF_QPEER = OFF_PREP;
constexpr size_t OFF_IDX = OFF_QPEER + (size_t)T * 2048 * 2;
constexpr size_t OFF_GSM = OFF_IDX + (size_t)T * 128 * 4;

constexpr int SMEM_BYTES = 79872;

struct Params {
  const float* in[30];
  float* out;
  char* ws;
};

typedef const __attribute__((address_space(4))) Params* KP;
__device__ __forceinline__ KP getp() {
  KP q = (KP)__builtin_amdgcn_kernarg_segment_ptr();
  asm volatile("" : "+s"(q));
  return q;
}
DI int tidx() { int t = threadIdx.x; asm volatile("" : "+v"(t)); return t; }
DI bf16_t f2bf(float x) { return __builtin_bit_cast(bf16_t, (__bf16)x); }
DI float bf2f(bf16_t b) { return __uint_as_float(((unsigned)b) << 16); }
DI unsigned pack2(float a, float b) { const f2_t v = {a, b}; return __builtin_bit_cast(unsigned, __builtin_convertvector(v, bf2_t)); }
DI float lo2f(unsigned u) { return __uint_as_float(u << 16); }
DI float hi2f(unsigned u) { return __uint_as_float(u & 0xffff0000u); }
DI int crow(int reg, int h) { return (reg & 3) + 8 * (reg >> 2) + 4 * h; }
DI float wave_sum(float v) {
#pragma unroll
  for (int o = 32; o >= 1; o >>= 1) v += __shfl_xor(v, o);
  return v;
}
DI float allreduce16(float v) {
  v += __int_as_float(__builtin_amdgcn_update_dpp(0, __float_as_int(v), 0x128, 0xf, 0xf, false));
  v += __int_as_float(__builtin_amdgcn_update_dpp(0, __float_as_int(v), 0x124, 0xf, 0xf, false));
  v += __int_as_float(__builtin_amdgcn_update_dpp(0, __float_as_int(v), 0x122, 0xf, 0xf, false));
  v += __int_as_float(__builtin_amdgcn_update_dpp(0, __float_as_int(v), 0x121, 0xf, 0xf, false));
  return v;
}
#define DPP_ADD(v, ctrl) v += __int_as_float(__builtin_amdgcn_update_dpp(0, __float_as_int(v), ctrl, 0xf, 0xf, false))
DI void allreduce16x2(float& a, float& b) {
  DPP_ADD(a, 0x128); DPP_ADD(b, 0x128);
  DPP_ADD(a, 0x124); DPP_ADD(b, 0x124);
  DPP_ADD(a, 0x122); DPP_ADD(b, 0x122);
  DPP_ADD(a, 0x121); DPP_ADD(b, 0x121);
}
DI float allreduce8(float v) {
  v += __int_as_float(__builtin_amdgcn_update_dpp(0, __float_as_int(v), 0xB1, 0xf, 0xf, false));
  v += __int_as_float(__builtin_amdgcn_update_dpp(0, __float_as_int(v), 0x4E, 0xf, 0xf, false));
  v += __int_as_float(__builtin_amdgcn_update_dpp(0, __float_as_int(v), 0x141, 0xf, 0xf, false));
  return v;
}
DI void unpack8f(const uint4& u, float (&f)[8]) {
  f[0] = lo2f(u.x); f[1] = hi2f(u.x); f[2] = lo2f(u.y); f[3] = hi2f(u.y);
  f[4] = lo2f(u.z); f[5] = hi2f(u.z); f[6] = lo2f(u.w); f[7] = hi2f(u.w);
}
DI uint4 pack8f(const float (&f)[8]) {
  return make_uint4(pack2(f[0], f[1]), pack2(f[2], f[3]), pack2(f[4], f[5]), pack2(f[6], f[7]));
}
DI float log_gamma(int hd) {
  const float e = __uint_as_float((unsigned)(127 - 5 - hd) << 23);
  return -e * (1.f + e * (0.5f + e * (0.33333334f + e * (0.25f + e * 0.2f))));
}
DI float sigmoidf_(float x) { return __builtin_amdgcn_rcpf(1.f + __expf(-x)); }
DI const float* xrow(KP p, int t) {
  return t < TP ? p->in[0] + (size_t)t * 1024 : p->in[1] + (size_t)(t - TP) * 1024;
}
struct TokInfo { int sample, b, l; };
DI TokInfo tokinfo(int t) {
  TokInfo ti;
  if (t >= TP) { ti.sample = 1; ti.b = (t - TP) >> 3; ti.l = (t - TP) & 7; }
  else { ti.sample = 0; ti.b = t >> 11; ti.l = t & 2047; }
  return ti;
}

#define XB_TMO      128
#define XB_XCNT(j)  (256  + 64 * (j))
#define XB_XSUB(j)  (1280 + 64 * (j))
#define XB_XGEN(j)  (2304 + 64 * (j))
#define XB_TOP      3328
#define XB_TOPGEN   3392
#define XCD_BAR_WORDS 3456
#define XB_SPIN_CAP (1u << 20)
#define LAS __attribute__((address_space(3)))
DI unsigned xb_ld(unsigned* p) { return __hip_atomic_load(p, __ATOMIC_RELAXED, __HIP_MEMORY_SCOPE_AGENT); }
DI unsigned xb_add(unsigned* p, unsigned v) { return __hip_atomic_fetch_add(p, v, __ATOMIC_RELAXED, __HIP_MEMORY_SCOPE_AGENT); }
DI unsigned xb_xcc_id() { return (unsigned)__builtin_amdgcn_s_getreg((3 << 11) | 20) & 0xFu; }
#define XB_SPIN(cond, bar) do { unsigned _sp = 0; while (cond) { __builtin_amdgcn_s_sleep(1); \
    if ((++_sp & 255u) == 0u) { if (xb_ld(&(bar)[XB_TMO])) break; if (_sp > XB_SPIN_CAP) { atomicAdd(&(bar)[XB_TMO], 1u); break; } } } } while (0)
struct XcdBarrier { unsigned* bar; unsigned x; volatile LAS unsigned* st; };
DI XcdBarrier xcd_barrier_post(unsigned* bar, volatile LAS unsigned* st) {
  XcdBarrier b; b.bar = bar; b.x = xb_xcc_id(); b.st = st;
  if (threadIdx.x == 0) (void)xb_add(&bar[XB_XCNT(b.x)], 1u);
  return b;
}
DI void xcd_barrier_complete(unsigned* bar, unsigned x, unsigned& nloc, unsigned& nx) {
  const unsigned G = gridDim.x * gridDim.y * gridDim.z;
  unsigned sum, cnt, mine, sp = 0u;
  for (;;) {
    sum = 0u; cnt = 0u; mine = 0u;
#pragma unroll
    for (unsigned j = 0; j < 16; ++j) { const unsigned c = xb_ld(&bar[XB_XCNT(j)]); sum += c; cnt += (c > 0u) ? 1u : 0u; mine = (j == x) ? c : mine; }
    if (sum == G) break;
    __builtin_amdgcn_s_sleep(1);
    if ((++sp & 255u) == 0u) { if (xb_ld(&bar[XB_TMO])) break; if (sp > XB_SPIN_CAP) { atomicAdd(&bar[XB_TMO], 1u); break; } }
  }
  nloc = mine > 0u ? mine : 1u; nx = cnt > 0u ? cnt : 1u;
}
DI void xcd_barrier(const XcdBarrier& b) {
  asm volatile("s_waitcnt vmcnt(0)" ::: "memory");
  __syncthreads();
  if (threadIdx.x == 0) {
    unsigned* bar = b.bar;
    __builtin_amdgcn_s_waitcnt(0);
    unsigned nloc = b.st[0], nx = b.st[1];
    if (nloc == 0u) { xcd_barrier_complete(bar, b.x, nloc, nx); b.st[0] = nloc; b.st[1] = nx; }
    const unsigned old = xb_add(&bar[XB_XSUB(b.x)], 1u);
    const unsigned gen = old / nloc;
    if (old + 1u == (gen + 1u) * nloc) {
      __builtin_amdgcn_fence(__ATOMIC_RELEASE, "agent");
      asm volatile("s_waitcnt vmcnt(0)" ::: "memory");
      const unsigned og = xb_add(&bar[XB_TOP], 1u);
      const unsigned tg = og / nx;
      if (og + 1u == (tg + 1u) * nx) xb_add(&bar[XB_TOPGEN], 1u);
      else XB_SPIN(xb_ld(&bar[XB_TOPGEN]) == tg, bar);
      __builtin_amdgcn_fence(__ATOMIC_ACQUIRE, "agent");
      xb_add(&bar[XB_XGEN(b.x)], 1u);
      asm volatile("s_waitcnt vmcnt(0)" ::: "memory");
    } else {
      XB_SPIN(xb_ld(&bar[XB_XGEN(b.x)]) == gen, bar);
      __builtin_amdgcn_fence(__ATOMIC_ACQUIRE, "agent");
      asm volatile("s_waitcnt vmcnt(0)" ::: "memory");
    }
  }
  __syncthreads();
}

constexpr int LDT = 72;
constexpr int GBUF = 2 * 128 * LDT;
template <bool AF32>
DI void gemm128(const void* __restrict__ Ap, int lda, const bf16_t* __restrict__ Bt, int ldb, int K,
                f32x16 (&acc)[2][2], char* smem) {
  bf16_t* S0 = (bf16_t*)smem;
  const int tid = tidx(), lane = tid & 63, w = tid >> 6;
  const int wm = w >> 1, wn = w & 1, r = lane & 31, h = lane >> 5;
  const int lrow = tid >> 3, lch = tid & 7;
#pragma unroll
  for (int i = 0; i < 2; ++i)
#pragma unroll
    for (int j = 0; j < 2; ++j)
#pragma unroll
      for (int e = 0; e < 16; ++e) acc[i][j][e] = 0.f;
  uint4 ra0, ra1, ra2, ra3, rb0, rb1, rb2, rb3;
  const bf16_t* Ab = (const bf16_t*)Ap + (size_t)lrow * lda + lch * 8;
  const float* Af = (const float*)Ap + (size_t)lrow * lda + lch * 8;
  const bf16_t* Bb = Bt + (size_t)lrow * ldb + lch * 8;
  const size_t a32 = (size_t)32 * lda, b32 = (size_t)32 * ldb;
#define GEMM_LDA(dst, q, k0)                                                                          \
  if constexpr (AF32) {                                                                               \
    const float4 f0 = *(const float4*)(Af + (q) * a32 + (k0));                                        \
    const float4 f1 = *(const float4*)(Af + (q) * a32 + (k0) + 4);                                    \
    dst = make_uint4(pack2(f0.x, f0.y), pack2(f0.z, f0.w), pack2(f1.x, f1.y), pack2(f1.z, f1.w));     \
  } else {                                                                                            \
    dst = *(const uint4*)(Ab + (q) * a32 + (k0));                                                     \
  }
#define GEMM_LOADG(k0)                                                                                \
  {                                                                                                   \
    GEMM_LDA(ra0, 0, k0) GEMM_LDA(ra1, 1, k0) GEMM_LDA(ra2, 2, k0) GEMM_LDA(ra3, 3, k0)               \
    rb0 = *(const uint4*)(Bb + (k0));                                                                 \
    rb1 = *(const uint4*)(Bb + b32 + (k0));                                                           \
    rb2 = *(const uint4*)(Bb + 2 * b32 + (k0));                                                       \
    rb3 = *(const uint4*)(Bb + 3 * b32 + (k0));                                                       \
  }
#define GEMM_STORE(buf)                                                                               \
  {                                                                                                   \
    bf16_t* ad = S0 + (buf) * GBUF + lrow * LDT + lch * 8;                                            \
    bf16_t* bd = ad + 128 * LDT;                                                                      \
    *(uint4*)(ad) = ra0; *(uint4*)(ad + 32 * LDT) = ra1; *(uint4*)(ad + 64 * LDT) = ra2; *(uint4*)(ad + 96 * LDT) = ra3; \
    *(uint4*)(bd) = rb0; *(uint4*)(bd + 32 * LDT) = rb1; *(uint4*)(bd + 64 * LDT) = rb2; *(uint4*)(bd + 96 * LDT) = rb3; \
  }
  const int nk = K >> 6;
  GEMM_LOADG(0)
  GEMM_STORE(0)
  if (nk > 1) GEMM_LOADG(64)
  __syncthreads();
  for (int kt = 0; kt < nk; ++kt) {
    if (kt + 1 < nk) GEMM_STORE((kt + 1) & 1)
    if (kt + 2 < nk) GEMM_LOADG((kt + 2) << 6)
    __builtin_amdgcn_sched_barrier(0);
    const bf16_t* As = S0 + (kt & 1) * GBUF;
    const bf16_t* Bs = As + 128 * LDT;
#pragma unroll
    for (int ks = 0; ks < 4; ++ks) {
      bf16x8 a0 = *(const bf16x8*)(As + (wm * 64 + r) * LDT + ks * 16 + h * 8);
      bf16x8 a1 = *(const bf16x8*)(As + (wm * 64 + 32 + r) * LDT + ks * 16 + h * 8);
      bf16x8 b0 = *(const bf16x8*)(Bs + (wn * 64 + r) * LDT + ks * 16 + h * 8);
      bf16x8 b1 = *(const bf16x8*)(Bs + (wn * 64 + 32 + r) * LDT + ks * 16 + h * 8);
      acc[0][0] = __builtin_amdgcn_mfma_f32_32x32x16_bf16(a0, b0, acc[0][0], 0, 0, 0);
      acc[0][1] = __builtin_amdgcn_mfma_f32_32x32x16_bf16(a0, b1, acc[0][1], 0, 0, 0);
      acc[1][0] = __builtin_amdgcn_mfma_f32_32x32x16_bf16(a1, b0, acc[1][0], 0, 0, 0);
      acc[1][1] = __builtin_amdgcn_mfma_f32_32x32x16_bf16(a1, b1, acc[1][1], 0, 0, 0);
    }
    __syncthreads();
  }
}
template <class F>
DI void epi_each(f32x16 (&acc)[2][2], F f) {
  const int lane = tidx() & 63, w = tidx() >> 6;
  const int wm = w >> 1, wn = w & 1, r = lane & 31, h = lane >> 5;
#pragma unroll
  for (int mi = 0; mi < 2; ++mi)
#pragma unroll
    for (int ni = 0; ni < 2; ++ni)
#pragma unroll
      for (int i = 0; i < 16; ++i) f(wm * 64 + mi * 32 + crow(i, h), wn * 64 + ni * 32 + r, acc[mi][ni][i]);
}

DI void transpose_tile(const float* __restrict__ src, bf16_t* __restrict__ dst, int K, int N, int kt, int nt, float* sm) {
  const int tid = tidx();
  const int k0 = kt * 64, n0 = nt * 64;
#pragma unroll
  for (int i = 0; i < 16; ++i) {
    int k = i * 4 + (tid >> 6), n = tid & 63;
    sm[k * 65 + n] = src[(size_t)(k0 + k) * N + n0 + n];
  }
  __syncthreads();
  int n = tid >> 2, ks = (tid & 3) * 16;
  unsigned pk[8];
#pragma unroll
  for (int j = 0; j < 8; ++j) pk[j] = pack2(sm[(ks + 2 * j) * 65 + n], sm[(ks + 2 * j + 1) * 65 + n]);
  uint4* d = (uint4*)(dst + (size_t)(n0 + n) * K + k0 + ks);
  d[0] = make_uint4(pk[0], pk[1], pk[2], pk[3]);
  d[1] = make_uint4(pk[4], pk[5], pk[6], pk[7]);
  __syncthreads();
}
DI void rmsnorm_row_bf(const float* __restrict__ x, const float* __restrict__ g, bf16_t* __restrict__ o, int lane) {
  float4 v[4];
  float ss = 0.f;
#pragma unroll
  for (int i = 0; i < 4; ++i) {
    v[i] = ((const float4*)x)[i * 64 + lane];
    ss += v[i].x * v[i].x + v[i].y * v[i].y + v[i].z * v[i].z + v[i].w * v[i].w;
  }
  ss = wave_sum(ss);
  float sc = rsqrtf(ss * (1.f / 1024.f) + 1e-6f);
#pragma unroll
  for (int i = 0; i < 4; ++i) {
    float4 gg = ((const float4*)g)[i * 64 + lane];
    uint2 pk = make_uint2(pack2(v[i].x * sc * gg.x, v[i].y * sc * gg.y), pack2(v[i].z * sc * gg.z, v[i].w * sc * gg.w));
    ((uint2*)o)[i * 64 + lane] = pk;
  }
}

#define TJ(IDX, OFF, KK_, NN_)                                                                             \
  {                                                                                                        \
    const int ntl = ((KK_) / 64) * ((NN_) / 64);                                                           \
    if (it < ntl) {                                                                                        \
      transpose_tile(p->in[IDX], (bf16_t*)(p->ws + (OFF)), (KK_), (NN_), it / ((NN_) / 64), it % ((NN_) / 64), (float*)smem); \
      continue;                                                                                            \
    }                                                                                                      \
    it -= ntl;                                                                                             \
  }

DI void phase0(KP p, char* smem) {
  const int tid = tidx(), lane = tid & 63, w = tid >> 6;
  constexpr int N_TR = 960 + 8 + 8 + 16;
  constexpr int N_KEYS = 128, N_ROPE = 257, N_NORM = T / 4;
  for (int item = blockIdx.x; item < N_TR + N_KEYS + N_ROPE + N_NORM; item += gridDim.x) {
    int it = item;
    TJ(8, OFF_WIN, 1024, 3840)
    TJ(11, OFF_W2, 64, 512)
    TJ(13, OFF_A2, 64, 512)
    TJ(14, OFF_G2, 128, 512)
    if (it < N_KEYS) {
      const float* src = p->in[23] + (size_t)it * 2048 + tid * 8;
      float4 f0 = *(const float4*)src, f1 = *(const float4*)(src + 4);
      *(uint4*)((bf16_t*)(p->ws + OFF_KEYS) + (size_t)it * 2048 + tid * 8) =
          make_uint4(pack2(f0.x, f0.y), pack2(f0.z, f0.w), pack2(f1.x, f1.y), pack2(f1.z, f1.w));
      continue;
    }
    it -= N_KEYS;
    if (it < N_ROPE) {
      int e = it * 256 + tid;
      int pidx = e >> 5, f = e & 31;
      if (pidx < 2056) {
        const float pos = (pidx < 2048) ? (float)pidx : (float)(16384 + pidx - 2048);
        const float inv = exp2f(-(float)f * 0.41524101186092f);
        const float ang = pos * inv;
        const float kq = rintf(ang * 0.15915494309189535f);
        float rr = fmaf(-kq, 6.28125f, ang);
        rr = fmaf(-kq, 1.9353071795864769e-3f, rr);
        float* rt = (float*)(p->ws + OFF_ROPE);
        rt[e * 2] = cosf(rr);
        rt[e * 2 + 1] = sinf(rr);
      }
      continue;
    }
    it -= N_ROPE;
    {
      int t = it * 4 + w;
      rmsnorm_row_bf(xrow(p, t), p->in[7], (bf16_t*)(p->ws + OFF_ACT) + (size_t)t * 1024, lane);
    }
  }
}

DI void phase1(KP p, char* smem) {
  const int lane = tidx() & 63, w = tidx() >> 6;
  const int wm = w >> 1, wn = w & 1, r = lane & 31, h = lane >> 5;
  bf16_t* RET = (bf16_t*)p->out;
  bf16_t* RWP = (bf16_t*)(p->ws + OFF_TAB);
  const float2* rope = (const float2*)(p->ws + OFF_ROPE);
  for (int tile = blockIdx.x; tile < 136 * 30; tile += gridDim.x) {
    const int nt = tile / 136, mt = tile - nt * 136;
    const int m0 = mt * 128, n0 = nt * 128;
    f32x16 acc[2][2];
    gemm128<false>((const bf16_t*)(p->ws + OFF_ACT) + (size_t)m0 * 1024, 1024,
                   (const bf16_t*)(p->ws + OFF_WIN) + (size_t)n0 * 1024, 1024, 1024, acc, smem);
    const int nb = n0 + wn * 64;
    if (nb < 1024) {
      float2 cs[2][16];
#pragma unroll
      for (int mi = 0; mi < 2; ++mi)
#pragma unroll
        for (int i = 0; i < 16; ++i) {
          const TokInfo ti = tokinfo(m0 + wm * 64 + mi * 32 + crow(i, h));
          cs[mi][i] = rope[(ti.sample ? 2048 + ti.l : ti.l) * 32 + r];
        }
      const float scl = (nb >= 512) ? 0.125f : 1.f;
#pragma unroll
      for (int mi = 0; mi < 2; ++mi)
#pragma unroll
        for (int i = 0; i < 16; ++i) {
          const float v0 = acc[mi][0][i], v1 = acc[mi][1][i];
          acc[mi][0][i] = (v0 * cs[mi][i].x - v1 * cs[mi][i].y) * scl;
          acc[mi][1][i] = (v1 * cs[mi][i].x + v0 * cs[mi][i].y) * scl;
        }
    }
#pragma unroll
    for (int mi = 0; mi < 2; ++mi)
#pragma unroll
      for (int i = 0; i < 16; ++i) {
        const int t = m0 + wm * 64 + mi * 32 + crow(i, h);
        const float v0 = acc[mi][0][i], v1 = acc[mi][1][i];
        if (nb < 2048) {
          RET[(size_t)t * 2048 + nb + r] = f2bf(v0);
          RET[(size_t)t * 2048 + nb + 32 + r] = f2bf(v1);
        } else {
          const TokInfo ti = tokinfo(t);
          const int c = nb - 2048 + r;
          RWP[(size_t)t * 1792 + c] = f2bf(v0);
          RWP[(size_t)t * 1792 + c + 32] = f2bf(v1);
          if (ti.sample) {
            if (ti.l == 7) { p->out[O_SHS + ti.b * 1792 + c] = v0; p->out[O_SHS + ti.b * 1792 + c + 32] = v1; }
          } else {
            if (ti.l == 2047) { p->out[O_SHP + ti.b * 1792 + c] = v0; p->out[O_SHP + ti.b * 1792 + c + 32] = v1; }
          }
        }
      }
  }
}

DI void phase2(KP p) {
  const int lane = tidx() & 63, w = tidx() >> 6;
  const bf16_t* RWP = (const bf16_t*)(p->ws + OFF_TAB);
  bf16_t* Rb = (bf16_t*)(p->ws + OFF_R);
  bf16_t* Kb = (bf16_t*)(p->ws + OFF_K);
  bf16_t* Vb = (bf16_t*)(p->ws + OFF_V);
  bf16_t* LA = (bf16_t*)(p->ws + OFF_LORA);
  float* INVN = (float*)(p->ws + OFF_INVN);
  const float* mu = p->in[9];
  const float* kkw = p->in[15];
  for (int t = blockIdx.x * 4 + w; t < T; t += gridDim.x * 4) {
    const TokInfo ti = tokinfo(t);
    const bf16_t* cur = RWP + (size_t)t * 1792;
    const bf16_t* prv = cur - 1792;
    const float* sh = p->in[4] + (size_t)ti.b * 1792;
    float f[4][8];
#pragma unroll
    for (int i = 0; i < 4; ++i) {
      const int c8 = (lane + 64 * i) * 8;
      if (i < 3 || lane < 32) {
        float cv[8], pv[8];
        unpack8f(*(const uint4*)(cur + c8), cv);
        if (ti.l > 0) unpack8f(*(const uint4*)(prv + c8), pv);
        else if (ti.sample) {
          const float4 s0 = *(const float4*)(sh + c8), s1 = *(const float4*)(sh + c8 + 4);
          pv[0] = s0.x; pv[1] = s0.y; pv[2] = s0.z; pv[3] = s0.w; pv[4] = s1.x; pv[5] = s1.y; pv[6] = s1.z; pv[7] = s1.w;
        } else {
#pragma unroll
          for (int k = 0; k < 8; ++k) pv[k] = 0.f;
        }
        const float4 m0 = *(const float4*)(mu + c8), m1 = *(const float4*)(mu + c8 + 4);
        const float mm[8] = {m0.x, m0.y, m0.z, m0.w, m1.x, m1.y, m1.z, m1.w};
#pragma unroll
        for (int k = 0; k < 8; ++k) f[i][k] = cv[k] + (pv[k] - cv[k]) * mm[k];
      } else {
#pragma unroll
        for (int k = 0; k < 8; ++k) f[i][k] = 0.f;
      }
    }
    *(uint4*)(Rb + (size_t)t * 512 + lane * 8) = pack8f(f[0]);
    {
      const uint4 kb = pack8f(f[1]);
      *(uint4*)(Kb + (size_t)t * 512 + lane * 8) = kb;
      float kr[8];
      unpack8f(kb, kr);
      const float4 q0 = *(const float4*)(kkw + lane * 8), q1 = *(const float4*)(kkw + lane * 8 + 4);
      const float qq[8] = {q0.x, q0.y, q0.z, q0.w, q1.x, q1.y, q1.z, q1.w};
      float ss = 0.f;
#pragma unroll
      for (int k = 0; k < 8; ++k) { const float kq = kr[k] * qq[k]; ss += kq * kq; }
      ss = allreduce8(ss);
      if ((lane & 7) == 0) INVN[t * 8 + (lane >> 3)] = 1.f / fmaxf(sqrtf(ss), 1e-12f);
    }
    *(uint4*)(Vb + (size_t)t * 512 + lane * 8) = pack8f(f[2]);
    if (lane < 32) {
      float o[8];
#pragma unroll
      for (int k = 0; k < 8; ++k) {
        const float x = f[3][k];
        o[k] = (lane < 8) ? (1.f - 2.f * __builtin_amdgcn_rcpf(1.f + __expf(2.f * x))) : ((lane < 16) ? x : sigmoidf_(x));
      }
      *(uint4*)(LA + (size_t)t * 256 + lane * 8) = pack8f(o);
    }
  }
}

DI void phase3(KP p, char* smem) {
  const bf16_t* LA = (const bf16_t*)(p->ws + OFF_LORA);
  bf16_t* Kb = (bf16_t*)(p->ws + OFF_K);
  bf16_t* KKb = (bf16_t*)(p->ws + OFF_KK);
  bf16_t* BBb = (bf16_t*)(p->ws + OFF_BB);
  bf16_t* GTb = (bf16_t*)(p->ws + OFF_GATE);
  float* EW = (float*)(p->ws + OFF_EW);
  const float* INVN = (const float*)(p->ws + OFF_INVN);
  const float* w0 = p->in[10];
  const float* a0 = p->in[12];
  const float* kkw = p->in[15];
  const float* kaw = p->in[16];
  for (int item = blockIdx.x; item < 136 * 12; item += gridDim.x) {
    const int mt = item / 12, rem = item % 12, kind = rem >> 2, nt = rem & 3;
    const int m0 = mt * 128, n0 = nt * 128;
    f32x16 acc[2][2];
    if (kind == 0) {
      gemm128<false>(LA + (size_t)m0 * 256, 256, (const bf16_t*)(p->ws + OFF_W2) + n0 * 64, 64, 64, acc, smem);
      epi_each(acc, [&](int rr, int cc, float v) {
        const int t = m0 + rr, c = n0 + cc;
        const float x = v + w0[c];
        const float z = -x;
        const float sp = fmaxf(z, 0.f) + __logf(1.f + __expf(-fabsf(z)));
        const float ww = -sp - 0.5f;
        EW[(size_t)t * 512 + c] = __expf(-__expf(ww));
      });
    } else if (kind == 1) {
      gemm128<false>(LA + (size_t)m0 * 256 + 64, 256, (const bf16_t*)(p->ws + OFF_A2) + n0 * 64, 64, 64, acc, smem);
      {
        const int lane = tidx() & 63, w = tidx() >> 6;
        const int wm = w >> 1, wn = w & 1, r = lane & 31, h = lane >> 5;
#pragma unroll 1
        for (int mi = 0; mi < 2; ++mi) {
          const int tb = m0 + wm * 64 + mi * 32;
          float inv[16];
#pragma unroll
          for (int i = 0; i < 16; ++i) inv[i] = INVN[(tb + crow(i, h)) * 8 + ((n0 + wn * 64) >> 6)];
#pragma unroll
          for (int ni = 0; ni < 2; ++ni) {
            const int c = n0 + wn * 64 + ni * 32 + r;
            const float a0c = a0[c], kkc = kkw[c], kac = kaw[c];
            float k7v[16];
#pragma unroll
            for (int i = 0; i < 16; ++i) k7v[i] = bf2f(Kb[(size_t)(tb + crow(i, h)) * 512 + c]);
#pragma unroll
            for (int i = 0; i < 16; ++i) {
              const float av = (mi == 0) ? acc[0][ni][i] : acc[1][ni][i];
              const float a = sigmoidf_(av + a0c);
              const size_t o = (size_t)(tb + crow(i, h)) * 512 + c;
              const float kkv = k7v[i] * kkc * inv[i];
              Kb[o] = f2bf(k7v[i] * (1.f + (a - 1.f) * kac));
              KKb[o] = f2bf(kkv);
              BBb[o] = f2bf(kkv * a);
            }
          }
        }
      }
    } else {
      gemm128<false>(LA + (size_t)m0 * 256 + 128, 256, (const bf16_t*)(p->ws + OFF_G2) + n0 * 128, 128, 128, acc, smem);
      epi_each(acc, [&](int rr, int cc, float v) { GTb[(size_t)(m0 + rr) * 512 + n0 + cc] = f2bf(v); });
    }
  }
}

DI void rwkv_scan(KP p, int tok0, int hd, int q, int nsteps, const float* __restrict__ S0, float* __restrict__ Sout, char* smem) {
  const int tid = tidx(), lane = tid & 63, w = tid >> 6, g = lane >> 4, l16 = lane & 15;
  const int rl = w * 4 + g;
  const int row = q * 16 + rl;
  const int j0 = l16 * 4;
  const bf16_t* Rb = (const bf16_t*)(p->ws + OFF_R);
  const bf16_t* Kb = (const bf16_t*)(p->ws + OFF_K);
  const bf16_t* Vb = (const bf16_t*)(p->ws + OFF_V);
  const bf16_t* KKb = (const bf16_t*)(p->ws + OFF_KK);
  const bf16_t* BBb = (const bf16_t*)(p->ws + OFF_BB);
  const float* EW = (const float*)(p->ws + OFF_EW);
  bf16_t* ACT = (bf16_t*)(p->ws + OFF_ACT);
  float* ew_s = (float*)smem;
  float* kk_s = ew_s + 2048;
  float* bb_s = kk_s + 2048;
  float* kp_s = bb_s + 2048;
  float* r_s = kp_s + 2048;
  float* v_s = r_s + 2048;
  float* y_s = v_s + 512;
  f2_t s01 = (f2_t){0.f, 0.f}, s23 = (f2_t){0.f, 0.f};
  if (S0) { const float4 t4 = *(const float4*)(S0 + row * 64 + j0); s01 = (f2_t){t4.x, t4.y}; s23 = (f2_t){t4.z, t4.w}; }
  uint4 rg_r = make_uint4(0, 0, 0, 0), rg_k = rg_r, rg_kk = rg_r, rg_bb = rg_r, rg_v = rg_r;
  float4 rg_e0 = make_float4(0, 0, 0, 0), rg_e1 = rg_e0;
  const int st_l = tid >> 3, c8 = (tid & 7) * 8;
  auto gload = [&](int sb) {
    if (sb + st_l < nsteps) {
      const size_t o = (size_t)(tok0 + sb + st_l) * 512 + hd * 64 + c8;
      rg_r = *(const uint4*)(Rb + o);
      rg_k = *(const uint4*)(Kb + o);
      rg_kk = *(const uint4*)(KKb + o);
      rg_bb = *(const uint4*)(BBb + o);
      rg_e0 = *(const float4*)(EW + o);
      rg_e1 = *(const float4*)(EW + o + 4);
    }
    if (tid < 64) {
      const int sv = tid >> 1;
      if (sb + sv < nsteps) rg_v = *(const uint4*)(Vb + (size_t)(tok0 + sb + sv) * 512 + hd * 64 + q * 16 + (tid & 1) * 8);
    }
  };
  auto unpack8 = [&](float* d, const uint4& u) {
    *(float4*)d = make_float4(lo2f(u.x), hi2f(u.x), lo2f(u.y), hi2f(u.y));
    *(float4*)(d + 4) = make_float4(lo2f(u.z), hi2f(u.z), lo2f(u.w), hi2f(u.w));
  };
  auto sstore = [&]() {
    const int o = st_l * 64 + c8;
    unpack8(r_s + o, rg_r);
    unpack8(kp_s + o, rg_k);
    unpack8(kk_s + o, rg_kk);
    unpack8(bb_s + o, rg_bb);
    *(float4*)(ew_s + o) = rg_e0;
    *(float4*)(ew_s + o + 4) = rg_e1;
    if (tid < 64) unpack8(v_s + (tid >> 1) * 16 + (tid & 1) * 8, rg_v);
  };
  gload(0);
  for (int sb = 0; sb < nsteps; sb += 32) {
    __syncthreads();
    sstore();
    __syncthreads();
    if (sb + 32 < nsteps) gload(sb + 32);
    const int tc = min(32, nsteps - sb);
#define SC_LD(X, st)                                              \
  {                                                               \
    const float* b_ = ew_s + (st) * 64 + j0;                      \
    X##e = *(const float4*)(b_);                                  \
    X##q = *(const float4*)(b_ + 2048);                           \
    X##b = *(const float4*)(b_ + 4096);                           \
    X##k = *(const float4*)(b_ + 6144);                           \
    X##r = *(const float4*)(b_ + 8192);                           \
    X##v = v_s[(st) * 16 + rl];                                   \
  }
#define SC_STEP(X, st)                                                                     \
  {                                                                                        \
    const f2_t p2 = s01 * (f2_t){X##q.x, X##q.y} + s23 * (f2_t){X##q.z, X##q.w};           \
    float pdp = p2.x + p2.y;                                                               \
      \
    const f2_t vk01 = (f2_t){X##k.x, X##k.y} * X##v, vk23 = (f2_t){X##k.z, X##k.w} * X##v; \
    const f2_t base01 = s01 * (f2_t){X##e.x, X##e.y} + vk01;                               \
    const f2_t base23 = s23 * (f2_t){X##e.z, X##e.w} + vk23;                               \
    allreduce16x2(pdp, ypart);     \
    if (l16 == 0 && (st) > 0) y_s[((st) - 1) * 16 + rl] = ypart;                           \
    s01 = base01 - (f2_t){X##b.x, X##b.y} * pdp;                              \
    s23 = base23 - (f2_t){X##b.z, X##b.w} * pdp;                                           \
    const f2_t y2 = s01 * (f2_t){X##r.x, X##r.y} + s23 * (f2_t){X##r.z, X##r.w};           \
    ypart = y2.x + y2.y;                                                                   \
  }
    {
      float4 Ae, Aq, Ab, Ak, Ar, Be, Bq, Bb, Bk, Br;
      float Av, Bv;
      float ypart = 0.f;
      SC_LD(A, 0)
      for (int st = 0; st < tc; st += 2) {
        SC_LD(B, st + 1)
        SC_STEP(A, st)
        SC_LD(A, min(st + 2, tc - 1))
        SC_STEP(B, st + 1)
      }
      ypart = allreduce16(ypart);
      if (l16 == 0) y_s[(tc - 1) * 16 + rl] = ypart;
    }
    __syncthreads();
    if (tid < tc * 8) {
      const int st = tid >> 3, pr = tid & 7;
      const unsigned pk = pack2(y_s[st * 16 + 2 * pr], y_s[st * 16 + 2 * pr + 1]);
      *(unsigned*)(ACT + (size_t)(tok0 + sb + st) * 1024 + 512 + hd * 64 + q * 16 + 2 * pr) = pk;
    }
  }
  *(float4*)(Sout + row * 64 + j0) = make_float4(s01.x, s01.y, s23.x, s23.y);
}

constexpr int RL = 136;
DI void ret_prompt(KP p, int b, int hd, char* smem) {
  const int tid = tidx(), lane = tid & 63, w = tid >> 6, r = lane & 31, h = lane >> 5;
  const bf16_t* RET = (const bf16_t*)p->out;
  bf16_t* ACT = (bf16_t*)(p->ws + OFF_ACT);
  bf16_t* Vt = (bf16_t*)smem;
  bf16_t* Kzt = (bf16_t*)(smem + 17408);
  bf16_t* St = (bf16_t*)(smem + 34816);
  bf16_t* Sc = (bf16_t*)(smem + 44032);
  float* Of = (float*)(smem + 44032);
  float* dec = (float*)(smem + 78848);
  const float lg = log_gamma(hd);
  if (tid < 129) dec[tid] = __expf((float)tid * lg);
  for (int e = tid; e < 64 * 72; e += 256) St[e] = 0;
  __syncthreads();
  const float g128 = dec[128];
  f32x16 Sacc;
#pragma unroll
  for (int e = 0; e < 16; ++e) Sacc[e] = 0.f;
  const int vt = w >> 1, dt = w & 1;
  for (int c = 0; c < 16; ++c) {
    const int tokc = b * 2048 + c * 128;
    {
      const int j = tid >> 1, hf = tid & 1;
      const bf16_t* vsrc = RET + (size_t)(tokc + j) * 2048 + 1024 + hd * 64 + hf * 32;
      const bf16_t* ksrc = RET + (size_t)(tokc + j) * 2048 + 512 + hd * 64 + hf * 32;
      const float zj = dec[127 - j];
#pragma unroll
      for (int qd = 0; qd < 4; ++qd) {
        const uint4 uv = *(const uint4*)(vsrc + qd * 8);
        const uint4 uk = *(const uint4*)(ksrc + qd * 8);
        const unsigned vv[4] = {uv.x, uv.y, uv.z, uv.w};
        const unsigned kk[4] = {uk.x, uk.y, uk.z, uk.w};
#pragma unroll
        for (int e = 0; e < 4; ++e) {
          const int col = hf * 32 + qd * 8 + e * 2;
          Vt[col * RL + j] = (bf16_t)(vv[e] & 0xffffu);
          Vt[(col + 1) * RL + j] = (bf16_t)(vv[e] >> 16);
          Kzt[col * RL + j] = f2bf(lo2f(kk[e]) * zj);
          Kzt[(col + 1) * RL + j] = f2bf(hi2f(kk[e]) * zj);
        }
      }
    }
    bf16x8 qf[4];
    {
      const bf16_t* qsrc = RET + (size_t)(tokc + 32 * w + r) * 2048 + hd * 64 + h * 8;
#pragma unroll
      for (int ks = 0; ks < 4; ++ks) qf[ks] = *(const bf16x8*)(qsrc + ks * 16);
    }
#pragma unroll
    for (int jb = 0; jb < 2; ++jb) {
      bf16x8 kf[2][4];
#pragma unroll
      for (int jj = 0; jj < 2; ++jj) {
        const int jt = jb * 2 + jj;
        if (jt <= w) {
          const bf16_t* ksrc = RET + (size_t)(tokc + 32 * jt + r) * 2048 + 512 + hd * 64 + h * 8;
#pragma unroll
          for (int ks = 0; ks < 4; ++ks) kf[jj][ks] = *(const bf16x8*)(ksrc + ks * 16);
        }
      }
#pragma unroll
      for (int jj = 0; jj < 2; ++jj) {
        const int jt = jb * 2 + jj;
        if (jt <= w) {
          f32x16 sc;
#pragma unroll
          for (int e = 0; e < 16; ++e) sc[e] = 0.f;
#pragma unroll
          for (int ks = 0; ks < 4; ++ks) sc = __builtin_amdgcn_mfma_f32_32x32x16_bf16(qf[ks], kf[jj][ks], sc, 0, 0, 0);
#pragma unroll
          for (int e = 0; e < 16; ++e) {
            const int i = 32 * w + crow(e, h), j = 32 * jt + r;
            const int d = i - j;
            const float val = (d >= 0) ? sc[e] * dec[d >= 0 ? d : 0] : 0.f;
            Sc[i * RL + j] = f2bf(val);
          }
        }
      }
    }
    __syncthreads();
    f32x16 oacc[2];
#pragma unroll
    for (int nt = 0; nt < 2; ++nt) {
#pragma unroll
      for (int e = 0; e < 16; ++e) oacc[nt][e] = 0.f;
#pragma unroll
      for (int ks = 0; ks < 4; ++ks) {
        const bf16x8 sf = *(const bf16x8*)(St + (nt * 32 + r) * 72 + ks * 16 + h * 8);
        oacc[nt] = __builtin_amdgcn_mfma_f32_32x32x16_bf16(qf[ks], sf, oacc[nt], 0, 0, 0);
      }
#pragma unroll
      for (int e = 0; e < 16; ++e) oacc[nt][e] *= dec[32 * w + crow(e, h) + 1];
    }
    for (int ks = 0; ks < 2 * (w + 1); ++ks) {
      const bf16x8 af = *(const bf16x8*)(Sc + (32 * w + r) * RL + ks * 16 + h * 8);
#pragma unroll
      for (int nt = 0; nt < 2; ++nt) {
        const bf16x8 vf = *(const bf16x8*)(Vt + (nt * 32 + r) * RL + ks * 16 + h * 8);
        oacc[nt] = __builtin_amdgcn_mfma_f32_32x32x16_bf16(af, vf, oacc[nt], 0, 0, 0);
      }
    }
#pragma unroll
    for (int e = 0; e < 16; ++e) Sacc[e] *= g128;
#pragma unroll
    for (int ks = 0; ks < 8; ++ks) {
      const bf16x8 af = *(const bf16x8*)(Vt + (vt * 32 + r) * RL + ks * 16 + h * 8);
      const bf16x8 bf = *(const bf16x8*)(Kzt + (dt * 32 + r) * RL + ks * 16 + h * 8);
      Sacc = __builtin_amdgcn_mfma_f32_32x32x16_bf16(af, bf, Sacc, 0, 0, 0);
    }
    __syncthreads();
#pragma unroll
    for (int nt = 0; nt < 2; ++nt)
#pragma unroll
      for (int e = 0; e < 16; ++e) Of[(32 * w + crow(e, h)) * 66 + nt * 32 + r] = oacc[nt][e];
#pragma unroll
    for (int e = 0; e < 16; ++e) St[(vt * 32 + crow(e, h)) * 72 + dt * 32 + r] = f2bf(Sacc[e]);
    __syncthreads();
    {
      const int i = tid >> 1, hf = tid & 1;
      const int t = tokc + i;
      float vals[32];
      float sm = 0.f;
#pragma unroll
      for (int k = 0; k < 32; ++k) { vals[k] = Of[i * 66 + hf * 32 + k]; sm += vals[k]; }
      sm += __shfl_xor(sm, 1);
      const float mean = sm * (1.f / 64.f);
      float vs = 0.f;
#pragma unroll
      for (int k = 0; k < 32; ++k) { vals[k] -= mean; vs += vals[k] * vals[k]; }
      vs += __shfl_xor(vs, 1);
      const float rs = rsqrtf(vs * (1.f / 64.f) + 1e-5f);
      const bf16_t* gsrc = RET + (size_t)t * 2048 + 1536 + hd * 64 + hf * 32;
      bf16_t* dst = ACT + (size_t)t * 1024 + hd * 64 + hf * 32;
#pragma unroll
      for (int qd = 0; qd < 4; ++qd) {
        const uint4 ug = *(const uint4*)(gsrc + qd * 8);
        const unsigned gg[4] = {ug.x, ug.y, ug.z, ug.w};
        unsigned o4[4];
#pragma unroll
        for (int e = 0; e < 4; ++e) {
          const float g0 = lo2f(gg[e]), g1 = hi2f(gg[e]);
          const float a0 = vals[qd * 8 + 2 * e] * rs * (g0 * sigmoidf_(g0));
          const float a1 = vals[qd * 8 + 2 * e + 1] * rs * (g1 * sigmoidf_(g1));
          o4[e] = pack2(a0, a1);
        }
        *(uint4*)(dst + qd * 8) = make_uint4(o4[0], o4[1], o4[2], o4[3]);
      }
    }
    __syncthreads();
  }
  float* so = p->out + O_RETP + (size_t)(b * 8 + hd) * 4096;
#pragma unroll
  for (int gq = 0; gq < 4; ++gq)
    *(float4*)(so + (dt * 32 + r) * 64 + vt * 32 + 8 * gq + 4 * h) =
        make_float4(Sacc[4 * gq], Sacc[4 * gq + 1], Sacc[4 * gq + 2], Sacc[4 * gq + 3]);
}

DI void ret_sample(KP p, int b, int hd, char* smem) {
  const int tid = tidx();
  const bf16_t* RET = (const bf16_t*)p->out;
  bf16_t* ACT = (bf16_t*)(p->ws + OFF_ACT);
  float* q_s = (float*)smem;
  float* k_s = q_s + 512;
  float* v_s = k_s + 512;
  float* A_s = v_s + 512;
  float* part = A_s + 64;
  const int tok0 = TP + b * 8;
  const float lg = log_gamma(hd);
  __syncthreads();
  {
    const int e = tid * 2, rw = e >> 6, cl = e & 63;
    const bf16_t* base = RET + (size_t)(tok0 + rw) * 2048 + hd * 64 + cl;
    const unsigned uq = *(const unsigned*)(base), uk = *(const unsigned*)(base + 512), uv = *(const unsigned*)(base + 1024);
    q_s[e] = lo2f(uq); q_s[e + 1] = hi2f(uq);
    k_s[e] = lo2f(uk); k_s[e + 1] = hi2f(uk);
    v_s[e] = lo2f(uv); v_s[e + 1] = hi2f(uv);
  }
  __syncthreads();
  if (tid < 64) {
    const int i = tid >> 3, j = tid & 7;
    float a = 0.f;
    if (i >= j) {
#pragma unroll 4
      for (int d = 0; d < 64; ++d) a = fmaf(q_s[i * 64 + d], k_s[j * 64 + d], a);
      a *= __expf((float)(i - j) * lg);
    }
    A_s[tid] = a;
  }
  {
    const int dg = tid >> 6, v = tid & 63;
    const float* S0 = p->in[2] + (size_t)(b * 8 + hd) * 4096;
    float* So = p->out + O_RETS + (size_t)(b * 8 + hd) * 4096;
    float oi[8];
#pragma unroll
    for (int i = 0; i < 8; ++i) oi[i] = 0.f;
    const float g8 = __expf(8.f * lg);
    float kv[8];
#pragma unroll
    for (int j = 0; j < 8; ++j) kv[j] = v_s[j * 64 + v] * __expf((float)(7 - j) * lg);
#pragma unroll 1
    for (int hb = 0; hb < 2; ++hb) {
      float sv[8];
#pragma unroll
      for (int dd = 0; dd < 8; ++dd) sv[dd] = S0[(dg * 16 + hb * 8 + dd) * 64 + v];
#pragma unroll
      for (int dd = 0; dd < 8; ++dd) {
        const int d = dg * 16 + hb * 8 + dd;
        const float s = sv[dd];
        float sn = s * g8;
#pragma unroll
        for (int j = 0; j < 8; ++j) sn = fmaf(k_s[j * 64 + d], kv[j], sn);
        So[d * 64 + v] = sn;
#pragma unroll
        for (int i = 0; i < 8; ++i) oi[i] = fmaf(q_s[i * 64 + d], s, oi[i]);
      }
    }
#pragma unroll
    for (int i = 0; i < 8; ++i) part[(dg * 8 + i) * 64 + v] = oi[i];
  }
  __syncthreads();
#pragma unroll
  for (int rep = 0; rep < 2; ++rep) {
    const int i = (tid >> 6) + 4 * rep, v = tid & 63;
    float o = part[(0 * 8 + i) * 64 + v] + part[(1 * 8 + i) * 64 + v] + part[(2 * 8 + i) * 64 + v] + part[(3 * 8 + i) * 64 + v];
    o *= __expf((float)(i + 1) * lg);
    for (int j = 0; j <= i; ++j) o = fmaf(A_s[i * 8 + j], v_s[j * 64 + v], o);
    const float mean = wave_sum(o) * (1.f / 64.f);
    const float dv = o - mean;
    const float var = wave_sum(dv * dv) * (1.f / 64.f);
    const int t = tok0 + i;
    const float gt = bf2f(RET[(size_t)t * 2048 + 1536 + hd * 64 + v]);
    ACT[(size_t)t * 1024 + hd * 64 + v] = f2bf(dv * rsqrtf(var + 1e-5f) * (gt * sigmoidf_(gt)));
  }
}

constexpr size_t TAB_V8 = (size_t)16384 * 1024;
constexpr size_t TAB_SC = (size_t)2 * 16384 * 1024;
DI void convert_tab(KP p, int it) {
  const int tid = tidx(), lane = tid & 63, w = tid >> 6;
  const int row0 = it * 8 + w * 2;
  const float* src = (row0 < 16384) ? p->in[24] + (size_t)row0 * 1024 : p->in[25] + (size_t)(row0 - 16384) * 1024;
  float4 v[2][4];
#pragma unroll
  for (int rr = 0; rr < 2; ++rr)
#pragma unroll
    for (int i = 0; i < 4; ++i) v[rr][i] = *(const float4*)(src + rr * 1024 + i * 256 + lane * 4);
#pragma unroll
  for (int rr = 0; rr < 2; ++rr) {
    float am = 0.f;
#pragma unroll
    for (int i = 0; i < 4; ++i)
      am = fmaxf(am, fmaxf(fmaxf(fabsf(v[rr][i].x), fabsf(v[rr][i].y)), fmaxf(fabsf(v[rr][i].z), fabsf(v[rr][i].w))));
#pragma unroll
    for (int o = 32; o >= 1; o >>= 1) am = fmaxf(am, __shfl_xor(am, o));
    am = fmaxf(am, 1e-30f);
    const float inv = 127.f / am;
    unsigned char* dst = (unsigned char*)(p->ws + OFF_TAB) + (size_t)(row0 + rr) * 1024;
#pragma unroll
    for (int i = 0; i < 4; ++i) {
      const unsigned q0 = (unsigned)((int)rintf(v[rr][i].x * inv) + 128);
      const unsigned q1 = (unsigned)((int)rintf(v[rr][i].y * inv) + 128);
      const unsigned q2 = (unsigned)((int)rintf(v[rr][i].z * inv) + 128);
      const unsigned q3 = (unsigned)((int)rintf(v[rr][i].w * inv) + 128);
      *(unsigned*)(dst + i * 256 + lane * 4) = q0 | (q1 << 8) | (q2 << 16) | (q3 << 24);
    }
    if (lane == 0) ((float*)(p->ws + OFF_TAB + TAB_SC))[row0 + rr] = am * (1.f / 127.f);
  }
}

DI void phase4_other(KP p, int it, char* smem) {
  if (it < 64) { ret_prompt(p, it >> 3, it & 7, smem); return; }
  it -= 64;
  if (it < 4096) {
    const int bh = it >> 2, q = it & 3, b = bh >> 3, hd = bh & 7;
    rwkv_scan(p, TP + b * 8, hd, q, 8, p->in[3] + (size_t)bh * 4096, p->out + O_WKVS + (size_t)bh * 4096, smem);
    return;
  }
  it -= 4096;
  if (it < 1024) { ret_sample(p, it >> 3, it & 7, smem); return; }
  it -= 1024;
  if (it < 4096) { convert_tab(p, it); return; }
  it -= 4096;
#define TJ4(IDX, OFF, KK_, NN_)                                                                            \
  {                                                                                                        \
    const int ntl = ((KK_) / 64) * ((NN_) / 64);                                                           \
    if (it < ntl) {                                                                                        \
      transpose_tile(p->in[IDX], (bf16_t*)(p->ws + (OFF)), (KK_), (NN_), it / ((NN_) / 64), it % ((NN_) / 64), (float*)smem); \
      return;                                                                                              \
    }                                                                                                      \
    it -= ntl;                                                                                             \
  }
  TJ4(20, OFF_WOUT, 1024, 1024)
  TJ4(22, OFF_WQ, 1024, 2048)
  TJ4(27, OFF_PG, 1024, 1024)
  TJ4(28, OFF_PP, 256, 1024)
}
DI void phase4(KP p, char* smem) {
  constexpr int N_OTHER = 64 + 4096 + 1024 + 4096 + (256 + 512 + 256 + 64);
  int* s_item = (int*)(smem + SMEM_BYTES - 16);
  unsigned* ctr = (unsigned*)(p->ws + OFF_CTR);
  unsigned* cukey = (unsigned*)(p->ws + OFF_CTR + 16384);
  __syncthreads();
  if (tidx() == 0) {
    const unsigned hw = (unsigned)__builtin_amdgcn_s_getreg((7 << 11) | (8 << 6) | 4);
    const unsigned key = (xb_xcc_id() << 8) | (hw & 0xffu);
    const unsigned old = atomicAdd(&cukey[key], 1u);
    int it = -1;
    if (old == 0u) { const unsigned q = atomicAdd(&ctr[1], 1u); if (q < 256u) it = (int)q; }
    *s_item = it;
  }
  __syncthreads();
  {
    const int it = *s_item;
    if (it >= 0) {
      const int bh = it >> 2, q = it & 3, b = bh >> 3, hd = bh & 7;
      __builtin_amdgcn_s_setprio(3);
      rwkv_scan(p, b * 2048, hd, q, 2048, nullptr, p->out + O_WKVP + (size_t)bh * 4096, smem);
      __builtin_amdgcn_s_setprio(0);
    }
  }
  for (;;) {
    __syncthreads();
    if (tidx() == 0) *s_item = (int)atomicAdd(&ctr[0], 1u);
    __syncthreads();
    const int it = *s_item;
    if (it >= N_OTHER) break;
    phase4_other(p, it, smem);
  }
  for (;;) {
    __syncthreads();
    if (tidx() == 0) *s_item = (int)atomicAdd(&ctr[1], 1u);
    __syncthreads();
    const int it = *s_item;
    if (it >= 256) break;
    const int bh = it >> 2, q = it & 3, b = bh >> 3, hd = bh & 7;
    rwkv_scan(p, b * 2048, hd, q, 2048, nullptr, p->out + O_WKVP + (size_t)bh * 4096, smem);
  }
}

DI void phase5(KP p) {
  const int lane = tidx() & 63, w = tidx() >> 6;
  bf16_t* ACT = (bf16_t*)(p->ws + OFF_ACT);
  const bf16_t* Rb = (const bf16_t*)(p->ws + OFF_R);
  const bf16_t* Kb = (const bf16_t*)(p->ws + OFF_K);
  const bf16_t* Vb = (const bf16_t*)(p->ws + OFF_V);
  const bf16_t* GTb = (const bf16_t*)(p->ws + OFF_GATE);
  const int c8 = lane * 8;
  float rk8[8], lg8[8], lb8[8];
  {
    const float4 a0 = *(const float4*)(p->in[17] + c8), a1 = *(const float4*)(p->in[17] + c8 + 4);
    const float4 b0 = *(const float4*)(p->in[18] + c8), b1 = *(const float4*)(p->in[18] + c8 + 4);
    const float4 d0 = *(const float4*)(p->in[19] + c8), d1 = *(const float4*)(p->in[19] + c8 + 4);
    rk8[0] = a0.x; rk8[1] = a0.y; rk8[2] = a0.z; rk8[3] = a0.w; rk8[4] = a1.x; rk8[5] = a1.y; rk8[6] = a1.z; rk8[7] = a1.w;
    lg8[0] = b0.x; lg8[1] = b0.y; lg8[2] = b0.z; lg8[3] = b0.w; lg8[4] = b1.x; lg8[5] = b1.y; lg8[6] = b1.z; lg8[7] = b1.w;
    lb8[0] = d0.x; lb8[1] = d0.y; lb8[2] = d0.z; lb8[3] = d0.w; lb8[4] = d1.x; lb8[5] = d1.y; lb8[6] = d1.z; lb8[7] = d1.w;
  }
  for (int t = blockIdx.x * 4 + w; t < T; t += gridDim.x * 4) {
    const size_t o = (size_t)t * 512 + c8;
    bf16_t* yp = ACT + (size_t)t * 1024 + 512 + c8;
    const uint4 uy = *(const uint4*)yp, ur = *(const uint4*)(Rb + o), uk = *(const uint4*)(Kb + o),
                uv = *(const uint4*)(Vb + o), ug = *(const uint4*)(GTb + o);
    float y[8], r[8], k[8], v[8], g[8];
    unpack8f(uy, y); unpack8f(ur, r); unpack8f(uk, k); unpack8f(uv, v); unpack8f(ug, g);
    float sm = 0.f, rk = 0.f;
#pragma unroll
    for (int e = 0; e < 8; ++e) { sm += y[e]; rk = fmaf(r[e] * k[e], rk8[e], rk); }
    sm = allreduce8(sm);
    rk = allreduce8(rk);
    const float mean = sm * (1.f / 64.f);
    float vs = 0.f;
#pragma unroll
    for (int e = 0; e < 8; ++e) { y[e] -= mean; vs += y[e] * y[e]; }
    vs = allreduce8(vs);
    const float rs = rsqrtf(vs * (1.f / 64.f) + 64e-5f);
    float ov[8];
#pragma unroll
    for (int e = 0; e < 8; ++e) ov[e] = (y[e] * rs * lg8[e] + lb8[e] + rk * v[e]) * g[e];
    *(uint4*)yp = pack8f(ov);
  }
}

DI void phase6(KP p, char* smem) {
  for (int tile = blockIdx.x; tile < 136 * 8; tile += gridDim.x) {
    const int nt = tile / 136, mt = tile - nt * 136;
    const int m0 = mt * 128, n0 = nt * 128;
    f32x16 acc[2][2];
    gemm128<false>((const bf16_t*)(p->ws + OFF_ACT) + (size_t)m0 * 1024, 1024,
                   (const bf16_t*)(p->ws + OFF_WOUT) + (size_t)n0 * 1024, 1024, 1024, acc, smem);
    {
      const int lane = tidx() & 63, w = tidx() >> 6;
      const int wm = w >> 1, wn = w & 1, r = lane & 31, h = lane >> 5;
      const float* xb = (m0 < TP) ? p->in[0] + (size_t)m0 * 1024 : p->in[1] + (size_t)(m0 - TP) * 1024;
#pragma unroll
      for (int mi = 0; mi < 2; ++mi)
#pragma unroll
        for (int ni = 0; ni < 2; ++ni)
#pragma unroll
          for (int i = 0; i < 16; ++i)
            acc[mi][ni][i] += xb[(size_t)(wm * 64 + mi * 32 + crow(i, h)) * 1024 + n0 + wn * 64 + ni * 32 + r];
#pragma unroll
      for (int mi = 0; mi < 2; ++mi)
#pragma unroll
        for (int ni = 0; ni < 2; ++ni)
#pragma unroll
          for (int i = 0; i < 16; ++i)
            p->out[(size_t)(m0 + wm * 64 + mi * 32 + crow(i, h)) * 1024 + n0 + wn * 64 + ni * 32 + r] = acc[mi][ni][i];
    }
  }
}

DI void phase7(KP p) {
  const int lane = tidx() & 63, w = tidx() >> 6;
  for (int t = blockIdx.x * 4 + w; t < T; t += gridDim.x * 4)
    rmsnorm_row_bf(p->out + (size_t)t * 1024, p->in[21], (bf16_t*)(p->ws + OFF_ACT) + (size_t)t * 1024, lane);
}

DI void phase8(KP p, char* smem) {
  bf16_t* QP = (bf16_t*)(p->ws + OFF_QPEER);
  for (int tile = blockIdx.x; tile < 136 * 16; tile += gridDim.x) {
    const int nt = tile / 136, mt = tile - nt * 136;
    const int m0 = mt * 128, n0 = nt * 128;
    f32x16 acc[2][2];
    gemm128<false>((const bf16_t*)(p->ws + OFF_ACT) + (size_t)m0 * 1024, 1024,
                   (const bf16_t*)(p->ws + OFF_WQ) + (size_t)n0 * 1024, 1024, 1024, acc, smem);
    epi_each(acc, [&](int rr, int cc, float v) { QP[(size_t)(m0 + rr) * 2048 + n0 + cc] = f2bf(v); });
  }
}

DI unsigned sortkey(float f) { unsigned u = __float_as_uint(f); return (u & 0x80000000u) ? ~u : (u | 0x80000000u); }
DI float unsortkey(unsigned k) { unsigned u = (k & 0x80000000u) ? (k ^ 0x80000000u) : ~k; return __uint_as_float(u); }
DI void ins16(unsigned (&l)[16], unsigned x) {
#pragma unroll
  for (int i = 0; i < 16; ++i) { const unsigned hi = max(l[i], x); x = min(l[i], x); l[i] = hi; }
}
DI void cswap_desc(unsigned& a, unsigned& b) { const unsigned hi = max(a, b), lo = min(a, b); a = hi; b = lo; }
DI void bsort16(unsigned (&v)[16]) {
#pragma unroll
  for (int ke = 1; ke <= 4; ++ke)
#pragma unroll
    for (int je = ke - 1; je >= 0; --je)
#pragma unroll
      for (int i = 0; i < 16; ++i) {
        const int k = 1 << ke, j = 1 << je, l = i ^ j;
        if (l > i) { if ((i & k) == 0) cswap_desc(v[i], v[l]); else cswap_desc(v[l], v[i]); }
      }
}
DI void bmerge16(unsigned (&a)[16], const unsigned (&b)[16]) {
#pragma unroll
  for (int i = 0; i < 16; ++i) a[i] = max(a[i], b[15 - i]);
#pragma unroll
  for (int je = 3; je >= 0; --je)
#pragma unroll
    for (int i = 0; i < 16; ++i) {
      const int j = 1 << je, l = i ^ j;
      if (l > i) cswap_desc(a[i], a[l]);
    }
}
DI void phase9(KP p, char* smem) {
  const int tid = tidx();
  const bf16_t* QP = (const bf16_t*)(p->ws + OFF_QPEER);
  const bf16_t* KEYS = (const bf16_t*)(p->ws + OFF_KEYS);
  int* IDX = (int*)(p->ws + OFF_IDX);
  float* GSM = (float*)(p->ws + OFF_GSM);
  float* sc = (float*)smem;
  unsigned* mrg = (unsigned*)smem;
  const int row = tid >> 1, half = tid & 1;
  for (int item = blockIdx.x; item < 136 * 8; item += gridDim.x) {
    const int mt = item >> 3, hd = item & 7;
    const int m0 = mt * 128;
    unsigned kc[2][16];
#pragma unroll
    for (int c = 0; c < 2; ++c) {
      f32x16 acc[2][2];
      gemm128<false>(QP + (size_t)m0 * 2048 + (hd * 2 + c) * 128, 2048, KEYS + (size_t)(hd * 2 + c) * 16384, 128, 128, acc, smem);
      __syncthreads();
      epi_each(acc, [&](int rr, int cc, float v) { sc[rr * 129 + cc] = v; });
      __syncthreads();
      unsigned lst[16];
#pragma unroll
      for (int gi = 0; gi < 4; ++gi) {
        unsigned grp[16];
#pragma unroll
        for (int i = 0; i < 16; ++i) {
          const int col = half * 64 + gi * 16 + i;
          grp[i] = (sortkey(sc[row * 129 + col]) & ~127u) | (unsigned)(127 - col);
        }
        bsort16(grp);
        if (gi == 0) {
#pragma unroll
          for (int i = 0; i < 16; ++i) lst[i] = grp[i];
        } else {
          bmerge16(lst, grp);
        }
      }
      __syncthreads();
      if (half) {
#pragma unroll
        for (int i = 0; i < 16; ++i) mrg[row * 16 + i] = lst[i];
      }
      __syncthreads();
      if (!half) {
        unsigned grp[16];
#pragma unroll
        for (int i = 0; i < 16; ++i) grp[i] = mrg[row * 16 + i];
        bmerge16(lst, grp);
      }
#pragma unroll
      for (int i = 0; i < 16; ++i) kc[c][i] = lst[i];
    }
    if (!half) {
      float sv0[16], sv1[16];
#pragma unroll
      for (int i = 0; i < 16; ++i) { sv0[i] = unsortkey(kc[0][i] & ~127u); sv1[i] = unsortkey(kc[1][i] & ~127u); }
      unsigned cl[16];
#pragma unroll
      for (int i = 0; i < 16; ++i) cl[i] = 0u;
#pragma unroll
      for (int a = 0; a < 16; ++a)
#pragma unroll
        for (int b = 0; b < 16 / (a + 1); ++b)
          ins16(cl, (sortkey(sv0[a] + sv1[b]) & ~255u) | (unsigned)(255 - (a * 16 + b)));
      float ex[16];
      float sum = 0.f;
      const float mx = unsortkey(cl[0] & ~255u);
#pragma unroll
      for (int i = 0; i < 16; ++i) { ex[i] = __expf(unsortkey(cl[i] & ~255u) - mx); sum += ex[i]; }
      const float inv = 1.f / sum;
      int eo[16];
#pragma unroll
      for (int i = 0; i < 16; ++i) {
        const int ci = 255 - (int)(cl[i] & 255u);
        const int a = ci >> 4, b = ci & 15;
        int i0 = 0, i1 = 0;
#pragma unroll
        for (int k = 0; k < 16; ++k) {
          i0 = (a == k) ? (127 - (int)(kc[0][k] & 127u)) : i0;
          i1 = (b == k) ? (127 - (int)(kc[1][k] & 127u)) : i1;
        }
        eo[i] = i0 * 128 + i1;
        ex[i] *= inv;
      }
      const size_t o = ((size_t)(m0 + row) * 8 + hd) * 16;
#pragma unroll
      for (int qd = 0; qd < 4; ++qd) {
        *(int4*)(IDX + o + qd * 4) = make_int4(eo[qd * 4], eo[qd * 4 + 1], eo[qd * 4 + 2], eo[qd * 4 + 3]);
        *(float4*)(GSM + o + qd * 4) = make_float4(ex[qd * 4], ex[qd * 4 + 1], ex[qd * 4 + 2], ex[qd * 4 + 3]);
      }
    }
  }
}

#define UB0(u) ((float)((u) & 0xffu))
#define UB1(u) ((float)(((u) >> 8) & 0xffu))
#define UB2(u) ((float)(((u) >> 16) & 0xffu))
#define UB3(u) ((float)((u) >> 24))
template <int MODE, bool HALF>
DI void peer_token(KP p, const int t, int it0, int it1, char* smem, const int uh = -1) {
  const int lane = tidx() & 63, w = tidx() >> 6;
  const int g = lane >> 4, l16 = lane & 15;
  bf16_t* ACT = (bf16_t*)(p->ws + OFF_ACT);
  const unsigned char* UB = (const unsigned char*)(p->ws + OFF_TAB);
  const unsigned char* VB = UB + TAB_V8;
  const float* USC = (const float*)(p->ws + OFF_TAB + TAB_SC);
  const float* VSC = USC + 16384;
  const int* IDX = (const int*)(p->ws + OFF_IDX);
  const float* GSM = (const float*)(p->ws + OFF_GSM);
  const float* pn = p->in[26];
  {
    bf16_t* act = ACT + (size_t)t * 1024;
    float xf[64];
    float xsum = 0.f;
    float* CV = (float*)(p->ws + OFF_QPEER) + (size_t)t * 128;
    float c0 = 0.f, c1 = 0.f;
    if (MODE == 3) { c0 = CV[lane]; c1 = CV[64 + lane]; }
#pragma unroll
    for (int s = 0; s < 4; ++s) {
      if (MODE == 3) break;
      const uint4 x0 = *(const uint4*)(act + s * 256 + l16 * 16);
      const uint4 x1 = *(const uint4*)(act + s * 256 + l16 * 16 + 8);
      const unsigned xx[8] = {x0.x, x0.y, x0.z, x0.w, x1.x, x1.y, x1.z, x1.w};
#pragma unroll
      for (int q = 0; q < 8; ++q) { xf[s * 16 + 2 * q] = lo2f(xx[q]); xf[s * 16 + 2 * q + 1] = hi2f(xx[q]); }
    }
#pragma unroll
    for (int k = 0; k < 64; ++k) xsum += (MODE == 3) ? 0.f : xf[k];
    int id0 = IDX[(size_t)t * 128 + lane], id1 = IDX[(size_t)t * 128 + 64 + lane];
    float gs0 = GSM[(size_t)t * 128 + lane], gs1 = GSM[(size_t)t * 128 + 64 + lane];
    int cnt0;
    {
      const bool ina = id0 < 8192, inb = id1 < 8192;
      const unsigned long long ba = __ballot(ina), bb = __ballot(inb);
      const unsigned long long lt = (1ull << lane) - 1ull;
      const int cnt_a = __popcll(ba), cnt_b = __popcll(bb);
      cnt0 = cnt_a + cnt_b;
      const int ra = ina ? __popcll(ba & lt) : cnt0 + __popcll(~ba & lt);
      const int rb = inb ? cnt_a + __popcll(bb & lt) : cnt0 + (64 - cnt_a) + __popcll(~bb & lt);
      int* pl = (int*)(smem + 16384) + w * 256;
      __builtin_amdgcn_wave_barrier();
      pl[ra] = id0; pl[rb] = id1;
      pl[128 + ra] = __float_as_int(gs0); pl[128 + rb] = __float_as_int(gs1);
      __builtin_amdgcn_fence(__ATOMIC_RELEASE, "wavefront");
      __builtin_amdgcn_wave_barrier();
      id0 = pl[lane]; id1 = pl[64 + lane];
      gs0 = __int_as_float(pl[128 + lane]); gs1 = __int_as_float(pl[192 + lane]);
      __builtin_amdgcn_wave_barrier();
    }
    if (uh == 0) { it0 = 0; it1 = (cnt0 + 3) >> 2; }
    if (uh == 1) { it0 = cnt0 >> 2; it1 = 32; }
    float acc[64];
#pragma unroll
    for (int k = 0; k < 64; ++k) acc[k] = 0.f;
    float csum = 0.f;
    for (int it = it0; it < it1; ++it) {
      const int n = (it * 4 + g) & 63;
      const int e = __shfl((it < 16) ? id0 : id1, n);
      const float gw = __shfl((it < 16) ? gs0 : gs1, n);
      const unsigned char* ur = UB + (size_t)e * 1024 + l16 * 16;
      const unsigned char* vr = VB + (size_t)e * 1024 + l16 * 16;
      uint4 uu[4], vv[4];
      if (MODE != 3) {
#pragma unroll
        for (int s = 0; s < 4; ++s) uu[s] = *(const uint4*)(ur + s * 256);
      }
      if (MODE != 2) {
#pragma unroll
        for (int s = 0; s < 4; ++s) vv[s] = *(const uint4*)(vr + s * 256);
      }
      float c;
      if (MODE == 3) {
        c = __shfl((it < 16) ? c0 : c1, n);
      } else {
      const float su = USC[e], sv = VSC[e];
      float hv = 0.f;
#pragma unroll
      for (int s = 0; s < 4; ++s) {
        const unsigned ww[4] = {uu[s].x, uu[s].y, uu[s].z, uu[s].w};
#pragma unroll
        for (int q = 0; q < 4; ++q) {
          hv = fmaf(xf[s * 16 + q * 4 + 0], UB0(ww[q]), hv);
          hv = fmaf(xf[s * 16 + q * 4 + 1], UB1(ww[q]), hv);
          hv = fmaf(xf[s * 16 + q * 4 + 2], UB2(ww[q]), hv);
          hv = fmaf(xf[s * 16 + q * 4 + 3], UB3(ww[q]), hv);
        }
      }
      hv = fmaf(-128.f, xsum, hv);
      hv = allreduce16(hv) * su;
      c = 0.5f * hv * (1.f + erff(hv * 0.70710678118f)) * gw * sv;
      }
      if (MODE == 2) {
        const float cc = __shfl(c, ((lane - it * 4) & 3) * 16);
        if ((lane >> 2) == (it & 15)) { if (it < 16) c0 = cc; else c1 = cc; }
        continue;
      }
      csum += c;
#pragma unroll
      for (int s = 0; s < 4; ++s) {
        const unsigned ww[4] = {vv[s].x, vv[s].y, vv[s].z, vv[s].w};
#pragma unroll
        for (int q = 0; q < 4; ++q) {
          acc[s * 16 + q * 4 + 0] = fmaf(c, UB0(ww[q]), acc[s * 16 + q * 4 + 0]);
          acc[s * 16 + q * 4 + 1] = fmaf(c, UB1(ww[q]), acc[s * 16 + q * 4 + 1]);
          acc[s * 16 + q * 4 + 2] = fmaf(c, UB2(ww[q]), acc[s * 16 + q * 4 + 2]);
          acc[s * 16 + q * 4 + 3] = fmaf(c, UB3(ww[q]), acc[s * 16 + q * 4 + 3]);
        }
      }
    }
    if (MODE == 2) {
      if ((lane >> 2) >= it0 && (lane >> 2) < it1) CV[lane] = c0;
      if (16 + (lane >> 2) >= it0 && 16 + (lane >> 2) < it1) CV[64 + lane] = c1;
      return;
    }
    const float cs128 = 128.f * csum;
#pragma unroll
    for (int k = 0; k < 64; ++k) {
      acc[k] -= cs128;
      acc[k] += __shfl_xor(acc[k], 16);
      acc[k] += __shfl_xor(acc[k], 32);
    }
    float* hrow = p->out + (size_t)t * 1024;
    float hvv[16];
#pragma unroll
    for (int s = 0; s < 4; ++s) {
      if (s == g) {
#pragma unroll
        for (int k = 0; k < 16; ++k) hvv[k] = acc[s * 16 + k];
      }
    }
    if (HALF) {
      float* ex = (float*)smem + ((w >> 1) * 64 + lane) * 16;
      if (w & 1) {
#pragma unroll
        for (int q = 0; q < 4; ++q) *(float4*)(ex + q * 4) = make_float4(hvv[q * 4], hvv[q * 4 + 1], hvv[q * 4 + 2], hvv[q * 4 + 3]);
      }
      __syncthreads();
      if (w & 1) return;
#pragma unroll
      for (int q = 0; q < 4; ++q) {
        const float4 e4 = *(const float4*)(ex + q * 4);
        hvv[q * 4] += e4.x; hvv[q * 4 + 1] += e4.y; hvv[q * 4 + 2] += e4.z; hvv[q * 4 + 3] += e4.w;
      }
    }
    {
      float* hp = hrow + g * 256 + l16 * 16;
      const float4 r0 = *(const float4*)(hp), r1 = *(const float4*)(hp + 4), r2 = *(const float4*)(hp + 8), r3 = *(const float4*)(hp + 12);
      hvv[0] += r0.x; hvv[1] += r0.y; hvv[2] += r0.z; hvv[3] += r0.w; hvv[4] += r1.x; hvv[5] += r1.y; hvv[6] += r1.z; hvv[7] += r1.w;
      hvv[8] += r2.x; hvv[9] += r2.y; hvv[10] += r2.z; hvv[11] += r2.w; hvv[12] += r3.x; hvv[13] += r3.y; hvv[14] += r3.z; hvv[15] += r3.w;
      *(float4*)(hp) = make_float4(hvv[0], hvv[1], hvv[2], hvv[3]);
      *(float4*)(hp + 4) = make_float4(hvv[4], hvv[5], hvv[6], hvv[7]);
      *(float4*)(hp + 8) = make_float4(hvv[8], hvv[9], hvv[10], hvv[11]);
      *(float4*)(hp + 12) = make_float4(hvv[12], hvv[13], hvv[14], hvv[15]);
    }
    float ss = 0.f;
#pragma unroll
    for (int k = 0; k < 16; ++k) ss += hvv[k] * hvv[k];
    ss = wave_sum(ss);
    const float scl = rsqrtf(ss * (1.f / 1024.f) + 1e-6f);
    {
      const int col = g * 256 + l16 * 16;
      unsigned o8[8];
#pragma unroll
      for (int q = 0; q < 4; ++q) {
        const float4 g0 = *(const float4*)(pn + col + q * 4);
        o8[q * 2] = pack2(hvv[q * 4 + 0] * scl * g0.x, hvv[q * 4 + 1] * scl * g0.y);
        o8[q * 2 + 1] = pack2(hvv[q * 4 + 2] * scl * g0.z, hvv[q * 4 + 3] * scl * g0.w);
      }
      *(uint4*)(act + col) = make_uint4(o8[0], o8[1], o8[2], o8[3]);
      *(uint4*)(act + col + 8) = make_uint4(o8[4], o8[5], o8[6], o8[7]);
    }
  }
}

DI void phase10(KP p, char* smem) {
  const int w = tidx() >> 6;
  if (gridDim.x == 512) {
#pragma unroll 1
    for (int k = 0; k < 16; ++k) peer_token<2, false>(p, (int)blockIdx.x * 4 + w + (k & 7) * 2048, 0, 32, smem, k >> 3);
#pragma unroll 1
    for (int k = 0; k < 8; ++k) peer_token<3, false>(p, (int)blockIdx.x * 4 + w + k * 2048, 0, 32, smem);
    __syncthreads();
    peer_token<2, true>(p, 16384 + 2 * (int)blockIdx.x + (w >> 1), (w & 1) * 16, (w & 1) * 16 + 16, smem);
    peer_token<3, true>(p, 16384 + 2 * (int)blockIdx.x + (w >> 1), (w & 1) * 16, (w & 1) * 16 + 16, smem);
  } else {
    for (int t = blockIdx.x * 4 + w; t < T; t += gridDim.x * 4) { peer_token<2, false>(p, t, 0, 32, smem); peer_token<3, false>(p, t, 0, 32, smem); }
  }
}

DI void phase11(KP p, char* smem) {
  for (int tile = blockIdx.x; tile < 136 * 8; tile += gridDim.x) {
    const int nt = tile / 136, mt = tile - nt * 136;
    const int m0 = mt * 128, n0 = nt * 128;
    f32x16 acc[2][2];
    unsigned ppk[2][2][8];
    const float* pa = (m0 < TP) ? p->in[5] + (size_t)m0 * 256 : p->in[6] + (size_t)(m0 - TP) * 256;
    gemm128<true>(pa, 256, (const bf16_t*)(p->ws + OFF_PP) + (size_t)n0 * 256, 256, 256, acc, smem);
#pragma unroll
    for (int mi = 0; mi < 2; ++mi)
#pragma unroll
      for (int ni = 0; ni < 2; ++ni)
#pragma unroll
        for (int i = 0; i < 8; ++i) ppk[mi][ni][i] = pack2(acc[mi][ni][2 * i], acc[mi][ni][2 * i + 1]);
    gemm128<false>((const bf16_t*)(p->ws + OFF_ACT) + (size_t)m0 * 1024, 1024,
                   (const bf16_t*)(p->ws + OFF_PG) + (size_t)n0 * 1024, 1024, 1024, acc, smem);
    const int lane = tidx() & 63, w = tidx() >> 6;
    const int wm = w >> 1, wn = w & 1, r = lane & 31, h = lane >> 5;
#pragma unroll
    for (int mi = 0; mi < 2; ++mi)
#pragma unroll
      for (int ni = 0; ni < 2; ++ni)
#pragma unroll
        for (int i = 0; i < 16; ++i) {
          const float pp = (i & 1) ? hi2f(ppk[mi][ni][i >> 1]) : lo2f(ppk[mi][ni][i >> 1]);
          acc[mi][ni][i] = sigmoidf_(acc[mi][ni][i]) * pp;
        }
#pragma unroll
    for (int mi = 0; mi < 2; ++mi) {
#pragma unroll
      for (int ni = 0; ni < 2; ++ni)
#pragma unroll
        for (int i = 0; i < 16; ++i)
          acc[mi][ni][i] += p->out[(size_t)(m0 + wm * 64 + mi * 32 + crow(i, h)) * 1024 + n0 + wn * 64 + ni * 32 + r];
#pragma unroll
      for (int ni = 0; ni < 2; ++ni)
#pragma unroll
        for (int i = 0; i < 16; ++i)
          p->out[(size_t)(m0 + wm * 64 + mi * 32 + crow(i, h)) * 1024 + n0 + wn * 64 + ni * 32 + r] = acc[mi][ni][i];
    }
  }
}

DI void phase12(KP p) {
  const int lane = tidx() & 63, w = tidx() >> 6;
  const float* g = p->in[29];
  for (int t = blockIdx.x * 4 + w; t < T; t += gridDim.x * 4) {
    float* x = p->out + (size_t)t * 1024;
    float4 v[4];
    float ss = 0.f;
#pragma unroll
    for (int i = 0; i < 4; ++i) {
      v[i] = ((const float4*)x)[i * 64 + lane];
      ss += v[i].x * v[i].x + v[i].y * v[i].y + v[i].z * v[i].z + v[i].w * v[i].w;
    }
    ss = wave_sum(ss);
    const float sc = rsqrtf(ss * (1.f / 1024.f) + 1e-6f);
#pragma unroll
    for (int i = 0; i < 4; ++i) {
      const float4 gg = ((const float4*)g)[i * 64 + lane];
      ((float4*)x)[i * 64 + lane] = make_float4(v[i].x * sc * gg.x, v[i].y * sc * gg.y, v[i].z * sc * gg.z, v[i].w * sc * gg.w);
    }
  }
}

DI void run_phase(int ph, char* smem) {
  KP p = getp();
  switch (ph) {
    case 0: phase0(p, smem); break;
    case 1: phase1(p, smem); break;
    case 2: phase2(p); break;
    case 3: phase3(p, smem); break;
    case 4: phase4(p, smem); break;
    case 5: phase5(p); break;
    case 6: phase6(p, smem); break;
    case 7: phase7(p); break;
    case 8: phase8(p, smem); break;
    case 9: phase9(p, smem); break;
    case 10: phase10(p, smem); break;
    case 11: phase11(p, smem); break;
    case 12: phase12(p); break;
    default: break;
  }
}

template <int LO, int HI>
__global__ void __launch_bounds__(256, 2) mega_kernel(Params p) {
  __shared__ __attribute__((aligned(16))) char smem[SMEM_BYTES];
  __shared__ uint4 xb_words;
  if (gridDim.x == 0x7fffffffu) cg::this_grid().sync();
  XcdBarrier xb;
  if (HI - LO > 1) {
    if (threadIdx.x == 0) xb_words = make_uint4(0u, 0u, 0u, 0u);
    __syncthreads();
    xb = xcd_barrier_post((unsigned*)(getp()->ws + OFF_CTR), (volatile LAS unsigned*)&xb_words);
  }
#pragma unroll
  for (int ph = LO; ph < HI; ++ph) {
    run_phase(ph, smem);
    if (ph + 1 < HI) xcd_barrier(xb);
  }
}

template <int PH>
static void launch_phases(const Params& p, int grid, hipStream_t stream) {
  hipLaunchKernelGGL((mega_kernel<PH, PH + 1>), dim3(grid), dim3(256), 0, stream, p);
  if constexpr (PH + 1 < 13) launch_phases<PH + 1>(p, grid, stream);
}

extern "C" void kernel_launch(void* const* d_in, const int* in_sizes, int n_in, void* d_out, int out_size,
                              void* d_ws, size_t ws_size, hipStream_t stream) {
  static int grid_blocks = 0;
  if (!grid_blocks) {
    int dev = 0, cus = 0, per_cu = 0;
    (void)hipGetDevice(&dev);
    (void)hipDeviceGetAttribute(&cus, hipDeviceAttributeMultiprocessorCount, dev);
#if MK_MULTI
    per_cu = 2;
#else
    (void)hipOccupancyMaxActiveBlocksPerMultiprocessor(&per_cu, mega_kernel<0, 13>, 256, 0);
#endif
    if (per_cu < 1) per_cu = 1;
    if (per_cu > 2) per_cu = 2;
    grid_blocks = cus * per_cu;
  }
  Params p{};
  for (int i = 0; i < 30; ++i) p.in[i] = (const float*)d_in[i];
  p.out = (float*)d_out;
  p.ws = (char*)d_ws;
  if (ws_size < WS_END) { fprintf(stderr, "workspace too small: %zu < %zu\n", ws_size, (size_t)WS_END); return; }
  (void)hipMemsetAsync((char*)d_ws + OFF_CTR, 0, 32768, stream);
#if MK_MULTI
  launch_phases<0>(p, grid_blocks, stream);
#else
  void* args[] = {&p};
  hipError_t e = hipLaunchCooperativeKernel((void*)mega_kernel<0, 13>, dim3(grid_blocks), dim3(256), args, 0, stream);
  if (e != hipSuccess) fprintf(stderr, "cooperative launch failed: %s (grid %d)\n", hipGetErrorString(e), grid_blocks);
#endif
}
```
